# Optimizing an MI355X kernel written in HIP

```python
import jax, jax.numpy as jnp
from jax import lax
import numpy as np

D_MODEL = 1024
BATCH = 8
SEQ = 4096
DEPTH = 2

GRID_W = 64
CTX_LEN = 256
N_MIXERS = 2
N_CONV_LAYERS = (DEPTH + N_MIXERS - 1) // N_MIXERS
N_ATTN_LAYERS = DEPTH // N_MIXERS
CONV_WIDTH = 31
N_HEADS = 16
HEAD_DIM = D_MODEL // N_HEADS
WIN_H = 8
WIN_W = 16
N_EXPERTS = 16
N_GROUPS = 4
EXPERTS_PER_GROUP = N_EXPERTS // N_GROUPS
TOP_K = 2
D_EXPERT = D_MODEL // 2
N_MOD = 6
EPS = 1e-6

kernel_name = "hybrid_conv_natten_grouped_moe_dit"


def rmsnorm(x, g):
    xf = x.astype(jnp.float32)
    y = xf * lax.rsqrt(jnp.mean(xf * xf, axis=-1, keepdims=True) + EPS)
    return (y * g.astype(jnp.float32)).astype(x.dtype)


def layernorm(x, g, b):
    xf = x.astype(jnp.float32)
    mu = jnp.mean(xf, axis=-1, keepdims=True)
    var = jnp.mean(jnp.square(xf - mu), axis=-1, keepdims=True)
    y = (xf - mu) * lax.rsqrt(var + EPS) * g.astype(jnp.float32) + b.astype(jnp.float32)
    return y.astype(x.dtype)


def modulate(x, g, shift, scale):
    return rmsnorm(x, g) * (1 + scale) + shift


def depthwise_conv(u, w, b):
    y = lax.conv_general_dilated(u, w[:, None, :], window_strides=(1,), padding='SAME',
                                 dimension_numbers=('NWC', 'WIO', 'NWC'),
                                 feature_group_count=u.shape[-1])
    return y + b


def conv_module(h, w_in, b_in, w_dw, b_dw, ln_g, ln_b, w_out, b_out):
    a, gt = jnp.split(h @ w_in + b_in, 2, axis=-1)
    u = a * jax.nn.sigmoid(gt)
    u = depthwise_conv(u, w_dw, b_dw)
    u = jax.nn.silu(layernorm(u, ln_g, ln_b))
    return u @ w_out + b_out


def dense_attention(q, k, v):
    s = jnp.einsum('bqhd,bkhd->bhqk', q, k).astype(jnp.float32) * (HEAD_DIM ** -0.5)
    p = jax.nn.softmax(s, axis=-1).astype(v.dtype)
    return jnp.einsum('bhqk,bkhd->bqhd', p, v)


def neighbourhood_attention(q, k, v, k_ctx, v_ctx, rpb):
    B, S, H, Dh = q.shape
    rows = S // GRID_W
    kh = min(WIN_H, rows)
    n_loc = kh * WIN_W
    qg = q.reshape(B, rows, GRID_W, H, Dh)
    kg = k.reshape(B, rows, GRID_W, H, Dh)
    vg = v.reshape(B, rows, GRID_W, H, Dh)
    col = jnp.arange(GRID_W)
    col_start = jnp.clip(col - WIN_W // 2, 0, GRID_W - WIN_W)
    col_idx = col_start[:, None] + jnp.arange(WIN_W)[None, :]
    dcol = col_idx - col[:, None]
    scale = Dh ** -0.5

    def row_block(r):
        r0 = jnp.clip(r - kh // 2, 0, rows - kh)
        qr = lax.dynamic_index_in_dim(qg, r, axis=1, keepdims=False)
        kb = lax.dynamic_slice_in_dim(kg, r0, kh, axis=1)
        vb = lax.dynamic_slice_in_dim(vg, r0, kh, axis=1)
        kw = kb[:, :, col_idx]
        vw = vb[:, :, col_idx]
        drow = r0 + jnp.arange(kh) - r
        ri = (drow + WIN_H - 1)[None, :, None]
        ci = (dcol + WIN_W - 1)[:, None, :]
        bias = rpb[:, ri, ci].astype(jnp.float32)
        s_loc = jnp.einsum('bqhd,biqjhd->bhqij', qr, kw).astype(jnp.float32) * scale + bias[None]
        s_ctx = jnp.einsum('bqhd,blhd->bhql', qr, k_ctx).astype(jnp.float32) * scale
        s = jnp.concatenate([s_loc.reshape(B, H, GRID_W, n_loc), s_ctx], axis=-1)
        p = jax.nn.softmax(s, axis=-1).astype(v.dtype)
        p_loc = p[..., :n_loc].reshape(B, H, GRID_W, kh, WIN_W)
        p_ctx = p[..., n_loc:]
        return (jnp.einsum('bhqij,biqjhd->bqhd', p_loc, vw)
                + jnp.einsum('bhql,blhd->bqhd', p_ctx, v_ctx))

    out = lax.map(row_block, jnp.arange(rows))
    return out.transpose(1, 0, 2, 3, 4).reshape(B, S, H, Dh)


def na_mixer(h, hc, w_qkv, w_o, rpb, with_ctx_out):
    B, S, D = h.shape
    L = hc.shape[1]
    q, k, v = jnp.split(h @ w_qkv, 3, axis=-1)
    q = q.reshape(B, S, N_HEADS, HEAD_DIM)
    k = k.reshape(B, S, N_HEADS, HEAD_DIM)
    v = v.reshape(B, S, N_HEADS, HEAD_DIM)
    if with_ctx_out:
        qc, kc, vc = jnp.split(hc @ w_qkv, 3, axis=-1)
    else:
        kc, vc = jnp.split(hc @ w_qkv[:, D:], 2, axis=-1)
    kc = kc.reshape(B, L, N_HEADS, HEAD_DIM)
    vc = vc.reshape(B, L, N_HEADS, HEAD_DIM)
    o = neighbourhood_attention(q, k, v, kc, vc, rpb).reshape(B, S, D) @ w_o
    if with_ctx_out:
        oc = dense_attention(qc.reshape(B, L, N_HEADS, HEAD_DIM), kc, vc).reshape(B, L, D) @ w_o
        return o, oc
    return o, None


def grouped_moe(h, router_w, router_b, w_gate, w_up, w_down):
    N = h.shape[0]
    s = jax.nn.sigmoid((h @ router_w).astype(jnp.float32))
    s_sel = s + router_b.astype(jnp.float32)
    group_score = lax.top_k(s_sel.reshape(N, N_GROUPS, EXPERTS_PER_GROUP), TOP_K)[0].sum(-1)
    g = jnp.argmax(group_score, axis=-1)
    in_group = (jnp.arange(N_EXPERTS) // EXPERTS_PER_GROUP)[None, :] == g[:, None]
    _, idx = lax.top_k(jnp.where(in_group, s_sel, -jnp.inf), TOP_K)
    w = jnp.take_along_axis(s, idx, axis=-1)
    w = w / jnp.sum(w, axis=-1, keepdims=True)
    combine = jnp.sum(jax.nn.one_hot(idx, N_EXPERTS, dtype=jnp.float32) * w[..., None], axis=1)
    combine = combine.astype(h.dtype)
    out = jnp.zeros_like(h)
    for e in range(N_EXPERTS):
        he = jax.nn.silu(h @ w_gate[e]) * (h @ w_up[e])
        out = out + combine[:, e:e + 1] * (he @ w_down[e])
    return out


def _normal(key, shape, scale):
    return jax.random.normal(key, shape, jnp.float32) * scale


def setup_inputs(seed: int = 0) -> dict:
    key = jax.random.key(seed)
    ks = jax.random.split(key, 32)
    D = D_MODEL
    return {
        "x": _normal(ks[0], (BATCH, SEQ, D), 1.0),
        "c": _normal(ks[1], (BATCH, D), 1.0),
        "ctx": _normal(ks[2], (BATCH, CTX_LEN, D), 1.0),
        "c_ctx": _normal(ks[3], (D,), 1.0),
        "w_ada": _normal(ks[4], (DEPTH, D, N_MOD * D), 0.4 * D ** -0.5),
        "b_ada": _normal(ks[5], (DEPTH, N_MOD * D), 0.02),
        "g_mix_pre": 1.0 + _normal(ks[6], (DEPTH, D), 0.05),
        "g_mix_post": 1.0 + _normal(ks[7], (DEPTH, D), 0.05),
        "g_ffn_pre": 1.0 + _normal(ks[8], (DEPTH, D), 0.05),
        "g_ffn_post": 1.0 + _normal(ks[9], (DEPTH, D), 0.05),
        "conv_w_in": _normal(ks[10], (N_CONV_LAYERS, D, 2 * D), D ** -0.5),
        "conv_b_in": _normal(ks[11], (N_CONV_LAYERS, 2 * D), 0.02),
        "conv_w_dw": _normal(ks[12], (N_CONV_LAYERS, CONV_WIDTH, D), CONV_WIDTH ** -0.5),
        "conv_b_dw": _normal(ks[13], (N_CONV_LAYERS, D), 0.02),
        "conv_ln_g": 1.0 + _normal(ks[14], (N_CONV_LAYERS, D), 0.05),
        "conv_ln_b": _normal(ks[15], (N_CONV_LAYERS, D), 0.02),
        "conv_w_out": _normal(ks[16], (N_CONV_LAYERS, D, D), D ** -0.5),
        "conv_b_out": _normal(ks[17], (N_CONV_LAYERS, D), 0.02),
        "attn_w_qkv": _normal(ks[18], (N_ATTN_LAYERS, D, 3 * D), D ** -0.5),
        "attn_w_o": _normal(ks[19], (N_ATTN_LAYERS, D, D), D ** -0.5),
        "attn_rpb": _normal(ks[20], (N_ATTN_LAYERS, N_HEADS, 2 * WIN_H - 1, 2 * WIN_W - 1), 0.2),
        "router_w": _normal(ks[21], (D, N_EXPERTS), D ** -0.5),
        "router_b": _normal(ks[22], (N_EXPERTS,), 0.01),
        "exp_w_gate": _normal(ks[23], (DEPTH, N_EXPERTS, D, D_EXPERT), D ** -0.5),
        "exp_w_up": _normal(ks[24], (DEPTH, N_EXPERTS, D, D_EXPERT), D ** -0.5),
        "exp_w_down": _normal(ks[25], (DEPTH, N_EXPERTS, D_EXPERT, D), D_EXPERT ** -0.5),
    }


def reference(x, c, ctx, c_ctx, w_ada, b_ada, g_mix_pre, g_mix_post, g_ffn_pre, g_ffn_post,
              conv_w_in, conv_b_in, conv_w_dw, conv_b_dw, conv_ln_g, conv_ln_b, conv_w_out,
              conv_b_out, attn_w_qkv, attn_w_o, attn_rpb, router_w, router_b,
              exp_w_gate, exp_w_up, exp_w_down):
    B, S, D = x.shape
    L = ctx.shape[1]
    xc = ctx
    for i in range(DEPTH):
        kind = i % N_MIXERS
        j = i // N_MIXERS
        update_ctx = i < DEPTH - 1
        mod = jax.nn.silu(c) @ w_ada[i] + b_ada[i]
        mod_c = jax.nn.silu(c_ctx) @ w_ada[i] + b_ada[i]
        sh1, sc1, ga1, sh2, sc2, ga2 = [m[:, None, :] for m in jnp.split(mod, N_MOD, axis=-1)]
        sh1c, sc1c, ga1c, sh2c, sc2c, ga2c = jnp.split(mod_c, N_MOD, axis=-1)

        h = modulate(x, g_mix_pre[i], sh1, sc1)
        hc = modulate(xc, g_mix_pre[i], sh1c, sc1c)
        if kind == 0:
            conv_args = (conv_w_in[j], conv_b_in[j], conv_w_dw[j], conv_b_dw[j],
                         conv_ln_g[j], conv_ln_b[j], conv_w_out[j], conv_b_out[j])
            y = conv_module(h, *conv_args)
            yc = conv_module(hc, *conv_args) if update_ctx else None
        else:
            y, yc = na_mixer(h, hc, attn_w_qkv[j], attn_w_o[j], attn_rpb[j], update_ctx)
        x = x + ga1 * rmsnorm(y, g_mix_post[i])
        if update_ctx:
            xc = xc + ga1c * rmsnorm(yc, g_mix_post[i])

        tokens = modulate(x, g_ffn_pre[i], sh2, sc2).reshape(B * S, D)
        if update_ctx:
            tokens_c = modulate(xc, g_ffn_pre[i], sh2c, sc2c).reshape(B * L, D)
            tokens = jnp.concatenate([tokens, tokens_c], axis=0)
        f = grouped_moe(tokens, router_w, router_b, exp_w_gate[i], exp_w_up[i], exp_w_down[i])
        x = x + ga2 * rmsnorm(f[:B * S].reshape(B, S, D), g_ffn_post[i])
        if update_ctx:
            xc = xc + ga2c * rmsnorm(f[B * S:].reshape(B, L, D), g_ffn_post[i])
    return x
```

```cpp
#include <hip/hip_runtime.h>
#include <cstdio>
#include <cstdint>

#ifndef DBG_SLOT
#define DBG_SLOT 0
#endif
#ifndef DBG_SKIP
#define DBG_SKIP 0
#endif
constexpr int D = 1024, BATCH = 8, SEQ = 4096, CTXL = 256;
constexpr int NLAT = BATCH * SEQ, NCTX = BATCH * CTXL, MT = NLAT + NCTX;
constexpr int NE = 16, DE = 512, NH = 16, HD = 64, GRIDW = 64, GROWS = 64, WINH = 8, WINW = 16, CONVW = 31;
constexpr int KSLOT = SEQ + CTXL;
constexpr int NMODR = 9, NMODC = 6 * D;
constexpr int MODKC = 8;
constexpr float EPS = 1e-6f;
constexpr int NWAVES = 8, NTHR = NWAVES * 64;

constexpr size_t MiB = 1u << 20;
constexpr size_t WS_CTL = 0, CTL_ZERO_BYTES = 1 * MiB;
constexpr size_t WS_SLOT = 1 * MiB;
constexpr size_t WS_PERM = 2 * MiB;
constexpr size_t WS_MODP = 5 * MiB;
constexpr size_t WS_XC = 9 * MiB;
constexpr size_t WS_WIN = 18 * MiB, WS_WOUT = 22 * MiB, WS_WQKV = 24 * MiB, WS_WO = 30 * MiB;
constexpr size_t WS_WGU = 32 * MiB;
constexpr size_t WS_WDN = 96 * MiB;
constexpr size_t WS_A = 128 * MiB, WS_B = 196 * MiB, WS_C = 264 * MiB, WS_D2 = 336 * MiB, WS_END = 480 * MiB;
constexpr int CW_BAR = 4096;
constexpr int CW_CNT = 8192;

constexpr int RING_BYTES = 131072;
constexpr int MISC_OFF = RING_BYTES;
constexpr int PERML_OFF = RING_BYTES + 1024;
constexpr int LDS_BYTES = 147456;

#define GAS __attribute__((address_space(1)))
#define LAS __attribute__((address_space(3)))
typedef unsigned short bf16;
typedef unsigned v4u __attribute__((ext_vector_type(4)));
typedef unsigned v2u __attribute__((ext_vector_type(2)));
typedef float f32x4 __attribute__((ext_vector_type(4)));
typedef float f32x2 __attribute__((ext_vector_type(2)));
typedef short bf16x8 __attribute__((ext_vector_type(8)));
typedef GAS unsigned gu32;
#define RLX_AGENT __ATOMIC_RELAXED, __HIP_MEMORY_SCOPE_AGENT
#define LDS_WAIT() asm volatile("s_waitcnt lgkmcnt(0)" ::: "memory")
#define VM_WAIT() asm volatile("s_waitcnt vmcnt(0)" ::: "memory")

__device__ __forceinline__ unsigned f2bf(float f) { unsigned u = __builtin_bit_cast(unsigned, f); return (u + 0x7fffu + ((u >> 16) & 1u)) >> 16; }
__device__ __forceinline__ unsigned pk2(float lo, float hi) { return f2bf(lo) | (f2bf(hi) << 16); }
__device__ __forceinline__ float bflo(unsigned w) { return __builtin_bit_cast(float, w << 16); }
__device__ __forceinline__ float bfhi(unsigned w) { return __builtin_bit_cast(float, w & 0xffff0000u); }
__device__ __forceinline__ float wave_sum(float v) {
#pragma unroll
    for (int o = 1; o < 64; o <<= 1) v += __shfl_xor(v, o);
    return v;
}
__device__ __forceinline__ int lane_id_asm() { int l; asm volatile("v_mbcnt_lo_u32_b32 %0, -1, 0\n\tv_mbcnt_hi_u32_b32 %0, -1, %0" : "=v"(l)); return l; }
__device__ __forceinline__ float fast_sigmoid(float x) { return __builtin_amdgcn_rcpf(1.0f + __builtin_amdgcn_exp2f(-1.4426950408889634f * x)); }

namespace pg8 {
#define PG8_LAS __attribute__((address_space(3)))
typedef unsigned short bf16_t;
typedef short bf16x8 __attribute__((ext_vector_type(8)));
typedef float f32x4 __attribute__((ext_vector_type(4)));
typedef unsigned u32x4 __attribute__((ext_vector_type(4)));
constexpr int BM = 256, BK = 64, HALF = 128, HTB = HALF * BK * 2, STAGE_BYTES = 8 * HTB, NXCD = 8, WGM = 8;

__host__ __device__ __forceinline__ int lds_byte(int r, int c) { const int st = (r >> 4) * 2 + (c >> 5), rr = r & 15, cc = c & 31, ob = rr * 64 + cc * 2; return st * 1024 + (ob ^ (((ob >> 9) & 1) << 5)); }
__host__ __device__ __forceinline__ void stage_rc(int b, int& R, int& C) { const int st = b / 1024, sb = b % 1024, swz = sb ^ (((sb >> 9) & 1) << 5); R = (st >> 1) * 16 + swz / 64; C = (st & 1) * 32 + (swz % 64) / 2; }
__host__ __device__ __forceinline__ int perm32(int rho) { const int n = rho >> 4, i = rho & 15; return 8 * (i >> 2) + 4 * n + (i & 3); }

struct Unit { int pm, pn; const char* a; const char* b; int li; int ex; };

__device__ __forceinline__ bool static_order(int L, int nM, int nN, int& pm, int& pn) {
    const int nwg = nM * nN; if (L >= nwg) return false;
    int wgid = L; { const int q = nwg / NXCD, r = nwg % NXCD, xcd = wgid % NXCD, off = wgid / NXCD; wgid = (xcd < r ? xcd * (q + 1) : r * (q + 1) + (xcd - r) * q) + off; }
    const int nig = WGM * nN, gid = wgid / nig, fm = gid * WGM, gsz = (nM - fm) < WGM ? (nM - fm) : WGM;
    pm = fm + ((wgid % nig) % gsz); pn = (wgid % nig) / gsz; return true;
}

__device__ __forceinline__ unsigned cvt_pk_bf16(float lo, float hi) { unsigned r; asm volatile("v_cvt_pk_bf16_f32 %0, %1, %2" : "=v"(r) : "v"(lo), "v"(hi)); return r; }

template <class Epi, class Sched, bool ALIGN_EPI>
__device__ __forceinline__ void gemm_phase(PG8_LAS unsigned char* lds, const int K, const Sched& S, const Epi& E, const int wid) {
    const int lane = lane_id_asm(), tid = wid * 64 + lane, wr = wid >> 2, wc = wid & 3, fr = lane & 15, fq = lane >> 4;
    const int nt = K / BK;
    int R[2], C[2]; unsigned voffB[2], vA[2][2];
    const size_t kstep = (size_t)(BK * 2);
    const size_t hstep = (size_t)HALF * K * 2;
#pragma unroll
    for (int i = 0; i < 2; ++i) { stage_rc(tid * 16 + i * 8192, R[i], C[i]); const int Rb = Epi::PERM ? ((R[i] & ~31) + perm32(R[i] & 31)) : R[i];
        voffB[i] = (unsigned)(Rb * K + C[i]) * 2u; vA[0][i] = (unsigned)(R[i] * K + C[i]) * 2u; vA[1][i] = vA[0][i] + (unsigned)hstep; }
    const unsigned ldsw = (unsigned)wid * 1024u;
    const int aoff = lds_byte(wr * 64 + fr, fq * 8), boff = lds_byte(wc * 32 + fr, fq * 8);
#define PG8_SA(b, h) (((b) * 2 + (h)) * HTB)
#define PG8_SB(b, h) ((4 + (b) * 2 + (h)) * HTB)
#define PG8_STAGE(bufoff, gbase, voff) do { _Pragma("unroll") for (int _i = 0; _i < 2; ++_i) \
        __builtin_amdgcn_global_load_lds((const unsigned*)((const char*)(gbase) + (voff)[_i]), (PG8_LAS unsigned*)(lds + (bufoff) + ldsw + _i * 8192), 16, 0, 0); } while (0)
#define PG8_LDA(dst, b, h) do { _Pragma("unroll") for (int m = 0; m < 4; ++m) _Pragma("unroll") for (int k = 0; k < 2; ++k) dst[m][k] = *(const PG8_LAS bf16x8*)(lds + PG8_SA(b, h) + aoff + m * 2048 + k * 1024); } while (0)
#define PG8_LDB(dst, b, h) do { _Pragma("unroll") for (int n = 0; n < 2; ++n) _Pragma("unroll") for (int k = 0; k < 2; ++k) dst[n][k] = *(const PG8_LAS bf16x8*)(lds + PG8_SB(b, h) + boff + n * 2048 + k * 1024); } while (0)
#define PG8_MMA(ai, bj, At, Bt) do { __builtin_amdgcn_s_setprio(1); _Pragma("unroll") for (int m = 0; m < 4; ++m) _Pragma("unroll") for (int n = 0; n < 2; ++n) _Pragma("unroll") for (int k = 0; k < 2; ++k) \
        acc[ai][bj][m][n] = __builtin_amdgcn_mfma_f32_16x16x32_bf16(Bt[n][k], At[m][k], acc[ai][bj][m][n], 0, 0, 0); __builtin_amdgcn_s_setprio(0); } while (0)
#define PG8_WAIT_V(n) asm volatile("s_waitcnt vmcnt(" #n ")" ::: "memory")
#define PG8_WAIT_L(n) asm volatile("s_waitcnt lgkmcnt(" #n ")" ::: "memory")
#define PG8_BAR __builtin_amdgcn_s_barrier()
#define PG8_SCHED __builtin_amdgcn_sched_barrier(0)
    Unit cur, nxt; int ui = 0;
    if (!S.next(0, cur)) return;
    if constexpr (Sched::GATHER) S.a_offsets(cur, R, C, K, vA);
    f32x4 acc[2][2][4][2];
#pragma unroll
    for (int a = 0; a < 2; ++a)
#pragma unroll
        for (int b = 0; b < 2; ++b)
#pragma unroll
            for (int m = 0; m < 4; ++m)
#pragma unroll
                for (int n = 0; n < 2; ++n) acc[a][b][m][n] = (f32x4){0.f, 0.f, 0.f, 0.f};
    bf16x8 At[4][2], B0[2][2], B1[2][2];
    const char* cA = cur.a; const char* cB = cur.b;
    PG8_STAGE(PG8_SB(0, 0), cB, voffB); PG8_STAGE(PG8_SB(0, 1), cB + hstep, voffB); PG8_STAGE(PG8_SA(0, 0), cA, vA[0]); PG8_STAGE(PG8_SA(0, 1), cA, vA[1]);
    if (wr == 1) PG8_BAR;
    PG8_WAIT_V(2); PG8_BAR;
    PG8_STAGE(PG8_SB(1, 0), cB + kstep, voffB); PG8_STAGE(PG8_SA(1, 0), cA + kstep, vA[0]); PG8_STAGE(PG8_SB(1, 1), cB + hstep + kstep, voffB);
    PG8_WAIT_V(6); PG8_BAR;
    for (;;) {
        const bool has_next = S.next(ui + 1, nxt);
        const char* nA = has_next ? nxt.a : cA; const char* nB = has_next ? nxt.b : cB;
        for (int t = 0; t < nt; t += 2) {
            const bool last = (t == nt - 2);
            const char* a1 = cA + (size_t)(t + 1) * kstep;
            const char* a2 = last ? nA : cA + (size_t)(t + 2) * kstep; const char* b2 = last ? nB : cB + (size_t)(t + 2) * kstep;
            const char* a3 = a2 + kstep; const char* b3 = b2 + kstep;
            PG8_LDB(B0, 0, 0); PG8_LDB(B1, 0, 1); PG8_SCHED; PG8_LDA(At, 0, 0); PG8_STAGE(PG8_SA(1, 1), a1, vA[1]);
            if constexpr (Sched::GATHER) { if (last && has_next) S.a_offsets(nxt, R, C, K, vA); }
            PG8_WAIT_V(8); PG8_WAIT_L(0); PG8_BAR; PG8_MMA(0, 0, At, B0); PG8_MMA(0, 1, At, B1); PG8_BAR; PG8_SCHED;
            PG8_LDA(At, 0, 1); PG8_STAGE(PG8_SB(0, 0), b2, voffB); PG8_STAGE(PG8_SB(0, 1), b2 + hstep, voffB); PG8_STAGE(PG8_SA(0, 0), a2, vA[0]);
            PG8_WAIT_V(8); PG8_WAIT_L(0); PG8_BAR; PG8_MMA(1, 0, At, B0); PG8_MMA(1, 1, At, B1); PG8_BAR; PG8_SCHED;
            PG8_LDB(B0, 1, 0); PG8_LDB(B1, 1, 1); PG8_SCHED; PG8_LDA(At, 1, 0); PG8_STAGE(PG8_SA(0, 1), a2, vA[1]);
            PG8_WAIT_V(8); PG8_WAIT_L(0); PG8_BAR; PG8_MMA(0, 0, At, B0); PG8_MMA(0, 1, At, B1); PG8_BAR; PG8_SCHED;
            PG8_LDA(At, 1, 1); PG8_STAGE(PG8_SB(1, 0), b3, voffB); PG8_STAGE(PG8_SB(1, 1), b3 + hstep, voffB); PG8_STAGE(PG8_SA(1, 0), a3, vA[0]);
            PG8_WAIT_V(8); PG8_WAIT_L(0); PG8_BAR; PG8_MMA(1, 0, At, B0); PG8_MMA(1, 1, At, B1); PG8_BAR; PG8_SCHED;
        }
        if constexpr (ALIGN_EPI) { if (wr == 0) PG8_BAR; }
        E(acc, cur, wr, wc, fr, fq);
        if (!has_next) break;
#pragma unroll
        for (int a = 0; a < 2; ++a)
#pragma unroll
            for (int b = 0; b < 2; ++b)
#pragma unroll
                for (int m = 0; m < 4; ++m)
#pragma unroll
                    for (int n = 0; n < 2; ++n) acc[a][b][m][n] = (f32x4){0.f, 0.f, 0.f, 0.f};
        cur = nxt; cA = nA; cB = nB; ++ui;
        if constexpr (ALIGN_EPI) { if (wr == 1) PG8_BAR; }
    }
    PG8_WAIT_V(0);
    if constexpr (!ALIGN_EPI) { if (wr == 0) PG8_BAR; }
    PG8_BAR;
#undef PG8_SA
#undef PG8_SB
#undef PG8_STAGE
#undef PG8_LDA
#undef PG8_LDB
#undef PG8_MMA
#undef PG8_WAIT_V
#undef PG8_WAIT_L
#undef PG8_BAR
#undef PG8_SCHED
}

struct DenseSched {
    static constexpr bool GATHER = false;
    const char* A; const char* Bt; int K, nM, nN, G, c;
    __device__ __forceinline__ bool next(int i, Unit& u) const {
        int pm, pn; if (!static_order(i * G + c, nM, nN, pm, pn)) return false;
        u.pm = pm; u.pn = pn; u.a = A + (size_t)pm * BM * K * 2; u.b = Bt + (size_t)pn * BM * K * 2; u.li = i; u.ex = 0; return true;
    }
    __device__ __forceinline__ void a_offsets(const Unit&, const int (&)[2], const int (&)[2], int, unsigned (&)[2][2]) const {}
};
struct QkvSched {
    static constexpr bool GATHER = false;
    const char* A; const char* Bt; int G, c;
    __device__ __forceinline__ bool next(int i, Unit& u) const {
        const int L = i * G + c; int pm, pn;
        if (L < 1536) { static_order(L, 128, 12, pm, pn); }
        else { const int l2 = L - 1536; if (l2 >= 64) return false; pm = 128 + (l2 >> 3); pn = 4 + (l2 & 7); }
        u.pm = pm; u.pn = pn; u.a = A + (size_t)pm * BM * D * 2; u.b = Bt + (size_t)pn * BM * D * 2; u.li = i; u.ex = 0; return true;
    }
    __device__ __forceinline__ void a_offsets(const Unit&, const int (&)[2], const int (&)[2], int, unsigned (&)[2][2]) const {}
};
struct MoeSchedBase {
    const volatile PG8_LAS int* tpre;
    int G, c;
    __device__ __forceinline__ bool locate(int i, int& rt, int& pn, int& e) const {
        const int L = i * G + c; const int ntile = tpre[16];
        if (L >= 4 * ntile) return false;
        rt = L >> 2; pn = L & 3; int ee = 0;
#pragma unroll
        for (int j = 1; j < 16; ++j) ee += (rt >= tpre[j]) ? 1 : 0;
        e = ee; return true;
    }
};
struct MoeUpSched : MoeSchedBase {
    static constexpr bool GATHER = true;
    const char* A; const char* Wgu; const PG8_LAS int* permL;
    __device__ __forceinline__ bool next(int i, Unit& u) const {
        int rt, pn, e; if (!locate(i, rt, pn, e)) return false;
        u.pm = rt; u.pn = pn; u.a = A; u.b = Wgu + (size_t)e * (1024 * 1024 * 2) + (size_t)pn * BM * D * 2; u.li = i; u.ex = e; return true;
    }
    __device__ __forceinline__ void a_offsets(const Unit& u, const int (&R)[2], const int (&C)[2], int K, unsigned (&vA)[2][2]) const {
#pragma unroll
        for (int h = 0; h < 2; ++h)
#pragma unroll
            for (int i = 0; i < 2; ++i) vA[h][i] = (unsigned)permL[u.li * 256 + h * HALF + R[i]] * (unsigned)(K * 2) + (unsigned)(C[i] * 2);
    }
};
struct MoeDownSched : MoeSchedBase {
    static constexpr bool GATHER = false;
    const char* A; const char* Wdn;
    __device__ __forceinline__ bool next(int i, Unit& u) const {
        int rt, pn, e; if (!locate(i, rt, pn, e)) return false;
        u.pm = rt; u.pn = pn; u.a = A + (size_t)rt * BM * DE * 2; u.b = Wdn + (size_t)e * (1024 * 512 * 2) + (size_t)pn * BM * DE * 2; u.li = i; u.ex = e; return true;
    }
    __device__ __forceinline__ void a_offsets(const Unit&, const int (&)[2], const int (&)[2], int, unsigned (&)[2][2]) const {}
};

struct EpiBf16 {
    static constexpr bool PERM = true;
    bf16_t* O; int ldc; const float* bias;
    __device__ __forceinline__ void operator()(const f32x4 (&acc)[2][2][4][2], const Unit& u, int wr, int wc, int fr, int fq) const {
        const int row0 = u.pm * BM + wr * 64 + fr, col0 = u.pn * BM + wc * 32 + 8 * fq;
        f32x4 bv[2][2];
#pragma unroll
        for (int bj = 0; bj < 2; ++bj)
#pragma unroll
            for (int n = 0; n < 2; ++n) bv[bj][n] = bias ? *(const f32x4*)(bias + col0 + bj * HALF + 4 * n) : (f32x4){0.f, 0.f, 0.f, 0.f};
#pragma unroll
        for (int ai = 0; ai < 2; ++ai)
#pragma unroll
            for (int m = 0; m < 4; ++m) { bf16_t* rowp = O + (size_t)(row0 + ai * HALF + m * 16) * ldc + col0;
#pragma unroll
                for (int bj = 0; bj < 2; ++bj) { const f32x4 v0 = acc[ai][bj][m][0] + bv[bj][0], v1 = acc[ai][bj][m][1] + bv[bj][1];
                    u32x4 w; w.x = cvt_pk_bf16(v0[0], v0[1]); w.y = cvt_pk_bf16(v0[2], v0[3]); w.z = cvt_pk_bf16(v1[0], v1[1]); w.w = cvt_pk_bf16(v1[2], v1[3]);
                    *(u32x4*)(rowp + bj * HALF) = w; } }
    }
};
template <int MODE  > struct EpiGated {
    static constexpr bool PERM = true;
    bf16_t* O; int ldc; const float* bias; int nch;
    __device__ __forceinline__ void operator()(const f32x4 (&acc)[2][2][4][2], const Unit& u, int wr, int wc, int fr, int fq) const {
        const int row0 = u.pm * BM + wr * 64 + fr, ch0 = u.pn * HALF + wc * 32 + 8 * fq;
        f32x4 b0[2], b1[2];
#pragma unroll
        for (int n = 0; n < 2; ++n) { if (MODE == 0) { b0[n] = *(const f32x4*)(bias + ch0 + 4 * n); b1[n] = *(const f32x4*)(bias + nch + ch0 + 4 * n); } else { b0[n] = (f32x4){0.f, 0.f, 0.f, 0.f}; b1[n] = b0[n]; } }
#pragma unroll
        for (int ai = 0; ai < 2; ++ai)
#pragma unroll
            for (int m = 0; m < 4; ++m) { bf16_t* rowp = O + (size_t)(row0 + ai * HALF + m * 16) * ldc + ch0; float o[8];
#pragma unroll
                for (int n = 0; n < 2; ++n) { const f32x4 x0 = acc[ai][0][m][n] + b0[n], x1 = acc[ai][1][m][n] + b1[n];
#pragma unroll
                    for (int e = 0; e < 4; ++e) o[4 * n + e] = (MODE == 0) ? x0[e] * fast_sigmoid(x1[e]) : (x0[e] * fast_sigmoid(x0[e])) * x1[e]; }
                u32x4 w; w.x = cvt_pk_bf16(o[0], o[1]); w.y = cvt_pk_bf16(o[2], o[3]); w.z = cvt_pk_bf16(o[4], o[5]); w.w = cvt_pk_bf16(o[6], o[7]);
                *(u32x4*)rowp = w; }
    }
};
struct EpiQkv {
    static constexpr bool PERM = true;
    bf16_t* Q; bf16_t* Kh; bf16_t* Vb;
    __device__ __forceinline__ void operator()(const f32x4 (&acc)[2][2][4][2], const Unit& u, int wr, int wc, int fr, int fq) const {
        const int which = u.pn >> 2; const bool isctx = u.pm >= 128;
        const int b = isctx ? (u.pm - 128) : (u.pm >> 4);
        const int key0 = isctx ? SEQ : ((u.pm & 15) << 8);
        const int d0 = 32 * (wc & 1) + 8 * fq;
#pragma unroll
        for (int ai = 0; ai < 2; ++ai)
#pragma unroll
            for (int m = 0; m < 4; ++m) { const int key = key0 + ai * HALF + wr * 64 + m * 16 + fr;
#pragma unroll
                for (int bj = 0; bj < 2; ++bj) { const int h = 4 * (u.pn & 3) + 2 * bj + (wc >> 1); const f32x4 v0 = acc[ai][bj][m][0], v1 = acc[ai][bj][m][1];
                    if (which == 2) {
                        bf16_t* p = Vb + ((size_t)(b * NH + h) * (KSLOT / 8) + (key >> 3)) * 512 + (size_t)d0 * 8 + (key & 7);
                        const unsigned w0 = cvt_pk_bf16(v0[0], v0[1]), w1 = cvt_pk_bf16(v0[2], v0[3]), w2 = cvt_pk_bf16(v1[0], v1[1]), w3 = cvt_pk_bf16(v1[2], v1[3]);
                        p[0] = (bf16_t)w0; p[8] = (bf16_t)(w0 >> 16); p[16] = (bf16_t)w1; p[24] = (bf16_t)(w1 >> 16); p[32] = (bf16_t)w2; p[40] = (bf16_t)(w2 >> 16); p[48] = (bf16_t)w3; p[56] = (bf16_t)(w3 >> 16);
                    } else {
                        u32x4 w; w.x = cvt_pk_bf16(v0[0], v0[1]); w.y = cvt_pk_bf16(v0[2], v0[3]); w.z = cvt_pk_bf16(v1[0], v1[1]); w.w = cvt_pk_bf16(v1[2], v1[3]);
                        bf16_t* p = (which == 0) ? Q + ((size_t)(b * NH + h) * SEQ + key) * HD + d0 : Kh + ((size_t)(b * NH + h) * KSLOT + key) * HD + d0;
                        *(u32x4*)p = w;
                    } } }
    }
};
}
#define XB_TMO      128
#define XB_XCNT(j)  (256  + 64 * (j))
#define XB_XSUB(j)  (1280 + 64 * (j))
#define XB_XGEN(j)  (2304 + 64 * (j))
#define XB_TOP      3328
#define XB_TOPGEN   3392
#define XCD_BAR_WORDS 3456
#define XB_SPIN_CAP (1u << 18)

__device__ __forceinline__ unsigned xb_ld(unsigned* p)              { return __hip_atomic_load(p, __ATOMIC_RELAXED, __HIP_MEMORY_SCOPE_AGENT); }
__device__ __forceinline__ unsigned xb_add(unsigned* p, unsigned v) { return __hip_atomic_fetch_add(p, v, __ATOMIC_RELAXED, __HIP_MEMORY_SCOPE_AGENT); }
__device__ __forceinline__ unsigned xb_xcc_id() { return (unsigned)__builtin_amdgcn_s_getreg((3 << 11) | 20) & 0xFu; }
#define XB_SPIN(cond, bar) do { unsigned _sp = 0; while (cond) { __builtin_amdgcn_s_sleep(1); \
    if ((++_sp & 255u) == 0u) { if (xb_ld(&(bar)[XB_TMO])) break; if (_sp > XB_SPIN_CAP) { atomicAdd(&(bar)[XB_TMO], 1u); break; } } } } while (0)

struct XcdBarrier {
    unsigned* bar; unsigned x;
    volatile LAS unsigned* st;
};

__device__ __forceinline__ XcdBarrier xcd_barrier_post(unsigned* bar, volatile LAS unsigned* st) {
    XcdBarrier b; b.bar = bar; b.x = xb_xcc_id(); b.st = st;
    if (threadIdx.x == 0) (void)xb_add(&bar[XB_XCNT(b.x)], 1u);
    return b;
}
__device__ __forceinline__ void xcd_barrier_complete(unsigned* bar, unsigned x, unsigned& nloc, unsigned& nx) {
    const unsigned G = gridDim.x * gridDim.y * gridDim.z;
    unsigned sum, cnt, mine, sp = 0u;
    for (;;) {
        sum = 0u; cnt = 0u; mine = 0u;
#pragma unroll
        for (unsigned j = 0; j < 16; ++j) { const unsigned c = xb_ld(&bar[XB_XCNT(j)]); sum += c; cnt += (c > 0u) ? 1u : 0u; mine = (j == x) ? c : mine; }
        if (sum == G) break;
        __builtin_amdgcn_s_sleep(1);
        if ((++sp & 255u) == 0u) { if (xb_ld(&bar[XB_TMO])) break; if (sp > XB_SPIN_CAP) { atomicAdd(&bar[XB_TMO], 1u); break; } }
    }
    nloc = mine > 0u ? mine : 1u; nx = cnt > 0u ? cnt : 1u;
}

__device__ __forceinline__ void xcd_barrier(const XcdBarrier& b) {
    asm volatile("s_waitcnt vmcnt(0)" ::: "memory");
    __syncthreads();
    if (threadIdx.x == 0) {
        unsigned* bar = b.bar;
        __builtin_amdgcn_s_waitcnt(0);
        unsigned nloc = b.st[0], nx = b.st[1];
        if (nloc == 0u) { xcd_barrier_complete(bar, b.x, nloc, nx); b.st[0] = nloc; b.st[1] = nx; }
        const unsigned old = xb_add(&bar[XB_XSUB(b.x)], 1u);
        const unsigned gen = old / nloc;
        if (old + 1u == (gen + 1u) * nloc) {
            __builtin_amdgcn_fence(__ATOMIC_RELEASE, "agent");
            asm volatile("s_waitcnt vmcnt(0)" ::: "memory");
            const unsigned og = xb_add(&bar[XB_TOP], 1u);
            const unsigned tg = og / nx;
            if (og + 1u == (tg + 1u) * nx) xb_add(&bar[XB_TOPGEN], 1u);
            else XB_SPIN(xb_ld(&bar[XB_TOPGEN]) == tg, bar);
            __builtin_amdgcn_fence(__ATOMIC_ACQUIRE, "agent");
            xb_add(&bar[XB_XGEN(b.x)], 1u);
            asm volatile("s_waitcnt vmcnt(0)" ::: "memory");
        } else {
            XB_SPIN(xb_ld(&bar[XB_XGEN(b.x)]) == gen, bar);
            __builtin_amdgcn_fence(__ATOMIC_ACQUIRE, "agent");
            asm volatile("s_waitcnt vmcnt(0)" ::: "memory");
        }
    }
    __syncthreads();
}

struct Frame {
    LAS unsigned char* lds;
    volatile LAS unsigned* MISC;
    gu32* ctl;
    int wave, G, bid;
    __device__ __forceinline__ int lane() const { return lane_id_asm(); }
    __device__ __forceinline__ int tid() const { return wave * 64 + lane_id_asm(); }
    unsigned char* ws;
    const float *x, *c, *ctx, *c_ctx, *w_ada, *b_ada, *g_mix_pre, *g_mix_post, *g_ffn_pre, *g_ffn_post;
    const float *conv_w_in, *conv_b_in, *conv_w_dw, *conv_b_dw, *conv_ln_g, *conv_ln_b, *conv_w_out, *conv_b_out;
    const float *attn_w_qkv, *attn_w_o, *attn_rpb, *router_w, *router_b, *exp_w_gate, *exp_w_up, *exp_w_down;
    float* out;
};

__device__ __forceinline__ void ld_row_f32(const float* row, int lane, f32x4 (&v)[4]) {
    const f32x4* p = (const f32x4*)row + lane;
#pragma unroll
    for (int j = 0; j < 4; ++j) v[j] = p[64 * j];
}
__device__ __forceinline__ void st_row_f32(float* row, int lane, const f32x4 (&v)[4]) {
    f32x4* p = (f32x4*)row + lane;
#pragma unroll
    for (int j = 0; j < 4; ++j) p[64 * j] = v[j];
}
__device__ __forceinline__ void ld_row_bf16(const bf16* row, int lane, f32x4 (&v)[4]) {
    const v2u* p = (const v2u*)row + lane;
#pragma unroll
    for (int j = 0; j < 4; ++j) { const v2u w = p[64 * j]; v[j] = (f32x4){bflo(w.x), bfhi(w.x), bflo(w.y), bfhi(w.y)}; }
}
__device__ __forceinline__ void st_row_bf16(bf16* row, int lane, const f32x4 (&v)[4]) {
    v2u* p = (v2u*)row + lane;
#pragma unroll
    for (int j = 0; j < 4; ++j) { v2u w; w.x = pk2(v[j][0], v[j][1]); w.y = pk2(v[j][2], v[j][3]); p[64 * j] = w; }
}
__device__ __forceinline__ float sumsq4(const f32x4 (&v)[4]) {
    float s = 0.f;
#pragma unroll
    for (int j = 0; j < 4; ++j) s += (v[j][0] * v[j][0] + v[j][1] * v[j][1]) + (v[j][2] * v[j][2] + v[j][3] * v[j][3]);
    return s;
}
__device__ __forceinline__ void ld_mod(const Frame& F, int l, int r, int ch, f32x4 (&v)[4]) {
    const float* modp = (const float*)(F.ws + WS_MODP); const int lane = F.lane();
    ld_row_f32(F.b_ada + (size_t)l * NMODC + ch * D, lane, v);
#pragma unroll
    for (int kc = 0; kc < MODKC; ++kc) { f32x4 t[4]; ld_row_f32(modp + ((size_t)((kc * 2 + l) * NMODR + r)) * NMODC + ch * D, lane, t);
#pragma unroll
        for (int j = 0; j < 4; ++j) v[j] += t[j]; }
}
__device__ __forceinline__ int row_batch(int m) { return m < NLAT ? (m >> 12) : 8; }

__device__ __forceinline__ void p0_transpose_item(const float* W, int K, int N, bf16* WT, int drow_off, LAS float* scr, int item, int lane) {
    const int nblk = N / 32, kb = item / nblk, nb = item % nblk, k0 = 64 * kb, n0 = 32 * nb;
#pragma unroll 8
    for (int i = 0; i < 32; ++i) { const int kk = 2 * i + (lane >> 5); scr[kk * 33 + (lane & 31)] = W[(size_t)(k0 + kk) * N + n0 + (lane & 31)]; }
    LDS_WAIT(); asm volatile("" ::: "memory");
    const int c = lane & 7;
#pragma unroll
    for (int j = 0; j < 4; ++j) { const int n = (lane >> 3) + 8 * j; const LAS float* s = scr + (8 * c) * 33 + n;
        v4u o; o.x = pk2(s[0 * 33], s[1 * 33]); o.y = pk2(s[2 * 33], s[3 * 33]); o.z = pk2(s[4 * 33], s[5 * 33]); o.w = pk2(s[6 * 33], s[7 * 33]);
        *(GAS v4u*)(WT + (size_t)(drow_off + n0 + n) * K + k0 + 8 * c) = o; }
    LDS_WAIT(); asm volatile("" ::: "memory");
}
constexpr int I_WIN = 1024, I_WOUT = 512, I_WQKV = 1536, I_WO = 512, I_EXP = 32 * 768, NITEMS_P0 = I_WIN + I_WOUT + I_WQKV + I_WO + I_EXP;
__device__ __forceinline__ void p0_item(const Frame& F, LAS float* scr, int it) {
    int r = it; const int lane = F.lane();
    if (r < I_WIN) { const int n0 = 32 * (r % 64), ch = n0 & 1023, hf = n0 >> 10, drow0 = 256 * (ch >> 7) + 128 * hf + (ch & 127);
        p0_transpose_item(F.conv_w_in, D, 2 * D, (bf16*)(F.ws + WS_WIN), drow0 - n0, scr, r, lane); return; }
    r -= I_WIN;
    if (r < I_WOUT) { p0_transpose_item(F.conv_w_out, D, D, (bf16*)(F.ws + WS_WOUT), 0, scr, r, lane); return; }
    r -= I_WOUT;
    if (r < I_WQKV) { p0_transpose_item(F.attn_w_qkv, D, 3 * D, (bf16*)(F.ws + WS_WQKV), 0, scr, r, lane); return; }
    r -= I_WQKV;
    if (r < I_WO) { p0_transpose_item(F.attn_w_o, D, D, (bf16*)(F.ws + WS_WO), 0, scr, r, lane); return; }
    r -= I_WO;
    const int le = r / 768; int q = r % 768;
    if (q < 512) { const bool up = q >= 256; if (up) q -= 256; const int n0 = 32 * (q % 16), drow0 = 256 * (n0 >> 7) + (up ? 128 : 0) + (n0 & 127);
        p0_transpose_item((up ? F.exp_w_up : F.exp_w_gate) + (size_t)le * D * DE, D, DE, (bf16*)(F.ws + WS_WGU) + (size_t)le * 1024 * 1024, drow0 - n0, scr, q, lane); return; }
    q -= 512;
    p0_transpose_item(F.exp_w_down + (size_t)le * DE * D, DE, D, (bf16*)(F.ws + WS_WDN) + (size_t)le * 1024 * 512, 0, scr, q, lane);
}
__device__ __forceinline__ void p0_mod_item(const Frame& F, LAS float* scr, int it) {
    const int lane = F.lane(), l = it / 192, rem = it % 192, cg = rem >> 3, kc = rem & 7, k0 = 128 * kc, n0 = 256 * cg + 4 * lane;
    for (int idx = lane; idx < NMODR * 128; idx += 64) { const int r = idx >> 7, kk = idx & 127; const float cv = (r < 8) ? F.c[r * D + k0 + kk] : F.c_ctx[k0 + kk];
        scr[idx] = cv / (1.0f + __expf(-cv)); }
    LDS_WAIT(); asm volatile("" ::: "memory");
    f32x4 acc[NMODR];
#pragma unroll
    for (int r = 0; r < NMODR; ++r) acc[r] = (f32x4){0.f, 0.f, 0.f, 0.f};
    const float* wp = F.w_ada + ((size_t)l * D + k0) * NMODC + n0;
#pragma unroll 8
    for (int kk = 0; kk < 128; ++kk) { const f32x4 w = *(const f32x4*)(wp + (size_t)kk * NMODC);
#pragma unroll
        for (int r = 0; r < NMODR; ++r) { const float s = scr[r * 128 + kk]; acc[r] += w * s; } }
    float* modp = (float*)(F.ws + WS_MODP);
#pragma unroll
    for (int r = 0; r < NMODR; ++r) *(f32x4*)(modp + ((size_t)((kc * 2 + l) * NMODR + r)) * NMODC + n0) = acc[r];
    LDS_WAIT(); asm volatile("" ::: "memory");
}
__device__ __forceinline__ void p0_prologue(const Frame& F) {
    LAS float* scr = (LAS float*)(F.lds + F.wave * 16384);
    if (F.wave == 0) p0_mod_item(F, scr, F.bid);
    if (F.wave == 1 && F.bid < 128) p0_mod_item(F, scr, 256 + F.bid);
    const int gw = F.bid * NWAVES + F.wave, NGW = F.G * NWAVES;
    for (int it = gw; it < NITEMS_P0; it += NGW) p0_item(F, scr, it);
}

__device__ __forceinline__ void p1_modulate(const Frame& F) {
    constexpr int RPB = MT / 256;
    bf16* H = (bf16*)(F.ws + WS_A);
    int rc = -1; f32x4 gs[4], sh[4]; const int lane = F.lane();
    for (int rl = F.wave; rl < RPB; rl += NWAVES) {
        const int m = F.bid * RPB + rl, r = row_batch(m);
        if (r != rc) { f32x4 g[4], sc[4]; ld_row_f32(F.g_mix_pre, lane, g); ld_mod(F, 0, r, 1, sc); ld_mod(F, 0, r, 0, sh);
#pragma unroll
            for (int j = 0; j < 4; ++j) gs[j] = g[j] * (sc[j] + 1.0f);
            rc = r; }
        f32x4 v[4]; ld_row_f32(m < NLAT ? F.x + (size_t)m * D : F.ctx + (size_t)(m - NLAT) * D, lane, v);
        const float rstd = 1.0f / sqrtf(wave_sum(sumsq4(v)) * (1.0f / D) + EPS);
#pragma unroll
        for (int j = 0; j < 4; ++j) v[j] = v[j] * rstd * gs[j] + sh[j];
        st_row_bf16(H + (size_t)m * D, lane, v);
    }
}

__device__ __forceinline__ void p3_conv(const Frame& F) {
    const bf16* U = (const bf16*)(F.ws + WS_B); bf16* V = (bf16*)(F.ws + WS_A);
    const int tid = F.tid(), lane = F.lane();
    f32x2 w[CONVW];
#pragma unroll
    for (int j = 0; j < CONVW; ++j) w[j] = *(const f32x2*)(F.conv_w_dw + j * D + 2 * tid);
    const f32x2 bias2 = *(const f32x2*)(F.conv_b_dw + 2 * tid);
    f32x4 lg[4], lb[4]; ld_row_f32(F.conv_ln_g, lane, lg); ld_row_f32(F.conv_ln_b, lane, lb);
    constexpr int TT = 32, NIN = TT + CONVW - 1;
    for (int tile = F.bid; tile < MT / TT; tile += F.G) {
        int rowbase, t0, T;
        if (tile < NLAT / TT) { rowbase = (tile >> 7) * SEQ; t0 = (tile & 127) * TT; T = SEQ; } else { const int t2 = tile - NLAT / TT; rowbase = NLAT + (t2 >> 3) * CTXL; t0 = (t2 & 7) * TT; T = CTXL; }
        for (int p = tid; p < NIN * 128; p += NTHR) { const int i = p >> 7, cp = p & 127, t = t0 - 15 + i;
            v4u val = (v4u){0u, 0u, 0u, 0u}; if (t >= 0 && t < T) val = *(const v4u*)(U + (size_t)(rowbase + t) * D + cp * 8);
            *(LAS v4u*)(F.lds + i * 2048 + cp * 16) = val; }
        __syncthreads();
        f32x2 res[TT];
#pragma unroll
        for (int g = 0; g < TT / 8; ++g) {
            f32x2 acc[8];
#pragma unroll
            for (int q = 0; q < 8; ++q) acc[q] = bias2;
#pragma unroll
            for (int ii = 0; ii < 8 + CONVW - 1; ++ii) { const int i = 8 * g + ii; const unsigned uw = *(const LAS unsigned*)(F.lds + i * 2048 + tid * 4); const f32x2 uv = (f32x2){bflo(uw), bfhi(uw)};
#pragma unroll
                for (int q = 0; q < 8; ++q) { const int j = ii - q; if (j >= 0 && j < CONVW) acc[q] += w[j] * uv; } }
#pragma unroll
            for (int q = 0; q < 8; ++q) res[8 * g + q] = acc[q];
        }
        __syncthreads();
#pragma unroll
        for (int tt = 0; tt < TT; ++tt) *(LAS f32x2*)(F.lds + tt * 4096 + tid * 8) = res[tt];
        __syncthreads();
#pragma unroll
        for (int q = 0; q < 4; ++q) { const int tt = 4 * F.wave + q; f32x4 v[4];
#pragma unroll
            for (int j = 0; j < 4; ++j) v[j] = *(const LAS f32x4*)(F.lds + tt * 4096 + j * 1024 + lane * 16);
            float s = 0.f;
#pragma unroll
            for (int j = 0; j < 4; ++j) s += (v[j][0] + v[j][1]) + (v[j][2] + v[j][3]);
            const float mean = wave_sum(s) * (1.0f / D);
#pragma unroll
            for (int j = 0; j < 4; ++j) v[j] = v[j] - mean;
            const float rstd = 1.0f / sqrtf(wave_sum(sumsq4(v)) * (1.0f / D) + EPS);
#pragma unroll
            for (int j = 0; j < 4; ++j) { f32x4 y = v[j] * rstd * lg[j] + lb[j];
#pragma unroll
                for (int e = 0; e < 4; ++e) y[e] = y[e] / (1.0f + __expf(-y[e]));
                v[j] = y; }
            st_row_bf16(V + (size_t)(rowbase + t0 + tt) * D, lane, v); }
        __syncthreads();
    }
}

constexpr int RW_OFF = 0, RW_BYTES = 256 * 272;
constexpr int REC_OFF = 72 * 1024;
constexpr int LRK_OFF = REC_OFF + 4096;
constexpr int BASE_OFF = LRK_OFF + 2048;
template <int L>
__device__ __forceinline__ void p_emid(const Frame& F) {
    constexpr int NROWS = (L == 0) ? MT : NLAT, RPB = NROWS / 256;
    const bf16* Y = (const bf16*)(F.ws + WS_B); bf16* TOK = (bf16*)(F.ws + WS_A);
    float* XC = (float*)(F.ws + WS_XC);
    const int tid = F.tid(), lane = F.lane(), m0 = F.bid * RPB;
    for (int idx = tid; idx < 4096; idx += NTHR) { const int k = idx >> 2, ep = idx & 3; const f32x4 v = *(const f32x4*)(F.router_w + k * 16 + ep * 4);
        *(LAS f32x4*)(F.lds + RW_OFF + (k >> 2) * 272 + (k & 3) * 64 + ep * 16) = v; }
    __syncthreads();
    float rb[16];
#pragma unroll
    for (int e = 0; e < 16; ++e) rb[e] = F.router_b[e];
    int rc = -1; f32x4 ga[4], gp[4], gs[4], sh[4];
    for (int rl = F.wave; rl < RPB; rl += NWAVES) {
        const int m = m0 + rl, r = row_batch(m);
        if (r != rc) { f32x4 g[4], sc[4]; ld_mod(F, L, r, 2, ga); ld_row_f32(F.g_mix_post + L * D, lane, gp); ld_row_f32(F.g_ffn_pre + L * D, lane, g); ld_mod(F, L, r, 4, sc); ld_mod(F, L, r, 3, sh);
#pragma unroll
            for (int j = 0; j < 4; ++j) gs[j] = g[j] * (sc[j] + 1.0f);
            rc = r; }
        f32x4 y[4], xv[4];
        ld_row_bf16(Y + (size_t)m * D, lane, y);
        const float* xin = (L == 0) ? (m < NLAT ? F.x + (size_t)m * D : F.ctx + (size_t)(m - NLAT) * D) : F.out + (size_t)m * D;
        ld_row_f32(xin, lane, xv);
        const float rstdy = 1.0f / sqrtf(wave_sum(sumsq4(y)) * (1.0f / D) + EPS);
#pragma unroll
        for (int j = 0; j < 4; ++j) xv[j] = xv[j] + ga[j] * (y[j] * rstdy * gp[j]) * (((DBG_SKIP >> (2 * L)) & 1) ? 0.f : 1.f);
        st_row_f32(m < NLAT ? F.out + (size_t)m * D : XC + (size_t)(m - NLAT) * D, lane, xv);
        const float rstd1 = 1.0f / sqrtf(wave_sum(sumsq4(xv)) * (1.0f / D) + EPS);
#pragma unroll
        for (int j = 0; j < 4; ++j) xv[j] = xv[j] * rstd1 * gs[j] + sh[j];
        st_row_bf16(TOK + (size_t)m * D, lane, xv);
        float a[16];
#pragma unroll
        for (int e = 0; e < 16; ++e) a[e] = 0.f;
#pragma unroll
        for (int j = 0; j < 4; ++j)
#pragma unroll
            for (int i = 0; i < 4; ++i) { const float tv = xv[j][i]; const LAS f32x4* wp = (const LAS f32x4*)(F.lds + RW_OFF + (64 * j + lane) * 272 + i * 64);
#pragma unroll
                for (int ep = 0; ep < 4; ++ep) { const f32x4 wv = wp[ep];
#pragma unroll
                    for (int cc = 0; cc < 4; ++cc) a[4 * ep + cc] += tv * wv[cc]; } }
        const bool hA = (lane & 32) != 0, hB = (lane & 16) != 0, hC = (lane & 8) != 0, hD = (lane & 4) != 0;
        float k8[8], k4[4], k2[2];
#pragma unroll
        for (int i = 0; i < 8; ++i) { const float snd = hA ? a[i] : a[8 + i]; const float rcv = __shfl_xor(snd, 32); k8[i] = (hA ? a[8 + i] : a[i]) + rcv; }
#pragma unroll
        for (int i = 0; i < 4; ++i) { const float snd = hB ? k8[i] : k8[4 + i]; const float rcv = __shfl_xor(snd, 16); k4[i] = (hB ? k8[4 + i] : k8[i]) + rcv; }
#pragma unroll
        for (int i = 0; i < 2; ++i) { const float snd = hC ? k4[i] : k4[2 + i]; const float rcv = __shfl_xor(snd, 8); k2[i] = (hC ? k4[2 + i] : k4[i]) + rcv; }
        float k1; { const float snd = hD ? k2[0] : k2[1]; const float rcv = __shfl_xor(snd, 4); k1 = (hD ? k2[1] : k2[0]) + rcv; }
        k1 += __shfl_xor(k1, 2); k1 += __shfl_xor(k1, 1);
        const float sg = 1.0f / (1.0f + __expf(-k1));
        float s[16], ss[16];
#pragma unroll
        for (int e = 0; e < 16; ++e) { s[e] = __builtin_bit_cast(float, __builtin_amdgcn_readlane(__builtin_bit_cast(int, sg), 4 * e)); ss[e] = s[e] + rb[e]; }
        float gsc[4]; int i0[4], i1[4];
#pragma unroll
        for (int g = 0; g < 4; ++g) { int a0 = 0; float mx = ss[4 * g];
#pragma unroll
            for (int i = 1; i < 4; ++i) if (ss[4 * g + i] > mx) { mx = ss[4 * g + i]; a0 = i; }
            int b0 = -1; float m2 = -3.0e38f;
#pragma unroll
            for (int i = 0; i < 4; ++i) if (i != a0 && ss[4 * g + i] > m2) { m2 = ss[4 * g + i]; b0 = i; }
            gsc[g] = mx + m2; i0[g] = 4 * g + a0; i1[g] = 4 * g + b0; }
        int gst = 0; float gm = gsc[0];
#pragma unroll
        for (int g = 1; g < 4; ++g) if (gsc[g] > gm) { gm = gsc[g]; gst = g; }
        int e0 = i0[0], e1 = i1[0];
#pragma unroll
        for (int g = 1; g < 4; ++g) if (gst == g) { e0 = i0[g]; e1 = i1[g]; }
        float w0 = 0.f, w1 = 0.f;
#pragma unroll
        for (int e = 0; e < 16; ++e) { if (e == e0) w0 = s[e]; if (e == e1) w1 = s[e]; }
        const float inv = 1.0f / (w0 + w1); w0 *= inv; w1 *= inv;
        if (lane == 0) *(LAS v4u*)(F.lds + REC_OFF + rl * 16) = (v4u){(unsigned)e0, (unsigned)e1, __builtin_bit_cast(unsigned, w0), __builtin_bit_cast(unsigned, w1)};
    }
    __syncthreads();
    if (F.wave == 0 && lane < 16) {
        int cntl = 0;
        for (int rl = 0; rl < RPB; ++rl) { const v4u rec = *(const LAS v4u*)(F.lds + REC_OFF + rl * 16);
            if ((int)rec.x == lane) { *(LAS int*)(F.lds + LRK_OFF + rl * 8) = cntl; ++cntl; }
            if ((int)rec.y == lane) { *(LAS int*)(F.lds + LRK_OFF + rl * 8 + 4) = cntl; ++cntl; } }
        const unsigned base = __hip_atomic_fetch_add((unsigned*)(F.ctl + CW_CNT + (L * 16 + lane) * 64), (unsigned)cntl, RLX_AGENT);
        *(LAS int*)(F.lds + BASE_OFF + lane * 4) = (int)base;
    }
    __syncthreads();
    int* perm2 = (int*)(F.ws + WS_PERM); v2u* slot = (v2u*)(F.ws + WS_SLOT);
    for (int idx = tid; idx < RPB * 2; idx += NTHR) { const int rl = idx >> 1, k = idx & 1; const v4u rec = *(const LAS v4u*)(F.lds + REC_OFF + rl * 16);
        const int e = k ? (int)rec.y : (int)rec.x; const unsigned wb = k ? rec.w : rec.z;
        const int rank = *(const LAS int*)(F.lds + BASE_OFF + e * 4) + *(const LAS int*)(F.lds + LRK_OFF + rl * 8 + k * 4);
        const int m = m0 + rl;
        perm2[(size_t)e * MT + rank] = m;
        slot[(size_t)m * 2 + k] = (v2u){((unsigned)e << 24) | (unsigned)rank, wb}; }
    __syncthreads();
}

__device__ __forceinline__ void moe_setup(const Frame& F, int L) {
    const int tid = F.tid();
    if (tid < 16) F.MISC[40 + tid] = __hip_atomic_load((unsigned*)(F.ctl + CW_CNT + (L * 16 + tid) * 64), RLX_AGENT);
    __syncthreads();
    if (tid == 0) { unsigned p = 0; for (int e = 0; e < 16; ++e) { F.MISC[16 + e] = p; p += (F.MISC[40 + e] + 255u) >> 8; } F.MISC[32] = p; }
    __syncthreads();
}
__device__ __forceinline__ void moe_stage_perm(const Frame& F) {
    const int* perm2 = (const int*)(F.ws + WS_PERM); LAS int* permL = (LAS int*)(F.lds + PERML_OFF);
    const int ntile = (int)F.MISC[32], tid = F.tid();
    for (int i = 0; i < 8; ++i) { const int Lu = i * F.G + F.bid; if (Lu >= 4 * ntile) break;
        const int rt = Lu >> 2; int e = 0;
        for (int j = 1; j < 16; ++j) e += (rt >= (int)F.MISC[16 + j]) ? 1 : 0;
        if (tid < 256) { const int rank = (rt - (int)F.MISC[16 + e]) * 256 + tid; permL[i * 256 + tid] = (rank < (int)F.MISC[40 + e]) ? perm2[(size_t)e * MT + rank] : 0; } }
    __syncthreads();
}

template <int L>
__device__ __forceinline__ void p_epost(const Frame& F) {
    constexpr int NROWS = (L == 0) ? MT : NLAT, RPB = NROWS / 256;
    const bf16* FB = (const bf16*)(F.ws + WS_D2); bf16* H = (bf16*)(F.ws + WS_A);
    float* XC = (float*)(F.ws + WS_XC); const v2u* slot = (const v2u*)(F.ws + WS_SLOT);
    const int lane = F.lane(), m0 = F.bid * RPB;
    int rc = -1; f32x4 ga[4], gp[4], gs[4], sh[4];
    for (int rl = F.wave; rl < RPB; rl += NWAVES) {
        const int m = m0 + rl, r = row_batch(m);
        if (r != rc) { ld_mod(F, L, r, 5, ga); ld_row_f32(F.g_ffn_post + L * D, lane, gp);
            if (L == 0) { f32x4 g[4], sc[4]; ld_row_f32(F.g_mix_pre + D, lane, g); ld_mod(F, 1, r, 1, sc); ld_mod(F, 1, r, 0, sh);
#pragma unroll
                for (int j = 0; j < 4; ++j) gs[j] = g[j] * (sc[j] + 1.0f); }
            rc = r; }
        const v2u s0 = slot[(size_t)m * 2], s1 = slot[(size_t)m * 2 + 1];
        const int e0 = (int)(s0.x >> 24), e1 = (int)(s1.x >> 24);
        const size_t v0 = (size_t)F.MISC[16 + e0] * 256 + (s0.x & 0xffffffu), v1 = (size_t)F.MISC[16 + e1] * 256 + (s1.x & 0xffffffu);
        const unsigned wb0 = s0.y, wb1 = s1.y;
        const float w0 = __uint_as_float(wb0), w1 = __uint_as_float(wb1);
        f32x4 f0[4], f1[4], xv[4];
        ld_row_bf16(FB + v0 * D, lane, f0); ld_row_bf16(FB + v1 * D, lane, f1);
        float* xp = m < NLAT ? F.out + (size_t)m * D : XC + (size_t)(m - NLAT) * D;
        ld_row_f32(xp, lane, xv);
#pragma unroll
        for (int j = 0; j < 4; ++j) f0[j] = (DBG_SLOT == 1) ? f0[j] : (DBG_SLOT == 2) ? f1[j] : (DBG_SLOT == 3) ? f0[j] * 0.5f + f1[j] * 0.5f : f0[j] * w0 + f1[j] * w1;
        const float rstdf = 1.0f / sqrtf(wave_sum(sumsq4(f0)) * (1.0f / D) + EPS);
#pragma unroll
        for (int j = 0; j < 4; ++j) xv[j] = xv[j] + ga[j] * (f0[j] * rstdf * gp[j]) * (((DBG_SKIP >> (2 * L + 1)) & 1) ? 0.f : 1.f);
        st_row_f32(xp, lane, xv);
        if (L == 0) {
            const float rstd2 = 1.0f / sqrtf(wave_sum(sumsq4(xv)) * (1.0f / D) + EPS);
#pragma unroll
            for (int j = 0; j < 4; ++j) xv[j] = xv[j] * rstd2 * gs[j] + sh[j];
            st_row_bf16(H + (size_t)m * D, lane, xv);
        }
    }
}

__device__ __forceinline__ void p10_attn(const Frame& F) {
    const bf16* Qh = (const bf16*)(F.ws + WS_B); const bf16* Kh = (const bf16*)(F.ws + WS_C); const bf16* Vb = (const bf16*)(F.ws + WS_D2); bf16* O = (bf16*)(F.ws + WS_A);
    LAS float* rpbL = (LAS float*)F.lds;
    for (int idx = F.tid(); idx < NH * 15 * 31; idx += NTHR) rpbL[idx] = F.attn_rpb[idx];
    __syncthreads();
    const int lane = F.lane(), qi = lane & 15, q4 = lane >> 4;
    const int per = (BATCH * NH * GROWS * 4) / F.G;
    for (int it = 0; it < per; it += NWAVES) {
        const int wu = F.bid * per + it + F.wave;
        const int seg = wu & 3, r = (wu >> 2) & 63, bh = wu >> 8, h = bh & 15, b = bh >> 4;
        const int r0 = min(max(r - WINH / 2, 0), GROWS - WINH);
        const int cb = (seg == 0) ? 0 : (seg == 1) ? 8 : (seg == 2) ? 24 : 32;
        const int qc = 16 * seg + qi, cs = min(max(qc - WINW / 2, 0), GRIDW - WINW);
        const bf16* Qp = Qh + ((size_t)bh * SEQ + r * GRIDW + qc) * HD;
        const bf16x8 qf0 = *(const bf16x8*)(Qp + 8 * q4), qf1 = *(const bf16x8*)(Qp + 32 + 8 * q4);
        const bf16* Kbh = Kh + (size_t)bh * KSLOT * HD; const bf16* Vbh = Vb + (size_t)bh * (KSLOT / 8) * 512;
        float mrun = -1.0e30f, lsum = 0.f;
        f32x4 o[4];
#pragma unroll
        for (int db = 0; db < 4; ++db) o[db] = (f32x4){0.f, 0.f, 0.f, 0.f};
#pragma unroll
        for (int grp = 0; grp < 4; ++grp) {
            f32x4 s[8];
#pragma unroll
            for (int bb = 0; bb < 4; ++bb) {
                const int blk = 4 * grp + bb;
                const int keybase = (blk < 8) ? (r0 + blk) * GRIDW + cb : SEQ + 32 * (blk - 8);
#pragma unroll
                for (int tl = 0; tl < 2; ++tl) {
                    const bf16* kp = Kbh + (size_t)(keybase + 8 * (qi >> 2) + 4 * tl + (qi & 3)) * HD;
                    const bf16x8 kf0 = *(const bf16x8*)(kp + 8 * q4), kf1 = *(const bf16x8*)(kp + 32 + 8 * q4);
                    f32x4 acc = (f32x4){0.f, 0.f, 0.f, 0.f};
                    acc = __builtin_amdgcn_mfma_f32_16x16x32_bf16(kf0, qf0, acc, 0, 0, 0);
                    acc = __builtin_amdgcn_mfma_f32_16x16x32_bf16(kf1, qf1, acc, 0, 0, 0);
                    if (blk < 8) {
                        const int ri = (r0 + blk) - r + (WINH - 1);
#pragma unroll
                        for (int i = 0; i < 4; ++i) { const int kc = cb + 8 * q4 + 4 * tl + i; const bool ok = (kc >= cs) && (kc < cs + WINW);
                            const int ci = min(max(kc - qc + (WINW - 1), 0), 2 * WINW - 2);
                            const float bias = rpbL[h * 465 + ri * 31 + ci];
                            acc[i] = ok ? acc[i] * 0.125f + bias : -1.0e30f; }
                    } else {
#pragma unroll
                        for (int i = 0; i < 4; ++i) acc[i] = acc[i] * 0.125f;
                    }
                    s[2 * bb + tl] = acc;
                }
            }
            float mx = mrun;
#pragma unroll
            for (int t = 0; t < 8; ++t) mx = fmaxf(fmaxf(mx, fmaxf(s[t][0], s[t][1])), fmaxf(s[t][2], s[t][3]));
            mx = fmaxf(mx, __shfl_xor(mx, 16)); mx = fmaxf(mx, __shfl_xor(mx, 32));
            const float alpha = __builtin_amdgcn_exp2f((mrun - mx) * 1.4426950408889634f);
            mrun = mx; lsum *= alpha;
#pragma unroll
            for (int db = 0; db < 4; ++db) o[db] = o[db] * alpha;
#pragma unroll
            for (int t = 0; t < 8; ++t)
#pragma unroll
                for (int i = 0; i < 4; ++i) { const float p = __builtin_amdgcn_exp2f((s[t][i] - mx) * 1.4426950408889634f); s[t][i] = p; lsum += p; }
#pragma unroll
            for (int bb = 0; bb < 4; ++bb) {
                const int blk = 4 * grp + bb;
                const int keybase = (blk < 8) ? (r0 + blk) * GRIDW + cb : SEQ + 32 * (blk - 8);
                v4u pw; pw.x = pk2(s[2 * bb][0], s[2 * bb][1]); pw.y = pk2(s[2 * bb][2], s[2 * bb][3]); pw.z = pk2(s[2 * bb + 1][0], s[2 * bb + 1][1]); pw.w = pk2(s[2 * bb + 1][2], s[2 * bb + 1][3]);
                const bf16x8 pf = __builtin_bit_cast(bf16x8, pw);
                const bf16* vp = Vbh + (size_t)((keybase >> 3) + q4) * 512 + qi * 8;
#pragma unroll
                for (int db = 0; db < 4; ++db) { const bf16x8 vf = *(const bf16x8*)(vp + db * 128);
                    o[db] = __builtin_amdgcn_mfma_f32_16x16x32_bf16(vf, pf, o[db], 0, 0, 0); }
            }
        }
        float sum = lsum; sum += __shfl_xor(sum, 16); sum += __shfl_xor(sum, 32);
        const float inv = 1.0f / sum;
        bf16* op = O + ((size_t)b * SEQ + r * GRIDW + qc) * D + h * HD + 4 * q4;
#pragma unroll
        for (int db = 0; db < 4; ++db) { v2u w; w.x = pk2(o[db][0] * inv, o[db][1] * inv); w.y = pk2(o[db][2] * inv, o[db][3] * inv); *(v2u*)(op + db * 16) = w; }
    }
    __syncthreads();
}

#ifndef MK_N_LAUNCHES
#define MK_N_LAUNCHES 1
#endif
constexpr int N_PHASES = 16;
constexpr int N_LAUNCHES = MK_N_LAUNCHES;
struct Args { const float* in[26]; float* out; unsigned char* ws; int ph_lo, ph_hi; };

__global__ void __launch_bounds__(NTHR, 2) fwd_kernel(Args args) {
    extern __shared__ __attribute__((aligned(16))) unsigned char lds[];
    Frame F;
    F.lds = (LAS unsigned char*)lds;
    F.MISC = (volatile LAS unsigned*)(F.lds + MISC_OFF);
    F.wave = __builtin_amdgcn_readfirstlane((int)threadIdx.x >> 6);
    F.G = gridDim.x; F.bid = blockIdx.x;
    F.ws = args.ws; F.ctl = (gu32*)(args.ws + WS_CTL); F.out = args.out;
    F.x = args.in[0]; F.c = args.in[1]; F.ctx = args.in[2]; F.c_ctx = args.in[3]; F.w_ada = args.in[4]; F.b_ada = args.in[5];
    F.g_mix_pre = args.in[6]; F.g_mix_post = args.in[7]; F.g_ffn_pre = args.in[8]; F.g_ffn_post = args.in[9];
    F.conv_w_in = args.in[10]; F.conv_b_in = args.in[11]; F.conv_w_dw = args.in[12]; F.conv_b_dw = args.in[13]; F.conv_ln_g = args.in[14]; F.conv_ln_b = args.in[15];
    F.conv_w_out = args.in[16]; F.conv_b_out = args.in[17]; F.attn_w_qkv = args.in[18]; F.attn_w_o = args.in[19]; F.attn_rpb = args.in[20];
    F.router_w = args.in[21]; F.router_b = args.in[22]; F.exp_w_gate = args.in[23]; F.exp_w_up = args.in[24]; F.exp_w_down = args.in[25];
    for (int u = threadIdx.x; u < 256; u += NTHR) F.MISC[u] = 0u;
    __syncthreads();
    XcdBarrier bar; bar.bar = (unsigned*)(F.ctl + CW_BAR); bar.x = 0; bar.st = nullptr;
    if (N_LAUNCHES == 1) bar = xcd_barrier_post((unsigned*)(F.ctl + CW_BAR), F.MISC + 8);
    const int lo = args.ph_lo, hi = args.ph_hi;
#ifndef PHASE_MASK
#define PHASE_MASK 0xFFFF
#endif
#define IN(k) ((((PHASE_MASK) >> (k)) & 1) && lo <= (k) && (k) < hi)
#define SEAM(k) do { if (IN(k) && IN((k) + 1)) xcd_barrier(bar); } while (0)
    const char* wsb = (const char*)F.ws;
    LAS unsigned char* ring = F.lds;

    if (IN(0)) p0_prologue(F);
    SEAM(0);
    if (IN(1)) p1_modulate(F);
    SEAM(1);
    if (IN(2)) {
        pg8::DenseSched S{wsb + WS_A, wsb + WS_WIN, D, MT / 256, 8, F.G, F.bid};
        pg8::EpiGated<0> E{(bf16*)(F.ws + WS_B), D, F.conv_b_in, D};
        pg8::gemm_phase<pg8::EpiGated<0>, pg8::DenseSched, true>(ring, D, S, E, F.wave);
    }
    SEAM(2);
    if (IN(3)) p3_conv(F);
    SEAM(3);
    if (IN(4)) {
        pg8::DenseSched S{wsb + WS_A, wsb + WS_WOUT, D, MT / 256, 4, F.G, F.bid};
        pg8::EpiBf16 E{(bf16*)(F.ws + WS_B), D, F.conv_b_out};
        pg8::gemm_phase<pg8::EpiBf16, pg8::DenseSched, true>(ring, D, S, E, F.wave);
    }
    SEAM(4);
    if (IN(5)) p_emid<0>(F);
    SEAM(5);
    if (IN(6)) {
        moe_setup(F, 0); moe_stage_perm(F);
        pg8::MoeUpSched S; S.tpre = (const volatile LAS int*)(F.MISC + 16); S.G = F.G; S.c = F.bid; S.A = wsb + WS_A; S.Wgu = wsb + WS_WGU; S.permL = (const LAS int*)(F.lds + PERML_OFF);
        pg8::EpiGated<1> E{(bf16*)(F.ws + WS_C), DE, nullptr, 0};
        pg8::gemm_phase<pg8::EpiGated<1>, pg8::MoeUpSched, true>(ring, D, S, E, F.wave);
    }
    SEAM(6);
    if (IN(7)) {
        moe_setup(F, 0);
        pg8::MoeDownSched S; S.tpre = (const volatile LAS int*)(F.MISC + 16); S.G = F.G; S.c = F.bid; S.A = wsb + WS_C; S.Wdn = wsb + WS_WDN;
        pg8::EpiBf16 E{(bf16*)(F.ws + WS_D2), D, nullptr};
        pg8::gemm_phase<pg8::EpiBf16, pg8::MoeDownSched, true>(ring, DE, S, E, F.wave);
    }
    SEAM(7);
    if (IN(8)) { moe_setup(F, 0); p_epost<0>(F); }
    SEAM(8);
    if (IN(9)) {
        pg8::QkvSched S{wsb + WS_A, wsb + WS_WQKV, F.G, F.bid};
        pg8::EpiQkv E{(bf16*)(F.ws + WS_B), (bf16*)(F.ws + WS_C), (bf16*)(F.ws + WS_D2)};
        pg8::gemm_phase<pg8::EpiQkv, pg8::QkvSched, true>(ring, D, S, E, F.wave);
    }
    SEAM(9);
    if (IN(10)) p10_attn(F);
    SEAM(10);
    if (IN(11)) {
        pg8::DenseSched S{wsb + WS_A, wsb + WS_WO, D, NLAT / 256, 4, F.G, F.bid};
        pg8::EpiBf16 E{(bf16*)(F.ws + WS_B), D, nullptr};
        pg8::gemm_phase<pg8::EpiBf16, pg8::DenseSched, true>(ring, D, S, E, F.wave);
    }
    SEAM(11);
    if (IN(12)) p_emid<1>(F);
    SEAM(12);
    if (IN(13)) {
        moe_setup(F, 1); moe_stage_perm(F);
        pg8::MoeUpSched S; S.tpre = (const volatile LAS int*)(F.MISC + 16); S.G = F.G; S.c = F.bid; S.A = wsb + WS_A; S.Wgu = wsb + WS_WGU + (size_t)16 * 1024 * 1024 * 2; S.permL = (const LAS int*)(F.lds + PERML_OFF);
        pg8::EpiGated<1> E{(bf16*)(F.ws + WS_C), DE, nullptr, 0};
        pg8::gemm_phase<pg8::EpiGated<1>, pg8::MoeUpSched, true>(ring, D, S, E, F.wave);
    }
    SEAM(13);
    if (IN(14)) {
        moe_setup(F, 1);
        pg8::MoeDownSched S; S.tpre = (const volatile LAS int*)(F.MISC + 16); S.G = F.G; S.c = F.bid; S.A = wsb + WS_C; S.Wdn = wsb + WS_WDN + (size_t)16 * 1024 * 512 * 2;
        pg8::EpiBf16 E{(bf16*)(F.ws + WS_D2), D, nullptr};
        pg8::gemm_phase<pg8::EpiBf16, pg8::MoeDownSched, true>(ring, DE, S, E, F.wave);
    }
    SEAM(14);
    if (IN(15)) { moe_setup(F, 1); p_epost<1>(F); }
#undef IN
#undef SEAM
}

extern "C" void kernel_launch(void* const* d_in, const int* in_sizes, int n_in, void* d_out, int out_size, void* d_ws, size_t ws_size, hipStream_t stream) {
    static int grid = 0;
    if (grid == 0) {
        if (n_in != 26 || in_sizes[0] != NLAT * D || out_size != NLAT * D || ws_size < WS_END) { fprintf(stderr, "kernel_launch: unexpected shapes (n_in %d, in0 %d, out %d, ws %zu); nothing launched\n", n_in, n_in > 0 ? in_sizes[0] : -1, out_size, ws_size); grid = -1; return; }
        if (hipFuncSetAttribute((const void*)fwd_kernel, hipFuncAttributeMaxDynamicSharedMemorySize, LDS_BYTES) != hipSuccess) { fprintf(stderr, "kernel_launch: hipFuncSetAttribute failed\n"); grid = -1; return; }
        int per_cu = 0;
        if (hipOccupancyMaxActiveBlocksPerMultiprocessor(&per_cu, (const void*)fwd_kernel, NTHR, LDS_BYTES) != hipSuccess || per_cu < 1) fprintf(stderr, "kernel_launch: note: occupancy query reports %d workgroups per CU\n", per_cu);
        (void)hipGetLastError();
        grid = 256;
    }
    if (grid < 0) return;
    if (hipMemsetAsync((char*)d_ws + WS_CTL, 0, CTL_ZERO_BYTES, stream) != hipSuccess) { fprintf(stderr, "kernel_launch: hipMemsetAsync failed\n"); return; }
    Args a{};
    for (int i = 0; i < 26; ++i) a.in[i] = (const float*)d_in[i];
    a.out = (float*)d_out; a.ws = (unsigned char*)d_ws;
    for (int li = 0; li < N_LAUNCHES; ++li) {
        a.ph_lo = (N_LAUNCHES == 1) ? 0 : li; a.ph_hi = (N_LAUNCHES == 1) ? N_PHASES : li + 1;
        hipLaunchKernelGGL(fwd_kernel, dim3(grid), dim3(NTHR), LDS_BYTES, stream, a);
        const hipError_t le = hipPeekAtLastError();
        if (le != hipSuccess) { fprintf(stderr, "kernel_launch: launch %d failed: %s\n", li, hipGetErrorName(le)); break; }
    }
}
```

```cpp
#include <hip/hip_runtime.h>
#include <cstdio>
#include <cstdint>

#ifndef PROBE_MASK
#define PROBE_MASK 0
#endif
#define REP(k) ((((PROBE_MASK) >> (k)) & 1) ? 2 : 1)
#ifndef DBG_SLOT
#define DBG_SLOT 0
#endif
#ifndef DBG_SKIP
#define DBG_SKIP 0
#endif
constexpr int D = 1024, BATCH = 8, SEQ = 4096, CTXL = 256;
constexpr int NLAT = BATCH * SEQ, NCTX = BATCH * CTXL, MT = NLAT + NCTX;
constexpr int NE = 16, DE = 512, NH = 16, HD = 64, GRIDW = 64, GROWS = 64, WINH = 8, WINW = 16, CONVW = 31;
constexpr int KSLOT = SEQ + CTXL;
constexpr int NMODR = 9, NMODC = 6 * D;
constexpr int MODKC = 8;
constexpr float EPS = 1e-6f;
constexpr int NWAVES = 8, NTHR = NWAVES * 64;

constexpr size_t MiB = 1u << 20;
constexpr size_t WS_CTL = 0, CTL_ZERO_BYTES = 1 * MiB;
constexpr size_t WS_SLOT = 1 * MiB;
constexpr size_t WS_PERM = 2 * MiB;
constexpr size_t WS_MODP = 5 * MiB;
constexpr size_t WS_XC = 9 * MiB;
constexpr size_t WS_WIN = 18 * MiB, WS_WOUT = 22 * MiB, WS_WQKV = 24 * MiB, WS_WO = 30 * MiB;
constexpr size_t WS_WGU = 32 * MiB;
constexpr size_t WS_WDN = 96 * MiB;
constexpr size_t WS_A = 128 * MiB, WS_B = 196 * MiB, WS_C = 264 * MiB, WS_D2 = 336 * MiB, WS_END = 480 * MiB;
constexpr int CW_BAR = 4096;
constexpr int CW_CNT = 8192;

constexpr int RING_BYTES = 131072;
constexpr int MISC_OFF = RING_BYTES;
constexpr int PTAB_OFF = RING_BYTES + 1024 + 8192;
constexpr int PERML_OFF = RING_BYTES + 1024;
constexpr int LDS_BYTES = 147456;

#define GAS __attribute__((address_space(1)))
#define LAS __attribute__((address_space(3)))
typedef unsigned short bf16;
typedef unsigned v4u __attribute__((ext_vector_type(4)));
typedef unsigned v2u __attribute__((ext_vector_type(2)));
typedef float f32x4 __attribute__((ext_vector_type(4)));
typedef float f32x2 __attribute__((ext_vector_type(2)));
typedef short bf16x8 __attribute__((ext_vector_type(8)));
typedef GAS unsigned gu32;
#define RLX_AGENT __ATOMIC_RELAXED, __HIP_MEMORY_SCOPE_AGENT
#define LDS_WAIT() asm volatile("s_waitcnt lgkmcnt(0)" ::: "memory")
#define VM_WAIT() asm volatile("s_waitcnt vmcnt(0)" ::: "memory")

__device__ __forceinline__ unsigned f2bf(float f) { unsigned u = __builtin_bit_cast(unsigned, f); return (u + 0x7fffu + ((u >> 16) & 1u)) >> 16; }
__device__ __forceinline__ unsigned pk2(float lo, float hi) { return f2bf(lo) | (f2bf(hi) << 16); }
__device__ __forceinline__ float bflo(unsigned w) { return __builtin_bit_cast(float, w << 16); }
__device__ __forceinline__ float bfhi(unsigned w) { return __builtin_bit_cast(float, w & 0xffff0000u); }
__device__ __forceinline__ float row16_sum(float v) {
    v += __builtin_bit_cast(float, __builtin_amdgcn_update_dpp(0, __builtin_bit_cast(int, v), 0xB1, 0xF, 0xF, false));
    v += __builtin_bit_cast(float, __builtin_amdgcn_update_dpp(0, __builtin_bit_cast(int, v), 0x4E, 0xF, 0xF, false));
    v += __builtin_bit_cast(float, __builtin_amdgcn_update_dpp(0, __builtin_bit_cast(int, v), 0x141, 0xF, 0xF, false));
    v += __builtin_bit_cast(float, __builtin_amdgcn_update_dpp(0, __builtin_bit_cast(int, v), 0x140, 0xF, 0xF, false));
    return v;
}
__device__ __forceinline__ float rdlane(float v, int l) { return __builtin_bit_cast(float, __builtin_amdgcn_readlane(__builtin_bit_cast(int, v), l)); }
__device__ __forceinline__ float wave_sum(float v) {
    v = row16_sum(v);
    return (rdlane(v, 0) + rdlane(v, 16)) + (rdlane(v, 32) + rdlane(v, 48));
}
__device__ __forceinline__ int lane_id_asm() { int l; asm volatile("v_mbcnt_lo_u32_b32 %0, -1, 0\n\tv_mbcnt_hi_u32_b32 %0, -1, %0" : "=v"(l)); return l; }
__device__ __forceinline__ float fast_sigmoid(float x) { return __builtin_amdgcn_rcpf(1.0f + __builtin_amdgcn_exp2f(-1.4426950408889634f * x)); }

namespace pg8 {
#define PG8_LAS __attribute__((address_space(3)))
typedef unsigned short bf16_t;
typedef short bf16x8 __attribute__((ext_vector_type(8)));
typedef float f32x4 __attribute__((ext_vector_type(4)));
typedef unsigned u32x4 __attribute__((ext_vector_type(4)));
constexpr int BM = 256, BK = 64, HALF = 128, HTB = HALF * BK * 2, STAGE_BYTES = 8 * HTB, NXCD = 8, WGM = 8;

__host__ __device__ __forceinline__ int lds_byte(int r, int c) { const int st = (r >> 4) * 2 + (c >> 5), rr = r & 15, cc = c & 31, ob = rr * 64 + cc * 2; return st * 1024 + (ob ^ (((ob >> 9) & 1) << 5)); }
__host__ __device__ __forceinline__ void stage_rc(int b, int& R, int& C) { const int st = b / 1024, sb = b % 1024, swz = sb ^ (((sb >> 9) & 1) << 5); R = (st >> 1) * 16 + swz / 64; C = (st & 1) * 32 + (swz % 64) / 2; }
__host__ __device__ __forceinline__ int perm32(int rho) { const int n = rho >> 4, i = rho & 15; return 8 * (i >> 2) + 4 * n + (i & 3); }

struct Unit { int pm, pn; const char* a; const char* b; int li; int ex; };

__device__ __forceinline__ bool static_order(int L, int nM, int nN, int& pm, int& pn) {
    const int nwg = nM * nN; if (L >= nwg) return false;
    int wgid = L; { const int q = nwg / NXCD, r = nwg % NXCD, xcd = wgid % NXCD, off = wgid / NXCD; wgid = (xcd < r ? xcd * (q + 1) : r * (q + 1) + (xcd - r) * q) + off; }
    const int nig = WGM * nN, gid = wgid / nig, fm = gid * WGM, gsz = (nM - fm) < WGM ? (nM - fm) : WGM;
    pm = fm + ((wgid % nig) % gsz); pn = (wgid % nig) / gsz; return true;
}

__device__ __forceinline__ unsigned cvt_pk_bf16(float lo, float hi) { unsigned r; asm volatile("v_cvt_pk_bf16_f32 %0, %1, %2" : "=v"(r) : "v"(lo), "v"(hi)); return r; }

template <class Epi, class Sched, bool ALIGN_EPI>
__device__ __forceinline__ void gemm_phase(PG8_LAS unsigned char* lds, const int K, const Sched& S, const Epi& E, const int wid) {
    const int lane = lane_id_asm(), tid = wid * 64 + lane, wr = wid >> 2, wc = wid & 3, fr = lane & 15, fq = lane >> 4;
    const int nt = K / BK;
    int R[2], C[2]; unsigned voffB[2], vA[2][2];
    const size_t kstep = (size_t)(BK * 2);
    const size_t hstep = (size_t)HALF * K * 2;
#pragma unroll
    for (int i = 0; i < 2; ++i) { stage_rc(tid * 16 + i * 8192, R[i], C[i]); const int Rb = Epi::PERM ? ((R[i] & ~31) + perm32(R[i] & 31)) : R[i];
        voffB[i] = (unsigned)(Rb * K + C[i]) * 2u; vA[0][i] = (unsigned)(R[i] * K + C[i]) * 2u; vA[1][i] = vA[0][i] + (unsigned)hstep; }
    const unsigned ldsw = (unsigned)wid * 1024u;
    const int aoff = lds_byte(wr * 64 + fr, fq * 8), boff = lds_byte(wc * 32 + fr, fq * 8);
#define PG8_SA(b, h) (((b) * 2 + (h)) * HTB)
#define PG8_SB(b, h) ((4 + (b) * 2 + (h)) * HTB)
#define PG8_STAGE(bufoff, gbase, voff) do { _Pragma("unroll") for (int _i = 0; _i < 2; ++_i) \
        __builtin_amdgcn_global_load_lds((const unsigned*)((const char*)(gbase) + (voff)[_i]), (PG8_LAS unsigned*)(lds + (bufoff) + ldsw + _i * 8192), 16, 0, 0); } while (0)
#define PG8_LDA(dst, b, h) do { _Pragma("unroll") for (int m = 0; m < 4; ++m) _Pragma("unroll") for (int k = 0; k < 2; ++k) dst[m][k] = *(const PG8_LAS bf16x8*)(lds + PG8_SA(b, h) + aoff + m * 2048 + k * 1024); } while (0)
#define PG8_LDB(dst, b, h) do { _Pragma("unroll") for (int n = 0; n < 2; ++n) _Pragma("unroll") for (int k = 0; k < 2; ++k) dst[n][k] = *(const PG8_LAS bf16x8*)(lds + PG8_SB(b, h) + boff + n * 2048 + k * 1024); } while (0)
#define PG8_MMA(ai, bj, At, Bt) do { __builtin_amdgcn_s_setprio(1); _Pragma("unroll") for (int m = 0; m < 4; ++m) _Pragma("unroll") for (int n = 0; n < 2; ++n) _Pragma("unroll") for (int k = 0; k < 2; ++k) \
        acc[ai][bj][m][n] = __builtin_amdgcn_mfma_f32_16x16x32_bf16(Bt[n][k], At[m][k], acc[ai][bj][m][n], 0, 0, 0); __builtin_amdgcn_s_setprio(0); } while (0)
#define PG8_WAIT_V(n) asm volatile("s_waitcnt vmcnt(" #n ")" ::: "memory")
#define PG8_WAIT_L(n) asm volatile("s_waitcnt lgkmcnt(" #n ")" ::: "memory")
#define PG8_BAR __builtin_amdgcn_s_barrier()
#define PG8_SCHED __builtin_amdgcn_sched_barrier(0)
    Unit cur, nxt; int ui = 0;
    if (!S.next(0, cur)) return;
    if constexpr (Sched::GATHER) S.a_offsets(cur, R, C, K, vA);
    f32x4 acc[2][2][4][2];
#pragma unroll
    for (int a = 0; a < 2; ++a)
#pragma unroll
        for (int b = 0; b < 2; ++b)
#pragma unroll
            for (int m = 0; m < 4; ++m)
#pragma unroll
                for (int n = 0; n < 2; ++n) acc[a][b][m][n] = (f32x4){0.f, 0.f, 0.f, 0.f};
    bf16x8 At[4][2], B0[2][2], B1[2][2];
    const char* cA = cur.a; const char* cB = cur.b;
    PG8_STAGE(PG8_SB(0, 0), cB, voffB); PG8_STAGE(PG8_SB(0, 1), cB + hstep, voffB); PG8_STAGE(PG8_SA(0, 0), cA, vA[0]); PG8_STAGE(PG8_SA(0, 1), cA, vA[1]);
    if (wr == 1) PG8_BAR;
    PG8_WAIT_V(2); PG8_BAR;
    PG8_STAGE(PG8_SB(1, 0), cB + kstep, voffB); PG8_STAGE(PG8_SA(1, 0), cA + kstep, vA[0]); PG8_STAGE(PG8_SB(1, 1), cB + hstep + kstep, voffB);
    PG8_WAIT_V(6); PG8_BAR;
    for (;;) {
        const bool has_next = S.next(ui + 1, nxt);
        const char* nA = has_next ? nxt.a : cA; const char* nB = has_next ? nxt.b : cB;
        for (int t = 0; t < nt; t += 2) {
            const bool last = (t == nt - 2);
            const char* a1 = cA + (size_t)(t + 1) * kstep;
            const char* a2 = last ? nA : cA + (size_t)(t + 2) * kstep; const char* b2 = last ? nB : cB + (size_t)(t + 2) * kstep;
            const char* a3 = a2 + kstep; const char* b3 = b2 + kstep;
            PG8_LDB(B0, 0, 0); PG8_LDB(B1, 0, 1); PG8_SCHED; PG8_LDA(At, 0, 0); PG8_STAGE(PG8_SA(1, 1), a1, vA[1]);
            if constexpr (Sched::GATHER) { if (last && has_next) S.a_offsets(nxt, R, C, K, vA); }
            PG8_WAIT_V(8); PG8_WAIT_L(0); PG8_BAR; PG8_MMA(0, 0, At, B0); PG8_MMA(0, 1, At, B1); PG8_BAR; PG8_SCHED;
            PG8_LDA(At, 0, 1); PG8_STAGE(PG8_SB(0, 0), b2, voffB); PG8_STAGE(PG8_SB(0, 1), b2 + hstep, voffB); PG8_STAGE(PG8_SA(0, 0), a2, vA[0]);
            PG8_WAIT_V(8); PG8_WAIT_L(0); PG8_BAR; PG8_MMA(1, 0, At, B0); PG8_MMA(1, 1, At, B1); PG8_BAR; PG8_SCHED;
            PG8_LDB(B0, 1, 0); PG8_LDB(B1, 1, 1); PG8_SCHED; PG8_LDA(At, 1, 0); PG8_STAGE(PG8_SA(0, 1), a2, vA[1]);
            PG8_WAIT_V(8); PG8_WAIT_L(0); PG8_BAR; PG8_MMA(0, 0, At, B0); PG8_MMA(0, 1, At, B1); PG8_BAR; PG8_SCHED;
            PG8_LDA(At, 1, 1); PG8_STAGE(PG8_SB(1, 0), b3, voffB); PG8_STAGE(PG8_SB(1, 1), b3 + hstep, voffB); PG8_STAGE(PG8_SA(1, 0), a3, vA[0]);
            PG8_WAIT_V(8); PG8_WAIT_L(0); PG8_BAR; PG8_MMA(1, 0, At, B0); PG8_MMA(1, 1, At, B1); PG8_BAR; PG8_SCHED;
        }
        if constexpr (ALIGN_EPI) { if (wr == 0) PG8_BAR; }
        E(acc, cur, wr, wc, fr, fq);
        if (!has_next) break;
#pragma unroll
        for (int a = 0; a < 2; ++a)
#pragma unroll
            for (int b = 0; b < 2; ++b)
#pragma unroll
                for (int m = 0; m < 4; ++m)
#pragma unroll
                    for (int n = 0; n < 2; ++n) acc[a][b][m][n] = (f32x4){0.f, 0.f, 0.f, 0.f};
        cur = nxt; cA = nA; cB = nB; ++ui;
        if constexpr (ALIGN_EPI) { if (wr == 1) PG8_BAR; }
    }
    PG8_WAIT_V(0);
    if constexpr (!ALIGN_EPI) { if (wr == 0) PG8_BAR; }
    PG8_BAR;
#undef PG8_SA
#undef PG8_SB
#undef PG8_STAGE
#undef PG8_LDA
#undef PG8_LDB
#undef PG8_MMA
#undef PG8_WAIT_V
#undef PG8_WAIT_L
#undef PG8_BAR
#undef PG8_SCHED
}

struct DenseSched {
    static constexpr bool GATHER = false;
    const char* A; const char* Bt; int K, nM, nN, G, c;
    __device__ __forceinline__ bool next(int i, Unit& u) const {
        int pm, pn; if (!static_order(i * G + c, nM, nN, pm, pn)) return false;
        u.pm = pm; u.pn = pn; u.a = A + (size_t)pm * BM * K * 2; u.b = Bt + (size_t)pn * BM * K * 2; u.li = i; u.ex = 0; return true;
    }
    __device__ __forceinline__ void a_offsets(const Unit&, const int (&)[2], const int (&)[2], int, unsigned (&)[2][2]) const {}
};
struct QkvSched {
    static constexpr bool GATHER = false;
    const char* A; const char* Bt; int G, c;
    __device__ __forceinline__ bool next(int i, Unit& u) const {
        const int L = i * G + c; int pm, pn;
        if (L < 1536) { static_order(L, 128, 12, pm, pn); }
        else { const int l2 = L - 1536; if (l2 >= 64) return false; pm = 128 + (l2 >> 3); pn = 4 + (l2 & 7); }
        u.pm = pm; u.pn = pn; u.a = A + (size_t)pm * BM * D * 2; u.b = Bt + (size_t)pn * BM * D * 2; u.li = i; u.ex = 0; return true;
    }
    __device__ __forceinline__ void a_offsets(const Unit&, const int (&)[2], const int (&)[2], int, unsigned (&)[2][2]) const {}
};
struct MoeSchedBase {
    const volatile PG8_LAS int* tpre;
    int G, c;
    __device__ __forceinline__ bool locate(int i, int& rt, int& pn, int& e) const {
        const int L = i * G + c; const int ntile = tpre[16];
        if (L >= 4 * ntile) return false;
        rt = L >> 2; pn = L & 3; int ee = 0;
#pragma unroll
        for (int j = 1; j < 16; ++j) ee += (rt >= tpre[j]) ? 1 : 0;
        e = ee; return true;
    }
};
struct MoeUpSched : MoeSchedBase {
    static constexpr bool GATHER = true;
    const char* A; const char* Wgu; const PG8_LAS int* permL;
    __device__ __forceinline__ bool next(int i, Unit& u) const {
        int rt, pn, e; if (!locate(i, rt, pn, e)) return false;
        u.pm = rt; u.pn = pn; u.a = A; u.b = Wgu + (size_t)e * (1024 * 1024 * 2) + (size_t)pn * BM * D * 2; u.li = i; u.ex = e; return true;
    }
    __device__ __forceinline__ void a_offsets(const Unit& u, const int (&R)[2], const int (&C)[2], int K, unsigned (&vA)[2][2]) const {
#pragma unroll
        for (int h = 0; h < 2; ++h)
#pragma unroll
            for (int i = 0; i < 2; ++i) vA[h][i] = (unsigned)permL[u.li * 256 + h * HALF + R[i]] * (unsigned)(K * 2) + (unsigned)(C[i] * 2);
    }
};
struct MoeDownSched : MoeSchedBase {
    static constexpr bool GATHER = false;
    const char* A; const char* Wdn;
    __device__ __forceinline__ bool next(int i, Unit& u) const {
        int rt, pn, e; if (!locate(i, rt, pn, e)) return false;
        u.pm = rt; u.pn = pn; u.a = A + (size_t)rt * BM * DE * 2; u.b = Wdn + (size_t)e * (1024 * 512 * 2) + (size_t)pn * BM * DE * 2; u.li = i; u.ex = e; return true;
    }
    __device__ __forceinline__ void a_offsets(const Unit&, const int (&)[2], const int (&)[2], int, unsigned (&)[2][2]) const {}
};

struct EpiBf16 {
    static constexpr bool PERM = true;
    bf16_t* O; int ldc; const float* bias;
    __device__ __forceinline__ void operator()(const f32x4 (&acc)[2][2][4][2], const Unit& u, int wr, int wc, int fr, int fq) const {
        const int row0 = u.pm * BM + wr * 64 + fr, col0 = u.pn * BM + wc * 32 + 8 * fq;
        f32x4 bv[2][2];
#pragma unroll
        for (int bj = 0; bj < 2; ++bj)
#pragma unroll
            for (int n = 0; n < 2; ++n) bv[bj][n] = bias ? *(const f32x4*)(bias + col0 + bj * HALF + 4 * n) : (f32x4){0.f, 0.f, 0.f, 0.f};
#pragma unroll
        for (int ai = 0; ai < 2; ++ai)
#pragma unroll
            for (int m = 0; m < 4; ++m) { bf16_t* rowp = O + (size_t)(row0 + ai * HALF + m * 16) * ldc + col0;
#pragma unroll
                for (int bj = 0; bj < 2; ++bj) { const f32x4 v0 = acc[ai][bj][m][0] + bv[bj][0], v1 = acc[ai][bj][m][1] + bv[bj][1];
                    u32x4 w; w.x = cvt_pk_bf16(v0[0], v0[1]); w.y = cvt_pk_bf16(v0[2], v0[3]); w.z = cvt_pk_bf16(v1[0], v1[1]); w.w = cvt_pk_bf16(v1[2], v1[3]);
                    *(u32x4*)(rowp + bj * HALF) = w; } }
    }
};
template <int MODE  > struct EpiGated {
    static constexpr bool PERM = true;
    bf16_t* O; int ldc; const float* bias; int nch;
    __device__ __forceinline__ void operator()(const f32x4 (&acc)[2][2][4][2], const Unit& u, int wr, int wc, int fr, int fq) const {
        const int row0 = u.pm * BM + wr * 64 + fr, ch0 = u.pn * HALF + wc * 32 + 8 * fq;
        f32x4 b0[2], b1[2];
#pragma unroll
        for (int n = 0; n < 2; ++n) { if (MODE == 0) { b0[n] = *(const f32x4*)(bias + ch0 + 4 * n); b1[n] = *(const f32x4*)(bias + nch + ch0 + 4 * n); } else { b0[n] = (f32x4){0.f, 0.f, 0.f, 0.f}; b1[n] = b0[n]; } }
#pragma unroll
        for (int ai = 0; ai < 2; ++ai)
#pragma unroll
            for (int m = 0; m < 4; ++m) { bf16_t* rowp = O + (size_t)(row0 + ai * HALF + m * 16) * ldc + ch0; float o[8];
#pragma unroll
                for (int n = 0; n < 2; ++n) { const f32x4 x0 = acc[ai][0][m][n] + b0[n], x1 = acc[ai][1][m][n] + b1[n];
#pragma unroll
                    for (int e = 0; e < 4; ++e) o[4 * n + e] = (MODE == 0) ? x0[e] * fast_sigmoid(x1[e]) : (x0[e] * fast_sigmoid(x0[e])) * x1[e]; }
                u32x4 w; w.x = cvt_pk_bf16(o[0], o[1]); w.y = cvt_pk_bf16(o[2], o[3]); w.z = cvt_pk_bf16(o[4], o[5]); w.w = cvt_pk_bf16(o[6], o[7]);
                *(u32x4*)rowp = w; }
    }
};
struct EpiQkv {
    static constexpr bool PERM = true;
    bf16_t* Q; bf16_t* Kh; bf16_t* Vb;
    __device__ __forceinline__ void operator()(const f32x4 (&acc)[2][2][4][2], const Unit& u, int wr, int wc, int fr, int fq) const {
        const int which = u.pn >> 2; const bool isctx = u.pm >= 128;
        const int b = isctx ? (u.pm - 128) : (u.pm >> 4);
        const int key0 = isctx ? SEQ : ((u.pm & 15) << 8);
        const int d0 = 32 * (wc & 1) + 8 * fq;
#pragma unroll
        for (int ai = 0; ai < 2; ++ai)
#pragma unroll
            for (int m = 0; m < 4; ++m) { const int key = key0 + ai * HALF + wr * 64 + m * 16 + fr;
#pragma unroll
                for (int bj = 0; bj < 2; ++bj) { const int h = 4 * (u.pn & 3) + 2 * bj + (wc >> 1); const f32x4 v0 = acc[ai][bj][m][0], v1 = acc[ai][bj][m][1];
                    if (which == 2) {
                        bf16_t* p = Vb + ((size_t)(b * NH + h) * (KSLOT / 8) + (key >> 3)) * 512 + (size_t)d0 * 8 + (key & 7);
                        const unsigned w0 = cvt_pk_bf16(v0[0], v0[1]), w1 = cvt_pk_bf16(v0[2], v0[3]), w2 = cvt_pk_bf16(v1[0], v1[1]), w3 = cvt_pk_bf16(v1[2], v1[3]);
                        p[0] = (bf16_t)w0; p[8] = (bf16_t)(w0 >> 16); p[16] = (bf16_t)w1; p[24] = (bf16_t)(w1 >> 16); p[32] = (bf16_t)w2; p[40] = (bf16_t)(w2 >> 16); p[48] = (bf16_t)w3; p[56] = (bf16_t)(w3 >> 16);
                    } else {
                        u32x4 w; w.x = cvt_pk_bf16(v0[0], v0[1]); w.y = cvt_pk_bf16(v0[2], v0[3]); w.z = cvt_pk_bf16(v1[0], v1[1]); w.w = cvt_pk_bf16(v1[2], v1[3]);
                        bf16_t* p = (which == 0) ? Q + ((size_t)(b * NH + h) * SEQ + key) * HD + d0 : Kh + ((size_t)(b * NH + h) * KSLOT + key) * HD + d0;
                        *(u32x4*)p = w;
                    } } }
    }
};
}
#define XB_TMO      128
#define XB_XCNT(j)  (256  + 64 * (j))
#define XB_XSUB(j)  (1280 + 64 * (j))
#define XB_XGEN(j)  (2304 + 64 * (j))
#define XB_TOP      3328
#define XB_TOPGEN   3392
#define XCD_BAR_WORDS 3456
#define XB_SPIN_CAP (1u << 18)

__device__ __forceinline__ unsigned xb_ld(unsigned* p)              { return __hip_atomic_load(p, __ATOMIC_RELAXED, __HIP_MEMORY_SCOPE_AGENT); }
__device__ __forceinline__ unsigned xb_add(unsigned* p, unsigned v) { return __hip_atomic_fetch_add(p, v, __ATOMIC_RELAXED, __HIP_MEMORY_SCOPE_AGENT); }
__device__ __forceinline__ unsigned xb_xcc_id() { return (unsigned)__builtin_amdgcn_s_getreg((3 << 11) | 20) & 0xFu; }
#define XB_SPIN(cond, bar) do { unsigned _sp = 0; while (cond) { __builtin_amdgcn_s_sleep(1); \
    if ((++_sp & 255u) == 0u) { if (xb_ld(&(bar)[XB_TMO])) break; if (_sp > XB_SPIN_CAP) { atomicAdd(&(bar)[XB_TMO], 1u); break; } } } } while (0)

struct XcdBarrier {
    unsigned* bar; unsigned x;
    volatile LAS unsigned* st;
};

__device__ __forceinline__ XcdBarrier xcd_barrier_post(unsigned* bar, volatile LAS unsigned* st) {
    XcdBarrier b; b.bar = bar; b.x = xb_xcc_id(); b.st = st;
    if (threadIdx.x == 0) (void)xb_add(&bar[XB_XCNT(b.x)], 1u);
    return b;
}
__device__ __forceinline__ void xcd_barrier_complete(unsigned* bar, unsigned x, unsigned& nloc, unsigned& nx) {
    const unsigned G = gridDim.x * gridDim.y * gridDim.z;
    unsigned sum, cnt, mine, sp = 0u;
    for (;;) {
        sum = 0u; cnt = 0u; mine = 0u;
#pragma unroll
        for (unsigned j = 0; j < 16; ++j) { const unsigned c = xb_ld(&bar[XB_XCNT(j)]); sum += c; cnt += (c > 0u) ? 1u : 0u; mine = (j == x) ? c : mine; }
        if (sum == G) break;
        __builtin_amdgcn_s_sleep(1);
        if ((++sp & 255u) == 0u) { if (xb_ld(&bar[XB_TMO])) break; if (sp > XB_SPIN_CAP) { atomicAdd(&bar[XB_TMO], 1u); break; } }
    }
    nloc = mine > 0u ? mine : 1u; nx = cnt > 0u ? cnt : 1u;
}

__device__ __forceinline__ void xcd_barrier(const XcdBarrier& b) {
    asm volatile("s_waitcnt vmcnt(0)" ::: "memory");
    __syncthreads();
    if (threadIdx.x == 0) {
        unsigned* bar = b.bar;
        __builtin_amdgcn_s_waitcnt(0);
        unsigned nloc = b.st[0], nx = b.st[1];
        if (nloc == 0u) { xcd_barrier_complete(bar, b.x, nloc, nx); b.st[0] = nloc; b.st[1] = nx; }
        const unsigned old = xb_add(&bar[XB_XSUB(b.x)], 1u);
        const unsigned gen = old / nloc;
        if (old + 1u == (gen + 1u) * nloc) {
            __builtin_amdgcn_fence(__ATOMIC_RELEASE, "agent");
            asm volatile("s_waitcnt vmcnt(0)" ::: "memory");
            const unsigned og = xb_add(&bar[XB_TOP], 1u);
            const unsigned tg = og / nx;
            if (og + 1u == (tg + 1u) * nx) xb_add(&bar[XB_TOPGEN], 1u);
            else XB_SPIN(xb_ld(&bar[XB_TOPGEN]) == tg, bar);
            __builtin_amdgcn_fence(__ATOMIC_ACQUIRE, "agent");
            xb_add(&bar[XB_XGEN(b.x)], 1u);
            asm volatile("s_waitcnt vmcnt(0)" ::: "memory");
        } else {
            XB_SPIN(xb_ld(&bar[XB_XGEN(b.x)]) == gen, bar);
            __builtin_amdgcn_fence(__ATOMIC_ACQUIRE, "agent");
            asm volatile("s_waitcnt vmcnt(0)" ::: "memory");
        }
    }
    __syncthreads();
}

struct Frame {
    LAS unsigned char* lds;
    volatile LAS unsigned* MISC;
    gu32* ctl;
    int wave, G, bid;
    __device__ __forceinline__ const float* in(int k) const { const volatile LAS unsigned* t = (const volatile LAS unsigned*)(lds + PTAB_OFF) + 2 * k;
        const unsigned lo = __builtin_amdgcn_readfirstlane(t[0]), hi = __builtin_amdgcn_readfirstlane(t[1]); return (const float*)(const GAS float*)(((unsigned long long)hi << 32) | lo); }
    __device__ __forceinline__ int lane() const { return lane_id_asm(); }
    __device__ __forceinline__ int tid() const { return wave * 64 + lane_id_asm(); }
    unsigned char* ws;
    float* out;
};

__device__ __forceinline__ void ld_row_f32(const float* row, int lane, f32x4 (&v)[4]) {
    const f32x4* p = (const f32x4*)row + lane;
#pragma unroll
    for (int j = 0; j < 4; ++j) v[j] = p[64 * j];
}
__device__ __forceinline__ void st_row_f32(float* row, int lane, const f32x4 (&v)[4]) {
    f32x4* p = (f32x4*)row + lane;
#pragma unroll
    for (int j = 0; j < 4; ++j) p[64 * j] = v[j];
}
__device__ __forceinline__ void ld_row_bf16(const bf16* row, int lane, f32x4 (&v)[4]) {
    const v2u* p = (const v2u*)row + lane;
#pragma unroll
    for (int j = 0; j < 4; ++j) { const v2u w = p[64 * j]; v[j] = (f32x4){bflo(w.x), bfhi(w.x), bflo(w.y), bfhi(w.y)}; }
}
__device__ __forceinline__ void st_row_bf16(bf16* row, int lane, const f32x4 (&v)[4]) {
    v2u* p = (v2u*)row + lane;
#pragma unroll
    for (int j = 0; j < 4; ++j) { v2u w; w.x = pk2(v[j][0], v[j][1]); w.y = pk2(v[j][2], v[j][3]); p[64 * j] = w; }
}
__device__ __forceinline__ float sumsq4(const f32x4 (&v)[4]) {
    float s = 0.f;
#pragma unroll
    for (int j = 0; j < 4; ++j) s += (v[j][0] * v[j][0] + v[j][1] * v[j][1]) + (v[j][2] * v[j][2] + v[j][3] * v[j][3]);
    return s;
}
__device__ __forceinline__ void ld_mod(const Frame& F, int l, int r, int ch, f32x4 (&v)[4]) {
    const float* modp = (const float*)(F.ws + WS_MODP); const int lane = F.lane();
    ld_row_f32(F.in(5) + (size_t)l * NMODC + ch * D, lane, v);
#pragma unroll
    for (int kc = 0; kc < MODKC; ++kc) { f32x4 t[4]; ld_row_f32(modp + ((size_t)((kc * 2 + l) * NMODR + r)) * NMODC + ch * D, lane, t);
#pragma unroll
        for (int j = 0; j < 4; ++j) v[j] += t[j]; }
}
__device__ __forceinline__ int row_batch(int m) { return m < NLAT ? (m >> 12) : 8; }

__device__ __forceinline__ void p0_transpose_item(const float* W, int K, int N, bf16* WT, int drow_off, LAS float* scr, int item, int lane) {
    const int nblk = N / 32, kb = item / nblk, nb = item % nblk, k0 = 64 * kb, n0 = 32 * nb;
#pragma unroll 8
    for (int i = 0; i < 32; ++i) { const int kk = 2 * i + (lane >> 5); scr[kk * 33 + (lane & 31)] = W[(size_t)(k0 + kk) * N + n0 + (lane & 31)]; }
    LDS_WAIT(); asm volatile("" ::: "memory");
    const int c = lane & 7;
#pragma unroll
    for (int j = 0; j < 4; ++j) { const int n = (lane >> 3) + 8 * j; const LAS float* s = scr + (8 * c) * 33 + n;
        v4u o; o.x = pk2(s[0 * 33], s[1 * 33]); o.y = pk2(s[2 * 33], s[3 * 33]); o.z = pk2(s[4 * 33], s[5 * 33]); o.w = pk2(s[6 * 33], s[7 * 33]);
        *(GAS v4u*)(WT + (size_t)(drow_off + n0 + n) * K + k0 + 8 * c) = o; }
    LDS_WAIT(); asm volatile("" ::: "memory");
}
constexpr int I_WIN = 1024, I_WOUT = 512, I_WQKV = 1536, I_WO = 512, I_EXP = 32 * 768, NITEMS_P0 = I_WIN + I_WOUT + I_WQKV + I_WO + I_EXP;
__device__ __forceinline__ void p0_item(const Frame& F, LAS float* scr, int it) {
    int r = it; const int lane = F.lane();
    if (r < I_WIN) { const int n0 = 32 * (r % 64), ch = n0 & 1023, hf = n0 >> 10, drow0 = 256 * (ch >> 7) + 128 * hf + (ch & 127);
        p0_transpose_item(F.in(10), D, 2 * D, (bf16*)(F.ws + WS_WIN), drow0 - n0, scr, r, lane); return; }
    r -= I_WIN;
    if (r < I_WOUT) { p0_transpose_item(F.in(16), D, D, (bf16*)(F.ws + WS_WOUT), 0, scr, r, lane); return; }
    r -= I_WOUT;
    if (r < I_WQKV) { p0_transpose_item(F.in(18), D, 3 * D, (bf16*)(F.ws + WS_WQKV), 0, scr, r, lane); return; }
    r -= I_WQKV;
    if (r < I_WO) { p0_transpose_item(F.in(19), D, D, (bf16*)(F.ws + WS_WO), 0, scr, r, lane); return; }
    r -= I_WO;
    const int le = r / 768; int q = r % 768;
    if (q < 512) { const bool up = q >= 256; if (up) q -= 256; const int n0 = 32 * (q % 16), drow0 = 256 * (n0 >> 7) + (up ? 128 : 0) + (n0 & 127);
        p0_transpose_item((up ? F.in(24) : F.in(23)) + (size_t)le * D * DE, D, DE, (bf16*)(F.ws + WS_WGU) + (size_t)le * 1024 * 1024, drow0 - n0, scr, q, lane); return; }
    q -= 512;
    p0_transpose_item(F.in(25) + (size_t)le * DE * D, DE, D, (bf16*)(F.ws + WS_WDN) + (size_t)le * 1024 * 512, 0, scr, q, lane);
}
__device__ __forceinline__ void p0_mod_item(const Frame& F, LAS float* scr, int it) {
    const int lane = F.lane(), l = it / 192, rem = it % 192, cg = rem >> 3, kc = rem & 7, k0 = 128 * kc, n0 = 256 * cg + 4 * lane;
    const float* cvec = F.in(1); const float* cctx = F.in(3);
    for (int idx = lane; idx < NMODR * 128; idx += 64) { const int r = idx >> 7, kk = idx & 127; const float cv = (r < 8) ? cvec[r * D + k0 + kk] : cctx[k0 + kk];
        scr[idx] = cv / (1.0f + __expf(-cv)); }
    LDS_WAIT(); asm volatile("" ::: "memory");
    f32x4 acc[NMODR];
#pragma unroll
    for (int r = 0; r < NMODR; ++r) acc[r] = (f32x4){0.f, 0.f, 0.f, 0.f};
    const float* wp = F.in(4) + ((size_t)l * D + k0) * NMODC + n0;
#pragma unroll 8
    for (int kk = 0; kk < 128; ++kk) { const f32x4 w = *(const f32x4*)(wp + (size_t)kk * NMODC);
#pragma unroll
        for (int r = 0; r < NMODR; ++r) { const float s = scr[r * 128 + kk]; acc[r] += w * s; } }
    float* modp = (float*)(F.ws + WS_MODP);
#pragma unroll
    for (int r = 0; r < NMODR; ++r) *(f32x4*)(modp + ((size_t)((kc * 2 + l) * NMODR + r)) * NMODC + n0) = acc[r];
    LDS_WAIT(); asm volatile("" ::: "memory");
}
__device__ __forceinline__ void p0_prologue(const Frame& F) {
    LAS float* scr = (LAS float*)(F.lds + F.wave * 16384);
    if (F.wave == 0) p0_mod_item(F, scr, F.bid);
    if (F.wave == 1 && F.bid < 128) p0_mod_item(F, scr, 256 + F.bid);
    const int gw = F.bid * NWAVES + F.wave, NGW = F.G * NWAVES;
    for (int it = gw; it < NITEMS_P0; it += NGW) p0_item(F, scr, it);
}

__device__ __forceinline__ void p1_modulate(const Frame& F) {
    constexpr int RPB = MT / 256;
    bf16* H = (bf16*)(F.ws + WS_A);
    int rc = -1; f32x4 gs[4], sh[4]; const int lane = F.lane();
    const float* xlat = F.in(0); const float* xctx = F.in(2);
    for (int rl = F.wave; rl < RPB; rl += NWAVES) {
        const int m = F.bid * RPB + rl, r = row_batch(m);
        if (r != rc) { f32x4 g[4], sc[4]; ld_row_f32(F.in(6), lane, g); ld_mod(F, 0, r, 1, sc); ld_mod(F, 0, r, 0, sh);
#pragma unroll
            for (int j = 0; j < 4; ++j) gs[j] = g[j] * (sc[j] + 1.0f);
            rc = r; }
        f32x4 v[4]; ld_row_f32(m < NLAT ? xlat + (size_t)m * D : xctx + (size_t)(m - NLAT) * D, lane, v);
        const float rstd = 1.0f / sqrtf(wave_sum(sumsq4(v)) * (1.0f / D) + EPS);
#pragma unroll
        for (int j = 0; j < 4; ++j) v[j] = v[j] * rstd * gs[j] + sh[j];
        st_row_bf16(H + (size_t)m * D, lane, v);
    }
}

__device__ __forceinline__ void p3_conv(const Frame& F) {
    const bf16* U = (const bf16*)(F.ws + WS_B); bf16* V = (bf16*)(F.ws + WS_A);
    const int tid = F.tid(), lane = F.lane();
    f32x2 w[CONVW]; const float* wdw = F.in(12);
#pragma unroll
    for (int j = 0; j < CONVW; ++j) w[j] = *(const f32x2*)(wdw + j * D + 2 * tid);
    const f32x2 bias2 = *(const f32x2*)(F.in(13) + 2 * tid);
    f32x4 lg[4], lb[4]; ld_row_f32(F.in(14), lane, lg); ld_row_f32(F.in(15), lane, lb);
    constexpr int TT = 32, NIN = TT + CONVW - 1;
    for (int tile = F.bid; tile < MT / TT; tile += F.G) {
        int rowbase, t0, T;
        if (tile < NLAT / TT) { rowbase = (tile >> 7) * SEQ; t0 = (tile & 127) * TT; T = SEQ; } else { const int t2 = tile - NLAT / TT; rowbase = NLAT + (t2 >> 3) * CTXL; t0 = (t2 & 7) * TT; T = CTXL; }
        for (int p = tid; p < NIN * 128; p += NTHR) { const int i = p >> 7, cp = p & 127, t = t0 - 15 + i;
            v4u val = (v4u){0u, 0u, 0u, 0u}; if (t >= 0 && t < T) val = *(const v4u*)(U + (size_t)(rowbase + t) * D + cp * 8);
            *(LAS v4u*)(F.lds + i * 2048 + cp * 16) = val; }
        __syncthreads();
        f32x2 res[TT];
#pragma unroll
        for (int g = 0; g < TT / 8; ++g) {
            f32x2 acc[8];
#pragma unroll
            for (int q = 0; q < 8; ++q) acc[q] = bias2;
#pragma unroll
            for (int ii = 0; ii < 8 + CONVW - 1; ++ii) { const int i = 8 * g + ii; const unsigned uw = *(const LAS unsigned*)(F.lds + i * 2048 + tid * 4); const f32x2 uv = (f32x2){bflo(uw), bfhi(uw)};
#pragma unroll
                for (int q = 0; q < 8; ++q) { const int j = ii - q; if (j >= 0 && j < CONVW) acc[q] += w[j] * uv; } }
#pragma unroll
            for (int q = 0; q < 8; ++q) res[8 * g + q] = acc[q];
        }
        __syncthreads();
#pragma unroll
        for (int tt = 0; tt < TT; ++tt) *(LAS f32x2*)(F.lds + tt * 4096 + tid * 8) = res[tt];
        __syncthreads();
#pragma unroll
        for (int q = 0; q < 4; ++q) { const int tt = 4 * F.wave + q; f32x4 v[4];
#pragma unroll
            for (int j = 0; j < 4; ++j) v[j] = *(const LAS f32x4*)(F.lds + tt * 4096 + j * 1024 + lane * 16);
            float s = 0.f;
#pragma unroll
            for (int j = 0; j < 4; ++j) s += (v[j][0] + v[j][1]) + (v[j][2] + v[j][3]);
            const float mean = wave_sum(s) * (1.0f / D);
#pragma unroll
            for (int j = 0; j < 4; ++j) v[j] = v[j] - mean;
            const float rstd = 1.0f / sqrtf(wave_sum(sumsq4(v)) * (1.0f / D) + EPS);
#pragma unroll
            for (int j = 0; j < 4; ++j) { f32x4 y = v[j] * rstd * lg[j] + lb[j];
#pragma unroll
                for (int e = 0; e < 4; ++e) y[e] = y[e] / (1.0f + __expf(-y[e]));
                v[j] = y; }
            st_row_bf16(V + (size_t)(rowbase + t0 + tt) * D, lane, v); }
        __syncthreads();
    }
}

constexpr int RW_OFF = 0, RW_BYTES = 256 * 272;
constexpr int REC_OFF = 72 * 1024;
constexpr int LRK_OFF = REC_OFF + 4096;
constexpr int BASE_OFF = LRK_OFF + 2048;
template <int L>
__device__ __forceinline__ void p_emid(const Frame& F) {
    constexpr int NROWS = (L == 0) ? MT : NLAT, RPB = NROWS / 256;
    const bf16* Y = (const bf16*)(F.ws + WS_B); bf16* TOK = (bf16*)(F.ws + WS_A);
    float* XC = (float*)(F.ws + WS_XC);
    const int tid = F.tid(), lane = F.lane(), m0 = F.bid * RPB;
    const float* rwG = F.in(21);
    for (int idx = tid; idx < 4096; idx += NTHR) { const int k = idx >> 2, ep = idx & 3; const f32x4 v = *(const f32x4*)(rwG + k * 16 + ep * 4);
        *(LAS f32x4*)(F.lds + RW_OFF + (k >> 2) * 272 + (k & 3) * 64 + ep * 16) = v; }
    __syncthreads();
    float rb[16];
    { const float* rbG = F.in(22);
#pragma unroll
    for (int e = 0; e < 16; ++e) rb[e] = rbG[e]; }
    int rc = -1; f32x4 ga[4], gp[4], gs[4], sh[4];
    const float* xlat = F.in(0); const float* xctx = F.in(2);
    for (int rl = F.wave; rl < RPB; rl += NWAVES) {
        const int m = m0 + rl, r = row_batch(m);
        if (r != rc) { f32x4 g[4], sc[4]; ld_mod(F, L, r, 2, ga); ld_row_f32(F.in(7) + L * D, lane, gp); ld_row_f32(F.in(8) + L * D, lane, g); ld_mod(F, L, r, 4, sc); ld_mod(F, L, r, 3, sh);
#pragma unroll
            for (int j = 0; j < 4; ++j) gs[j] = g[j] * (sc[j] + 1.0f);
            rc = r; }
        f32x4 y[4], xv[4];
        ld_row_bf16(Y + (size_t)m * D, lane, y);
        const float* xin = (L == 0) ? (m < NLAT ? xlat + (size_t)m * D : xctx + (size_t)(m - NLAT) * D) : F.out + (size_t)m * D;
        ld_row_f32(xin, lane, xv);
        const float rstdy = 1.0f / sqrtf(wave_sum(sumsq4(y)) * (1.0f / D) + EPS);
#pragma unroll
        for (int j = 0; j < 4; ++j) xv[j] = xv[j] + ga[j] * (y[j] * rstdy * gp[j]) * (((DBG_SKIP >> (2 * L)) & 1) ? 0.f : 1.f);
        st_row_f32(m < NLAT ? F.out + (size_t)m * D : XC + (size_t)(m - NLAT) * D, lane, xv);
        const float rstd1 = 1.0f / sqrtf(wave_sum(sumsq4(xv)) * (1.0f / D) + EPS);
#pragma unroll
        for (int j = 0; j < 4; ++j) xv[j] = xv[j] * rstd1 * gs[j] + sh[j];
        st_row_bf16(TOK + (size_t)m * D, lane, xv);
        float a[16];
#pragma unroll
        for (int e = 0; e < 16; ++e) a[e] = 0.f;
#pragma unroll
        for (int j = 0; j < 4; ++j)
#pragma unroll
            for (int i = 0; i < 4; ++i) { const float tv = xv[j][i]; const LAS f32x4* wp = (const LAS f32x4*)(F.lds + RW_OFF + (64 * j + lane) * 272 + i * 64);
#pragma unroll
                for (int ep = 0; ep < 4; ++ep) { const f32x4 wv = wp[ep];
#pragma unroll
                    for (int cc = 0; cc < 4; ++cc) a[4 * ep + cc] += tv * wv[cc]; } }
        float k8[8], k4[4];
#pragma unroll
        for (int i = 0; i < 8; ++i) { const auto rr = __builtin_amdgcn_permlane32_swap(__builtin_bit_cast(unsigned, a[i]), __builtin_bit_cast(unsigned, a[8 + i]), false, false);
            const unsigned r0_ = rr[0], r1_ = rr[1]; k8[i] = __uint_as_float(r0_) + __uint_as_float(r1_); }
#pragma unroll
        for (int i = 0; i < 4; ++i) { const auto rr = __builtin_amdgcn_permlane16_swap(__builtin_bit_cast(unsigned, k8[i]), __builtin_bit_cast(unsigned, k8[4 + i]), false, false);
            const unsigned r0_ = rr[0], r1_ = rr[1]; k4[i] = row16_sum(__uint_as_float(r0_) + __uint_as_float(r1_)); }
        float s[16], ss[16];
        const float lgsel = (lane & 2) ? ((lane & 1) ? k4[3] : k4[2]) : ((lane & 1) ? k4[1] : k4[0]);
        const float sgl = 1.0f / (1.0f + __expf(-lgsel));
#pragma unroll
        for (int e = 0; e < 16; ++e) { s[e] = rdlane(sgl, 16 * (e >> 2) + (e & 3)); ss[e] = s[e] + rb[e]; }
        float gsc[4]; int i0[4], i1[4];
#pragma unroll
        for (int g = 0; g < 4; ++g) { int a0 = 0; float mx = ss[4 * g];
#pragma unroll
            for (int i = 1; i < 4; ++i) if (ss[4 * g + i] > mx) { mx = ss[4 * g + i]; a0 = i; }
            int b0 = -1; float m2 = -3.0e38f;
#pragma unroll
            for (int i = 0; i < 4; ++i) if (i != a0 && ss[4 * g + i] > m2) { m2 = ss[4 * g + i]; b0 = i; }
            gsc[g] = mx + m2; i0[g] = 4 * g + a0; i1[g] = 4 * g + b0; }
        int gst = 0; float gm = gsc[0];
#pragma unroll
        for (int g = 1; g < 4; ++g) if (gsc[g] > gm) { gm = gsc[g]; gst = g; }
        int e0 = i0[0], e1 = i1[0];
#pragma unroll
        for (int g = 1; g < 4; ++g) if (gst == g) { e0 = i0[g]; e1 = i1[g]; }
        float w0 = 0.f, w1 = 0.f;
#pragma unroll
        for (int e = 0; e < 16; ++e) { if (e == e0) w0 = s[e]; if (e == e1) w1 = s[e]; }
        const float inv = 1.0f / (w0 + w1); w0 *= inv; w1 *= inv;
        if (lane == 0) *(LAS v4u*)(F.lds + REC_OFF + rl * 16) = (v4u){(unsigned)e0, (unsigned)e1, __builtin_bit_cast(unsigned, w0), __builtin_bit_cast(unsigned, w1)};
    }
    __syncthreads();
    if (F.wave == 0 && lane < 16) {
        int cntl = 0;
        for (int rl = 0; rl < RPB; ++rl) { const v4u rec = *(const LAS v4u*)(F.lds + REC_OFF + rl * 16);
            if ((int)rec.x == lane) { *(LAS int*)(F.lds + LRK_OFF + rl * 8) = cntl; ++cntl; }
            if ((int)rec.y == lane) { *(LAS int*)(F.lds + LRK_OFF + rl * 8 + 4) = cntl; ++cntl; } }
        const unsigned base = __hip_atomic_fetch_add((unsigned*)(F.ctl + CW_CNT + (L * 16 + lane) * 64), (unsigned)cntl, RLX_AGENT);
        *(LAS int*)(F.lds + BASE_OFF + lane * 4) = (int)base;
    }
    __syncthreads();
    int* perm2 = (int*)(F.ws + WS_PERM); v2u* slot = (v2u*)(F.ws + WS_SLOT);
    for (int idx = tid; idx < RPB * 2; idx += NTHR) { const int rl = idx >> 1, k = idx & 1; const v4u rec = *(const LAS v4u*)(F.lds + REC_OFF + rl * 16);
        const int e = k ? (int)rec.y : (int)rec.x; const unsigned wb = k ? rec.w : rec.z;
        const int rank = *(const LAS int*)(F.lds + BASE_OFF + e * 4) + *(const LAS int*)(F.lds + LRK_OFF + rl * 8 + k * 4);
        const int m = m0 + rl;
        perm2[(size_t)e * MT + rank] = m;
        slot[(size_t)m * 2 + k] = (v2u){((unsigned)e << 24) | (unsigned)rank, wb}; }
    __syncthreads();
}

__device__ __forceinline__ void moe_setup(const Frame& F, int L) {
    const int tid = F.tid();
    if (tid < 16) F.MISC[40 + tid] = __hip_atomic_load((unsigned*)(F.ctl + CW_CNT + (L * 16 + tid) * 64), RLX_AGENT);
    __syncthreads();
    if (tid == 0) { unsigned p = 0; for (int e = 0; e < 16; ++e) { F.MISC[16 + e] = p; p += (F.MISC[40 + e] + 255u) >> 8; } F.MISC[32] = p; }
    __syncthreads();
}
__device__ __forceinline__ void moe_stage_perm(const Frame& F) {
    const int* perm2 = (const int*)(F.ws + WS_PERM); LAS int* permL = (LAS int*)(F.lds + PERML_OFF);
    const int ntile = (int)F.MISC[32], tid = F.tid();
    for (int i = 0; i < 8; ++i) { const int Lu = i * F.G + F.bid; if (Lu >= 4 * ntile) break;
        const int rt = Lu >> 2; int e = 0;
        for (int j = 1; j < 16; ++j) e += (rt >= (int)F.MISC[16 + j]) ? 1 : 0;
        if (tid < 256) { const int rank = (rt - (int)F.MISC[16 + e]) * 256 + tid; permL[i * 256 + tid] = (rank < (int)F.MISC[40 + e]) ? perm2[(size_t)e * MT + rank] : 0; } }
    __syncthreads();
}

template <int L>
__device__ __forceinline__ void p_epost(const Frame& F) {
    constexpr int NROWS = (L == 0) ? MT : NLAT, RPB = NROWS / 256;
    const bf16* FB = (const bf16*)(F.ws + WS_D2); bf16* H = (bf16*)(F.ws + WS_A);
    float* XC = (float*)(F.ws + WS_XC); const v2u* slot = (const v2u*)(F.ws + WS_SLOT);
    const int lane = F.lane(), m0 = F.bid * RPB;
    int rc = -1; f32x4 ga[4], gp[4], gs[4], sh[4];
    for (int rl = F.wave; rl < RPB; rl += NWAVES) {
        const int m = m0 + rl, r = row_batch(m);
        if (r != rc) { ld_mod(F, L, r, 5, ga); ld_row_f32(F.in(9) + L * D, lane, gp);
            if (L == 0) { f32x4 g[4], sc[4]; ld_row_f32(F.in(6) + D, lane, g); ld_mod(F, 1, r, 1, sc); ld_mod(F, 1, r, 0, sh);
#pragma unroll
                for (int j = 0; j < 4; ++j) gs[j] = g[j] * (sc[j] + 1.0f); }
            rc = r; }
        const v2u s0 = slot[(size_t)m * 2], s1 = slot[(size_t)m * 2 + 1];
        const int e0 = (int)(s0.x >> 24), e1 = (int)(s1.x >> 24);
        const size_t v0 = (size_t)F.MISC[16 + e0] * 256 + (s0.x & 0xffffffu), v1 = (size_t)F.MISC[16 + e1] * 256 + (s1.x & 0xffffffu);
        const unsigned wb0 = s0.y, wb1 = s1.y;
        const float w0 = __uint_as_float(wb0), w1 = __uint_as_float(wb1);
        f32x4 f0[4], f1[4], xv[4];
        ld_row_bf16(FB + v0 * D, lane, f0); ld_row_bf16(FB + v1 * D, lane, f1);
        float* xp = m < NLAT ? F.out + (size_t)m * D : XC + (size_t)(m - NLAT) * D;
        ld_row_f32(xp, lane, xv);
#pragma unroll
        for (int j = 0; j < 4; ++j) f0[j] = (DBG_SLOT == 1) ? f0[j] : (DBG_SLOT == 2) ? f1[j] : (DBG_SLOT == 3) ? f0[j] * 0.5f + f1[j] * 0.5f : f0[j] * w0 + f1[j] * w1;
        const float rstdf = 1.0f / sqrtf(wave_sum(sumsq4(f0)) * (1.0f / D) + EPS);
#pragma unroll
        for (int j = 0; j < 4; ++j) xv[j] = xv[j] + ga[j] * (f0[j] * rstdf * gp[j]) * (((DBG_SKIP >> (2 * L + 1)) & 1) ? 0.f : 1.f);
        st_row_f32(xp, lane, xv);
        if (L == 0) {
            const float rstd2 = 1.0f / sqrtf(wave_sum(sumsq4(xv)) * (1.0f / D) + EPS);
#pragma unroll
            for (int j = 0; j < 4; ++j) xv[j] = xv[j] * rstd2 * gs[j] + sh[j];
            st_row_bf16(H + (size_t)m * D, lane, xv);
        }
    }
}

__device__ __forceinline__ void p10_attn(const Frame& F) {
    const bf16* Qh = (const bf16*)(F.ws + WS_B); const bf16* Kh = (const bf16*)(F.ws + WS_C); const bf16* Vb = (const bf16*)(F.ws + WS_D2); bf16* O = (bf16*)(F.ws + WS_A);
    LAS float* rpbL = (LAS float*)F.lds;
    { const float* rpbG = F.in(20); for (int idx = F.tid(); idx < NH * 15 * 31; idx += NTHR) rpbL[idx] = rpbG[idx]; }
    __syncthreads();
    const int lane = F.lane(), qi = lane & 15, q4 = lane >> 4;
    const int per = (BATCH * NH * GROWS * 4) / F.G;
    for (int it = 0; it < per; it += NWAVES) {
        const int wu = F.bid * per + it + F.wave;
        const int seg = wu & 3, r = (wu >> 2) & 63, bh = wu >> 8, h = bh & 15, b = bh >> 4;
        const int r0 = min(max(r - WINH / 2, 0), GROWS - WINH);
        const int cb = (seg == 0) ? 0 : (seg == 1) ? 8 : (seg == 2) ? 24 : 32;
        const int qc = 16 * seg + qi, cs = min(max(qc - WINW / 2, 0), GRIDW - WINW);
        const bf16* Qp = Qh + ((size_t)bh * SEQ + r * GRIDW + qc) * HD;
        const bf16x8 qf0 = *(const bf16x8*)(Qp + 8 * q4), qf1 = *(const bf16x8*)(Qp + 32 + 8 * q4);
        const bf16* Kbh = Kh + (size_t)bh * KSLOT * HD; const bf16* Vbh = Vb + (size_t)bh * (KSLOT / 8) * 512;
        float mrun = -1.0e30f, lsum = 0.f;
        f32x4 o[4];
#pragma unroll
        for (int db = 0; db < 4; ++db) o[db] = (f32x4){0.f, 0.f, 0.f, 0.f};
#pragma unroll
        for (int grp = 0; grp < 4; ++grp) {
            f32x4 s[8];
#pragma unroll
            for (int bb = 0; bb < 4; ++bb) {
                const int blk = 4 * grp + bb;
                const int keybase = (blk < 8) ? (r0 + blk) * GRIDW + cb : SEQ + 32 * (blk - 8);
#pragma unroll
                for (int tl = 0; tl < 2; ++tl) {
                    const bf16* kp = Kbh + (size_t)(keybase + 8 * (qi >> 2) + 4 * tl + (qi & 3)) * HD;
                    const bf16x8 kf0 = *(const bf16x8*)(kp + 8 * q4), kf1 = *(const bf16x8*)(kp + 32 + 8 * q4);
                    f32x4 acc = (f32x4){0.f, 0.f, 0.f, 0.f};
                    acc = __builtin_amdgcn_mfma_f32_16x16x32_bf16(kf0, qf0, acc, 0, 0, 0);
                    acc = __builtin_amdgcn_mfma_f32_16x16x32_bf16(kf1, qf1, acc, 0, 0, 0);
                    if (blk < 8) {
                        const int ri = (r0 + blk) - r + (WINH - 1);
#pragma unroll
                        for (int i = 0; i < 4; ++i) { const int kc = cb + 8 * q4 + 4 * tl + i; const bool ok = (kc >= cs) && (kc < cs + WINW);
                            const int ci = min(max(kc - qc + (WINW - 1), 0), 2 * WINW - 2);
                            const float bias = rpbL[h * 465 + ri * 31 + ci];
                            acc[i] = ok ? acc[i] * 0.125f + bias : -1.0e30f; }
                    } else {
#pragma unroll
                        for (int i = 0; i < 4; ++i) acc[i] = acc[i] * 0.125f;
                    }
                    s[2 * bb + tl] = acc;
                }
            }
            float mx = mrun;
#pragma unroll
            for (int t = 0; t < 8; ++t) mx = fmaxf(fmaxf(mx, fmaxf(s[t][0], s[t][1])), fmaxf(s[t][2], s[t][3]));
            mx = fmaxf(mx, __shfl_xor(mx, 16)); mx = fmaxf(mx, __shfl_xor(mx, 32));
            const float alpha = __builtin_amdgcn_exp2f((mrun - mx) * 1.4426950408889634f);
            mrun = mx; lsum *= alpha;
#pragma unroll
            for (int db = 0; db < 4; ++db) o[db] = o[db] * alpha;
#pragma unroll
            for (int t = 0; t < 8; ++t)
#pragma unroll
                for (int i = 0; i < 4; ++i) { const float p = __builtin_amdgcn_exp2f((s[t][i] - mx) * 1.4426950408889634f); s[t][i] = p; lsum += p; }
#pragma unroll
            for (int bb = 0; bb < 4; ++bb) {
                const int blk = 4 * grp + bb;
                const int keybase = (blk < 8) ? (r0 + blk) * GRIDW + cb : SEQ + 32 * (blk - 8);
                v4u pw; pw.x = pk2(s[2 * bb][0], s[2 * bb][1]); pw.y = pk2(s[2 * bb][2], s[2 * bb][3]); pw.z = pk2(s[2 * bb + 1][0], s[2 * bb + 1][1]); pw.w = pk2(s[2 * bb + 1][2], s[2 * bb + 1][3]);
                const bf16x8 pf = __builtin_bit_cast(bf16x8, pw);
                const bf16* vp = Vbh + (size_t)((keybase >> 3) + q4) * 512 + qi * 8;
#pragma unroll
                for (int db = 0; db < 4; ++db) { const bf16x8 vf = *(const bf16x8*)(vp + db * 128);
                    o[db] = __builtin_amdgcn_mfma_f32_16x16x32_bf16(vf, pf, o[db], 0, 0, 0); }
            }
        }
        float sum = lsum; sum += __shfl_xor(sum, 16); sum += __shfl_xor(sum, 32);
        const float inv = 1.0f / sum;
        bf16* op = O + ((size_t)b * SEQ + r * GRIDW + qc) * D + h * HD + 4 * q4;
#pragma unroll
        for (int db = 0; db < 4; ++db) { v2u w; w.x = pk2(o[db][0] * inv, o[db][1] * inv); w.y = pk2(o[db][2] * inv, o[db][3] * inv); *(v2u*)(op + db * 16) = w; }
    }
    __syncthreads();
}

#ifndef MK_N_LAUNCHES
#define MK_N_LAUNCHES 1
#endif
constexpr int N_PHASES = 16;
constexpr int N_LAUNCHES = MK_N_LAUNCHES;
struct Args { const float* in[26]; float* out; unsigned char* ws; int ph_lo, ph_hi; };

__global__ void __launch_bounds__(NTHR, 2) fwd_kernel(Args args) {
    extern __shared__ __attribute__((aligned(16))) unsigned char lds[];
    Frame F;
    F.lds = (LAS unsigned char*)lds;
    F.MISC = (volatile LAS unsigned*)(F.lds + MISC_OFF);
    F.wave = __builtin_amdgcn_readfirstlane((int)threadIdx.x >> 6);
    F.G = gridDim.x; F.bid = blockIdx.x;
    F.ws = args.ws; F.ctl = (gu32*)(args.ws + WS_CTL); F.out = args.out;
    for (int u = threadIdx.x; u < 256; u += NTHR) F.MISC[u] = 0u;
    if (threadIdx.x < 26) { const unsigned long long pv = (unsigned long long)args.in[threadIdx.x]; volatile LAS unsigned* t = (volatile LAS unsigned*)(F.lds + PTAB_OFF) + 2 * threadIdx.x; t[0] = (unsigned)pv; t[1] = (unsigned)(pv >> 32); }
    __syncthreads();
    XcdBarrier bar; bar.bar = (unsigned*)(F.ctl + CW_BAR); bar.x = 0; bar.st = nullptr;
    if (N_LAUNCHES == 1) bar = xcd_barrier_post((unsigned*)(F.ctl + CW_BAR), F.MISC + 8);
    const int lo = args.ph_lo, hi = args.ph_hi;
#ifndef PHASE_MASK
#define PHASE_MASK 0xFFFF
#endif
#define IN(k) ((((PHASE_MASK) >> (k)) & 1) && lo <= (k) && (k) < hi)
#define SEAM(k) do { if (IN(k) && IN((k) + 1)) xcd_barrier(bar); } while (0)
    const char* wsb = (const char*)F.ws;
    LAS unsigned char* ring = F.lds;

    if (IN(0)) { _Pragma("unroll") for (int rep = 0; rep < REP(0); ++rep) { p0_prologue(F); __syncthreads(); } }
    SEAM(0);
    if (IN(1)) { _Pragma("unroll") for (int rep = 0; rep < REP(1); ++rep) p1_modulate(F); }
    SEAM(1);
    if (IN(2)) {
        pg8::DenseSched S{wsb + WS_A, wsb + WS_WIN, D, MT / 256, 8, F.G, F.bid};
        pg8::EpiGated<0> E{(bf16*)(F.ws + WS_B), D, F.in(11), D};
        _Pragma("unroll") for (int rep = 0; rep < REP(2); ++rep) pg8::gemm_phase<pg8::EpiGated<0>, pg8::DenseSched, true>(ring, D, S, E, F.wave);
    }
    SEAM(2);
    if (IN(3)) { _Pragma("unroll") for (int rep = 0; rep < REP(3); ++rep) p3_conv(F); }
    SEAM(3);
    if (IN(4)) {
        pg8::DenseSched S{wsb + WS_A, wsb + WS_WOUT, D, MT / 256, 4, F.G, F.bid};
        pg8::EpiBf16 E{(bf16*)(F.ws + WS_B), D, F.in(17)};
        _Pragma("unroll") for (int rep = 0; rep < REP(4); ++rep) pg8::gemm_phase<pg8::EpiBf16, pg8::DenseSched, true>(ring, D, S, E, F.wave);
    }
    SEAM(4);
    if (IN(5)) p_emid<0>(F);
    SEAM(5);
    if (IN(6)) {
        moe_setup(F, 0); moe_stage_perm(F);
        pg8::MoeUpSched S; S.tpre = (const volatile LAS int*)(F.MISC + 16); S.G = F.G; S.c = F.bid; S.A = wsb + WS_A; S.Wgu = wsb + WS_WGU; S.permL = (const LAS int*)(F.lds + PERML_OFF);
        pg8::EpiGated<1> E{(bf16*)(F.ws + WS_C), DE, nullptr, 0};
        _Pragma("unroll") for (int rep = 0; rep < REP(6); ++rep) pg8::gemm_phase<pg8::EpiGated<1>, pg8::MoeUpSched, true>(ring, D, S, E, F.wave);
    }
    SEAM(6);
    if (IN(7)) {
        moe_setup(F, 0);
        pg8::MoeDownSched S; S.tpre = (const volatile LAS int*)(F.MISC + 16); S.G = F.G; S.c = F.bid; S.A = wsb + WS_C; S.Wdn = wsb + WS_WDN;
        pg8::EpiBf16 E{(bf16*)(F.ws + WS_D2), D, nullptr};
        _Pragma("unroll") for (int rep = 0; rep < REP(7); ++rep) pg8::gemm_phase<pg8::EpiBf16, pg8::MoeDownSched, true>(ring, DE, S, E, F.wave);
    }
    SEAM(7);
    if (IN(8)) { moe_setup(F, 0); p_epost<0>(F); }
    SEAM(8);
    if (IN(9)) {
        pg8::QkvSched S{wsb + WS_A, wsb + WS_WQKV, F.G, F.bid};
        pg8::EpiQkv E{(bf16*)(F.ws + WS_B), (bf16*)(F.ws + WS_C), (bf16*)(F.ws + WS_D2)};
        _Pragma("unroll") for (int rep = 0; rep < REP(9); ++rep) pg8::gemm_phase<pg8::EpiQkv, pg8::QkvSched, true>(ring, D, S, E, F.wave);
    }
    SEAM(9);
    if (IN(10)) { _Pragma("unroll") for (int rep = 0; rep < REP(10); ++rep) p10_attn(F); }
    SEAM(10);
    if (IN(11)) {
        pg8::DenseSched S{wsb + WS_A, wsb + WS_WO, D, NLAT / 256, 4, F.G, F.bid};
        pg8::EpiBf16 E{(bf16*)(F.ws + WS_B), D, nullptr};
        _Pragma("unroll") for (int rep = 0; rep < REP(11); ++rep) pg8::gemm_phase<pg8::EpiBf16, pg8::DenseSched, true>(ring, D, S, E, F.wave);
    }
    SEAM(11);
    if (IN(12)) p_emid<1>(F);
    SEAM(12);
    if (IN(13)) {
        moe_setup(F, 1); moe_stage_perm(F);
        pg8::MoeUpSched S; S.tpre = (const volatile LAS int*)(F.MISC + 16); S.G = F.G; S.c = F.bid; S.A = wsb + WS_A; S.Wgu = wsb + WS_WGU + (size_t)16 * 1024 * 1024 * 2; S.permL = (const LAS int*)(F.lds + PERML_OFF);
        pg8::EpiGated<1> E{(bf16*)(F.ws + WS_C), DE, nullptr, 0};
        _Pragma("unroll") for (int rep = 0; rep < REP(13); ++rep) pg8::gemm_phase<pg8::EpiGated<1>, pg8::MoeUpSched, true>(ring, D, S, E, F.wave);
    }
    SEAM(13);
    if (IN(14)) {
        moe_setup(F, 1);
        pg8::MoeDownSched S; S.tpre = (const volatile LAS int*)(F.MISC + 16); S.G = F.G; S.c = F.bid; S.A = wsb + WS_C; S.Wdn = wsb + WS_WDN + (size_t)16 * 1024 * 512 * 2;
        pg8::EpiBf16 E{(bf16*)(F.ws + WS_D2), D, nullptr};
        _Pragma("unroll") for (int rep = 0; rep < REP(14); ++rep) pg8::gemm_phase<pg8::EpiBf16, pg8::MoeDownSched, true>(ring, DE, S, E, F.wave);
    }
    SEAM(14);
    if (IN(15)) { moe_setup(F, 1); p_epost<1>(F); }
#undef IN
#undef SEAM
}

extern "C" void kernel_launch(void* const* d_in, const int* in_sizes, int n_in, void* d_out, int out_size, void* d_ws, size_t ws_size, hipStream_t stream) {
    static int grid = 0;
    if (grid == 0) {
        if (n_in != 26 || in_sizes[0] != NLAT * D || out_size != NLAT * D || ws_size < WS_END) { fprintf(stderr, "kernel_launch: unexpected shapes (n_in %d, in0 %d, out %d, ws %zu); nothing launched\n", n_in, n_in > 0 ? in_sizes[0] : -1, out_size, ws_size); grid = -1; return; }
        if (hipFuncSetAttribute((const void*)fwd_kernel, hipFuncAttributeMaxDynamicSharedMemorySize, LDS_BYTES) != hipSuccess) { fprintf(stderr, "kernel_launch: hipFuncSetAttribute failed\n"); grid = -1; return; }
        int per_cu = 0;
        if (hipOccupancyMaxActiveBlocksPerMultiprocessor(&per_cu, (const void*)fwd_kernel, NTHR, LDS_BYTES) != hipSuccess || per_cu < 1) fprintf(stderr, "kernel_launch: note: occupancy query reports %d workgroups per CU\n", per_cu);
        (void)hipGetLastError();
        grid = 256;
    }
    if (grid < 0) return;
    if (hipMemsetAsync((char*)d_ws + WS_CTL, 0, CTL_ZERO_BYTES, stream) != hipSuccess) { fprintf(stderr, "kernel_launch: hipMemsetAsync failed\n"); return; }
    Args a{};
    for (int i = 0; i < 26; ++i) a.in[i] = (const float*)d_in[i];
    a.out = (float*)d_out; a.ws = (unsigned char*)d_ws;
    for (int li = 0; li < N_LAUNCHES; ++li) {
        a.ph_lo = (N_LAUNCHES == 1) ? 0 : li; a.ph_hi = (N_LAUNCHES == 1) ? N_PHASES : li + 1;
        hipLaunchKernelGGL(fwd_kernel, dim3(grid), dim3(NTHR), LDS_BYTES, stream, a);
        const hipError_t le = hipPeekAtLastError();
        if (le != hipSuccess) { fprintf(stderr, "kernel_launch: launch %d failed: %s\n", li, hipGetErrorName(le)); break; }
    }
}
```

```cpp
#include <hip/hip_runtime.h>
#include <cstdio>
#include <cstdint>

#ifndef PROBE_MASK
#define PROBE_MASK 0
#endif
#define REP(k) ((((PROBE_MASK) >> (k)) & 1) ? 2 : 1)
#ifndef DBG_SLOT
#define DBG_SLOT 0
#endif
#ifndef DBG_SKIP
#define DBG_SKIP 0
#endif
constexpr int D = 1024, BATCH = 8, SEQ = 4096, CTXL = 256;
constexpr int NLAT = BATCH * SEQ, NCTX = BATCH * CTXL, MT = NLAT + NCTX;
constexpr int NE = 16, DE = 512, NH = 16, HD = 64, GRIDW = 64, GROWS = 64, WINH = 8, WINW = 16, CONVW = 31;
constexpr int KSLOT = SEQ + CTXL;
constexpr int NMODR = 9, NMODC = 6 * D;
constexpr int MODKC = 8;
constexpr float EPS = 1e-6f;
constexpr int NWAVES = 8, NTHR = NWAVES * 64;

constexpr size_t MiB = 1u << 20;
constexpr size_t WS_CTL = 0, CTL_ZERO_BYTES = 1 * MiB;
constexpr size_t WS_SLOT = 1 * MiB;
constexpr size_t WS_PERM = 2 * MiB;
constexpr size_t WS_MODP = 5 * MiB;
constexpr size_t WS_XC = 9 * MiB;
constexpr size_t WS_WIN = 18 * MiB, WS_WOUT = 22 * MiB, WS_WQKV = 24 * MiB, WS_WO = 30 * MiB;
constexpr size_t WS_WGU = 32 * MiB;
constexpr size_t WS_WDN = 96 * MiB;
constexpr size_t WS_A = 128 * MiB, WS_B = 196 * MiB, WS_C = 264 * MiB, WS_D2 = 336 * MiB, WS_END = 480 * MiB;
constexpr int CW_BAR = 4096;
constexpr int CW_CNT = 8192;

constexpr int RING_BYTES = 131072;
constexpr int MISC_OFF = RING_BYTES;
constexpr int PTAB_OFF = RING_BYTES + 1024 + 8192;
constexpr int PERML_OFF = RING_BYTES + 1024;
constexpr int LDS_BYTES = 147456;

#define GAS __attribute__((address_space(1)))
#define LAS __attribute__((address_space(3)))
typedef unsigned short bf16;
typedef unsigned v4u __attribute__((ext_vector_type(4)));
typedef unsigned v2u __attribute__((ext_vector_type(2)));
typedef float f32x4 __attribute__((ext_vector_type(4)));
typedef float f32x2 __attribute__((ext_vector_type(2)));
typedef short bf16x8 __attribute__((ext_vector_type(8)));
typedef GAS unsigned gu32;
#define RLX_AGENT __ATOMIC_RELAXED, __HIP_MEMORY_SCOPE_AGENT
#define LDS_WAIT() asm volatile("s_waitcnt lgkmcnt(0)" ::: "memory")
#define VM_WAIT() asm volatile("s_waitcnt vmcnt(0)" ::: "memory")

__device__ __forceinline__ unsigned f2bf(float f) { unsigned u = __builtin_bit_cast(unsigned, f); return (u + 0x7fffu + ((u >> 16) & 1u)) >> 16; }
__device__ __forceinline__ unsigned pk2(float lo, float hi) { return f2bf(lo) | (f2bf(hi) << 16); }
__device__ __forceinline__ float bflo(unsigned w) { return __builtin_bit_cast(float, w << 16); }
__device__ __forceinline__ float bfhi(unsigned w) { return __builtin_bit_cast(float, w & 0xffff0000u); }
__device__ __forceinline__ float row16_sum(float v) {
    v += __builtin_bit_cast(float, __builtin_amdgcn_update_dpp(0, __builtin_bit_cast(int, v), 0xB1, 0xF, 0xF, false));
    v += __builtin_bit_cast(float, __builtin_amdgcn_update_dpp(0, __builtin_bit_cast(int, v), 0x4E, 0xF, 0xF, false));
    v += __builtin_bit_cast(float, __builtin_amdgcn_update_dpp(0, __builtin_bit_cast(int, v), 0x141, 0xF, 0xF, false));
    v += __builtin_bit_cast(float, __builtin_amdgcn_update_dpp(0, __builtin_bit_cast(int, v), 0x140, 0xF, 0xF, false));
    return v;
}
__device__ __forceinline__ float rdlane(float v, int l) { return __builtin_bit_cast(float, __builtin_amdgcn_readlane(__builtin_bit_cast(int, v), l)); }
__device__ __forceinline__ float wave_sum(float v) {
    v = row16_sum(v);
    return (rdlane(v, 0) + rdlane(v, 16)) + (rdlane(v, 32) + rdlane(v, 48));
}
__device__ __forceinline__ int lane_id_asm() { int l; asm volatile("v_mbcnt_lo_u32_b32 %0, -1, 0\n\tv_mbcnt_hi_u32_b32 %0, -1, %0" : "=v"(l)); return l; }
__device__ __forceinline__ float fast_sigmoid(float x) { return __builtin_amdgcn_rcpf(1.0f + __builtin_amdgcn_exp2f(-1.4426950408889634f * x)); }

namespace pg8 {
#define PG8_LAS __attribute__((address_space(3)))
typedef unsigned short bf16_t;
typedef short bf16x8 __attribute__((ext_vector_type(8)));
typedef float f32x4 __attribute__((ext_vector_type(4)));
typedef unsigned u32x4 __attribute__((ext_vector_type(4)));
constexpr int BM = 256, BK = 64, HALF = 128, HTB = HALF * BK * 2, STAGE_BYTES = 8 * HTB, NXCD = 8, WGM = 8;

__host__ __device__ __forceinline__ int lds_byte(int r, int c) { const int st = (r >> 4) * 2 + (c >> 5), rr = r & 15, cc = c & 31, ob = rr * 64 + cc * 2; return st * 1024 + (ob ^ (((ob >> 9) & 1) << 5)); }
__host__ __device__ __forceinline__ void stage_rc(int b, int& R, int& C) { const int st = b / 1024, sb = b % 1024, swz = sb ^ (((sb >> 9) & 1) << 5); R = (st >> 1) * 16 + swz / 64; C = (st & 1) * 32 + (swz % 64) / 2; }
__host__ __device__ __forceinline__ int perm32(int rho) { const int n = rho >> 4, i = rho & 15; return 8 * (i >> 2) + 4 * n + (i & 3); }

struct Unit { int pm, pn; const char* a; const char* b; int li; int ex; };

__device__ __forceinline__ bool static_order(int L, int nM, int nN, int& pm, int& pn) {
    const int nwg = nM * nN; if (L >= nwg) return false;
    int wgid = L; { const int q = nwg / NXCD, r = nwg % NXCD, xcd = wgid % NXCD, off = wgid / NXCD; wgid = (xcd < r ? xcd * (q + 1) : r * (q + 1) + (xcd - r) * q) + off; }
    const int nig = WGM * nN, gid = wgid / nig, fm = gid * WGM, gsz = (nM - fm) < WGM ? (nM - fm) : WGM;
    pm = fm + ((wgid % nig) % gsz); pn = (wgid % nig) / gsz; return true;
}

typedef float cvt_f32x2_t __attribute__((ext_vector_type(2))); typedef __bf16 cvt_bf16x2_t __attribute__((ext_vector_type(2)));
__device__ __forceinline__ unsigned cvt_pk_bf16(float lo, float hi) { const cvt_f32x2_t v = {lo, hi}; const cvt_bf16x2_t b = __builtin_convertvector(v, cvt_bf16x2_t); return __builtin_bit_cast(unsigned, b); }

template <class Epi, class Sched, bool ALIGN_EPI>
__device__ __forceinline__ void gemm_phase(PG8_LAS unsigned char* lds, const int K, const Sched& S, const Epi& E, const int wid) {
    const int lane = lane_id_asm(), tid = wid * 64 + lane, wr = wid >> 2, wc = wid & 3, fr = lane & 15, fq = lane >> 4;
    const int nt = K / BK;
    int R[2], C[2]; unsigned voffB[2], vA[2][2];
    const size_t kstep = (size_t)(BK * 2);
    const size_t hstep = (size_t)HALF * K * 2;
#pragma unroll
    for (int i = 0; i < 2; ++i) { stage_rc(tid * 16 + i * 8192, R[i], C[i]); const int Rb = Epi::PERM ? ((R[i] & ~31) + perm32(R[i] & 31)) : R[i];
        voffB[i] = (unsigned)(Rb * K + C[i]) * 2u; vA[0][i] = (unsigned)(R[i] * K + C[i]) * 2u; vA[1][i] = vA[0][i] + (unsigned)hstep; }
    const unsigned ldsw = (unsigned)wid * 1024u;
    const int aoff = lds_byte(wr * 64 + fr, fq * 8), boff = lds_byte(wc * 32 + fr, fq * 8);
#define PG8_SA(b, h) (((b) * 2 + (h)) * HTB)
#define PG8_SB(b, h) ((4 + (b) * 2 + (h)) * HTB)
#define PG8_STAGE(bufoff, gbase, voff) do { _Pragma("unroll") for (int _i = 0; _i < 2; ++_i) \
        __builtin_amdgcn_global_load_lds((const unsigned*)((const char*)(gbase) + (voff)[_i]), (PG8_LAS unsigned*)(lds + (bufoff) + ldsw + _i * 8192), 16, 0, 0); } while (0)
#define PG8_LDA(dst, b, h) do { _Pragma("unroll") for (int m = 0; m < 4; ++m) _Pragma("unroll") for (int k = 0; k < 2; ++k) dst[m][k] = *(const PG8_LAS bf16x8*)(lds + PG8_SA(b, h) + aoff + m * 2048 + k * 1024); } while (0)
#define PG8_LDB(dst, b, h) do { _Pragma("unroll") for (int n = 0; n < 2; ++n) _Pragma("unroll") for (int k = 0; k < 2; ++k) dst[n][k] = *(const PG8_LAS bf16x8*)(lds + PG8_SB(b, h) + boff + n * 2048 + k * 1024); } while (0)
#define PG8_MMA(ai, bj, At, Bt) do { __builtin_amdgcn_s_setprio(1); _Pragma("unroll") for (int m = 0; m < 4; ++m) _Pragma("unroll") for (int n = 0; n < 2; ++n) _Pragma("unroll") for (int k = 0; k < 2; ++k) \
        acc[ai][bj][m][n] = __builtin_amdgcn_mfma_f32_16x16x32_bf16(Bt[n][k], At[m][k], acc[ai][bj][m][n], 0, 0, 0); __builtin_amdgcn_s_setprio(0); } while (0)
#define PG8_WAIT_V(n) asm volatile("s_waitcnt vmcnt(" #n ")" ::: "memory")
#define PG8_WAIT_L(n) asm volatile("s_waitcnt lgkmcnt(" #n ")" ::: "memory")
#define PG8_BAR __builtin_amdgcn_s_barrier()
#define PG8_SCHED __builtin_amdgcn_sched_barrier(0)
    Unit cur, nxt; int ui = 0;
    if (!S.next(0, cur)) return;
    if constexpr (Sched::GATHER) S.a_offsets(cur, R, C, K, vA);
    f32x4 acc[2][2][4][2];
#pragma unroll
    for (int a = 0; a < 2; ++a)
#pragma unroll
        for (int b = 0; b < 2; ++b)
#pragma unroll
            for (int m = 0; m < 4; ++m)
#pragma unroll
                for (int n = 0; n < 2; ++n) acc[a][b][m][n] = (f32x4){0.f, 0.f, 0.f, 0.f};
    bf16x8 At[4][2], B0[2][2], B1[2][2];
    const char* cA = cur.a; const char* cB = cur.b;
    PG8_STAGE(PG8_SB(0, 0), cB, voffB); PG8_STAGE(PG8_SB(0, 1), cB + hstep, voffB); PG8_STAGE(PG8_SA(0, 0), cA, vA[0]); PG8_STAGE(PG8_SA(0, 1), cA, vA[1]);
    if (wr == 1) PG8_BAR;
    PG8_WAIT_V(2); PG8_BAR;
    PG8_STAGE(PG8_SB(1, 0), cB + kstep, voffB); PG8_STAGE(PG8_SA(1, 0), cA + kstep, vA[0]); PG8_STAGE(PG8_SB(1, 1), cB + hstep + kstep, voffB);
    PG8_WAIT_V(6); PG8_BAR;
    for (;;) {
        const bool has_next = S.next(ui + 1, nxt);
        const char* nA = has_next ? nxt.a : cA; const char* nB = has_next ? nxt.b : cB;
        for (int t = 0; t < nt; t += 2) {
            const bool last = (t == nt - 2);
            const char* a1 = cA + (size_t)(t + 1) * kstep;
            const char* a2 = last ? nA : cA + (size_t)(t + 2) * kstep; const char* b2 = last ? nB : cB + (size_t)(t + 2) * kstep;
            const char* a3 = a2 + kstep; const char* b3 = b2 + kstep;
            PG8_LDB(B0, 0, 0); PG8_LDB(B1, 0, 1); PG8_SCHED; PG8_LDA(At, 0, 0); PG8_STAGE(PG8_SA(1, 1), a1, vA[1]);
            if constexpr (Sched::GATHER) { if (last && has_next) S.a_offsets(nxt, R, C, K, vA); }
            PG8_WAIT_V(8); PG8_WAIT_L(0); PG8_BAR; PG8_MMA(0, 0, At, B0); PG8_MMA(0, 1, At, B1); PG8_BAR; PG8_SCHED;
            PG8_LDA(At, 0, 1); PG8_STAGE(PG8_SB(0, 0), b2, voffB); PG8_STAGE(PG8_SB(0, 1), b2 + hstep, voffB); PG8_STAGE(PG8_SA(0, 0), a2, vA[0]);
            PG8_WAIT_V(8); PG8_WAIT_L(0); PG8_BAR; PG8_MMA(1, 0, At, B0); PG8_MMA(1, 1, At, B1); PG8_BAR; PG8_SCHED;
            PG8_LDB(B0, 1, 0); PG8_LDB(B1, 1, 1); PG8_SCHED; PG8_LDA(At, 1, 0); PG8_STAGE(PG8_SA(0, 1), a2, vA[1]);
            PG8_WAIT_V(8); PG8_WAIT_L(0); PG8_BAR; PG8_MMA(0, 0, At, B0); PG8_MMA(0, 1, At, B1); PG8_BAR; PG8_SCHED;
            PG8_LDA(At, 1, 1); PG8_STAGE(PG8_SB(1, 0), b3, voffB); PG8_STAGE(PG8_SB(1, 1), b3 + hstep, voffB); PG8_STAGE(PG8_SA(1, 0), a3, vA[0]);
            PG8_WAIT_V(8); PG8_WAIT_L(0); PG8_BAR; PG8_MMA(1, 0, At, B0); PG8_MMA(1, 1, At, B1); PG8_BAR; PG8_SCHED;
        }
        if constexpr (ALIGN_EPI) { if (wr == 0) PG8_BAR; }
        E(acc, cur, wr, wc, fr, fq);
        if (!has_next) break;
#pragma unroll
        for (int a = 0; a < 2; ++a)
#pragma unroll
            for (int b = 0; b < 2; ++b)
#pragma unroll
                for (int m = 0; m < 4; ++m)
#pragma unroll
                    for (int n = 0; n < 2; ++n) acc[a][b][m][n] = (f32x4){0.f, 0.f, 0.f, 0.f};
        cur = nxt; cA = nA; cB = nB; ++ui;
        if constexpr (ALIGN_EPI) { if (wr == 1) PG8_BAR; }
    }
    PG8_WAIT_V(0);
    if constexpr (!ALIGN_EPI) { if (wr == 0) PG8_BAR; }
    PG8_BAR;
#undef PG8_SA
#undef PG8_SB
#undef PG8_STAGE
#undef PG8_LDA
#undef PG8_LDB
#undef PG8_MMA
#undef PG8_WAIT_V
#undef PG8_WAIT_L
#undef PG8_BAR
#undef PG8_SCHED
}

struct DenseSched {
    static constexpr bool GATHER = false;
    const char* A; const char* Bt; int K, nM, nN, G, c;
    __device__ __forceinline__ bool next(int i, Unit& u) const {
        int pm, pn; if (!static_order(i * G + c, nM, nN, pm, pn)) return false;
        u.pm = pm; u.pn = pn; u.a = A + (size_t)pm * BM * K * 2; u.b = Bt + (size_t)pn * BM * K * 2; u.li = i; u.ex = 0; return true;
    }
    __device__ __forceinline__ void a_offsets(const Unit&, const int (&)[2], const int (&)[2], int, unsigned (&)[2][2]) const {}
};
struct QkvSched {
    static constexpr bool GATHER = false;
    const char* A; const char* Bt; int G, c;
    __device__ __forceinline__ bool next(int i, Unit& u) const {
        const int L = i * G + c; int pm, pn;
        if (L < 1536) { static_order(L, 128, 12, pm, pn); }
        else { const int l2 = L - 1536; if (l2 >= 64) return false; pm = 128 + (l2 >> 3); pn = 4 + (l2 & 7); }
        u.pm = pm; u.pn = pn; u.a = A + (size_t)pm * BM * D * 2; u.b = Bt + (size_t)pn * BM * D * 2; u.li = i; u.ex = 0; return true;
    }
    __device__ __forceinline__ void a_offsets(const Unit&, const int (&)[2], const int (&)[2], int, unsigned (&)[2][2]) const {}
};
struct MoeSchedBase {
    const volatile PG8_LAS int* tpre;
    int G, c;
    __device__ __forceinline__ bool locate(int i, int& rt, int& pn, int& e) const {
        const int L = i * G + c; const int ntile = tpre[16];
        if (L >= 4 * ntile) return false;
        rt = L >> 2; pn = L & 3; int ee = 0;
#pragma unroll
        for (int j = 1; j < 16; ++j) ee += (rt >= tpre[j]) ? 1 : 0;
        e = ee; return true;
    }
};
struct MoeUpSched : MoeSchedBase {
    static constexpr bool GATHER = true;
    const char* A; const char* Wgu; const PG8_LAS int* permL;
    __device__ __forceinline__ bool next(int i, Unit& u) const {
        int rt, pn, e; if (!locate(i, rt, pn, e)) return false;
        u.pm = rt; u.pn = pn; u.a = A; u.b = Wgu + (size_t)e * (1024 * 1024 * 2) + (size_t)pn * BM * D * 2; u.li = i; u.ex = e; return true;
    }
    __device__ __forceinline__ void a_offsets(const Unit& u, const int (&R)[2], const int (&C)[2], int K, unsigned (&vA)[2][2]) const {
#pragma unroll
        for (int h = 0; h < 2; ++h)
#pragma unroll
            for (int i = 0; i < 2; ++i) vA[h][i] = (unsigned)permL[u.li * 256 + h * HALF + R[i]] * (unsigned)(K * 2) + (unsigned)(C[i] * 2);
    }
};
struct MoeDownSched : MoeSchedBase {
    static constexpr bool GATHER = false;
    const char* A; const char* Wdn;
    __device__ __forceinline__ bool next(int i, Unit& u) const {
        int rt, pn, e; if (!locate(i, rt, pn, e)) return false;
        u.pm = rt; u.pn = pn; u.a = A + (size_t)rt * BM * DE * 2; u.b = Wdn + (size_t)e * (1024 * 512 * 2) + (size_t)pn * BM * DE * 2; u.li = i; u.ex = e; return true;
    }
    __device__ __forceinline__ void a_offsets(const Unit&, const int (&)[2], const int (&)[2], int, unsigned (&)[2][2]) const {}
};

struct EpiBf16 {
    static constexpr bool PERM = true;
    bf16_t* O; int ldc; const float* bias;
    __device__ __forceinline__ void operator()(const f32x4 (&acc)[2][2][4][2], const Unit& u, int wr, int wc, int fr, int fq) const {
        const int row0 = u.pm * BM + wr * 64 + fr, col0 = u.pn * BM + wc * 32 + 8 * fq;
        f32x4 bv[2][2];
#pragma unroll
        for (int bj = 0; bj < 2; ++bj)
#pragma unroll
            for (int n = 0; n < 2; ++n) bv[bj][n] = bias ? *(const f32x4*)(bias + col0 + bj * HALF + 4 * n) : (f32x4){0.f, 0.f, 0.f, 0.f};
#pragma unroll
        for (int ai = 0; ai < 2; ++ai)
#pragma unroll
            for (int m = 0; m < 4; ++m) { bf16_t* rowp = O + (size_t)(row0 + ai * HALF + m * 16) * ldc + col0;
#pragma unroll
                for (int bj = 0; bj < 2; ++bj) { const f32x4 v0 = acc[ai][bj][m][0] + bv[bj][0], v1 = acc[ai][bj][m][1] + bv[bj][1];
                    u32x4 w; w.x = cvt_pk_bf16(v0[0], v0[1]); w.y = cvt_pk_bf16(v0[2], v0[3]); w.z = cvt_pk_bf16(v1[0], v1[1]); w.w = cvt_pk_bf16(v1[2], v1[3]);
                    *(u32x4*)(rowp + bj * HALF) = w; } }
    }
};
template <int MODE  > struct EpiGated {
    static constexpr bool PERM = true;
    bf16_t* O; int ldc; const float* bias; int nch;
    __device__ __forceinline__ void operator()(const f32x4 (&acc)[2][2][4][2], const Unit& u, int wr, int wc, int fr, int fq) const {
        const int row0 = u.pm * BM + wr * 64 + fr, ch0 = u.pn * HALF + wc * 32 + 8 * fq;
        f32x4 b0[2], b1[2];
#pragma unroll
        for (int n = 0; n < 2; ++n) { if (MODE == 0) { b0[n] = *(const f32x4*)(bias + ch0 + 4 * n); b1[n] = *(const f32x4*)(bias + nch + ch0 + 4 * n); } else { b0[n] = (f32x4){0.f, 0.f, 0.f, 0.f}; b1[n] = b0[n]; } }
#pragma unroll
        for (int ai = 0; ai < 2; ++ai)
#pragma unroll
            for (int m = 0; m < 4; ++m) { bf16_t* rowp = O + (size_t)(row0 + ai * HALF + m * 16) * ldc + ch0; float o[8];
#pragma unroll
                for (int n = 0; n < 2; ++n) { const f32x4 x0 = acc[ai][0][m][n] + b0[n], x1 = acc[ai][1][m][n] + b1[n];
#pragma unroll
                    for (int e = 0; e < 4; ++e) o[4 * n + e] = (MODE == 0) ? x0[e] * fast_sigmoid(x1[e]) : (x0[e] * fast_sigmoid(x0[e])) * x1[e]; }
                u32x4 w; w.x = cvt_pk_bf16(o[0], o[1]); w.y = cvt_pk_bf16(o[2], o[3]); w.z = cvt_pk_bf16(o[4], o[5]); w.w = cvt_pk_bf16(o[6], o[7]);
                *(u32x4*)rowp = w; }
    }
};
struct EpiQkv {
    static constexpr bool PERM = true;
    bf16_t* Q; bf16_t* Kh; bf16_t* Vb; float qscale;
    __device__ __forceinline__ void operator()(const f32x4 (&acc)[2][2][4][2], const Unit& u, int wr, int wc, int fr, int fq) const {
        const int which = u.pn >> 2; const bool isctx = u.pm >= 128;
        const int b = isctx ? (u.pm - 128) : (u.pm >> 4);
        const int key0 = isctx ? SEQ : ((u.pm & 15) << 8);
        const int d0 = 32 * (wc & 1) + 8 * fq;
#pragma unroll
        for (int ai = 0; ai < 2; ++ai)
#pragma unroll
            for (int m = 0; m < 4; ++m) { const int key = key0 + ai * HALF + wr * 64 + m * 16 + fr;
#pragma unroll
                for (int bj = 0; bj < 2; ++bj) { const int h = 4 * (u.pn & 3) + 2 * bj + (wc >> 1); const f32x4 v0 = acc[ai][bj][m][0], v1 = acc[ai][bj][m][1];
                    if (which == 2) {
                        bf16_t* p = Vb + ((size_t)(b * NH + h) * (KSLOT / 8) + (key >> 3)) * 512 + (size_t)d0 * 8 + (key & 7);
                        const unsigned w0 = cvt_pk_bf16(v0[0], v0[1]), w1 = cvt_pk_bf16(v0[2], v0[3]), w2 = cvt_pk_bf16(v1[0], v1[1]), w3 = cvt_pk_bf16(v1[2], v1[3]);
                        p[0] = (bf16_t)w0; p[8] = (bf16_t)(w0 >> 16); p[16] = (bf16_t)w1; p[24] = (bf16_t)(w1 >> 16); p[32] = (bf16_t)w2; p[40] = (bf16_t)(w2 >> 16); p[48] = (bf16_t)w3; p[56] = (bf16_t)(w3 >> 16);
                    } else {
                        const float qs = (which == 0) ? qscale : 1.0f; const f32x4 y0 = v0 * qs, y1 = v1 * qs;
                        u32x4 w; w.x = cvt_pk_bf16(y0[0], y0[1]); w.y = cvt_pk_bf16(y0[2], y0[3]); w.z = cvt_pk_bf16(y1[0], y1[1]); w.w = cvt_pk_bf16(y1[2], y1[3]);
                        bf16_t* p = (which == 0) ? Q + ((size_t)(b * NH + h) * SEQ + key) * HD + d0 : Kh + ((size_t)(b * NH + h) * KSLOT + key) * HD + d0;
                        *(u32x4*)p = w;
                    } } }
    }
};
}
#define XB_TMO      128
#define XB_XCNT(j)  (256  + 64 * (j))
#define XB_XSUB(j)  (1280 + 64 * (j))
#define XB_XGEN(j)  (2304 + 64 * (j))
#define XB_TOP      3328
#define XB_TOPGEN   3392
#define XCD_BAR_WORDS 3456
#define XB_SPIN_CAP (1u << 18)

__device__ __forceinline__ unsigned xb_ld(unsigned* p)              { return __hip_atomic_load(p, __ATOMIC_RELAXED, __HIP_MEMORY_SCOPE_AGENT); }
__device__ __forceinline__ unsigned xb_add(unsigned* p, unsigned v) { return __hip_atomic_fetch_add(p, v, __ATOMIC_RELAXED, __HIP_MEMORY_SCOPE_AGENT); }
__device__ __forceinline__ unsigned xb_xcc_id() { return (unsigned)__builtin_amdgcn_s_getreg((3 << 11) | 20) & 0xFu; }
#define XB_SPIN(cond, bar) do { unsigned _sp = 0; while (cond) { __builtin_amdgcn_s_sleep(1); \
    if ((++_sp & 255u) == 0u) { if (xb_ld(&(bar)[XB_TMO])) break; if (_sp > XB_SPIN_CAP) { atomicAdd(&(bar)[XB_TMO], 1u); break; } } } } while (0)

struct XcdBarrier {
    unsigned* bar; unsigned x;
    volatile LAS unsigned* st;
};

__device__ __forceinline__ XcdBarrier xcd_barrier_post(unsigned* bar, volatile LAS unsigned* st) {
    XcdBarrier b; b.bar = bar; b.x = xb_xcc_id(); b.st = st;
    if (threadIdx.x == 0) (void)xb_add(&bar[XB_XCNT(b.x)], 1u);
    return b;
}
__device__ __forceinline__ void xcd_barrier_complete(unsigned* bar, unsigned x, unsigned& nloc, unsigned& nx) {
    const unsigned G = gridDim.x * gridDim.y * gridDim.z;
    unsigned sum, cnt, mine, sp = 0u;
    for (;;) {
        sum = 0u; cnt = 0u; mine = 0u;
#pragma unroll
        for (unsigned j = 0; j < 16; ++j) { const unsigned c = xb_ld(&bar[XB_XCNT(j)]); sum += c; cnt += (c > 0u) ? 1u : 0u; mine = (j == x) ? c : mine; }
        if (sum == G) break;
        __builtin_amdgcn_s_sleep(1);
        if ((++sp & 255u) == 0u) { if (xb_ld(&bar[XB_TMO])) break; if (sp > XB_SPIN_CAP) { atomicAdd(&bar[XB_TMO], 1u); break; } }
    }
    nloc = mine > 0u ? mine : 1u; nx = cnt > 0u ? cnt : 1u;
}

__device__ __forceinline__ void xcd_barrier(const XcdBarrier& b) {
    asm volatile("s_waitcnt vmcnt(0)" ::: "memory");
    __syncthreads();
    if (threadIdx.x == 0) {
        unsigned* bar = b.bar;
        __builtin_amdgcn_s_waitcnt(0);
        unsigned nloc = b.st[0], nx = b.st[1];
        if (nloc == 0u) { xcd_barrier_complete(bar, b.x, nloc, nx); b.st[0] = nloc; b.st[1] = nx; }
        const unsigned old = xb_add(&bar[XB_XSUB(b.x)], 1u);
        const unsigned gen = old / nloc;
        if (old + 1u == (gen + 1u) * nloc) {
            __builtin_amdgcn_fence(__ATOMIC_RELEASE, "agent");
            asm volatile("s_waitcnt vmcnt(0)" ::: "memory");
            const unsigned og = xb_add(&bar[XB_TOP], 1u);
            const unsigned tg = og / nx;
            if (og + 1u == (tg + 1u) * nx) xb_add(&bar[XB_TOPGEN], 1u);
            else XB_SPIN(xb_ld(&bar[XB_TOPGEN]) == tg, bar);
            __builtin_amdgcn_fence(__ATOMIC_ACQUIRE, "agent");
            xb_add(&bar[XB_XGEN(b.x)], 1u);
            asm volatile("s_waitcnt vmcnt(0)" ::: "memory");
        } else {
            XB_SPIN(xb_ld(&bar[XB_XGEN(b.x)]) == gen, bar);
            __builtin_amdgcn_fence(__ATOMIC_ACQUIRE, "agent");
            asm volatile("s_waitcnt vmcnt(0)" ::: "memory");
        }
    }
    __syncthreads();
}

struct Frame {
    LAS unsigned char* lds;
    volatile LAS unsigned* MISC;
    gu32* ctl;
    int wave, G, bid;
    __device__ __forceinline__ const float* in(int k) const { const volatile LAS unsigned* t = (const volatile LAS unsigned*)(lds + PTAB_OFF) + 2 * k;
        const unsigned lo = __builtin_amdgcn_readfirstlane(t[0]), hi = __builtin_amdgcn_readfirstlane(t[1]); return (const float*)(const GAS float*)(((unsigned long long)hi << 32) | lo); }
    __device__ __forceinline__ int lane() const { return lane_id_asm(); }
    __device__ __forceinline__ int tid() const { return wave * 64 + lane_id_asm(); }
    unsigned char* ws;
    float* out;
};

__device__ __forceinline__ void ld_row_f32(const float* row, int lane, f32x4 (&v)[4]) {
    const f32x4* p = (const f32x4*)row + lane;
#pragma unroll
    for (int j = 0; j < 4; ++j) v[j] = p[64 * j];
}
__device__ __forceinline__ void st_row_f32(float* row, int lane, const f32x4 (&v)[4]) {
    f32x4* p = (f32x4*)row + lane;
#pragma unroll
    for (int j = 0; j < 4; ++j) p[64 * j] = v[j];
}
__device__ __forceinline__ void ld_row_bf16(const bf16* row, int lane, f32x4 (&v)[4]) {
    const v2u* p = (const v2u*)row + lane;
#pragma unroll
    for (int j = 0; j < 4; ++j) { const v2u w = p[64 * j]; v[j] = (f32x4){bflo(w.x), bfhi(w.x), bflo(w.y), bfhi(w.y)}; }
}
__device__ __forceinline__ void st_row_bf16(bf16* row, int lane, const f32x4 (&v)[4]) {
    v2u* p = (v2u*)row + lane;
#pragma unroll
    for (int j = 0; j < 4; ++j) { v2u w; w.x = pk2(v[j][0], v[j][1]); w.y = pk2(v[j][2], v[j][3]); p[64 * j] = w; }
}
__device__ __forceinline__ float sumsq4(const f32x4 (&v)[4]) {
    float s = 0.f;
#pragma unroll
    for (int j = 0; j < 4; ++j) s += (v[j][0] * v[j][0] + v[j][1] * v[j][1]) + (v[j][2] * v[j][2] + v[j][3] * v[j][3]);
    return s;
}
__device__ __forceinline__ void ld_mod(const Frame& F, int l, int r, int ch, f32x4 (&v)[4]) {
    const float* modp = (const float*)(F.ws + WS_MODP); const int lane = F.lane();
    ld_row_f32(F.in(5) + (size_t)l * NMODC + ch * D, lane, v);
#pragma unroll
    for (int kc = 0; kc < MODKC; ++kc) { f32x4 t[4]; ld_row_f32(modp + ((size_t)((kc * 2 + l) * NMODR + r)) * NMODC + ch * D, lane, t);
#pragma unroll
        for (int j = 0; j < 4; ++j) v[j] += t[j]; }
}
__device__ __forceinline__ int row_batch(int m) { return m < NLAT ? (m >> 12) : 8; }

__device__ __forceinline__ void p0_transpose_item(const float* W, int K, int N, bf16* WT, int drow_off, LAS float* scr, int item, int lane) {
    const int nblk = N / 32, kb = item / nblk, nb = item % nblk, k0 = 64 * kb, n0 = 32 * nb;
#pragma unroll 8
    for (int i = 0; i < 32; ++i) { const int kk = 2 * i + (lane >> 5); scr[kk * 33 + (lane & 31)] = W[(size_t)(k0 + kk) * N + n0 + (lane & 31)]; }
    LDS_WAIT(); asm volatile("" ::: "memory");
    const int c = lane & 7;
#pragma unroll
    for (int j = 0; j < 4; ++j) { const int n = (lane >> 3) + 8 * j; const LAS float* s = scr + (8 * c) * 33 + n;
        v4u o; o.x = pk2(s[0 * 33], s[1 * 33]); o.y = pk2(s[2 * 33], s[3 * 33]); o.z = pk2(s[4 * 33], s[5 * 33]); o.w = pk2(s[6 * 33], s[7 * 33]);
        *(GAS v4u*)(WT + (size_t)(drow_off + n0 + n) * K + k0 + 8 * c) = o; }
    LDS_WAIT(); asm volatile("" ::: "memory");
}
constexpr int I_WIN = 1024, I_WOUT = 512, I_WQKV = 1536, I_WO = 512, I_EXP = 32 * 768, NITEMS_P0 = I_WIN + I_WOUT + I_WQKV + I_WO + I_EXP;
__device__ __forceinline__ void p0_item(const Frame& F, LAS float* scr, int it) {
    int r = it; const int lane = F.lane();
    if (r < I_WIN) { const int n0 = 32 * (r % 64), ch = n0 & 1023, hf = n0 >> 10, drow0 = 256 * (ch >> 7) + 128 * hf + (ch & 127);
        p0_transpose_item(F.in(10), D, 2 * D, (bf16*)(F.ws + WS_WIN), drow0 - n0, scr, r, lane); return; }
    r -= I_WIN;
    if (r < I_WOUT) { p0_transpose_item(F.in(16), D, D, (bf16*)(F.ws + WS_WOUT), 0, scr, r, lane); return; }
    r -= I_WOUT;
    if (r < I_WQKV) { p0_transpose_item(F.in(18), D, 3 * D, (bf16*)(F.ws + WS_WQKV), 0, scr, r, lane); return; }
    r -= I_WQKV;
    if (r < I_WO) { p0_transpose_item(F.in(19), D, D, (bf16*)(F.ws + WS_WO), 0, scr, r, lane); return; }
    r -= I_WO;
    const int le = r / 768; int q = r % 768;
    if (q < 512) { const bool up = q >= 256; if (up) q -= 256; const int n0 = 32 * (q % 16), drow0 = 256 * (n0 >> 7) + (up ? 128 : 0) + (n0 & 127);
        p0_transpose_item((up ? F.in(24) : F.in(23)) + (size_t)le * D * DE, D, DE, (bf16*)(F.ws + WS_WGU) + (size_t)le * 1024 * 1024, drow0 - n0, scr, q, lane); return; }
    q -= 512;
    p0_transpose_item(F.in(25) + (size_t)le * DE * D, DE, D, (bf16*)(F.ws + WS_WDN) + (size_t)le * 1024 * 512, 0, scr, q, lane);
}
__device__ __forceinline__ void p0_mod_item(const Frame& F, LAS float* scr, int it) {
    const int lane = F.lane(), l = it / 192, rem = it % 192, cg = rem >> 3, kc = rem & 7, k0 = 128 * kc, n0 = 256 * cg + 4 * lane;
    const float* cvec = F.in(1); const float* cctx = F.in(3);
    for (int idx = lane; idx < NMODR * 128; idx += 64) { const int r = idx >> 7, kk = idx & 127; const float cv = (r < 8) ? cvec[r * D + k0 + kk] : cctx[k0 + kk];
        scr[idx] = cv / (1.0f + __expf(-cv)); }
    LDS_WAIT(); asm volatile("" ::: "memory");
    f32x4 acc[NMODR];
#pragma unroll
    for (int r = 0; r < NMODR; ++r) acc[r] = (f32x4){0.f, 0.f, 0.f, 0.f};
    const float* wp = F.in(4) + ((size_t)l * D + k0) * NMODC + n0;
#pragma unroll 8
    for (int kk = 0; kk < 128; ++kk) { const f32x4 w = *(const f32x4*)(wp + (size_t)kk * NMODC);
#pragma unroll
        for (int r = 0; r < NMODR; ++r) { const float s = scr[r * 128 + kk]; acc[r] += w * s; } }
    float* modp = (float*)(F.ws + WS_MODP);
#pragma unroll
    for (int r = 0; r < NMODR; ++r) *(f32x4*)(modp + ((size_t)((kc * 2 + l) * NMODR + r)) * NMODC + n0) = acc[r];
    LDS_WAIT(); asm volatile("" ::: "memory");
}
__device__ __forceinline__ void p0_prologue(const Frame& F) {
    LAS float* scr = (LAS float*)(F.lds + F.wave * 16384);
    if (F.wave == 0) p0_mod_item(F, scr, F.bid);
    if (F.wave == 1 && F.bid < 128) p0_mod_item(F, scr, 256 + F.bid);
    const int gw = F.bid * NWAVES + F.wave, NGW = F.G * NWAVES;
    for (int it = gw; it < NITEMS_P0; it += NGW) p0_item(F, scr, it);
}

__device__ __forceinline__ void p1_modulate(const Frame& F) {
    constexpr int RPB = MT / 256;
    bf16* H = (bf16*)(F.ws + WS_A);
    int rc = -1; f32x4 gs[4], sh[4]; const int lane = F.lane();
    const float* xlat = F.in(0); const float* xctx = F.in(2);
    for (int rl = F.wave; rl < RPB; rl += NWAVES) {
        const int m = F.bid * RPB + rl, r = row_batch(m);
        if (r != rc) { f32x4 g[4], sc[4]; ld_row_f32(F.in(6), lane, g); ld_mod(F, 0, r, 1, sc); ld_mod(F, 0, r, 0, sh);
#pragma unroll
            for (int j = 0; j < 4; ++j) gs[j] = g[j] * (sc[j] + 1.0f);
            rc = r; }
        f32x4 v[4]; ld_row_f32(m < NLAT ? xlat + (size_t)m * D : xctx + (size_t)(m - NLAT) * D, lane, v);
        const float rstd = 1.0f / sqrtf(wave_sum(sumsq4(v)) * (1.0f / D) + EPS);
#pragma unroll
        for (int j = 0; j < 4; ++j) v[j] = v[j] * rstd * gs[j] + sh[j];
        st_row_bf16(H + (size_t)m * D, lane, v);
    }
}

__device__ __forceinline__ void p3_conv(const Frame& F) {
    const bf16* U = (const bf16*)(F.ws + WS_B); bf16* V = (bf16*)(F.ws + WS_A);
    const int tid = F.tid(), lane = F.lane();
    f32x2 w[CONVW]; const float* wdw = F.in(12);
#pragma unroll
    for (int j = 0; j < CONVW; ++j) w[j] = *(const f32x2*)(wdw + j * D + 2 * tid);
    const f32x2 bias2 = *(const f32x2*)(F.in(13) + 2 * tid);
    f32x4 lg[4], lb[4]; ld_row_f32(F.in(14), lane, lg); ld_row_f32(F.in(15), lane, lb);
    constexpr int TT = 32, NIN = TT + CONVW - 1;
    for (int tile = F.bid; tile < MT / TT; tile += F.G) {
        int rowbase, t0, T;
        if (tile < NLAT / TT) { rowbase = (tile >> 7) * SEQ; t0 = (tile & 127) * TT; T = SEQ; } else { const int t2 = tile - NLAT / TT; rowbase = NLAT + (t2 >> 3) * CTXL; t0 = (t2 & 7) * TT; T = CTXL; }
        for (int p = tid; p < NIN * 128; p += NTHR) { const int i = p >> 7, cp = p & 127, t = t0 - 15 + i;
            v4u val = (v4u){0u, 0u, 0u, 0u}; if (t >= 0 && t < T) val = *(const v4u*)(U + (size_t)(rowbase + t) * D + cp * 8);
            *(LAS v4u*)(F.lds + i * 2048 + cp * 16) = val; }
        __syncthreads();
        f32x2 res[TT];
#pragma unroll
        for (int g = 0; g < TT / 8; ++g) {
            f32x2 acc[8];
#pragma unroll
            for (int q = 0; q < 8; ++q) acc[q] = bias2;
#pragma unroll
            for (int ii = 0; ii < 8 + CONVW - 1; ++ii) { const int i = 8 * g + ii; const unsigned uw = *(const LAS unsigned*)(F.lds + i * 2048 + tid * 4); const f32x2 uv = (f32x2){bflo(uw), bfhi(uw)};
#pragma unroll
                for (int q = 0; q < 8; ++q) { const int j = ii - q; if (j >= 0 && j < CONVW) acc[q] += w[j] * uv; } }
#pragma unroll
            for (int q = 0; q < 8; ++q) res[8 * g + q] = acc[q];
        }
        __syncthreads();
#pragma unroll
        for (int tt = 0; tt < TT; ++tt) *(LAS f32x2*)(F.lds + tt * 4096 + tid * 8) = res[tt];
        __syncthreads();
#pragma unroll
        for (int q = 0; q < 4; ++q) { const int tt = 4 * F.wave + q; f32x4 v[4];
#pragma unroll
            for (int j = 0; j < 4; ++j) v[j] = *(const LAS f32x4*)(F.lds + tt * 4096 + j * 1024 + lane * 16);
            float s = 0.f;
#pragma unroll
            for (int j = 0; j < 4; ++j) s += (v[j][0] + v[j][1]) + (v[j][2] + v[j][3]);
            const float mean = wave_sum(s) * (1.0f / D);
#pragma unroll
            for (int j = 0; j < 4; ++j) v[j] = v[j] - mean;
            const float rstd = 1.0f / sqrtf(wave_sum(sumsq4(v)) * (1.0f / D) + EPS);
#pragma unroll
            for (int j = 0; j < 4; ++j) { f32x4 y = v[j] * rstd * lg[j] + lb[j];
#pragma unroll
                for (int e = 0; e < 4; ++e) y[e] = y[e] / (1.0f + __expf(-y[e]));
                v[j] = y; }
            st_row_bf16(V + (size_t)(rowbase + t0 + tt) * D, lane, v); }
        __syncthreads();
    }
}

constexpr int RW_OFF = 0, RW_BYTES = 256 * 272;
constexpr int REC_OFF = 72 * 1024;
constexpr int LRK_OFF = REC_OFF + 4096;
constexpr int BASE_OFF = LRK_OFF + 2048;
template <int L>
__device__ __forceinline__ void p_emid(const Frame& F) {
    constexpr int NROWS = (L == 0) ? MT : NLAT, RPB = NROWS / 256;
    const bf16* Y = (const bf16*)(F.ws + WS_B); bf16* TOK = (bf16*)(F.ws + WS_A);
    float* XC = (float*)(F.ws + WS_XC);
    const int tid = F.tid(), lane = F.lane(), m0 = F.bid * RPB;
    const float* rwG = F.in(21);
    for (int idx = tid; idx < 4096; idx += NTHR) { const int k = idx >> 2, ep = idx & 3; const f32x4 v = *(const f32x4*)(rwG + k * 16 + ep * 4);
        *(LAS f32x4*)(F.lds + RW_OFF + (k >> 2) * 272 + (k & 3) * 64 + ep * 16) = v; }
    __syncthreads();
    float rb[16];
    { const float* rbG = F.in(22);
#pragma unroll
    for (int e = 0; e < 16; ++e) rb[e] = rbG[e]; }
    int rc = -1; f32x4 ga[4], gp[4], gs[4], sh[4];
    const float* xlat = F.in(0); const float* xctx = F.in(2);
    for (int rl = F.wave; rl < RPB; rl += NWAVES) {
        const int m = m0 + rl, r = row_batch(m);
        if (r != rc) { f32x4 g[4], sc[4]; ld_mod(F, L, r, 2, ga); ld_row_f32(F.in(7) + L * D, lane, gp); ld_row_f32(F.in(8) + L * D, lane, g); ld_mod(F, L, r, 4, sc); ld_mod(F, L, r, 3, sh);
#pragma unroll
            for (int j = 0; j < 4; ++j) gs[j] = g[j] * (sc[j] + 1.0f);
            rc = r; }
        f32x4 y[4], xv[4];
        ld_row_bf16(Y + (size_t)m * D, lane, y);
        const float* xin = (L == 0) ? (m < NLAT ? xlat + (size_t)m * D : xctx + (size_t)(m - NLAT) * D) : F.out + (size_t)m * D;
        ld_row_f32(xin, lane, xv);
        const float rstdy = 1.0f / sqrtf(wave_sum(sumsq4(y)) * (1.0f / D) + EPS);
#pragma unroll
        for (int j = 0; j < 4; ++j) xv[j] = xv[j] + ga[j] * (y[j] * rstdy * gp[j]) * (((DBG_SKIP >> (2 * L)) & 1) ? 0.f : 1.f);
        st_row_f32(m < NLAT ? F.out + (size_t)m * D : XC + (size_t)(m - NLAT) * D, lane, xv);
        const float rstd1 = 1.0f / sqrtf(wave_sum(sumsq4(xv)) * (1.0f / D) + EPS);
#pragma unroll
        for (int j = 0; j < 4; ++j) xv[j] = xv[j] * rstd1 * gs[j] + sh[j];
        st_row_bf16(TOK + (size_t)m * D, lane, xv);
        float a[16];
#pragma unroll
        for (int e = 0; e < 16; ++e) a[e] = 0.f;
#pragma unroll
        for (int j = 0; j < 4; ++j)
#pragma unroll
            for (int i = 0; i < 4; ++i) { const float tv = xv[j][i]; const LAS f32x4* wp = (const LAS f32x4*)(F.lds + RW_OFF + (64 * j + lane) * 272 + i * 64);
#pragma unroll
                for (int ep = 0; ep < 4; ++ep) { const f32x4 wv = wp[ep];
#pragma unroll
                    for (int cc = 0; cc < 4; ++cc) a[4 * ep + cc] += tv * wv[cc]; } }
        float k8[8], k4[4];
#pragma unroll
        for (int i = 0; i < 8; ++i) { const auto rr = __builtin_amdgcn_permlane32_swap(__builtin_bit_cast(unsigned, a[i]), __builtin_bit_cast(unsigned, a[8 + i]), false, false);
            const unsigned r0_ = rr[0], r1_ = rr[1]; k8[i] = __uint_as_float(r0_) + __uint_as_float(r1_); }
#pragma unroll
        for (int i = 0; i < 4; ++i) { const auto rr = __builtin_amdgcn_permlane16_swap(__builtin_bit_cast(unsigned, k8[i]), __builtin_bit_cast(unsigned, k8[4 + i]), false, false);
            const unsigned r0_ = rr[0], r1_ = rr[1]; k4[i] = row16_sum(__uint_as_float(r0_) + __uint_as_float(r1_)); }
        float s[16], ss[16];
        const float lgsel = (lane & 2) ? ((lane & 1) ? k4[3] : k4[2]) : ((lane & 1) ? k4[1] : k4[0]);
        const float sgl = 1.0f / (1.0f + __expf(-lgsel));
#pragma unroll
        for (int e = 0; e < 16; ++e) { s[e] = rdlane(sgl, 16 * (e >> 2) + (e & 3)); ss[e] = s[e] + rb[e]; }
        float gsc[4]; int i0[4], i1[4];
#pragma unroll
        for (int g = 0; g < 4; ++g) { int a0 = 0; float mx = ss[4 * g];
#pragma unroll
            for (int i = 1; i < 4; ++i) if (ss[4 * g + i] > mx) { mx = ss[4 * g + i]; a0 = i; }
            int b0 = -1; float m2 = -3.0e38f;
#pragma unroll
            for (int i = 0; i < 4; ++i) if (i != a0 && ss[4 * g + i] > m2) { m2 = ss[4 * g + i]; b0 = i; }
            gsc[g] = mx + m2; i0[g] = 4 * g + a0; i1[g] = 4 * g + b0; }
        int gst = 0; float gm = gsc[0];
#pragma unroll
        for (int g = 1; g < 4; ++g) if (gsc[g] > gm) { gm = gsc[g]; gst = g; }
        int e0 = i0[0], e1 = i1[0];
#pragma unroll
        for (int g = 1; g < 4; ++g) if (gst == g) { e0 = i0[g]; e1 = i1[g]; }
        float w0 = 0.f, w1 = 0.f;
#pragma unroll
        for (int e = 0; e < 16; ++e) { if (e == e0) w0 = s[e]; if (e == e1) w1 = s[e]; }
        const float inv = 1.0f / (w0 + w1); w0 *= inv; w1 *= inv;
        if (lane == 0) *(LAS v4u*)(F.lds + REC_OFF + rl * 16) = (v4u){(unsigned)e0, (unsigned)e1, __builtin_bit_cast(unsigned, w0), __builtin_bit_cast(unsigned, w1)};
    }
    __syncthreads();
    if (F.wave == 0 && lane < 16) {
        int cntl = 0;
        for (int rl = 0; rl < RPB; ++rl) { const v4u rec = *(const LAS v4u*)(F.lds + REC_OFF + rl * 16);
            if ((int)rec.x == lane) { *(LAS int*)(F.lds + LRK_OFF + rl * 8) = cntl; ++cntl; }
            if ((int)rec.y == lane) { *(LAS int*)(F.lds + LRK_OFF + rl * 8 + 4) = cntl; ++cntl; } }
        const unsigned base = __hip_atomic_fetch_add((unsigned*)(F.ctl + CW_CNT + (L * 16 + lane) * 64), (unsigned)cntl, RLX_AGENT);
        *(LAS int*)(F.lds + BASE_OFF + lane * 4) = (int)base;
    }
    __syncthreads();
    int* perm2 = (int*)(F.ws + WS_PERM); v2u* slot = (v2u*)(F.ws + WS_SLOT);
    for (int idx = tid; idx < RPB * 2; idx += NTHR) { const int rl = idx >> 1, k = idx & 1; const v4u rec = *(const LAS v4u*)(F.lds + REC_OFF + rl * 16);
        const int e = k ? (int)rec.y : (int)rec.x; const unsigned wb = k ? rec.w : rec.z;
        const int rank = *(const LAS int*)(F.lds + BASE_OFF + e * 4) + *(const LAS int*)(F.lds + LRK_OFF + rl * 8 + k * 4);
        const int m = m0 + rl;
        perm2[(size_t)e * MT + rank] = m;
        slot[(size_t)m * 2 + k] = (v2u){((unsigned)e << 24) | (unsigned)rank, wb}; }
    __syncthreads();
}

__device__ __forceinline__ void moe_setup(const Frame& F, int L) {
    const int tid = F.tid();
    if (tid < 16) F.MISC[40 + tid] = __hip_atomic_load((unsigned*)(F.ctl + CW_CNT + (L * 16 + tid) * 64), RLX_AGENT);
    __syncthreads();
    if (tid == 0) { unsigned p = 0; for (int e = 0; e < 16; ++e) { F.MISC[16 + e] = p; p += (F.MISC[40 + e] + 255u) >> 8; } F.MISC[32] = p; }
    __syncthreads();
}
__device__ __forceinline__ void moe_stage_perm(const Frame& F) {
    const int* perm2 = (const int*)(F.ws + WS_PERM); LAS int* permL = (LAS int*)(F.lds + PERML_OFF);
    const int ntile = (int)F.MISC[32], tid = F.tid();
    for (int i = 0; i < 8; ++i) { const int Lu = i * F.G + F.bid; if (Lu >= 4 * ntile) break;
        const int rt = Lu >> 2; int e = 0;
        for (int j = 1; j < 16; ++j) e += (rt >= (int)F.MISC[16 + j]) ? 1 : 0;
        if (tid < 256) { const int rank = (rt - (int)F.MISC[16 + e]) * 256 + tid; permL[i * 256 + tid] = (rank < (int)F.MISC[40 + e]) ? perm2[(size_t)e * MT + rank] : 0; } }
    __syncthreads();
}

template <int L>
__device__ __forceinline__ void p_epost(const Frame& F) {
    constexpr int NROWS = (L == 0) ? MT : NLAT, RPB = NROWS / 256;
    const bf16* FB = (const bf16*)(F.ws + WS_D2); bf16* H = (bf16*)(F.ws + WS_A);
    float* XC = (float*)(F.ws + WS_XC); const v2u* slot = (const v2u*)(F.ws + WS_SLOT);
    const int lane = F.lane(), m0 = F.bid * RPB;
    int rc = -1; f32x4 ga[4], gp[4], gs[4], sh[4];
    for (int rl = F.wave; rl < RPB; rl += NWAVES) {
        const int m = m0 + rl, r = row_batch(m);
        if (r != rc) { ld_mod(F, L, r, 5, ga); ld_row_f32(F.in(9) + L * D, lane, gp);
            if (L == 0) { f32x4 g[4], sc[4]; ld_row_f32(F.in(6) + D, lane, g); ld_mod(F, 1, r, 1, sc); ld_mod(F, 1, r, 0, sh);
#pragma unroll
                for (int j = 0; j < 4; ++j) gs[j] = g[j] * (sc[j] + 1.0f); }
            rc = r; }
        const v2u s0 = slot[(size_t)m * 2], s1 = slot[(size_t)m * 2 + 1];
        const int e0 = (int)(s0.x >> 24), e1 = (int)(s1.x >> 24);
        const size_t v0 = (size_t)F.MISC[16 + e0] * 256 + (s0.x & 0xffffffu), v1 = (size_t)F.MISC[16 + e1] * 256 + (s1.x & 0xffffffu);
        const unsigned wb0 = s0.y, wb1 = s1.y;
        const float w0 = __uint_as_float(wb0), w1 = __uint_as_float(wb1);
        f32x4 f0[4], f1[4], xv[4];
        ld_row_bf16(FB + v0 * D, lane, f0); ld_row_bf16(FB + v1 * D, lane, f1);
        float* xp = m < NLAT ? F.out + (size_t)m * D : XC + (size_t)(m - NLAT) * D;
        ld_row_f32(xp, lane, xv);
#pragma unroll
        for (int j = 0; j < 4; ++j) f0[j] = (DBG_SLOT == 1) ? f0[j] : (DBG_SLOT == 2) ? f1[j] : (DBG_SLOT == 3) ? f0[j] * 0.5f + f1[j] * 0.5f : f0[j] * w0 + f1[j] * w1;
        const float rstdf = 1.0f / sqrtf(wave_sum(sumsq4(f0)) * (1.0f / D) + EPS);
#pragma unroll
        for (int j = 0; j < 4; ++j) xv[j] = xv[j] + ga[j] * (f0[j] * rstdf * gp[j]) * (((DBG_SKIP >> (2 * L + 1)) & 1) ? 0.f : 1.f);
        st_row_f32(xp, lane, xv);
        if (L == 0) {
            const float rstd2 = 1.0f / sqrtf(wave_sum(sumsq4(xv)) * (1.0f / D) + EPS);
#pragma unroll
            for (int j = 0; j < 4; ++j) xv[j] = xv[j] * rstd2 * gs[j] + sh[j];
            st_row_bf16(H + (size_t)m * D, lane, xv);
        }
    }
}

constexpr int AT_CK = 0, AT_CV = 32768, AT_RPB = 65536;
constexpr float LOG2E = 1.4426950408889634f;
__device__ __forceinline__ float xrow_max(float m) {
    { const auto rr = __builtin_amdgcn_permlane16_swap(__builtin_bit_cast(unsigned, m), __builtin_bit_cast(unsigned, m), false, false); const unsigned a_ = rr[0], b_ = rr[1]; m = fmaxf(__uint_as_float(a_), __uint_as_float(b_)); }
    { const auto rr = __builtin_amdgcn_permlane32_swap(__builtin_bit_cast(unsigned, m), __builtin_bit_cast(unsigned, m), false, false); const unsigned a_ = rr[0], b_ = rr[1]; m = fmaxf(__uint_as_float(a_), __uint_as_float(b_)); }
    return m;
}
__device__ __forceinline__ float xrow_sum(float m) {
    { const auto rr = __builtin_amdgcn_permlane16_swap(__builtin_bit_cast(unsigned, m), __builtin_bit_cast(unsigned, m), false, false); const unsigned a_ = rr[0], b_ = rr[1]; m = __uint_as_float(a_) + __uint_as_float(b_); }
    { const auto rr = __builtin_amdgcn_permlane32_swap(__builtin_bit_cast(unsigned, m), __builtin_bit_cast(unsigned, m), false, false); const unsigned a_ = rr[0], b_ = rr[1]; m = __uint_as_float(a_) + __uint_as_float(b_); }
    return m;
}
__device__ __forceinline__ void attn_softmax(f32x4 (&s)[4], float& mrun, float& lsum, f32x4 (&o)[4], bf16x8 (&pf)[2]) {
    float mx = mrun;
#pragma unroll
    for (int t = 0; t < 4; ++t) mx = fmaxf(fmaxf(mx, fmaxf(s[t][0], s[t][1])), fmaxf(s[t][2], s[t][3]));
    mx = xrow_max(mx);
    const float alpha = __builtin_amdgcn_exp2f(mrun - mx);
    mrun = mx; lsum *= alpha;
#pragma unroll
    for (int db = 0; db < 4; ++db) o[db] = o[db] * alpha;
#pragma unroll
    for (int t = 0; t < 4; ++t)
#pragma unroll
        for (int i = 0; i < 4; ++i) { const float p = __builtin_amdgcn_exp2f(s[t][i] - mx); s[t][i] = p; lsum += p; }
#pragma unroll
    for (int bb = 0; bb < 2; ++bb) { v4u pw; pw.x = pg8::cvt_pk_bf16(s[2 * bb][0], s[2 * bb][1]); pw.y = pg8::cvt_pk_bf16(s[2 * bb][2], s[2 * bb][3]);
        pw.z = pg8::cvt_pk_bf16(s[2 * bb + 1][0], s[2 * bb + 1][1]); pw.w = pg8::cvt_pk_bf16(s[2 * bb + 1][2], s[2 * bb + 1][3]); pf[bb] = __builtin_bit_cast(bf16x8, pw); }
}
__device__ __forceinline__ void p10_attn(const Frame& F) {
    const bf16* Qh = (const bf16*)(F.ws + WS_B); const bf16* Kh = (const bf16*)(F.ws + WS_C); const bf16* Vb = (const bf16*)(F.ws + WS_D2); bf16* O = (bf16*)(F.ws + WS_A);
    const int lane = F.lane(), tid = F.wave * 64 + lane, qi = lane & 15, q4 = lane >> 4;
    const int per = (BATCH * NH * GROWS * 4) / F.G;
    const int bh = (F.bid * per) >> 8, h = bh & 15, b = bh >> 4;
    const bf16* Kbh = Kh + (size_t)bh * KSLOT * HD; const bf16* Vbh = Vb + (size_t)bh * (KSLOT / 8) * 512;
#pragma unroll
    for (int i = 0; i < 4; ++i) { const int kf = F.wave * 4 + i, blk = kf >> 2, tl = (kf >> 1) & 1, dh = kf & 1;
        const v4u kv = *(const v4u*)(Kbh + (size_t)(SEQ + 32 * blk + 8 * (qi >> 2) + 4 * tl + (qi & 3)) * HD + dh * 32 + 8 * q4);
        const int vblk = kf >> 2, db = kf & 3;
        const v4u vv = *(const v4u*)(Vbh + (size_t)(SEQ / 8 + 4 * vblk + q4) * 512 + (db * 16 + qi) * 8);
        *(LAS v4u*)(F.lds + AT_CK + kf * 1024 + lane * 16) = kv; *(LAS v4u*)(F.lds + AT_CV + kf * 1024 + lane * 16) = vv; }
    { const float* rpbG = F.in(20) + h * 465; LAS float* rpbW = (LAS float*)(F.lds + AT_RPB);
        for (int idx = tid; idx < 15 * 32; idx += NTHR) { const int ri = idx >> 5, ci = idx & 31; rpbW[idx] = (ci < 31) ? rpbG[ri * 31 + ci] * LOG2E : -1.0e30f; } }
    __syncthreads();
    const int seg = F.wave & 3;
    const int cb = (seg == 0) ? 0 : (seg == 1) ? 8 : (seg == 2) ? 24 : 32;
    const int qc = 16 * seg + qi, cs = min(max(qc - WINW / 2, 0), GRIDW - WINW);
    int coff[2][4];
#pragma unroll
    for (int tl = 0; tl < 2; ++tl)
#pragma unroll
        for (int i = 0; i < 4; ++i) { const int kc = cb + 8 * q4 + 4 * tl + i; const bool ok = (kc >= cs) && (kc < cs + WINW); coff[tl][i] = AT_RPB + 4 * (ok ? (kc - qc + (WINW - 1)) : 31); }
    for (int it = 0; it < per; it += NWAVES) {
        const int wu = F.bid * per + it + F.wave;
        const int r = (wu >> 2) & 63;
        const int r0 = min(max(r - WINH / 2, 0), GROWS - WINH);
        const bf16* Qp = Qh + ((size_t)bh * SEQ + r * GRIDW + qc) * HD;
        const bf16x8 qf0 = *(const bf16x8*)(Qp + 8 * q4), qf1 = *(const bf16x8*)(Qp + 32 + 8 * q4);
        const bf16* kp0 = Kbh + (size_t)(r0 * GRIDW + cb + 8 * (qi >> 2) + (qi & 3)) * HD + 8 * q4;
        const bf16* vp0 = Vbh + (size_t)((r0 * GRIDW + cb) / 8 + q4) * 512 + qi * 8;
        int boff[2][4];
#pragma unroll
        for (int tl = 0; tl < 2; ++tl)
#pragma unroll
            for (int i = 0; i < 4; ++i) boff[tl][i] = coff[tl][i] + (r0 - r + (WINH - 1)) * 128;
        bf16x8 kw[4][2][2][2], vw[4][2][4];
#define AT_LOADK(g) do { _Pragma("unroll") for (int bb = 0; bb < 2; ++bb) _Pragma("unroll") for (int tl = 0; tl < 2; ++tl) { \
            kw[g][bb][tl][0] = *(const bf16x8*)(kp0 + (size_t)((2 * (g) + bb) * GRIDW + 4 * tl) * HD); kw[g][bb][tl][1] = *(const bf16x8*)(kp0 + (size_t)((2 * (g) + bb) * GRIDW + 4 * tl) * HD + 32); } } while (0)
#define AT_LOADV(g) do { _Pragma("unroll") for (int bb = 0; bb < 2; ++bb) _Pragma("unroll") for (int db = 0; db < 4; ++db) vw[g][bb][db] = *(const bf16x8*)(vp0 + (size_t)((2 * (g) + bb) * (GRIDW / 8)) * 512 + db * 128); } while (0)
        float mrun = -1.0e30f, lsum = 0.f;
        f32x4 o[4];
#pragma unroll
        for (int db = 0; db < 4; ++db) o[db] = (f32x4){0.f, 0.f, 0.f, 0.f};
        AT_LOADK(0); AT_LOADV(0);
        __builtin_amdgcn_sched_barrier(0);
#pragma unroll
        for (int g = 0; g < 4; ++g) {
            {
                f32x4 s[4]; bf16x8 pf[2];
#pragma unroll
                for (int bb = 0; bb < 2; ++bb) { const int blk = 2 * g + bb;
#pragma unroll
                    for (int tl = 0; tl < 2; ++tl) { const bf16x8 k0 = *(const LAS bf16x8*)(F.lds + AT_CK + ((blk * 2 + tl) * 2 + 0) * 1024 + lane * 16), k1 = *(const LAS bf16x8*)(F.lds + AT_CK + ((blk * 2 + tl) * 2 + 1) * 1024 + lane * 16);
                        f32x4 acc = (f32x4){0.f, 0.f, 0.f, 0.f};
                        acc = __builtin_amdgcn_mfma_f32_16x16x32_bf16(k0, qf0, acc, 0, 0, 0);
                        acc = __builtin_amdgcn_mfma_f32_16x16x32_bf16(k1, qf1, acc, 0, 0, 0);
                        s[2 * bb + tl] = acc; } }
                attn_softmax(s, mrun, lsum, o, pf);
#pragma unroll
                for (int bb = 0; bb < 2; ++bb)
#pragma unroll
                    for (int db = 0; db < 4; ++db) { const bf16x8 vf = *(const LAS bf16x8*)(F.lds + AT_CV + ((2 * g + bb) * 4 + db) * 1024 + lane * 16);
                        o[db] = __builtin_amdgcn_mfma_f32_16x16x32_bf16(vf, pf[bb], o[db], 0, 0, 0); }
            }
            __builtin_amdgcn_sched_barrier(0);
            {
                f32x4 s[4]; bf16x8 pf[2];
#pragma unroll
                for (int bb = 0; bb < 2; ++bb)
#pragma unroll
                    for (int tl = 0; tl < 2; ++tl) { f32x4 acc = (f32x4){0.f, 0.f, 0.f, 0.f};
                        acc = __builtin_amdgcn_mfma_f32_16x16x32_bf16(kw[g][bb][tl][0], qf0, acc, 0, 0, 0);
                        acc = __builtin_amdgcn_mfma_f32_16x16x32_bf16(kw[g][bb][tl][1], qf1, acc, 0, 0, 0);
#pragma unroll
                        for (int i = 0; i < 4; ++i) acc[i] += *(const LAS float*)(F.lds + boff[tl][i] + (2 * g + bb) * 128);
                        s[2 * bb + tl] = acc; }
                if (g < 3) { AT_LOADK(g + 1); }
                __builtin_amdgcn_sched_barrier(0);
                attn_softmax(s, mrun, lsum, o, pf);
#pragma unroll
                for (int bb = 0; bb < 2; ++bb)
#pragma unroll
                    for (int db = 0; db < 4; ++db) o[db] = __builtin_amdgcn_mfma_f32_16x16x32_bf16(vw[g][bb][db], pf[bb], o[db], 0, 0, 0);
                if (g < 3) { AT_LOADV(g + 1); }
                __builtin_amdgcn_sched_barrier(0);
            }
        }
#undef AT_LOADK
#undef AT_LOADV
        const float inv = 1.0f / xrow_sum(lsum);
        bf16* op = O + ((size_t)b * SEQ + r * GRIDW + qc) * D + h * HD + 4 * q4;
#pragma unroll
        for (int db = 0; db < 4; ++db) { v2u w; w.x = pg8::cvt_pk_bf16(o[db][0] * inv, o[db][1] * inv); w.y = pg8::cvt_pk_bf16(o[db][2] * inv, o[db][3] * inv); *(v2u*)(op + db * 16) = w; }
    }
    __syncthreads();
}

#ifndef MK_N_LAUNCHES
#define MK_N_LAUNCHES 1
#endif
constexpr int N_PHASES = 16;
constexpr int N_LAUNCHES = MK_N_LAUNCHES;
struct Args { const float* in[26]; float* out; unsigned char* ws; int ph_lo, ph_hi; };

__global__ void __launch_bounds__(NTHR, 2) fwd_kernel(Args args) {
    extern __shared__ __attribute__((aligned(16))) unsigned char lds[];
    Frame F;
    F.lds = (LAS unsigned char*)lds;
    F.MISC = (volatile LAS unsigned*)(F.lds + MISC_OFF);
    F.wave = __builtin_amdgcn_readfirstlane((int)threadIdx.x >> 6);
    F.G = gridDim.x; F.bid = blockIdx.x;
    F.ws = args.ws; F.ctl = (gu32*)(args.ws + WS_CTL); F.out = args.out;
    for (int u = threadIdx.x; u < 256; u += NTHR) F.MISC[u] = 0u;
    if (threadIdx.x < 26) { const unsigned long long pv = (unsigned long long)args.in[threadIdx.x]; volatile LAS unsigned* t = (volatile LAS unsigned*)(F.lds + PTAB_OFF) + 2 * threadIdx.x; t[0] = (unsigned)pv; t[1] = (unsigned)(pv >> 32); }
    __syncthreads();
    XcdBarrier bar; bar.bar = (unsigned*)(F.ctl + CW_BAR); bar.x = 0; bar.st = nullptr;
    if (N_LAUNCHES == 1) bar = xcd_barrier_post((unsigned*)(F.ctl + CW_BAR), F.MISC + 8);
    const int lo = args.ph_lo, hi = args.ph_hi;
#ifndef PHASE_MASK
#define PHASE_MASK 0xFFFF
#endif
#define IN(k) ((((PHASE_MASK) >> (k)) & 1) && lo <= (k) && (k) < hi)
#define SEAM(k) do { if (IN(k) && IN((k) + 1)) xcd_barrier(bar); } while (0)
    const char* wsb = (const char*)F.ws;
    LAS unsigned char* ring = F.lds;

    if (IN(0)) { _Pragma("unroll") for (int rep = 0; rep < REP(0); ++rep) { p0_prologue(F); __syncthreads(); } }
    SEAM(0);
    if (IN(1)) { _Pragma("unroll") for (int rep = 0; rep < REP(1); ++rep) p1_modulate(F); }
    SEAM(1);
    if (IN(2)) {
        pg8::DenseSched S{wsb + WS_A, wsb + WS_WIN, D, MT / 256, 8, F.G, F.bid};
        pg8::EpiGated<0> E{(bf16*)(F.ws + WS_B), D, F.in(11), D};
        _Pragma("unroll") for (int rep = 0; rep < REP(2); ++rep) pg8::gemm_phase<pg8::EpiGated<0>, pg8::DenseSched, true>(ring, D, S, E, F.wave);
    }
    SEAM(2);
    if (IN(3)) { _Pragma("unroll") for (int rep = 0; rep < REP(3); ++rep) p3_conv(F); }
    SEAM(3);
    if (IN(4)) {
        pg8::DenseSched S{wsb + WS_A, wsb + WS_WOUT, D, MT / 256, 4, F.G, F.bid};
        pg8::EpiBf16 E{(bf16*)(F.ws + WS_B), D, F.in(17)};
        _Pragma("unroll") for (int rep = 0; rep < REP(4); ++rep) pg8::gemm_phase<pg8::EpiBf16, pg8::DenseSched, true>(ring, D, S, E, F.wave);
    }
    SEAM(4);
    if (IN(5)) p_emid<0>(F);
    SEAM(5);
    if (IN(6)) {
        moe_setup(F, 0); moe_stage_perm(F);
        pg8::MoeUpSched S; S.tpre = (const volatile LAS int*)(F.MISC + 16); S.G = F.G; S.c = F.bid; S.A = wsb + WS_A; S.Wgu = wsb + WS_WGU; S.permL = (const LAS int*)(F.lds + PERML_OFF);
        pg8::EpiGated<1> E{(bf16*)(F.ws + WS_C), DE, nullptr, 0};
        _Pragma("unroll") for (int rep = 0; rep < REP(6); ++rep) pg8::gemm_phase<pg8::EpiGated<1>, pg8::MoeUpSched, true>(ring, D, S, E, F.wave);
    }
    SEAM(6);
    if (IN(7)) {
        moe_setup(F, 0);
        pg8::MoeDownSched S; S.tpre = (const volatile LAS int*)(F.MISC + 16); S.G = F.G; S.c = F.bid; S.A = wsb + WS_C; S.Wdn = wsb + WS_WDN;
        pg8::EpiBf16 E{(bf16*)(F.ws + WS_D2), D, nullptr};
        _Pragma("unroll") for (int rep = 0; rep < REP(7); ++rep) pg8::gemm_phase<pg8::EpiBf16, pg8::MoeDownSched, true>(ring, DE, S, E, F.wave);
    }
    SEAM(7);
    if (IN(8)) { moe_setup(F, 0); p_epost<0>(F); }
    SEAM(8);
    if (IN(9)) {
        pg8::QkvSched S{wsb + WS_A, wsb + WS_WQKV, F.G, F.bid};
        pg8::EpiQkv E{(bf16*)(F.ws + WS_B), (bf16*)(F.ws + WS_C), (bf16*)(F.ws + WS_D2), 0.125f * 1.4426950408889634f};
        _Pragma("unroll") for (int rep = 0; rep < REP(9); ++rep) pg8::gemm_phase<pg8::EpiQkv, pg8::QkvSched, true>(ring, D, S, E, F.wave);
    }
    SEAM(9);
    if (IN(10)) { _Pragma("unroll") for (int rep = 0; rep < REP(10); ++rep) p10_attn(F); }
    SEAM(10);
    if (IN(11)) {
        pg8::DenseSched S{wsb + WS_A, wsb + WS_WO, D, NLAT / 256, 4, F.G, F.bid};
        pg8::EpiBf16 E{(bf16*)(F.ws + WS_B), D, nullptr};
        _Pragma("unroll") for (int rep = 0; rep < REP(11); ++rep) pg8::gemm_phase<pg8::EpiBf16, pg8::DenseSched, true>(ring, D, S, E, F.wave);
    }
    SEAM(11);
    if (IN(12)) p_emid<1>(F);
    SEAM(12);
    if (IN(13)) {
        moe_setup(F, 1); moe_stage_perm(F);
        pg8::MoeUpSched S; S.tpre = (const volatile LAS int*)(F.MISC + 16); S.G = F.G; S.c = F.bid; S.A = wsb + WS_A; S.Wgu = wsb + WS_WGU + (size_t)16 * 1024 * 1024 * 2; S.permL = (const LAS int*)(F.lds + PERML_OFF);
        pg8::EpiGated<1> E{(bf16*)(F.ws + WS_C), DE, nullptr, 0};
        _Pragma("unroll") for (int rep = 0; rep < REP(13); ++rep) pg8::gemm_phase<pg8::EpiGated<1>, pg8::MoeUpSched, true>(ring, D, S, E, F.wave);
    }
    SEAM(13);
    if (IN(14)) {
        moe_setup(F, 1);
        pg8::MoeDownSched S; S.tpre = (const volatile LAS int*)(F.MISC + 16); S.G = F.G; S.c = F.bid; S.A = wsb + WS_C; S.Wdn = wsb + WS_WDN + (size_t)16 * 1024 * 512 * 2;
        pg8::EpiBf16 E{(bf16*)(F.ws + WS_D2), D, nullptr};
        _Pragma("unroll") for (int rep = 0; rep < REP(14); ++rep) pg8::gemm_phase<pg8::EpiBf16, pg8::MoeDownSched, true>(ring, DE, S, E, F.wave);
    }
    SEAM(14);
    if (IN(15)) { moe_setup(F, 1); p_epost<1>(F); }
#undef IN
#undef SEAM
}

extern "C" void kernel_launch(void* const* d_in, const int* in_sizes, int n_in, void* d_out, int out_size, void* d_ws, size_t ws_size, hipStream_t stream) {
    static int grid = 0;
    if (grid == 0) {
        if (n_in != 26 || in_sizes[0] != NLAT * D || out_size != NLAT * D || ws_size < WS_END) { fprintf(stderr, "kernel_launch: unexpected shapes (n_in %d, in0 %d, out %d, ws %zu); nothing launched\n", n_in, n_in > 0 ? in_sizes[0] : -1, out_size, ws_size); grid = -1; return; }
        if (hipFuncSetAttribute((const void*)fwd_kernel, hipFuncAttributeMaxDynamicSharedMemorySize, LDS_BYTES) != hipSuccess) { fprintf(stderr, "kernel_launch: hipFuncSetAttribute failed\n"); grid = -1; return; }
        int per_cu = 0;
        if (hipOccupancyMaxActiveBlocksPerMultiprocessor(&per_cu, (const void*)fwd_kernel, NTHR, LDS_BYTES) != hipSuccess || per_cu < 1) fprintf(stderr, "kernel_launch: note: occupancy query reports %d workgroups per CU\n", per_cu);
        (void)hipGetLastError();
        grid = 256;
    }
    if (grid < 0) return;
    if (hipMemsetAsync((char*)d_ws + WS_CTL, 0, CTL_ZERO_BYTES, stream) != hipSuccess) { fprintf(stderr, "kernel_launch: hipMemsetAsync failed\n"); return; }
    Args a{};
    for (int i = 0; i < 26; ++i) a.in[i] = (const float*)d_in[i];
    a.out = (float*)d_out; a.ws = (unsigned char*)d_ws;
    for (int li = 0; li < N_LAUNCHES; ++li) {
        a.ph_lo = (N_LAUNCHES == 1) ? 0 : li; a.ph_hi = (N_LAUNCHES == 1) ? N_PHASES : li + 1;
        hipLaunchKernelGGL(fwd_kernel, dim3(grid), dim3(NTHR), LDS_BYTES, stream, a);
        const hipError_t le = hipPeekAtLastError();
        if (le != hipSuccess) { fprintf(stderr, "kernel_launch: launch %d failed: %s\n", li, hipGetErrorName(le)); break; }
    }
}
```

```cpp
#include <hip/hip_runtime.h>
#include <cstdio>
#include <cstdint>

#ifndef PROBE_MASK
#define PROBE_MASK 0
#endif
#define REP(k) ((((PROBE_MASK) >> (k)) & 1) ? 2 : 1)
#ifndef DBG_SLOT
#define DBG_SLOT 0
#endif
#ifndef DBG_SKIP
#define DBG_SKIP 0
#endif
constexpr int D = 1024, BATCH = 8, SEQ = 4096, CTXL = 256;
constexpr int NLAT = BATCH * SEQ, NCTX = BATCH * CTXL, MT = NLAT + NCTX;
constexpr int NE = 16, DE = 512, NH = 16, HD = 64, GRIDW = 64, GROWS = 64, WINH = 8, WINW = 16, CONVW = 31;
constexpr int KSLOT = SEQ + CTXL;
constexpr int NMODR = 9, NMODC = 6 * D;
constexpr int MODKC = 8;
constexpr float EPS = 1e-6f;
constexpr int NWAVES = 8, NTHR = NWAVES * 64;

constexpr size_t MiB = 1u << 20;
constexpr size_t WS_CTL = 0, CTL_ZERO_BYTES = 1 * MiB;
constexpr size_t WS_SLOT = 1 * MiB;
constexpr size_t WS_PERM = 2 * MiB;
constexpr size_t WS_MODP = 5 * MiB;
constexpr size_t WS_XC = 9 * MiB;
constexpr size_t WS_WIN = 18 * MiB, WS_WOUT = 22 * MiB, WS_WQKV = 24 * MiB, WS_WO = 30 * MiB;
constexpr size_t WS_WGU = 32 * MiB;
constexpr size_t WS_WDN = 96 * MiB;
constexpr size_t WS_A = 128 * MiB, WS_B = 196 * MiB, WS_C = 264 * MiB, WS_D2 = 336 * MiB, WS_END = 480 * MiB;
constexpr int CW_BAR = 4096;
constexpr int CW_CNT = 8192;

constexpr int RING_BYTES = 131072;
constexpr int MISC_OFF = RING_BYTES;
constexpr int PTAB_OFF = RING_BYTES + 1024 + 8192;
constexpr int PERML_OFF = RING_BYTES + 1024;
constexpr int LDS_BYTES = 147456;

#define GAS __attribute__((address_space(1)))
#define LAS __attribute__((address_space(3)))
typedef unsigned short bf16;
typedef unsigned v4u __attribute__((ext_vector_type(4)));
typedef unsigned v2u __attribute__((ext_vector_type(2)));
typedef float f32x4 __attribute__((ext_vector_type(4)));
typedef float f32x2 __attribute__((ext_vector_type(2)));
typedef short bf16x8 __attribute__((ext_vector_type(8)));
typedef GAS unsigned gu32;
#define RLX_AGENT __ATOMIC_RELAXED, __HIP_MEMORY_SCOPE_AGENT
#define LDS_WAIT() asm volatile("s_waitcnt lgkmcnt(0)" ::: "memory")
#define VM_WAIT() asm volatile("s_waitcnt vmcnt(0)" ::: "memory")

__device__ __forceinline__ unsigned f2bf(float f) { unsigned u = __builtin_bit_cast(unsigned, f); return (u + 0x7fffu + ((u >> 16) & 1u)) >> 16; }
__device__ __forceinline__ unsigned pk2(float lo, float hi) { return f2bf(lo) | (f2bf(hi) << 16); }
__device__ __forceinline__ unsigned pk4_fp8(float a, float b, float c, float d) { int p = __builtin_amdgcn_cvt_pk_fp8_f32(a, b, 0, false); p = __builtin_amdgcn_cvt_pk_fp8_f32(c, d, p, true); return (unsigned)p; }
__device__ __forceinline__ float bflo(unsigned w) { return __builtin_bit_cast(float, w << 16); }
__device__ __forceinline__ float bfhi(unsigned w) { return __builtin_bit_cast(float, w & 0xffff0000u); }
__device__ __forceinline__ float row16_sum(float v) {
    v += __builtin_bit_cast(float, __builtin_amdgcn_update_dpp(0, __builtin_bit_cast(int, v), 0xB1, 0xF, 0xF, false));
    v += __builtin_bit_cast(float, __builtin_amdgcn_update_dpp(0, __builtin_bit_cast(int, v), 0x4E, 0xF, 0xF, false));
    v += __builtin_bit_cast(float, __builtin_amdgcn_update_dpp(0, __builtin_bit_cast(int, v), 0x141, 0xF, 0xF, false));
    v += __builtin_bit_cast(float, __builtin_amdgcn_update_dpp(0, __builtin_bit_cast(int, v), 0x140, 0xF, 0xF, false));
    return v;
}
__device__ __forceinline__ float rdlane(float v, int l) { return __builtin_bit_cast(float, __builtin_amdgcn_readlane(__builtin_bit_cast(int, v), l)); }
__device__ __forceinline__ float wave_sum(float v) {
    v = row16_sum(v);
    return (rdlane(v, 0) + rdlane(v, 16)) + (rdlane(v, 32) + rdlane(v, 48));
}
__device__ __forceinline__ int lane_id_asm() { int l; asm volatile("v_mbcnt_lo_u32_b32 %0, -1, 0\n\tv_mbcnt_hi_u32_b32 %0, -1, %0" : "=v"(l)); return l; }
__device__ __forceinline__ float fast_sigmoid(float x) { return __builtin_amdgcn_rcpf(1.0f + __builtin_amdgcn_exp2f(-1.4426950408889634f * x)); }

namespace pg8 {
#define PG8_LAS __attribute__((address_space(3)))
typedef unsigned short bf16_t;
typedef short bf16x8 __attribute__((ext_vector_type(8)));
typedef float f32x4 __attribute__((ext_vector_type(4)));
typedef unsigned u32x4 __attribute__((ext_vector_type(4)));
constexpr int BM = 256, BK = 64, HALF = 128, HTB = HALF * BK * 2, STAGE_BYTES = 8 * HTB, NXCD = 8, WGM = 8;

__host__ __device__ __forceinline__ int lds_byte(int r, int c) { const int st = (r >> 4) * 2 + (c >> 5), rr = r & 15, cc = c & 31, ob = rr * 64 + cc * 2; return st * 1024 + (ob ^ (((ob >> 9) & 1) << 5)); }
__host__ __device__ __forceinline__ void stage_rc(int b, int& R, int& C) { const int st = b / 1024, sb = b % 1024, swz = sb ^ (((sb >> 9) & 1) << 5); R = (st >> 1) * 16 + swz / 64; C = (st & 1) * 32 + (swz % 64) / 2; }
__host__ __device__ __forceinline__ int perm32(int rho) { const int n = rho >> 4, i = rho & 15; return 8 * (i >> 2) + 4 * n + (i & 3); }

struct Unit { int pm, pn; const char* a; const char* b; int li; int ex; };

__device__ __forceinline__ bool static_order(int L, int nM, int nN, int& pm, int& pn) {
    const int nwg = nM * nN; if (L >= nwg) return false;
    int wgid = L; { const int q = nwg / NXCD, r = nwg % NXCD, xcd = wgid % NXCD, off = wgid / NXCD; wgid = (xcd < r ? xcd * (q + 1) : r * (q + 1) + (xcd - r) * q) + off; }
    const int nig = WGM * nN, gid = wgid / nig, fm = gid * WGM, gsz = (nM - fm) < WGM ? (nM - fm) : WGM;
    pm = fm + ((wgid % nig) % gsz); pn = (wgid % nig) / gsz; return true;
}

typedef float cvt_f32x2_t __attribute__((ext_vector_type(2))); typedef __bf16 cvt_bf16x2_t __attribute__((ext_vector_type(2)));
__device__ __forceinline__ unsigned cvt_pk_bf16(float lo, float hi) { const cvt_f32x2_t v = {lo, hi}; const cvt_bf16x2_t b = __builtin_convertvector(v, cvt_bf16x2_t); return __builtin_bit_cast(unsigned, b); }

typedef int v8i_t __attribute__((ext_vector_type(8)));
typedef int v4i_t __attribute__((ext_vector_type(4)));
template <class Epi, class Sched, bool ALIGN_EPI, bool FP8 = false>
__device__ __forceinline__ void gemm_phase(PG8_LAS unsigned char* lds, const int K_, const Sched& S, const Epi& E, const int wid) {
    int K = K_; asm volatile("" : "+s"(K));
    const int lane = lane_id_asm(), tid = wid * 64 + lane, wr = wid >> 2, wc = wid & 3, fr = lane & 15, fq = lane >> 4;
    const int nt = K / BK;
    int R[2], C[2]; unsigned voffB[2], vA[2][2];
    const size_t kstep = (size_t)(BK * 2);
    const size_t hstep = (size_t)HALF * K * 2;
#pragma unroll
    for (int i = 0; i < 2; ++i) { stage_rc(tid * 16 + i * 8192, R[i], C[i]); const int Rb = Epi::PERM ? ((R[i] & ~31) + perm32(R[i] & 31)) : R[i];
        voffB[i] = (unsigned)(Rb * K + C[i]) * 2u; vA[0][i] = (unsigned)(R[i] * K + C[i]) * 2u; vA[1][i] = vA[0][i] + (unsigned)hstep; }
    const unsigned ldsw = (unsigned)wid * 1024u;
    const int aoff = lds_byte(wr * 64 + fr, fq * 8), boff = lds_byte(wc * 32 + fr, fq * 8);
#define PG8_SA(b, h) (((b) * 2 + (h)) * HTB)
#define PG8_SB(b, h) ((4 + (b) * 2 + (h)) * HTB)
#define PG8_STAGE(bufoff, gbase, voff) do { _Pragma("unroll") for (int _i = 0; _i < 2; ++_i) \
        __builtin_amdgcn_global_load_lds((const unsigned*)((const char*)(gbase) + (voff)[_i]), (PG8_LAS unsigned*)(lds + (bufoff) + ldsw + _i * 8192), 16, 0, 0); } while (0)
#define PG8_LD8(addr) __builtin_shufflevector(*(const PG8_LAS v4i_t*)(addr), *(const PG8_LAS v4i_t*)((addr) + 1024), 0, 1, 2, 3, 4, 5, 6, 7)
#define PG8_LDA(dst, b, h) do { _Pragma("unroll") for (int m = 0; m < 4; ++m) dst[m] = PG8_LD8(lds + PG8_SA(b, h) + aoff + m * 2048); } while (0)
#define PG8_LDB(dst, b, h) do { _Pragma("unroll") for (int n = 0; n < 2; ++n) dst[n] = PG8_LD8(lds + PG8_SB(b, h) + boff + n * 2048); } while (0)
#define PG8_LO(x) __builtin_bit_cast(bf16x8, __builtin_shufflevector((x), (x), 0, 1, 2, 3))
#define PG8_HI(x) __builtin_bit_cast(bf16x8, __builtin_shufflevector((x), (x), 4, 5, 6, 7))
#define PG8_MMA(ai, bj, At, Bt) do { __builtin_amdgcn_s_setprio(1); _Pragma("unroll") for (int m = 0; m < 4; ++m) _Pragma("unroll") for (int n = 0; n < 2; ++n) { \
        if constexpr (FP8) acc[ai][bj][m][n] = __builtin_amdgcn_mfma_scale_f32_16x16x128_f8f6f4(Bt[n], At[m], acc[ai][bj][m][n], 0, 0, 0, 0x79797979, 0, 0x7f7f7f7f); \
        else { acc[ai][bj][m][n] = __builtin_amdgcn_mfma_f32_16x16x32_bf16(PG8_LO(Bt[n]), PG8_LO(At[m]), acc[ai][bj][m][n], 0, 0, 0); \
               acc[ai][bj][m][n] = __builtin_amdgcn_mfma_f32_16x16x32_bf16(PG8_HI(Bt[n]), PG8_HI(At[m]), acc[ai][bj][m][n], 0, 0, 0); } } __builtin_amdgcn_s_setprio(0); } while (0)
#define PG8_WAIT_V(n) asm volatile("s_waitcnt vmcnt(" #n ")" ::: "memory")
#define PG8_WAIT_L(n) asm volatile("s_waitcnt lgkmcnt(" #n ")" ::: "memory")
#define PG8_BAR __builtin_amdgcn_s_barrier()
#define PG8_SCHED __builtin_amdgcn_sched_barrier(0)
    Unit cur, nxt; int ui = 0;
    if (!S.next(0, cur)) return;
    if constexpr (Sched::GATHER) S.a_offsets(cur, R, C, K, vA);
    f32x4 acc[2][2][4][2];
#pragma unroll
    for (int a = 0; a < 2; ++a)
#pragma unroll
        for (int b = 0; b < 2; ++b)
#pragma unroll
            for (int m = 0; m < 4; ++m)
#pragma unroll
                for (int n = 0; n < 2; ++n) acc[a][b][m][n] = (f32x4){0.f, 0.f, 0.f, 0.f};
    v8i_t At[4], B0[2], B1[2];
    const char* cA = cur.a; const char* cB = cur.b;
    PG8_STAGE(PG8_SB(0, 0), cB, voffB); PG8_STAGE(PG8_SB(0, 1), cB + hstep, voffB); PG8_STAGE(PG8_SA(0, 0), cA, vA[0]); PG8_STAGE(PG8_SA(0, 1), cA, vA[1]);
    if (wr == 1) PG8_BAR;
    PG8_WAIT_V(2); PG8_BAR;
    PG8_STAGE(PG8_SB(1, 0), cB + kstep, voffB); PG8_STAGE(PG8_SA(1, 0), cA + kstep, vA[0]); PG8_STAGE(PG8_SB(1, 1), cB + hstep + kstep, voffB);
    PG8_WAIT_V(6); PG8_BAR;
    for (;;) {
        const bool has_next = S.next(ui + 1, nxt);
        const char* nA = has_next ? nxt.a : cA; const char* nB = has_next ? nxt.b : cB;
#pragma unroll 1
        for (int t = 0; t < nt; t += 2) {
            const bool last = (t == nt - 2);
            const char* a1 = cA + (size_t)(t + 1) * kstep;
            const char* a2 = last ? nA : cA + (size_t)(t + 2) * kstep; const char* b2 = last ? nB : cB + (size_t)(t + 2) * kstep;
            const char* a3 = a2 + kstep; const char* b3 = b2 + kstep;
            PG8_LDB(B0, 0, 0); PG8_LDB(B1, 0, 1); PG8_SCHED; PG8_LDA(At, 0, 0); PG8_STAGE(PG8_SA(1, 1), a1, vA[1]);
            if constexpr (Sched::GATHER) { if (last && has_next) S.a_offsets(nxt, R, C, K, vA); }
            PG8_WAIT_V(8); PG8_WAIT_L(0); PG8_BAR; PG8_MMA(0, 0, At, B0); PG8_MMA(0, 1, At, B1); PG8_BAR; PG8_SCHED;
            PG8_LDA(At, 0, 1); PG8_STAGE(PG8_SB(0, 0), b2, voffB); PG8_STAGE(PG8_SB(0, 1), b2 + hstep, voffB); PG8_STAGE(PG8_SA(0, 0), a2, vA[0]);
            PG8_WAIT_V(8); PG8_WAIT_L(0); PG8_BAR; PG8_MMA(1, 0, At, B0); PG8_MMA(1, 1, At, B1); PG8_BAR; PG8_SCHED;
            PG8_LDB(B0, 1, 0); PG8_LDB(B1, 1, 1); PG8_SCHED; PG8_LDA(At, 1, 0); PG8_STAGE(PG8_SA(0, 1), a2, vA[1]);
            PG8_WAIT_V(8); PG8_WAIT_L(0); PG8_BAR; PG8_MMA(0, 0, At, B0); PG8_MMA(0, 1, At, B1); PG8_BAR; PG8_SCHED;
            PG8_LDA(At, 1, 1); PG8_STAGE(PG8_SB(1, 0), b3, voffB); PG8_STAGE(PG8_SB(1, 1), b3 + hstep, voffB); PG8_STAGE(PG8_SA(1, 0), a3, vA[0]);
            PG8_WAIT_V(8); PG8_WAIT_L(0); PG8_BAR; PG8_MMA(1, 0, At, B0); PG8_MMA(1, 1, At, B1); PG8_BAR; PG8_SCHED;
        }
        if constexpr (ALIGN_EPI) { if (wr == 0) PG8_BAR; }
        E(acc, cur, wr, wc, fr, fq);
        if (!has_next) break;
#pragma unroll
        for (int a = 0; a < 2; ++a)
#pragma unroll
            for (int b = 0; b < 2; ++b)
#pragma unroll
                for (int m = 0; m < 4; ++m)
#pragma unroll
                    for (int n = 0; n < 2; ++n) acc[a][b][m][n] = (f32x4){0.f, 0.f, 0.f, 0.f};
        cur = nxt; cA = nA; cB = nB; ++ui;
        if constexpr (ALIGN_EPI) { if (wr == 1) PG8_BAR; }
    }
    PG8_WAIT_V(0);
    if constexpr (!ALIGN_EPI) { if (wr == 0) PG8_BAR; }
    PG8_BAR;
#undef PG8_SA
#undef PG8_SB
#undef PG8_STAGE
#undef PG8_LDA
#undef PG8_LDB
#undef PG8_MMA
#undef PG8_LO
#undef PG8_HI
#undef PG8_LD8
#undef PG8_WAIT_V
#undef PG8_WAIT_L
#undef PG8_BAR
#undef PG8_SCHED
}

struct DenseSched {
    static constexpr bool GATHER = false;
    const char* A; const char* Bt; int K, nM, nN, G, c;
    __device__ __forceinline__ bool next(int i, Unit& u) const {
        int pm, pn; if (!static_order(i * G + c, nM, nN, pm, pn)) return false;
        u.pm = pm; u.pn = pn; u.a = A + (size_t)pm * BM * K * 2; u.b = Bt + (size_t)pn * BM * K * 2; u.li = i; u.ex = 0; return true;
    }
    __device__ __forceinline__ void a_offsets(const Unit&, const int (&)[2], const int (&)[2], int, unsigned (&)[2][2]) const {}
};
struct QkvSched {
    static constexpr bool GATHER = false;
    const char* A; const char* Bt; int G, c;
    __device__ __forceinline__ bool next(int i, Unit& u) const {
        const int L = i * G + c; int pm, pn;
        if (L < 1536) { static_order(L, 128, 12, pm, pn); }
        else { const int l2 = L - 1536; if (l2 >= 64) return false; pm = 128 + (l2 >> 3); pn = 4 + (l2 & 7); }
        u.pm = pm; u.pn = pn; u.a = A + (size_t)pm * BM * D * 2; u.b = Bt + (size_t)pn * BM * D * 2; u.li = i; u.ex = 0; return true;
    }
    __device__ __forceinline__ void a_offsets(const Unit&, const int (&)[2], const int (&)[2], int, unsigned (&)[2][2]) const {}
};
struct MoeSchedBase {
    const volatile PG8_LAS int* tpre;
    int G, c;
    __device__ __forceinline__ bool locate(int i, int& rt, int& pn, int& e) const {
        const int L = i * G + c; const int ntile = tpre[16];
        if (L >= 4 * ntile) return false;
        rt = L >> 2; pn = L & 3; int ee = 0;
#pragma unroll
        for (int j = 1; j < 16; ++j) ee += (rt >= tpre[j]) ? 1 : 0;
        e = ee; return true;
    }
};
struct MoeUpSched : MoeSchedBase {
    static constexpr bool GATHER = true;
    const char* A; const char* Wgu; const PG8_LAS int* permL; int kb;
    __device__ __forceinline__ bool next(int i, Unit& u) const {
        int rt, pn, e; if (!locate(i, rt, pn, e)) return false;
        u.pm = rt; u.pn = pn; u.a = A; u.b = Wgu + (size_t)e * 1024 * kb + (size_t)pn * BM * kb; u.li = i; u.ex = e; return true;
    }
    __device__ __forceinline__ void a_offsets(const Unit& u, const int (&R)[2], const int (&C)[2], int K, unsigned (&vA)[2][2]) const {
#pragma unroll
        for (int h = 0; h < 2; ++h)
#pragma unroll
            for (int i = 0; i < 2; ++i) vA[h][i] = (unsigned)permL[u.li * 256 + h * HALF + R[i]] * (unsigned)(K * 2) + (unsigned)(C[i] * 2);
    }
};
struct MoeDownSched : MoeSchedBase {
    static constexpr bool GATHER = false;
    const char* A; const char* Wdn; int kb;
    __device__ __forceinline__ bool next(int i, Unit& u) const {
        int rt, pn, e; if (!locate(i, rt, pn, e)) return false;
        u.pm = rt; u.pn = pn; u.a = A + (size_t)rt * BM * kb; u.b = Wdn + (size_t)e * 1024 * kb + (size_t)pn * BM * kb; u.li = i; u.ex = e; return true;
    }
    __device__ __forceinline__ void a_offsets(const Unit&, const int (&)[2], const int (&)[2], int, unsigned (&)[2][2]) const {}
};

template <bool HAS_BIAS> struct EpiBf16T {
    static constexpr bool PERM = true;
    bf16_t* O; int ldc; const float* bias;
    __device__ __forceinline__ void operator()(const f32x4 (&acc)[2][2][4][2], const Unit& u, int wr, int wc, int fr, int fq) const {
        const int row0 = u.pm * BM + wr * 64 + fr, col0 = u.pn * BM + wc * 32 + 8 * fq;
        f32x4 bv[2][2];
#pragma unroll
        for (int bj = 0; bj < 2; ++bj)
#pragma unroll
            for (int n = 0; n < 2; ++n) bv[bj][n] = HAS_BIAS ? *(const f32x4*)(bias + col0 + bj * HALF + 4 * n) : (f32x4){0.f, 0.f, 0.f, 0.f};
#pragma unroll
        for (int ai = 0; ai < 2; ++ai)
#pragma unroll
            for (int m = 0; m < 4; ++m) { bf16_t* rowp = O + (size_t)(row0 + ai * HALF + m * 16) * ldc + col0;
#pragma unroll
                for (int bj = 0; bj < 2; ++bj) { f32x4 v0 = acc[ai][bj][m][0], v1 = acc[ai][bj][m][1]; if constexpr (HAS_BIAS) { v0 += bv[bj][0]; v1 += bv[bj][1]; }
                    u32x4 w; w.x = cvt_pk_bf16(v0[0], v0[1]); w.y = cvt_pk_bf16(v0[2], v0[3]); w.z = cvt_pk_bf16(v1[0], v1[1]); w.w = cvt_pk_bf16(v1[2], v1[3]);
                    *(u32x4*)(rowp + bj * HALF) = w; } }
    }
};
typedef EpiBf16T<true> EpiBf16B; typedef EpiBf16T<false> EpiBf16;
template <int MODE  , bool OUT8 = false  > struct EpiGated {
    static constexpr bool PERM = true;
    bf16_t* O; int ldc; const float* bias; int nch;
    __device__ __forceinline__ void operator()(const f32x4 (&acc)[2][2][4][2], const Unit& u, int wr, int wc, int fr, int fq) const {
        const int row0 = u.pm * BM + wr * 64 + fr, ch0 = u.pn * HALF + wc * 32 + 8 * fq;
        f32x4 b0[2], b1[2];
#pragma unroll
        for (int n = 0; n < 2; ++n) { if (MODE == 0) { b0[n] = *(const f32x4*)(bias + ch0 + 4 * n); b1[n] = *(const f32x4*)(bias + nch + ch0 + 4 * n); } else { b0[n] = (f32x4){0.f, 0.f, 0.f, 0.f}; b1[n] = b0[n]; } }
#pragma unroll
        for (int ai = 0; ai < 2; ++ai)
#pragma unroll
            for (int m = 0; m < 4; ++m) { bf16_t* rowp = O + (size_t)(row0 + ai * HALF + m * 16) * ldc + ch0; float o[8];
#pragma unroll
                for (int n = 0; n < 2; ++n) { const f32x4 x0 = acc[ai][0][m][n] + b0[n], x1 = acc[ai][1][m][n] + b1[n];
#pragma unroll
                    for (int e = 0; e < 4; ++e) o[4 * n + e] = (MODE == 0) ? x0[e] * fast_sigmoid(x1[e]) : (x0[e] * fast_sigmoid(x0[e])) * x1[e]; }
                if constexpr (OUT8) { unsigned char* rp8 = (unsigned char*)O + (size_t)(row0 + ai * HALF + m * 16) * ldc + ch0;
                    *(unsigned long long*)rp8 = (unsigned long long)pk4_fp8(o[0], o[1], o[2], o[3]) | ((unsigned long long)pk4_fp8(o[4], o[5], o[6], o[7]) << 32); }
                else { u32x4 w; w.x = cvt_pk_bf16(o[0], o[1]); w.y = cvt_pk_bf16(o[2], o[3]); w.z = cvt_pk_bf16(o[4], o[5]); w.w = cvt_pk_bf16(o[6], o[7]);
                    *(u32x4*)rowp = w; } }
    }
};
struct EpiQkv {
    static constexpr bool PERM = true;
    bf16_t* Q; bf16_t* Kh; bf16_t* Vb; float qscale;
    __device__ __forceinline__ void operator()(const f32x4 (&acc)[2][2][4][2], const Unit& u, int wr, int wc, int fr, int fq) const {
        const int which = u.pn >> 2; const bool isctx = u.pm >= 128;
        const int b = isctx ? (u.pm - 128) : (u.pm >> 4);
        const int key0 = isctx ? SEQ : ((u.pm & 15) << 8);
        const int d0 = 32 * (wc & 1) + 8 * fq;
#pragma unroll
        for (int ai = 0; ai < 2; ++ai)
#pragma unroll
            for (int m = 0; m < 4; ++m) { const int key = key0 + ai * HALF + wr * 64 + m * 16 + fr;
#pragma unroll
                for (int bj = 0; bj < 2; ++bj) { const int h = 4 * (u.pn & 3) + 2 * bj + (wc >> 1); const f32x4 v0 = acc[ai][bj][m][0], v1 = acc[ai][bj][m][1];
                    if (which == 2) {
                        bf16_t* p = Vb + ((size_t)(b * NH + h) * (KSLOT / 8) + (key >> 3)) * 512 + (size_t)d0 * 8 + (key & 7);
                        const unsigned w0 = cvt_pk_bf16(v0[0], v0[1]), w1 = cvt_pk_bf16(v0[2], v0[3]), w2 = cvt_pk_bf16(v1[0], v1[1]), w3 = cvt_pk_bf16(v1[2], v1[3]);
                        p[0] = (bf16_t)w0; p[8] = (bf16_t)(w0 >> 16); p[16] = (bf16_t)w1; p[24] = (bf16_t)(w1 >> 16); p[32] = (bf16_t)w2; p[40] = (bf16_t)(w2 >> 16); p[48] = (bf16_t)w3; p[56] = (bf16_t)(w3 >> 16);
                    } else {
                        const float qs = (which == 0) ? qscale : 1.0f; const f32x4 y0 = v0 * qs, y1 = v1 * qs;
                        u32x4 w; w.x = cvt_pk_bf16(y0[0], y0[1]); w.y = cvt_pk_bf16(y0[2], y0[3]); w.z = cvt_pk_bf16(y1[0], y1[1]); w.w = cvt_pk_bf16(y1[2], y1[3]);
                        bf16_t* p = (which == 0) ? Q + ((size_t)(b * NH + h) * SEQ + key) * HD + d0 : Kh + ((size_t)(b * NH + h) * KSLOT + key) * HD + d0;
                        *(u32x4*)p = w;
                    } } }
    }
};
}
#define XB_TMO      128
#define XB_XCNT(j)  (256  + 64 * (j))
#define XB_XSUB(j)  (1280 + 64 * (j))
#define XB_XGEN(j)  (2304 + 64 * (j))
#define XB_TOP      3328
#define XB_TOPGEN   3392
#define XCD_BAR_WORDS 3456
#define XB_SPIN_CAP (1u << 18)

__device__ __forceinline__ unsigned xb_ld(unsigned* p)              { return __hip_atomic_load(p, __ATOMIC_RELAXED, __HIP_MEMORY_SCOPE_AGENT); }
__device__ __forceinline__ unsigned xb_add(unsigned* p, unsigned v) { return __hip_atomic_fetch_add(p, v, __ATOMIC_RELAXED, __HIP_MEMORY_SCOPE_AGENT); }
__device__ __forceinline__ unsigned xb_xcc_id() { return (unsigned)__builtin_amdgcn_s_getreg((3 << 11) | 20) & 0xFu; }
#define XB_SPIN(cond, bar) do { unsigned _sp = 0; while (cond) { __builtin_amdgcn_s_sleep(1); \
    if ((++_sp & 255u) == 0u) { if (xb_ld(&(bar)[XB_TMO])) break; if (_sp > XB_SPIN_CAP) { atomicAdd(&(bar)[XB_TMO], 1u); break; } } } } while (0)

struct XcdBarrier {
    unsigned* bar; unsigned x;
    volatile LAS unsigned* st;
};

__device__ __forceinline__ XcdBarrier xcd_barrier_post(unsigned* bar, volatile LAS unsigned* st) {
    XcdBarrier b; b.bar = bar; b.x = xb_xcc_id(); b.st = st;
    if (threadIdx.x == 0) (void)xb_add(&bar[XB_XCNT(b.x)], 1u);
    return b;
}
__device__ __forceinline__ void xcd_barrier_complete(unsigned* bar, unsigned x, unsigned& nloc, unsigned& nx) {
    const unsigned G = gridDim.x * gridDim.y * gridDim.z;
    unsigned sum, cnt, mine, sp = 0u;
    for (;;) {
        sum = 0u; cnt = 0u; mine = 0u;
#pragma unroll
        for (unsigned j = 0; j < 16; ++j) { const unsigned c = xb_ld(&bar[XB_XCNT(j)]); sum += c; cnt += (c > 0u) ? 1u : 0u; mine = (j == x) ? c : mine; }
        if (sum == G) break;
        __builtin_amdgcn_s_sleep(1);
        if ((++sp & 255u) == 0u) { if (xb_ld(&bar[XB_TMO])) break; if (sp > XB_SPIN_CAP) { atomicAdd(&bar[XB_TMO], 1u); break; } }
    }
    nloc = mine > 0u ? mine : 1u; nx = cnt > 0u ? cnt : 1u;
}

__device__ __forceinline__ void xcd_barrier(const XcdBarrier& b) {
    asm volatile("s_waitcnt vmcnt(0)" ::: "memory");
    __syncthreads();
    if (threadIdx.x == 0) {
        unsigned* bar = b.bar;
        __builtin_amdgcn_s_waitcnt(0);
        unsigned nloc = b.st[0], nx = b.st[1];
        if (nloc == 0u) { xcd_barrier_complete(bar, b.x, nloc, nx); b.st[0] = nloc; b.st[1] = nx; }
        const unsigned old = xb_add(&bar[XB_XSUB(b.x)], 1u);
        const unsigned gen = old / nloc;
        if (old + 1u == (gen + 1u) * nloc) {
            __builtin_amdgcn_fence(__ATOMIC_RELEASE, "agent");
            asm volatile("s_waitcnt vmcnt(0)" ::: "memory");
            const unsigned og = xb_add(&bar[XB_TOP], 1u);
            const unsigned tg = og / nx;
            if (og + 1u == (tg + 1u) * nx) xb_add(&bar[XB_TOPGEN], 1u);
            else XB_SPIN(xb_ld(&bar[XB_TOPGEN]) == tg, bar);
            __builtin_amdgcn_fence(__ATOMIC_ACQUIRE, "agent");
            xb_add(&bar[XB_XGEN(b.x)], 1u);
            asm volatile("s_waitcnt vmcnt(0)" ::: "memory");
        } else {
            XB_SPIN(xb_ld(&bar[XB_XGEN(b.x)]) == gen, bar);
            __builtin_amdgcn_fence(__ATOMIC_ACQUIRE, "agent");
            asm volatile("s_waitcnt vmcnt(0)" ::: "memory");
        }
    }
    __syncthreads();
}

struct Frame {
    LAS unsigned char* lds;
    volatile LAS unsigned* MISC;
    gu32* ctl;
    int wave, G, bid;
    __device__ __forceinline__ const float* in(int k) const { const volatile LAS unsigned* t = (const volatile LAS unsigned*)(lds + PTAB_OFF) + 2 * k;
        const unsigned lo = __builtin_amdgcn_readfirstlane(t[0]), hi = __builtin_amdgcn_readfirstlane(t[1]); return (const float*)(const GAS float*)(((unsigned long long)hi << 32) | lo); }
    __device__ __forceinline__ int lane() const { return lane_id_asm(); }
    __device__ __forceinline__ int tid() const { return wave * 64 + lane_id_asm(); }
    unsigned char* ws;
    float* out;
};

__device__ __forceinline__ void ld_row_f32(const float* row, int lane, f32x4 (&v)[4]) {
    const f32x4* p = (const f32x4*)row + lane;
#pragma unroll
    for (int j = 0; j < 4; ++j) v[j] = p[64 * j];
}
__device__ __forceinline__ void st_row_f32(float* row, int lane, const f32x4 (&v)[4]) {
    f32x4* p = (f32x4*)row + lane;
#pragma unroll
    for (int j = 0; j < 4; ++j) p[64 * j] = v[j];
}
__device__ __forceinline__ void ld_row_bf16(const bf16* row, int lane, f32x4 (&v)[4]) {
    const v2u* p = (const v2u*)row + lane;
#pragma unroll
    for (int j = 0; j < 4; ++j) { const v2u w = p[64 * j]; v[j] = (f32x4){bflo(w.x), bfhi(w.x), bflo(w.y), bfhi(w.y)}; }
}
__device__ __forceinline__ void st_row_bf16(bf16* row, int lane, const f32x4 (&v)[4]) {
    v2u* p = (v2u*)row + lane;
#pragma unroll
    for (int j = 0; j < 4; ++j) { v2u w; w.x = pk2(v[j][0], v[j][1]); w.y = pk2(v[j][2], v[j][3]); p[64 * j] = w; }
}
__device__ __forceinline__ void st_row_fp8(unsigned char* row, int lane, const f32x4 (&v)[4]) {
    unsigned* p = (unsigned*)row + lane;
#pragma unroll
    for (int j = 0; j < 4; ++j) p[64 * j] = pk4_fp8(v[j][0], v[j][1], v[j][2], v[j][3]);
}
__device__ __forceinline__ float sumsq4(const f32x4 (&v)[4]) {
    float s = 0.f;
#pragma unroll
    for (int j = 0; j < 4; ++j) s += (v[j][0] * v[j][0] + v[j][1] * v[j][1]) + (v[j][2] * v[j][2] + v[j][3] * v[j][3]);
    return s;
}
__device__ __forceinline__ void ld_mod(const Frame& F, int l, int r, int ch, f32x4 (&v)[4]) {
    const float* modp = (const float*)(F.ws + WS_MODP); const int lane = F.lane();
    ld_row_f32(F.in(5) + (size_t)l * NMODC + ch * D, lane, v);
#pragma unroll
    for (int kc = 0; kc < MODKC; ++kc) { f32x4 t[4]; ld_row_f32(modp + ((size_t)((kc * 2 + l) * NMODR + r)) * NMODC + ch * D, lane, t);
#pragma unroll
        for (int j = 0; j < 4; ++j) v[j] += t[j]; }
}
__device__ __forceinline__ int row_batch(int m) { return m < NLAT ? (m >> 12) : 8; }

__device__ __forceinline__ void p0_transpose_item(const float* W, int K, int N, bf16* WT, int drow_off, LAS float* scr, int item, int lane) {
    const int nblk = N / 32, kb = item / nblk, nb = item % nblk, k0 = 64 * kb, n0 = 32 * nb;
#pragma unroll 8
    for (int i = 0; i < 32; ++i) { const int kk = 2 * i + (lane >> 5); scr[kk * 33 + (lane & 31)] = W[(size_t)(k0 + kk) * N + n0 + (lane & 31)]; }
    LDS_WAIT(); asm volatile("" ::: "memory");
    const int c = lane & 7;
#pragma unroll
    for (int j = 0; j < 4; ++j) { const int n = (lane >> 3) + 8 * j; const LAS float* s = scr + (8 * c) * 33 + n;
        v4u o; o.x = pk2(s[0 * 33], s[1 * 33]); o.y = pk2(s[2 * 33], s[3 * 33]); o.z = pk2(s[4 * 33], s[5 * 33]); o.w = pk2(s[6 * 33], s[7 * 33]);
        *(GAS v4u*)(WT + (size_t)(drow_off + n0 + n) * K + k0 + 8 * c) = o; }
    LDS_WAIT(); asm volatile("" ::: "memory");
}
__device__ __forceinline__ void p0_transpose_item_fp8(const float* W, int K, int N, unsigned char* WT, int drow_off, float wscale, LAS float* scr, int item, int lane) {
    const int nblk = N / 32, kb = item / nblk, nb = item % nblk, k0 = 64 * kb, n0 = 32 * nb;
#pragma unroll 8
    for (int i = 0; i < 32; ++i) { const int kk = 2 * i + (lane >> 5); scr[kk * 33 + (lane & 31)] = W[(size_t)(k0 + kk) * N + n0 + (lane & 31)] * wscale; }
    LDS_WAIT(); asm volatile("" ::: "memory");
    const int c = lane & 3;
#pragma unroll
    for (int j = 0; j < 2; ++j) { const int n = (lane >> 2) + 16 * j; const LAS float* s = scr + (16 * c) * 33 + n;
        v4u o; o.x = pk4_fp8(s[0 * 33], s[1 * 33], s[2 * 33], s[3 * 33]); o.y = pk4_fp8(s[4 * 33], s[5 * 33], s[6 * 33], s[7 * 33]);
        o.z = pk4_fp8(s[8 * 33], s[9 * 33], s[10 * 33], s[11 * 33]); o.w = pk4_fp8(s[12 * 33], s[13 * 33], s[14 * 33], s[15 * 33]);
        *(GAS v4u*)(WT + (size_t)(drow_off + n0 + n) * K + k0 + 16 * c) = o; }
    LDS_WAIT(); asm volatile("" ::: "memory");
}
constexpr float W8SCALE = 64.0f;
constexpr int I_WIN = 1024, I_WOUT = 512, I_WQKV = 1536, I_WO = 512, I_EXP = 32 * 768, NITEMS_P0 = I_WIN + I_WOUT + I_WQKV + I_WO + I_EXP;
__device__ __forceinline__ void p0_item(const Frame& F, LAS float* scr, int it) {
    int r = it; const int lane = F.lane();
    if (r < I_WIN) { const int n0 = 32 * (r % 64), ch = n0 & 1023, hf = n0 >> 10, drow0 = 256 * (ch >> 7) + 128 * hf + (ch & 127);
        p0_transpose_item(F.in(10), D, 2 * D, (bf16*)(F.ws + WS_WIN), drow0 - n0, scr, r, lane); return; }
    r -= I_WIN;
    if (r < I_WOUT) { p0_transpose_item(F.in(16), D, D, (bf16*)(F.ws + WS_WOUT), 0, scr, r, lane); return; }
    r -= I_WOUT;
    if (r < I_WQKV) { p0_transpose_item(F.in(18), D, 3 * D, (bf16*)(F.ws + WS_WQKV), 0, scr, r, lane); return; }
    r -= I_WQKV;
    if (r < I_WO) { p0_transpose_item(F.in(19), D, D, (bf16*)(F.ws + WS_WO), 0, scr, r, lane); return; }
    r -= I_WO;
    const int le = r / 768; int q = r % 768;
    if (q < 512) { const bool up = q >= 256; if (up) q -= 256; const int n0 = 32 * (q % 16), drow0 = 256 * (n0 >> 7) + (up ? 128 : 0) + (n0 & 127);
        p0_transpose_item_fp8((up ? F.in(24) : F.in(23)) + (size_t)le * D * DE, D, DE, (unsigned char*)(F.ws + WS_WGU) + (size_t)le * 1024 * 1024, drow0 - n0, W8SCALE, scr, q, lane); return; }
    q -= 512;
    p0_transpose_item(F.in(25) + (size_t)le * DE * D, DE, D, (bf16*)(F.ws + WS_WDN) + (size_t)le * 1024 * 512, 0, scr, q, lane);
}
__device__ __forceinline__ void p0_mod_item(const Frame& F, LAS float* scr, int it) {
    const int lane = F.lane(), l = it / 192, rem = it % 192, cg = rem >> 3, kc = rem & 7, k0 = 128 * kc, n0 = 256 * cg + 4 * lane;
    const float* cvec = F.in(1); const float* cctx = F.in(3);
    for (int idx = lane; idx < NMODR * 128; idx += 64) { const int r = idx >> 7, kk = idx & 127; const float cv = (r < 8) ? cvec[r * D + k0 + kk] : cctx[k0 + kk];
        scr[idx] = cv / (1.0f + __expf(-cv)); }
    LDS_WAIT(); asm volatile("" ::: "memory");
    f32x4 acc[NMODR];
#pragma unroll
    for (int r = 0; r < NMODR; ++r) acc[r] = (f32x4){0.f, 0.f, 0.f, 0.f};
    const float* wp = F.in(4) + ((size_t)l * D + k0) * NMODC + n0;
#pragma unroll 8
    for (int kk = 0; kk < 128; ++kk) { const f32x4 w = *(const f32x4*)(wp + (size_t)kk * NMODC);
#pragma unroll
        for (int r = 0; r < NMODR; ++r) { const float s = scr[r * 128 + kk]; acc[r] += w * s; } }
    float* modp = (float*)(F.ws + WS_MODP);
#pragma unroll
    for (int r = 0; r < NMODR; ++r) *(f32x4*)(modp + ((size_t)((kc * 2 + l) * NMODR + r)) * NMODC + n0) = acc[r];
    LDS_WAIT(); asm volatile("" ::: "memory");
}
__device__ __forceinline__ void p0_prologue(const Frame& F) {
    LAS float* scr = (LAS float*)(F.lds + F.wave * 16384);
    if (F.wave == 0) p0_mod_item(F, scr, F.bid);
    if (F.wave == 1 && F.bid < 128) p0_mod_item(F, scr, 256 + F.bid);
    const int gw = F.bid * NWAVES + F.wave, NGW = F.G * NWAVES;
    for (int it = gw; it < NITEMS_P0; it += NGW) p0_item(F, scr, it);
}

__device__ __forceinline__ void p1_modulate(const Frame& F) {
    constexpr int RPB = MT / 256;
    bf16* H = (bf16*)(F.ws + WS_A);
    int rc = -1; f32x4 gs[4], sh[4]; const int lane = F.lane();
    const float* xlat = F.in(0); const float* xctx = F.in(2);
    for (int rl = F.wave; rl < RPB; rl += NWAVES) {
        const int m = F.bid * RPB + rl, r = row_batch(m);
        if (r != rc) { f32x4 g[4], sc[4]; ld_row_f32(F.in(6), lane, g); ld_mod(F, 0, r, 1, sc); ld_mod(F, 0, r, 0, sh);
#pragma unroll
            for (int j = 0; j < 4; ++j) gs[j] = g[j] * (sc[j] + 1.0f);
            rc = r; }
        f32x4 v[4]; ld_row_f32(m < NLAT ? xlat + (size_t)m * D : xctx + (size_t)(m - NLAT) * D, lane, v);
        const float rstd = 1.0f / sqrtf(wave_sum(sumsq4(v)) * (1.0f / D) + EPS);
#pragma unroll
        for (int j = 0; j < 4; ++j) v[j] = v[j] * rstd * gs[j] + sh[j];
        st_row_bf16(H + (size_t)m * D, lane, v);
    }
}

__device__ __forceinline__ void p3_conv(const Frame& F) {
    const bf16* U = (const bf16*)(F.ws + WS_B); bf16* V = (bf16*)(F.ws + WS_A);
    const int tid = F.tid(), lane = F.lane();
    f32x2 w[CONVW]; const float* wdw = F.in(12);
#pragma unroll
    for (int j = 0; j < CONVW; ++j) w[j] = *(const f32x2*)(wdw + j * D + 2 * tid);
    const f32x2 bias2 = *(const f32x2*)(F.in(13) + 2 * tid);
    f32x4 lg[4], lb[4]; ld_row_f32(F.in(14), lane, lg); ld_row_f32(F.in(15), lane, lb);
    constexpr int TT = 32, NIN = TT + CONVW - 1;
    for (int tile = F.bid; tile < MT / TT; tile += F.G) {
        int rowbase, t0, T;
        if (tile < NLAT / TT) { rowbase = (tile >> 7) * SEQ; t0 = (tile & 127) * TT; T = SEQ; } else { const int t2 = tile - NLAT / TT; rowbase = NLAT + (t2 >> 3) * CTXL; t0 = (t2 & 7) * TT; T = CTXL; }
        for (int p = tid; p < NIN * 128; p += NTHR) { const int i = p >> 7, cp = p & 127, t = t0 - 15 + i;
            v4u val = (v4u){0u, 0u, 0u, 0u}; if (t >= 0 && t < T) val = *(const v4u*)(U + (size_t)(rowbase + t) * D + cp * 8);
            *(LAS v4u*)(F.lds + i * 2048 + cp * 16) = val; }
        __syncthreads();
        f32x2 res[TT];
#pragma unroll
        for (int g = 0; g < TT / 8; ++g) {
            f32x2 acc[8];
#pragma unroll
            for (int q = 0; q < 8; ++q) acc[q] = bias2;
#pragma unroll
            for (int ii = 0; ii < 8 + CONVW - 1; ++ii) { const int i = 8 * g + ii; const unsigned uw = *(const LAS unsigned*)(F.lds + i * 2048 + tid * 4); const f32x2 uv = (f32x2){bflo(uw), bfhi(uw)};
#pragma unroll
                for (int q = 0; q < 8; ++q) { const int j = ii - q; if (j >= 0 && j < CONVW) acc[q] += w[j] * uv; } }
#pragma unroll
            for (int q = 0; q < 8; ++q) res[8 * g + q] = acc[q];
        }
        __syncthreads();
#pragma unroll
        for (int tt = 0; tt < TT; ++tt) *(LAS f32x2*)(F.lds + tt * 4096 + tid * 8) = res[tt];
        __syncthreads();
#pragma unroll
        for (int q = 0; q < 4; ++q) { const int tt = 4 * F.wave + q; f32x4 v[4];
#pragma unroll
            for (int j = 0; j < 4; ++j) v[j] = *(const LAS f32x4*)(F.lds + tt * 4096 + j * 1024 + lane * 16);
            float s = 0.f;
#pragma unroll
            for (int j = 0; j < 4; ++j) s += (v[j][0] + v[j][1]) + (v[j][2] + v[j][3]);
            const float mean = wave_sum(s) * (1.0f / D);
#pragma unroll
            for (int j = 0; j < 4; ++j) v[j] = v[j] - mean;
            const float rstd = 1.0f / sqrtf(wave_sum(sumsq4(v)) * (1.0f / D) + EPS);
#pragma unroll
            for (int j = 0; j < 4; ++j) { f32x4 y = v[j] * rstd * lg[j] + lb[j];
#pragma unroll
                for (int e = 0; e < 4; ++e) y[e] = y[e] / (1.0f + __expf(-y[e]));
                v[j] = y; }
            st_row_bf16(V + (size_t)(rowbase + t0 + tt) * D, lane, v); }
        __syncthreads();
    }
}

constexpr int RW_OFF = 0, RW_BYTES = 256 * 272;
constexpr int REC_OFF = 72 * 1024;
constexpr int LRK_OFF = REC_OFF + 4096;
constexpr int BASE_OFF = LRK_OFF + 2048;
template <int L>
__device__ __forceinline__ void p_emid(const Frame& F) {
    constexpr int NROWS = (L == 0) ? MT : NLAT, RPB = NROWS / 256;
    const bf16* Y = (const bf16*)(F.ws + WS_B); unsigned char* TOK = (unsigned char*)(F.ws + WS_A);
    float* XC = (float*)(F.ws + WS_XC);
    const int tid = F.tid(), lane = F.lane(), m0 = F.bid * RPB;
    const float* rwG = F.in(21);
    for (int idx = tid; idx < 4096; idx += NTHR) { const int k = idx >> 2, ep = idx & 3; const f32x4 v = *(const f32x4*)(rwG + k * 16 + ep * 4);
        *(LAS f32x4*)(F.lds + RW_OFF + (k >> 2) * 272 + (k & 3) * 64 + ep * 16) = v; }
    __syncthreads();
    float rb[16];
    { const float* rbG = F.in(22);
#pragma unroll
    for (int e = 0; e < 16; ++e) rb[e] = rbG[e]; }
    int rc = -1; f32x4 ga[4], gp[4], gs[4], sh[4];
    const float* xlat = F.in(0); const float* xctx = F.in(2);
    for (int rl = F.wave; rl < RPB; rl += NWAVES) {
        const int m = m0 + rl, r = row_batch(m);
        if (r != rc) { f32x4 g[4], sc[4]; ld_mod(F, L, r, 2, ga); ld_row_f32(F.in(7) + L * D, lane, gp); ld_row_f32(F.in(8) + L * D, lane, g); ld_mod(F, L, r, 4, sc); ld_mod(F, L, r, 3, sh);
#pragma unroll
            for (int j = 0; j < 4; ++j) gs[j] = g[j] * (sc[j] + 1.0f);
            rc = r; }
        f32x4 y[4], xv[4];
        ld_row_bf16(Y + (size_t)m * D, lane, y);
        const float* xin = (L == 0) ? (m < NLAT ? xlat + (size_t)m * D : xctx + (size_t)(m - NLAT) * D) : F.out + (size_t)m * D;
        ld_row_f32(xin, lane, xv);
        const float rstdy = 1.0f / sqrtf(wave_sum(sumsq4(y)) * (1.0f / D) + EPS);
#pragma unroll
        for (int j = 0; j < 4; ++j) xv[j] = xv[j] + ga[j] * (y[j] * rstdy * gp[j]) * (((DBG_SKIP >> (2 * L)) & 1) ? 0.f : 1.f);
        st_row_f32(m < NLAT ? F.out + (size_t)m * D : XC + (size_t)(m - NLAT) * D, lane, xv);
        const float rstd1 = 1.0f / sqrtf(wave_sum(sumsq4(xv)) * (1.0f / D) + EPS);
#pragma unroll
        for (int j = 0; j < 4; ++j) xv[j] = xv[j] * rstd1 * gs[j] + sh[j];
        st_row_fp8(TOK + (size_t)m * D, lane, xv);
        float a[16];
#pragma unroll
        for (int e = 0; e < 16; ++e) a[e] = 0.f;
#pragma unroll
        for (int j = 0; j < 4; ++j)
#pragma unroll
            for (int i = 0; i < 4; ++i) { const float tv = xv[j][i]; const LAS f32x4* wp = (const LAS f32x4*)(F.lds + RW_OFF + (64 * j + lane) * 272 + i * 64);
#pragma unroll
                for (int ep = 0; ep < 4; ++ep) { const f32x4 wv = wp[ep];
#pragma unroll
                    for (int cc = 0; cc < 4; ++cc) a[4 * ep + cc] += tv * wv[cc]; } }
        float k8[8], k4[4];
#pragma unroll
        for (int i = 0; i < 8; ++i) { const auto rr = __builtin_amdgcn_permlane32_swap(__builtin_bit_cast(unsigned, a[i]), __builtin_bit_cast(unsigned, a[8 + i]), false, false);
            const unsigned r0_ = rr[0], r1_ = rr[1]; k8[i] = __uint_as_float(r0_) + __uint_as_float(r1_); }
#pragma unroll
        for (int i = 0; i < 4; ++i) { const auto rr = __builtin_amdgcn_permlane16_swap(__builtin_bit_cast(unsigned, k8[i]), __builtin_bit_cast(unsigned, k8[4 + i]), false, false);
            const unsigned r0_ = rr[0], r1_ = rr[1]; k4[i] = row16_sum(__uint_as_float(r0_) + __uint_as_float(r1_)); }
        float s[16], ss[16];
        const float lgsel = (lane & 2) ? ((lane & 1) ? k4[3] : k4[2]) : ((lane & 1) ? k4[1] : k4[0]);
        const float sgl = 1.0f / (1.0f + __expf(-lgsel));
#pragma unroll
        for (int e = 0; e < 16; ++e) { s[e] = rdlane(sgl, 16 * (e >> 2) + (e & 3)); ss[e] = s[e] + rb[e]; }
        float gsc[4]; int i0[4], i1[4];
#pragma unroll
        for (int g = 0; g < 4; ++g) { int a0 = 0; float mx = ss[4 * g];
#pragma unroll
            for (int i = 1; i < 4; ++i) if (ss[4 * g + i] > mx) { mx = ss[4 * g + i]; a0 = i; }
            int b0 = -1; float m2 = -3.0e38f;
#pragma unroll
            for (int i = 0; i < 4; ++i) if (i != a0 && ss[4 * g + i] > m2) { m2 = ss[4 * g + i]; b0 = i; }
            gsc[g] = mx + m2; i0[g] = 4 * g + a0; i1[g] = 4 * g + b0; }
        int gst = 0; float gm = gsc[0];
#pragma unroll
        for (int g = 1; g < 4; ++g) if (gsc[g] > gm) { gm = gsc[g]; gst = g; }
        int e0 = i0[0], e1 = i1[0];
#pragma unroll
        for (int g = 1; g < 4; ++g) if (gst == g) { e0 = i0[g]; e1 = i1[g]; }
        float w0 = 0.f, w1 = 0.f;
#pragma unroll
        for (int e = 0; e < 16; ++e) { if (e == e0) w0 = s[e]; if (e == e1) w1 = s[e]; }
        const float inv = 1.0f / (w0 + w1); w0 *= inv; w1 *= inv;
        if (lane == 0) *(LAS v4u*)(F.lds + REC_OFF + rl * 16) = (v4u){(unsigned)e0, (unsigned)e1, __builtin_bit_cast(unsigned, w0), __builtin_bit_cast(unsigned, w1)};
    }
    __syncthreads();
    if (F.wave == 0 && lane < 16) {
        int cntl = 0;
        for (int rl = 0; rl < RPB; ++rl) { const v4u rec = *(const LAS v4u*)(F.lds + REC_OFF + rl * 16);
            if ((int)rec.x == lane) { *(LAS int*)(F.lds + LRK_OFF + rl * 8) = cntl; ++cntl; }
            if ((int)rec.y == lane) { *(LAS int*)(F.lds + LRK_OFF + rl * 8 + 4) = cntl; ++cntl; } }
        const unsigned base = __hip_atomic_fetch_add((unsigned*)(F.ctl + CW_CNT + (L * 16 + lane) * 64), (unsigned)cntl, RLX_AGENT);
        *(LAS int*)(F.lds + BASE_OFF + lane * 4) = (int)base;
    }
    __syncthreads();
    int* perm2 = (int*)(F.ws + WS_PERM); v2u* slot = (v2u*)(F.ws + WS_SLOT);
    for (int idx = tid; idx < RPB * 2; idx += NTHR) { const int rl = idx >> 1, k = idx & 1; const v4u rec = *(const LAS v4u*)(F.lds + REC_OFF + rl * 16);
        const int e = k ? (int)rec.y : (int)rec.x; const unsigned wb = k ? rec.w : rec.z;
        const int rank = *(const LAS int*)(F.lds + BASE_OFF + e * 4) + *(const LAS int*)(F.lds + LRK_OFF + rl * 8 + k * 4);
        const int m = m0 + rl;
        perm2[(size_t)e * MT + rank] = m;
        slot[(size_t)m * 2 + k] = (v2u){((unsigned)e << 24) | (unsigned)rank, wb}; }
    __syncthreads();
}

__device__ __forceinline__ void moe_setup(const Frame& F, int L) {
    const int tid = F.tid();
    if (tid < 16) F.MISC[40 + tid] = __hip_atomic_load((unsigned*)(F.ctl + CW_CNT + (L * 16 + tid) * 64), RLX_AGENT);
    __syncthreads();
    if (tid == 0) { unsigned p = 0; for (int e = 0; e < 16; ++e) { F.MISC[16 + e] = p; p += (F.MISC[40 + e] + 255u) >> 8; } F.MISC[32] = p; }
    __syncthreads();
}
__device__ __forceinline__ void moe_stage_perm(const Frame& F) {
    const int* perm2 = (const int*)(F.ws + WS_PERM); LAS int* permL = (LAS int*)(F.lds + PERML_OFF);
    const int ntile = (int)F.MISC[32], tid = F.tid();
    for (int i = 0; i < 8; ++i) { const int Lu = i * F.G + F.bid; if (Lu >= 4 * ntile) break;
        const int rt = Lu >> 2; int e = 0;
        for (int j = 1; j < 16; ++j) e += (rt >= (int)F.MISC[16 + j]) ? 1 : 0;
        if (tid < 256) { const int rank = (rt - (int)F.MISC[16 + e]) * 256 + tid; permL[i * 256 + tid] = (rank < (int)F.MISC[40 + e]) ? perm2[(size_t)e * MT + rank] : 0; } }
    __syncthreads();
}

template <int L>
__device__ __forceinline__ void p_epost(const Frame& F) {
    constexpr int NROWS = (L == 0) ? MT : NLAT, RPB = NROWS / 256;
    const bf16* FB = (const bf16*)(F.ws + WS_D2); bf16* H = (bf16*)(F.ws + WS_A);
    float* XC = (float*)(F.ws + WS_XC); const v2u* slot = (const v2u*)(F.ws + WS_SLOT);
    const int lane = F.lane(), m0 = F.bid * RPB;
    int rc = -1; f32x4 ga[4], gp[4], gs[4], sh[4];
    for (int rl = F.wave; rl < RPB; rl += NWAVES) {
        const int m = m0 + rl, r = row_batch(m);
        if (r != rc) { ld_mod(F, L, r, 5, ga); ld_row_f32(F.in(9) + L * D, lane, gp);
            if (L == 0) { f32x4 g[4], sc[4]; ld_row_f32(F.in(6) + D, lane, g); ld_mod(F, 1, r, 1, sc); ld_mod(F, 1, r, 0, sh);
#pragma unroll
                for (int j = 0; j < 4; ++j) gs[j] = g[j] * (sc[j] + 1.0f); }
            rc = r; }
        const v2u s0 = slot[(size_t)m * 2], s1 = slot[(size_t)m * 2 + 1];
        const int e0 = (int)(s0.x >> 24), e1 = (int)(s1.x >> 24);
        const size_t v0 = (size_t)F.MISC[16 + e0] * 256 + (s0.x & 0xffffffu), v1 = (size_t)F.MISC[16 + e1] * 256 + (s1.x & 0xffffffu);
        const unsigned wb0 = s0.y, wb1 = s1.y;
        const float w0 = __uint_as_float(wb0), w1 = __uint_as_float(wb1);
        f32x4 f0[4], f1[4], xv[4];
        ld_row_bf16(FB + v0 * D, lane, f0); ld_row_bf16(FB + v1 * D, lane, f1);
        float* xp = m < NLAT ? F.out + (size_t)m * D : XC + (size_t)(m - NLAT) * D;
        ld_row_f32(xp, lane, xv);
#pragma unroll
        for (int j = 0; j < 4; ++j) f0[j] = (DBG_SLOT == 1) ? f0[j] : (DBG_SLOT == 2) ? f1[j] : (DBG_SLOT == 3) ? f0[j] * 0.5f + f1[j] * 0.5f : f0[j] * w0 + f1[j] * w1;
        const float rstdf = 1.0f / sqrtf(wave_sum(sumsq4(f0)) * (1.0f / D) + EPS);
#pragma unroll
        for (int j = 0; j < 4; ++j) xv[j] = xv[j] + ga[j] * (f0[j] * rstdf * gp[j]) * (((DBG_SKIP >> (2 * L + 1)) & 1) ? 0.f : 1.f);
        st_row_f32(xp, lane, xv);
        if (L == 0) {
            const float rstd2 = 1.0f / sqrtf(wave_sum(sumsq4(xv)) * (1.0f / D) + EPS);
#pragma unroll
            for (int j = 0; j < 4; ++j) xv[j] = xv[j] * rstd2 * gs[j] + sh[j];
            st_row_bf16(H + (size_t)m * D, lane, xv);
        }
    }
}

constexpr int AT_CK = 0, AT_CV = 32768, AT_RPB = 65536;
constexpr float LOG2E = 1.4426950408889634f;
__device__ __forceinline__ float xrow_max(float m) {
    { const auto rr = __builtin_amdgcn_permlane16_swap(__builtin_bit_cast(unsigned, m), __builtin_bit_cast(unsigned, m), false, false); const unsigned a_ = rr[0], b_ = rr[1]; m = fmaxf(__uint_as_float(a_), __uint_as_float(b_)); }
    { const auto rr = __builtin_amdgcn_permlane32_swap(__builtin_bit_cast(unsigned, m), __builtin_bit_cast(unsigned, m), false, false); const unsigned a_ = rr[0], b_ = rr[1]; m = fmaxf(__uint_as_float(a_), __uint_as_float(b_)); }
    return m;
}
__device__ __forceinline__ float xrow_sum(float m) {
    { const auto rr = __builtin_amdgcn_permlane16_swap(__builtin_bit_cast(unsigned, m), __builtin_bit_cast(unsigned, m), false, false); const unsigned a_ = rr[0], b_ = rr[1]; m = __uint_as_float(a_) + __uint_as_float(b_); }
    { const auto rr = __builtin_amdgcn_permlane32_swap(__builtin_bit_cast(unsigned, m), __builtin_bit_cast(unsigned, m), false, false); const unsigned a_ = rr[0], b_ = rr[1]; m = __uint_as_float(a_) + __uint_as_float(b_); }
    return m;
}
__device__ __forceinline__ void attn_softmax(f32x4 (&s)[4], float& mrun, float& lsum, f32x4 (&o)[4], bf16x8 (&pf)[2]) {
    float mx = mrun;
#pragma unroll
    for (int t = 0; t < 4; ++t) mx = fmaxf(fmaxf(mx, fmaxf(s[t][0], s[t][1])), fmaxf(s[t][2], s[t][3]));
    mx = xrow_max(mx);
    const float alpha = __builtin_amdgcn_exp2f(mrun - mx);
    mrun = mx; lsum *= alpha;
#pragma unroll
    for (int db = 0; db < 4; ++db) o[db] = o[db] * alpha;
#pragma unroll
    for (int t = 0; t < 4; ++t)
#pragma unroll
        for (int i = 0; i < 4; ++i) { const float p = __builtin_amdgcn_exp2f(s[t][i] - mx); s[t][i] = p; lsum += p; }
#pragma unroll
    for (int bb = 0; bb < 2; ++bb) { v4u pw; pw.x = pg8::cvt_pk_bf16(s[2 * bb][0], s[2 * bb][1]); pw.y = pg8::cvt_pk_bf16(s[2 * bb][2], s[2 * bb][3]);
        pw.z = pg8::cvt_pk_bf16(s[2 * bb + 1][0], s[2 * bb + 1][1]); pw.w = pg8::cvt_pk_bf16(s[2 * bb + 1][2], s[2 * bb + 1][3]); pf[bb] = __builtin_bit_cast(bf16x8, pw); }
}
__device__ __forceinline__ void p10_attn(const Frame& F) {
    const bf16* Qh = (const bf16*)(F.ws + WS_B); const bf16* Kh = (const bf16*)(F.ws + WS_C); const bf16* Vb = (const bf16*)(F.ws + WS_D2); bf16* O = (bf16*)(F.ws + WS_A);
    const int lane = F.lane(), tid = F.wave * 64 + lane, qi = lane & 15, q4 = lane >> 4;
    const int per = (BATCH * NH * GROWS * 4) / F.G;
    const int bh = (F.bid * per) >> 8, h = bh & 15, b = bh >> 4;
    const bf16* Kbh = Kh + (size_t)bh * KSLOT * HD; const bf16* Vbh = Vb + (size_t)bh * (KSLOT / 8) * 512;
#pragma unroll
    for (int i = 0; i < 4; ++i) { const int kf = F.wave * 4 + i, blk = kf >> 2, tl = (kf >> 1) & 1, dh = kf & 1;
        const v4u kv = *(const v4u*)(Kbh + (size_t)(SEQ + 32 * blk + 8 * (qi >> 2) + 4 * tl + (qi & 3)) * HD + dh * 32 + 8 * q4);
        const int vblk = kf >> 2, db = kf & 3;
        const v4u vv = *(const v4u*)(Vbh + (size_t)(SEQ / 8 + 4 * vblk + q4) * 512 + (db * 16 + qi) * 8);
        *(LAS v4u*)(F.lds + AT_CK + kf * 1024 + lane * 16) = kv; *(LAS v4u*)(F.lds + AT_CV + kf * 1024 + lane * 16) = vv; }
    { const float* rpbG = F.in(20) + h * 465; LAS float* rpbW = (LAS float*)(F.lds + AT_RPB);
        for (int idx = tid; idx < 15 * 32; idx += NTHR) { const int ri = idx >> 5, ci = idx & 31; rpbW[idx] = (ci < 31) ? rpbG[ri * 31 + ci] * LOG2E : -1.0e30f; } }
    __syncthreads();
    const int seg = F.wave & 3;
    const int cb = (seg == 0) ? 0 : (seg == 1) ? 8 : (seg == 2) ? 24 : 32;
    const int qc = 16 * seg + qi, cs = min(max(qc - WINW / 2, 0), GRIDW - WINW);
    int coff[2][4];
#pragma unroll
    for (int tl = 0; tl < 2; ++tl)
#pragma unroll
        for (int i = 0; i < 4; ++i) { const int kc = cb + 8 * q4 + 4 * tl + i; const bool ok = (kc >= cs) && (kc < cs + WINW); coff[tl][i] = AT_RPB + 4 * (ok ? (kc - qc + (WINW - 1)) : 31); }
    for (int it = 0; it < per; it += NWAVES) {
        const int wu = F.bid * per + it + F.wave;
        const int r = (wu >> 2) & 63;
        const int r0 = min(max(r - WINH / 2, 0), GROWS - WINH);
        const bf16* Qp = Qh + ((size_t)bh * SEQ + r * GRIDW + qc) * HD;
        const bf16x8 qf0 = *(const bf16x8*)(Qp + 8 * q4), qf1 = *(const bf16x8*)(Qp + 32 + 8 * q4);
        const bf16* kp0 = Kbh + (size_t)(r0 * GRIDW + cb + 8 * (qi >> 2) + (qi & 3)) * HD + 8 * q4;
        const bf16* vp0 = Vbh + (size_t)((r0 * GRIDW + cb) / 8 + q4) * 512 + qi * 8;
        int boff[2][4];
#pragma unroll
        for (int tl = 0; tl < 2; ++tl)
#pragma unroll
            for (int i = 0; i < 4; ++i) boff[tl][i] = coff[tl][i] + (r0 - r + (WINH - 1)) * 128;
        bf16x8 kw[4][2][2][2], vw[4][2][4];
#define AT_LOADK(g) do { _Pragma("unroll") for (int bb = 0; bb < 2; ++bb) _Pragma("unroll") for (int tl = 0; tl < 2; ++tl) { \
            kw[g][bb][tl][0] = *(const bf16x8*)(kp0 + (size_t)((2 * (g) + bb) * GRIDW + 4 * tl) * HD); kw[g][bb][tl][1] = *(const bf16x8*)(kp0 + (size_t)((2 * (g) + bb) * GRIDW + 4 * tl) * HD + 32); } } while (0)
#define AT_LOADV(g) do { _Pragma("unroll") for (int bb = 0; bb < 2; ++bb) _Pragma("unroll") for (int db = 0; db < 4; ++db) vw[g][bb][db] = *(const bf16x8*)(vp0 + (size_t)((2 * (g) + bb) * (GRIDW / 8)) * 512 + db * 128); } while (0)
        float mrun = -1.0e30f, lsum = 0.f;
        f32x4 o[4];
#pragma unroll
        for (int db = 0; db < 4; ++db) o[db] = (f32x4){0.f, 0.f, 0.f, 0.f};
        AT_LOADK(0); AT_LOADV(0);
        __builtin_amdgcn_sched_barrier(0);
#pragma unroll
        for (int g = 0; g < 4; ++g) {
            {
                f32x4 s[4]; bf16x8 pf[2];
#pragma unroll
                for (int bb = 0; bb < 2; ++bb) { const int blk = 2 * g + bb;
#pragma unroll
                    for (int tl = 0; tl < 2; ++tl) { const bf16x8 k0 = *(const LAS bf16x8*)(F.lds + AT_CK + ((blk * 2 + tl) * 2 + 0) * 1024 + lane * 16), k1 = *(const LAS bf16x8*)(F.lds + AT_CK + ((blk * 2 + tl) * 2 + 1) * 1024 + lane * 16);
                        f32x4 acc = (f32x4){0.f, 0.f, 0.f, 0.f};
                        acc = __builtin_amdgcn_mfma_f32_16x16x32_bf16(k0, qf0, acc, 0, 0, 0);
                        acc = __builtin_amdgcn_mfma_f32_16x16x32_bf16(k1, qf1, acc, 0, 0, 0);
                        s[2 * bb + tl] = acc; } }
                attn_softmax(s, mrun, lsum, o, pf);
#pragma unroll
                for (int bb = 0; bb < 2; ++bb)
#pragma unroll
                    for (int db = 0; db < 4; ++db) { const bf16x8 vf = *(const LAS bf16x8*)(F.lds + AT_CV + ((2 * g + bb) * 4 + db) * 1024 + lane * 16);
                        o[db] = __builtin_amdgcn_mfma_f32_16x16x32_bf16(vf, pf[bb], o[db], 0, 0, 0); }
            }
            __builtin_amdgcn_sched_barrier(0);
            {
                f32x4 s[4]; bf16x8 pf[2];
#pragma unroll
                for (int bb = 0; bb < 2; ++bb)
#pragma unroll
                    for (int tl = 0; tl < 2; ++tl) { f32x4 acc = (f32x4){0.f, 0.f, 0.f, 0.f};
                        acc = __builtin_amdgcn_mfma_f32_16x16x32_bf16(kw[g][bb][tl][0], qf0, acc, 0, 0, 0);
                        acc = __builtin_amdgcn_mfma_f32_16x16x32_bf16(kw[g][bb][tl][1], qf1, acc, 0, 0, 0);
#pragma unroll
                        for (int i = 0; i < 4; ++i) acc[i] += *(const LAS float*)(F.lds + boff[tl][i] + (2 * g + bb) * 128);
                        s[2 * bb + tl] = acc; }
                if (g < 3) { AT_LOADK(g + 1); }
                __builtin_amdgcn_sched_barrier(0);
                attn_softmax(s, mrun, lsum, o, pf);
#pragma unroll
                for (int bb = 0; bb < 2; ++bb)
#pragma unroll
                    for (int db = 0; db < 4; ++db) o[db] = __builtin_amdgcn_mfma_f32_16x16x32_bf16(vw[g][bb][db], pf[bb], o[db], 0, 0, 0);
                if (g < 3) { AT_LOADV(g + 1); }
                __builtin_amdgcn_sched_barrier(0);
            }
        }
#undef AT_LOADK
#undef AT_LOADV
        const float inv = 1.0f / xrow_sum(lsum);
        bf16* op = O + ((size_t)b * SEQ + r * GRIDW + qc) * D + h * HD + 4 * q4;
#pragma unroll
        for (int db = 0; db < 4; ++db) { v2u w; w.x = pg8::cvt_pk_bf16(o[db][0] * inv, o[db][1] * inv); w.y = pg8::cvt_pk_bf16(o[db][2] * inv, o[db][3] * inv); *(v2u*)(op + db * 16) = w; }
    }
    __syncthreads();
}

#ifndef MK_N_LAUNCHES
#define MK_N_LAUNCHES 1
#endif
constexpr int N_PHASES = 16;
constexpr int N_LAUNCHES = MK_N_LAUNCHES;
struct Args { const float* in[26]; float* out; unsigned char* ws; int ph_lo, ph_hi; };

__global__ void __launch_bounds__(NTHR, 2) fwd_kernel(Args args) {
    extern __shared__ __attribute__((aligned(16))) unsigned char lds[];
    Frame F;
    F.lds = (LAS unsigned char*)lds;
    F.MISC = (volatile LAS unsigned*)(F.lds + MISC_OFF);
    F.wave = __builtin_amdgcn_readfirstlane((int)threadIdx.x >> 6);
    F.G = gridDim.x; F.bid = blockIdx.x;
    F.ws = args.ws; F.ctl = (gu32*)(args.ws + WS_CTL); F.out = args.out;
    for (int u = threadIdx.x; u < 256; u += NTHR) F.MISC[u] = 0u;
    if (threadIdx.x < 26) { const unsigned long long pv = (unsigned long long)args.in[threadIdx.x]; volatile LAS unsigned* t = (volatile LAS unsigned*)(F.lds + PTAB_OFF) + 2 * threadIdx.x; t[0] = (unsigned)pv; t[1] = (unsigned)(pv >> 32); }
    __syncthreads();
    XcdBarrier bar; bar.bar = (unsigned*)(F.ctl + CW_BAR); bar.x = 0; bar.st = nullptr;
    if (N_LAUNCHES == 1) bar = xcd_barrier_post((unsigned*)(F.ctl + CW_BAR), F.MISC + 8);
    const int lo = args.ph_lo, hi = args.ph_hi;
#ifndef PHASE_MASK
#define PHASE_MASK 0xFFFF
#endif
#define IN(k) ((((PHASE_MASK) >> (k)) & 1) && lo <= (k) && (k) < hi)
#define SEAM(k) do { if (IN(k) && IN((k) + 1)) xcd_barrier(bar); } while (0)
    const char* wsb = (const char*)F.ws;
    LAS unsigned char* ring = F.lds;

    if (IN(0)) { _Pragma("unroll") for (int rep = 0; rep < REP(0); ++rep) { p0_prologue(F); __syncthreads(); } }
    SEAM(0);
    if (IN(1)) { _Pragma("unroll") for (int rep = 0; rep < REP(1); ++rep) p1_modulate(F); }
    SEAM(1);
    if (IN(2)) {
        pg8::DenseSched S{wsb + WS_A, wsb + WS_WIN, D, MT / 256, 8, F.G, F.bid};
        pg8::EpiGated<0> E{(bf16*)(F.ws + WS_B), D, F.in(11), D};
        _Pragma("unroll") for (int rep = 0; rep < REP(2); ++rep) pg8::gemm_phase<pg8::EpiGated<0>, pg8::DenseSched, true>(ring, D, S, E, F.wave);
    }
    SEAM(2);
    if (IN(3)) { _Pragma("unroll") for (int rep = 0; rep < REP(3); ++rep) p3_conv(F); }
    SEAM(3);
    if (IN(4)) {
        pg8::DenseSched S{wsb + WS_A, wsb + WS_WOUT, D, MT / 256, 4, F.G, F.bid};
        pg8::EpiBf16B E{(bf16*)(F.ws + WS_B), D, F.in(17)};
        _Pragma("unroll") for (int rep = 0; rep < REP(4); ++rep) pg8::gemm_phase<pg8::EpiBf16B, pg8::DenseSched, true>(ring, D, S, E, F.wave);
    }
    SEAM(4);
    if (IN(5)) p_emid<0>(F);
    SEAM(5);
    if (IN(6)) {
        moe_setup(F, 0); moe_stage_perm(F);
        pg8::MoeUpSched S; S.tpre = (const volatile LAS int*)(F.MISC + 16); S.G = F.G; S.c = F.bid; S.A = wsb + WS_A; S.Wgu = wsb + WS_WGU + (size_t)0 * 16 * 1024 * 1024; S.permL = (const LAS int*)(F.lds + PERML_OFF); S.kb = D;
        pg8::EpiGated<1> E{(bf16*)(F.ws + WS_C), DE, nullptr, 0};
        _Pragma("unroll") for (int rep = 0; rep < REP(6); ++rep) pg8::gemm_phase<pg8::EpiGated<1>, pg8::MoeUpSched, true, true>(ring, D / 2, S, E, F.wave);
    }
    SEAM(6);
    if (IN(7)) {
        moe_setup(F, 0);
        pg8::MoeDownSched S; S.tpre = (const volatile LAS int*)(F.MISC + 16); S.G = F.G; S.c = F.bid; S.A = wsb + WS_C; S.Wdn = wsb + WS_WDN + (size_t)0 * 16 * 1024 * 512 * 2; S.kb = DE * 2;
        pg8::EpiBf16 E{(bf16*)(F.ws + WS_D2), D, nullptr};
        _Pragma("unroll") for (int rep = 0; rep < REP(7); ++rep) pg8::gemm_phase<pg8::EpiBf16, pg8::MoeDownSched, true>(ring, DE, S, E, F.wave);
    }
    SEAM(7);
    if (IN(8)) { moe_setup(F, 0); p_epost<0>(F); }
    SEAM(8);
    if (IN(9)) {
        pg8::QkvSched S{wsb + WS_A, wsb + WS_WQKV, F.G, F.bid};
        pg8::EpiQkv E{(bf16*)(F.ws + WS_B), (bf16*)(F.ws + WS_C), (bf16*)(F.ws + WS_D2), 0.125f * 1.4426950408889634f};
        _Pragma("unroll") for (int rep = 0; rep < REP(9); ++rep) pg8::gemm_phase<pg8::EpiQkv, pg8::QkvSched, true>(ring, D, S, E, F.wave);
    }
    SEAM(9);
    if (IN(10)) { _Pragma("unroll") for (int rep = 0; rep < REP(10); ++rep) p10_attn(F); }
    SEAM(10);
    if (IN(11)) {
        pg8::DenseSched S{wsb + WS_A, wsb + WS_WO, D, NLAT / 256, 4, F.G, F.bid};
        pg8::EpiBf16 E{(bf16*)(F.ws + WS_B), D, nullptr};
        _Pragma("unroll") for (int rep = 0; rep < REP(11); ++rep) pg8::gemm_phase<pg8::EpiBf16, pg8::DenseSched, true>(ring, D, S, E, F.wave);
    }
    SEAM(11);
    if (IN(12)) p_emid<1>(F);
    SEAM(12);
    if (IN(13)) {
        moe_setup(F, 1); moe_stage_perm(F);
        pg8::MoeUpSched S; S.tpre = (const volatile LAS int*)(F.MISC + 16); S.G = F.G; S.c = F.bid; S.A = wsb + WS_A; S.Wgu = wsb + WS_WGU + (size_t)1 * 16 * 1024 * 1024; S.permL = (const LAS int*)(F.lds + PERML_OFF); S.kb = D;
        pg8::EpiGated<1> E{(bf16*)(F.ws + WS_C), DE, nullptr, 0};
        _Pragma("unroll") for (int rep = 0; rep < REP(13); ++rep) pg8::gemm_phase<pg8::EpiGated<1>, pg8::MoeUpSched, true, true>(ring, D / 2, S, E, F.wave);
    }
    SEAM(13);
    if (IN(14)) {
        moe_setup(F, 1);
        pg8::MoeDownSched S; S.tpre = (const volatile LAS int*)(F.MISC + 16); S.G = F.G; S.c = F.bid; S.A = wsb + WS_C; S.Wdn = wsb + WS_WDN + (size_t)1 * 16 * 1024 * 512 * 2; S.kb = DE * 2;
        pg8::EpiBf16 E{(bf16*)(F.ws + WS_D2), D, nullptr};
        _Pragma("unroll") for (int rep = 0; rep < REP(14); ++rep) pg8::gemm_phase<pg8::EpiBf16, pg8::MoeDownSched, true>(ring, DE, S, E, F.wave);
    }
    SEAM(14);
    if (IN(15)) { moe_setup(F, 1); p_epost<1>(F); }
#undef IN
#undef SEAM
}

extern "C" void kernel_launch(void* const* d_in, const int* in_sizes, int n_in, void* d_out, int out_size, void* d_ws, size_t ws_size, hipStream_t stream) {
    static int grid = 0;
    if (grid == 0) {
        if (n_in != 26 || in_sizes[0] != NLAT * D || out_size != NLAT * D || ws_size < WS_END) { fprintf(stderr, "kernel_launch: unexpected shapes (n_in %d, in0 %d, out %d, ws %zu); nothing launched\n", n_in, n_in > 0 ? in_sizes[0] : -1, out_size, ws_size); grid = -1; return; }
        if (hipFuncSetAttribute((const void*)fwd_kernel, hipFuncAttributeMaxDynamicSharedMemorySize, LDS_BYTES) != hipSuccess) { fprintf(stderr, "kernel_launch: hipFuncSetAttribute failed\n"); grid = -1; return; }
        int per_cu = 0;
        if (hipOccupancyMaxActiveBlocksPerMultiprocessor(&per_cu, (const void*)fwd_kernel, NTHR, LDS_BYTES) != hipSuccess || per_cu < 1) fprintf(stderr, "kernel_launch: note: occupancy query reports %d workgroups per CU\n", per_cu);
        (void)hipGetLastError();
        grid = 256;
    }
    if (grid < 0) return;
    if (hipMemsetAsync((char*)d_ws + WS_CTL, 0, CTL_ZERO_BYTES, stream) != hipSuccess) { fprintf(stderr, "kernel_launch: hipMemsetAsync failed\n"); return; }
    Args a{};
    for (int i = 0; i < 26; ++i) a.in[i] = (const float*)d_in[i];
    a.out = (float*)d_out; a.ws = (unsigned char*)d_ws;
    for (int li = 0; li < N_LAUNCHES; ++li) {
        a.ph_lo = (N_LAUNCHES == 1) ? 0 : li; a.ph_hi = (N_LAUNCHES == 1) ? N_PHASES : li + 1;
        hipLaunchKernelGGL(fwd_kernel, dim3(grid), dim3(NTHR), LDS_BYTES, stream, a);
        const hipError_t le = hipPeekAtLastError();
        if (le != hipSuccess) { fprintf(stderr, "kernel_launch: launch %d failed: %s\n", li, hipGetErrorName(le)); break; }
    }
}
```

```cpp
#include <hip/hip_runtime.h>
#include <cstdio>
#include <cstdint>

#ifndef PROBE_MASK
#define PROBE_MASK 0
#endif
#define REP(k) ((((PROBE_MASK) >> (k)) & 1) ? 2 : 1)
#ifndef DBG_SLOT
#define DBG_SLOT 0
#endif
#ifndef DBG_SKIP
#define DBG_SKIP 0
#endif
constexpr int D = 1024, BATCH = 8, SEQ = 4096, CTXL = 256;
constexpr int NLAT = BATCH * SEQ, NCTX = BATCH * CTXL, MT = NLAT + NCTX;
constexpr int NE = 16, DE = 512, NH = 16, HD = 64, GRIDW = 64, GROWS = 64, WINH = 8, WINW = 16, CONVW = 31;
constexpr int KSLOT = SEQ + CTXL;
constexpr int NMODR = 9, NMODC = 6 * D;
constexpr int MODKC = 8;
constexpr float EPS = 1e-6f;
constexpr int NWAVES = 8, NTHR = NWAVES * 64;

constexpr size_t MiB = 1u << 20;
constexpr size_t WS_CTL = 0, CTL_ZERO_BYTES = 1 * MiB;
constexpr size_t WS_SLOT = 1 * MiB;
constexpr size_t WS_PERM = 2 * MiB;
constexpr size_t WS_MODP = 5 * MiB;
constexpr size_t WS_XC = 9 * MiB;
constexpr size_t WS_WIN = 18 * MiB, WS_WOUT = 22 * MiB, WS_WQKV = 24 * MiB, WS_WO = 30 * MiB;
constexpr size_t WS_WGU = 32 * MiB;
constexpr size_t WS_WDN = 96 * MiB;
constexpr size_t WS_A = 128 * MiB, WS_B = 196 * MiB, WS_C = 264 * MiB, WS_D2 = 336 * MiB, WS_END = 480 * MiB;
constexpr int CW_BAR = 4096;
constexpr int CW_CNT = 8192;

constexpr int RING_BYTES = 131072;
constexpr int MISC_OFF = RING_BYTES;
constexpr int PTAB_OFF = RING_BYTES + 1024 + 8192;
constexpr int PERML_OFF = RING_BYTES + 1024;
constexpr int LDS_BYTES = 147456;

#define GAS __attribute__((address_space(1)))
#define LAS __attribute__((address_space(3)))
typedef unsigned short bf16;
typedef unsigned v4u __attribute__((ext_vector_type(4)));
typedef unsigned v2u __attribute__((ext_vector_type(2)));
typedef float f32x4 __attribute__((ext_vector_type(4)));
typedef float f32x2 __attribute__((ext_vector_type(2)));
typedef short bf16x8 __attribute__((ext_vector_type(8)));
typedef GAS unsigned gu32;
#define RLX_AGENT __ATOMIC_RELAXED, __HIP_MEMORY_SCOPE_AGENT
#define LDS_WAIT() asm volatile("s_waitcnt lgkmcnt(0)" ::: "memory")
#define VM_WAIT() asm volatile("s_waitcnt vmcnt(0)" ::: "memory")

__device__ __forceinline__ unsigned f2bf(float f) { unsigned u = __builtin_bit_cast(unsigned, f); return (u + 0x7fffu + ((u >> 16) & 1u)) >> 16; }
__device__ __forceinline__ unsigned pk2(float lo, float hi) { return f2bf(lo) | (f2bf(hi) << 16); }
__device__ __forceinline__ unsigned pk4_fp8(float a, float b, float c, float d) { int p = __builtin_amdgcn_cvt_pk_fp8_f32(a, b, 0, false); p = __builtin_amdgcn_cvt_pk_fp8_f32(c, d, p, true); return (unsigned)p; }
__device__ __forceinline__ float bflo(unsigned w) { return __builtin_bit_cast(float, w << 16); }
__device__ __forceinline__ float bfhi(unsigned w) { return __builtin_bit_cast(float, w & 0xffff0000u); }
__device__ __forceinline__ float row16_sum(float v) {
    v += __builtin_bit_cast(float, __builtin_amdgcn_update_dpp(0, __builtin_bit_cast(int, v), 0xB1, 0xF, 0xF, false));
    v += __builtin_bit_cast(float, __builtin_amdgcn_update_dpp(0, __builtin_bit_cast(int, v), 0x4E, 0xF, 0xF, false));
    v += __builtin_bit_cast(float, __builtin_amdgcn_update_dpp(0, __builtin_bit_cast(int, v), 0x141, 0xF, 0xF, false));
    v += __builtin_bit_cast(float, __builtin_amdgcn_update_dpp(0, __builtin_bit_cast(int, v), 0x140, 0xF, 0xF, false));
    return v;
}
__device__ __forceinline__ float rdlane(float v, int l) { return __builtin_bit_cast(float, __builtin_amdgcn_readlane(__builtin_bit_cast(int, v), l)); }
__device__ __forceinline__ float wave_sum(float v) {
    v = row16_sum(v);
    return (rdlane(v, 0) + rdlane(v, 16)) + (rdlane(v, 32) + rdlane(v, 48));
}
__device__ __forceinline__ int lane_id_asm() { int l; asm volatile("v_mbcnt_lo_u32_b32 %0, -1, 0\n\tv_mbcnt_hi_u32_b32 %0, -1, %0" : "=v"(l)); return l; }
__device__ __forceinline__ float fast_sigmoid(float x) { return __builtin_amdgcn_rcpf(1.0f + __builtin_amdgcn_exp2f(-1.4426950408889634f * x)); }

namespace pg8 {
#define PG8_LAS __attribute__((address_space(3)))
typedef unsigned short bf16_t;
typedef short bf16x8 __attribute__((ext_vector_type(8)));
typedef float f32x4 __attribute__((ext_vector_type(4)));
typedef unsigned u32x4 __attribute__((ext_vector_type(4)));
constexpr int BM = 256, BK = 64, HALF = 128, HTB = HALF * BK * 2, STAGE_BYTES = 8 * HTB, NXCD = 8, WGM = 8;

__host__ __device__ __forceinline__ int lds_byte(int r, int c) { const int st = (r >> 4) * 2 + (c >> 5), rr = r & 15, cc = c & 31, ob = rr * 64 + cc * 2; return st * 1024 + (ob ^ (((ob >> 9) & 1) << 5)); }
__host__ __device__ __forceinline__ void stage_rc(int b, int& R, int& C) { const int st = b / 1024, sb = b % 1024, swz = sb ^ (((sb >> 9) & 1) << 5); R = (st >> 1) * 16 + swz / 64; C = (st & 1) * 32 + (swz % 64) / 2; }
__host__ __device__ __forceinline__ int perm32(int rho) { const int n = rho >> 4, i = rho & 15; return 8 * (i >> 2) + 4 * n + (i & 3); }

struct Unit { int pm, pn; const char* a; const char* b; int li; int ex; };

__device__ __forceinline__ bool static_order(int L, int nM, int nN, int& pm, int& pn) {
    const int nwg = nM * nN; if (L >= nwg) return false;
    int wgid = L; { const int q = nwg / NXCD, r = nwg % NXCD, xcd = wgid % NXCD, off = wgid / NXCD; wgid = (xcd < r ? xcd * (q + 1) : r * (q + 1) + (xcd - r) * q) + off; }
    const int nig = WGM * nN, gid = wgid / nig, fm = gid * WGM, gsz = (nM - fm) < WGM ? (nM - fm) : WGM;
    pm = fm + ((wgid % nig) % gsz); pn = (wgid % nig) / gsz; return true;
}

typedef float cvt_f32x2_t __attribute__((ext_vector_type(2))); typedef __bf16 cvt_bf16x2_t __attribute__((ext_vector_type(2)));
__device__ __forceinline__ unsigned cvt_pk_bf16(float lo, float hi) { const cvt_f32x2_t v = {lo, hi}; const cvt_bf16x2_t b = __builtin_convertvector(v, cvt_bf16x2_t); return __builtin_bit_cast(unsigned, b); }

typedef int v8i_t __attribute__((ext_vector_type(8)));
typedef int v4i_t __attribute__((ext_vector_type(4)));
template <class Epi, class Sched, bool ALIGN_EPI, bool FP8 = false>
__device__ __forceinline__ void gemm_phase(PG8_LAS unsigned char* lds, const int K_, const Sched& S, const Epi& E, const int wid) {
    int K = K_; asm volatile("" : "+s"(K));
    const int lane = lane_id_asm(), tid = wid * 64 + lane, wr = wid >> 2, wc = wid & 3, fr = lane & 15, fq = lane >> 4;
    const int nt = K / BK;
    int R[2], C[2]; unsigned voffB[2], vA[2][2];
    const size_t kstep = (size_t)(BK * 2);
    const size_t hstep = (size_t)HALF * K * 2;
#pragma unroll
    for (int i = 0; i < 2; ++i) { stage_rc(tid * 16 + i * 8192, R[i], C[i]); const int Rb = Epi::PERM ? ((R[i] & ~31) + perm32(R[i] & 31)) : R[i];
        voffB[i] = (unsigned)(Rb * K + C[i]) * 2u; vA[0][i] = (unsigned)(R[i] * K + C[i]) * 2u; vA[1][i] = vA[0][i] + (unsigned)hstep; }
    const unsigned ldsw = (unsigned)wid * 1024u;
    const int aoff = lds_byte(wr * 64 + fr, fq * 8), boff = lds_byte(wc * 32 + fr, fq * 8);
#define PG8_SA(b, h) (((b) * 2 + (h)) * HTB)
#define PG8_SB(b, h) ((4 + (b) * 2 + (h)) * HTB)
#define PG8_STAGE(bufoff, gbase, voff) do { _Pragma("unroll") for (int _i = 0; _i < 2; ++_i) \
        __builtin_amdgcn_global_load_lds((const unsigned*)((const char*)(gbase) + (voff)[_i]), (PG8_LAS unsigned*)(lds + (bufoff) + ldsw + _i * 8192), 16, 0, 0); } while (0)
#define PG8_LD8(addr) __builtin_shufflevector(*(const PG8_LAS v4i_t*)(addr), *(const PG8_LAS v4i_t*)((addr) + 1024), 0, 1, 2, 3, 4, 5, 6, 7)
#define PG8_LDA(dst, b, h) do { _Pragma("unroll") for (int m = 0; m < 4; ++m) dst[m] = PG8_LD8(lds + PG8_SA(b, h) + aoff + m * 2048); } while (0)
#define PG8_LDB(dst, b, h) do { _Pragma("unroll") for (int n = 0; n < 2; ++n) dst[n] = PG8_LD8(lds + PG8_SB(b, h) + boff + n * 2048); } while (0)
#define PG8_LO(x) __builtin_bit_cast(bf16x8, __builtin_shufflevector((x), (x), 0, 1, 2, 3))
#define PG8_HI(x) __builtin_bit_cast(bf16x8, __builtin_shufflevector((x), (x), 4, 5, 6, 7))
#define PG8_MMA(ai, bj, At, Bt) do { __builtin_amdgcn_s_setprio(1); _Pragma("unroll") for (int m = 0; m < 4; ++m) _Pragma("unroll") for (int n = 0; n < 2; ++n) { \
        if constexpr (FP8) acc[ai][bj][m][n] = __builtin_amdgcn_mfma_scale_f32_16x16x128_f8f6f4(Bt[n], At[m], acc[ai][bj][m][n], 0, 0, 0, 0x79797979, 0, 0x7f7f7f7f); \
        else { acc[ai][bj][m][n] = __builtin_amdgcn_mfma_f32_16x16x32_bf16(PG8_LO(Bt[n]), PG8_LO(At[m]), acc[ai][bj][m][n], 0, 0, 0); \
               acc[ai][bj][m][n] = __builtin_amdgcn_mfma_f32_16x16x32_bf16(PG8_HI(Bt[n]), PG8_HI(At[m]), acc[ai][bj][m][n], 0, 0, 0); } } __builtin_amdgcn_s_setprio(0); } while (0)
#define PG8_WAIT_V(n) asm volatile("s_waitcnt vmcnt(" #n ")" ::: "memory")
#define PG8_WAIT_L(n) asm volatile("s_waitcnt lgkmcnt(" #n ")" ::: "memory")
#define PG8_BAR __builtin_amdgcn_s_barrier()
#define PG8_SCHED __builtin_amdgcn_sched_barrier(0)
    Unit cur, nxt; int ui = 0;
    if (!S.next(0, cur)) return;
    if constexpr (Sched::GATHER) S.a_offsets(cur, R, C, K, vA);
    f32x4 acc[2][2][4][2];
#pragma unroll
    for (int a = 0; a < 2; ++a)
#pragma unroll
        for (int b = 0; b < 2; ++b)
#pragma unroll
            for (int m = 0; m < 4; ++m)
#pragma unroll
                for (int n = 0; n < 2; ++n) acc[a][b][m][n] = (f32x4){0.f, 0.f, 0.f, 0.f};
    v8i_t At[4], B0[2], B1[2];
    const char* cA = cur.a; const char* cB = cur.b;
    PG8_STAGE(PG8_SB(0, 0), cB, voffB); PG8_STAGE(PG8_SB(0, 1), cB + hstep, voffB); PG8_STAGE(PG8_SA(0, 0), cA, vA[0]); PG8_STAGE(PG8_SA(0, 1), cA, vA[1]);
    if (wr == 1) PG8_BAR;
    PG8_WAIT_V(2); PG8_BAR;
    PG8_STAGE(PG8_SB(1, 0), cB + kstep, voffB); PG8_STAGE(PG8_SA(1, 0), cA + kstep, vA[0]); PG8_STAGE(PG8_SB(1, 1), cB + hstep + kstep, voffB);
    PG8_WAIT_V(6); PG8_BAR;
    for (;;) {
        const bool has_next = S.next(ui + 1, nxt);
        const char* nA = has_next ? nxt.a : cA; const char* nB = has_next ? nxt.b : cB;
#pragma unroll 1
        for (int t = 0; t < nt; t += 2) {
            const bool last = (t == nt - 2);
            const char* a1 = cA + (size_t)(t + 1) * kstep;
            const char* a2 = last ? nA : cA + (size_t)(t + 2) * kstep; const char* b2 = last ? nB : cB + (size_t)(t + 2) * kstep;
            const char* a3 = a2 + kstep; const char* b3 = b2 + kstep;
            PG8_LDB(B0, 0, 0); PG8_LDB(B1, 0, 1); PG8_SCHED; PG8_LDA(At, 0, 0); PG8_STAGE(PG8_SA(1, 1), a1, vA[1]);
            if constexpr (Sched::GATHER) { if (last && has_next) S.a_offsets(nxt, R, C, K, vA); }
            PG8_WAIT_V(8); PG8_WAIT_L(0); PG8_BAR; PG8_MMA(0, 0, At, B0); PG8_MMA(0, 1, At, B1); PG8_BAR; PG8_SCHED;
            PG8_LDA(At, 0, 1); PG8_STAGE(PG8_SB(0, 0), b2, voffB); PG8_STAGE(PG8_SB(0, 1), b2 + hstep, voffB); PG8_STAGE(PG8_SA(0, 0), a2, vA[0]);
            PG8_WAIT_V(8); PG8_WAIT_L(0); PG8_BAR; PG8_MMA(1, 0, At, B0); PG8_MMA(1, 1, At, B1); PG8_BAR; PG8_SCHED;
            PG8_LDB(B0, 1, 0); PG8_LDB(B1, 1, 1); PG8_SCHED; PG8_LDA(At, 1, 0); PG8_STAGE(PG8_SA(0, 1), a2, vA[1]);
            PG8_WAIT_V(8); PG8_WAIT_L(0); PG8_BAR; PG8_MMA(0, 0, At, B0); PG8_MMA(0, 1, At, B1); PG8_BAR; PG8_SCHED;
            PG8_LDA(At, 1, 1); PG8_STAGE(PG8_SB(1, 0), b3, voffB); PG8_STAGE(PG8_SB(1, 1), b3 + hstep, voffB); PG8_STAGE(PG8_SA(1, 0), a3, vA[0]);
            PG8_WAIT_V(8); PG8_WAIT_L(0); PG8_BAR; PG8_MMA(1, 0, At, B0); PG8_MMA(1, 1, At, B1); PG8_BAR; PG8_SCHED;
        }
        if constexpr (ALIGN_EPI) { if (wr == 0) PG8_BAR; }
        E(acc, cur, wr, wc, fr, fq);
        if (!has_next) break;
#pragma unroll
        for (int a = 0; a < 2; ++a)
#pragma unroll
            for (int b = 0; b < 2; ++b)
#pragma unroll
                for (int m = 0; m < 4; ++m)
#pragma unroll
                    for (int n = 0; n < 2; ++n) acc[a][b][m][n] = (f32x4){0.f, 0.f, 0.f, 0.f};
        cur = nxt; cA = nA; cB = nB; ++ui;
        if constexpr (ALIGN_EPI) { if (wr == 1) PG8_BAR; }
    }
    PG8_WAIT_V(0);
    if constexpr (!ALIGN_EPI) { if (wr == 0) PG8_BAR; }
    PG8_BAR;
#undef PG8_SA
#undef PG8_SB
#undef PG8_STAGE
#undef PG8_LDA
#undef PG8_LDB
#undef PG8_MMA
#undef PG8_LO
#undef PG8_HI
#undef PG8_LD8
#undef PG8_WAIT_V
#undef PG8_WAIT_L
#undef PG8_BAR
#undef PG8_SCHED
}

struct DenseSched {
    static constexpr bool GATHER = false;
    const char* A; const char* Bt; int K, nM, nN, G, c;
    __device__ __forceinline__ bool next(int i, Unit& u) const {
        int pm, pn; if (!static_order(i * G + c, nM, nN, pm, pn)) return false;
        u.pm = pm; u.pn = pn; u.a = A + (size_t)pm * BM * K * 2; u.b = Bt + (size_t)pn * BM * K * 2; u.li = i; u.ex = 0; return true;
    }
    __device__ __forceinline__ void a_offsets(const Unit&, const int (&)[2], const int (&)[2], int, unsigned (&)[2][2]) const {}
};
struct QkvSched {
    static constexpr bool GATHER = false;
    const char* A; const char* Bt; int G, c;
    __device__ __forceinline__ bool next(int i, Unit& u) const {
        const int L = i * G + c; int pm, pn;
        if (L < 1536) { static_order(L, 128, 12, pm, pn); }
        else { const int l2 = L - 1536; if (l2 >= 64) return false; pm = 128 + (l2 >> 3); pn = 4 + (l2 & 7); }
        u.pm = pm; u.pn = pn; u.a = A + (size_t)pm * BM * D * 2; u.b = Bt + (size_t)pn * BM * D * 2; u.li = i; u.ex = 0; return true;
    }
    __device__ __forceinline__ void a_offsets(const Unit&, const int (&)[2], const int (&)[2], int, unsigned (&)[2][2]) const {}
};
struct MoeSchedBase {
    const volatile PG8_LAS int* tpre;
    int G, c;
    __device__ __forceinline__ bool locate(int i, int& rt, int& pn, int& e) const {
        const int L = i * G + c; const int ntile = tpre[16];
        if (L >= 4 * ntile) return false;
        rt = L >> 2; pn = L & 3; int ee = 0;
#pragma unroll
        for (int j = 1; j < 16; ++j) ee += (rt >= tpre[j]) ? 1 : 0;
        e = ee; return true;
    }
};
struct MoeUpSched : MoeSchedBase {
    static constexpr bool GATHER = true;
    const char* A; const char* Wgu; const PG8_LAS int* permL; int kb;
    __device__ __forceinline__ bool next(int i, Unit& u) const {
        int rt, pn, e; if (!locate(i, rt, pn, e)) return false;
        u.pm = rt; u.pn = pn; u.a = A; u.b = Wgu + (size_t)e * 1024 * kb + (size_t)pn * BM * kb; u.li = i; u.ex = e; return true;
    }
    __device__ __forceinline__ void a_offsets(const Unit& u, const int (&R)[2], const int (&C)[2], int K, unsigned (&vA)[2][2]) const {
#pragma unroll
        for (int h = 0; h < 2; ++h)
#pragma unroll
            for (int i = 0; i < 2; ++i) vA[h][i] = (unsigned)permL[u.li * 256 + h * HALF + R[i]] * (unsigned)(K * 2) + (unsigned)(C[i] * 2);
    }
};
struct MoeDownSched : MoeSchedBase {
    static constexpr bool GATHER = false;
    const char* A; const char* Wdn; int kb;
    __device__ __forceinline__ bool next(int i, Unit& u) const {
        int rt, pn, e; if (!locate(i, rt, pn, e)) return false;
        u.pm = rt; u.pn = pn; u.a = A + (size_t)rt * BM * kb; u.b = Wdn + (size_t)e * 1024 * kb + (size_t)pn * BM * kb; u.li = i; u.ex = e; return true;
    }
    __device__ __forceinline__ void a_offsets(const Unit&, const int (&)[2], const int (&)[2], int, unsigned (&)[2][2]) const {}
};

template <bool HAS_BIAS> struct EpiBf16T {
    static constexpr bool PERM = true;
    bf16_t* O; int ldc; const float* bias;
    __device__ __forceinline__ void operator()(const f32x4 (&acc)[2][2][4][2], const Unit& u, int wr, int wc, int fr, int fq) const {
        const int row0 = u.pm * BM + wr * 64 + fr, col0 = u.pn * BM + wc * 32 + 8 * fq;
        f32x4 bv[2][2];
#pragma unroll
        for (int bj = 0; bj < 2; ++bj)
#pragma unroll
            for (int n = 0; n < 2; ++n) bv[bj][n] = HAS_BIAS ? *(const f32x4*)(bias + col0 + bj * HALF + 4 * n) : (f32x4){0.f, 0.f, 0.f, 0.f};
#pragma unroll
        for (int ai = 0; ai < 2; ++ai)
#pragma unroll
            for (int m = 0; m < 4; ++m) { bf16_t* rowp = O + (size_t)(row0 + ai * HALF + m * 16) * ldc + col0;
#pragma unroll
                for (int bj = 0; bj < 2; ++bj) { f32x4 v0 = acc[ai][bj][m][0], v1 = acc[ai][bj][m][1]; if constexpr (HAS_BIAS) { v0 += bv[bj][0]; v1 += bv[bj][1]; }
                    u32x4 w; w.x = cvt_pk_bf16(v0[0], v0[1]); w.y = cvt_pk_bf16(v0[2], v0[3]); w.z = cvt_pk_bf16(v1[0], v1[1]); w.w = cvt_pk_bf16(v1[2], v1[3]);
                    *(u32x4*)(rowp + bj * HALF) = w; } }
    }
};
typedef EpiBf16T<true> EpiBf16B; typedef EpiBf16T<false> EpiBf16;
template <int MODE  , bool OUT8 = false  > struct EpiGated {
    static constexpr bool PERM = true;
    bf16_t* O; int ldc; const float* bias; int nch;
    __device__ __forceinline__ void operator()(const f32x4 (&acc)[2][2][4][2], const Unit& u, int wr, int wc, int fr, int fq) const {
        const int row0 = u.pm * BM + wr * 64 + fr, ch0 = u.pn * HALF + wc * 32 + 8 * fq;
        f32x4 b0[2], b1[2];
#pragma unroll
        for (int n = 0; n < 2; ++n) { if (MODE == 0) { b0[n] = *(const f32x4*)(bias + ch0 + 4 * n); b1[n] = *(const f32x4*)(bias + nch + ch0 + 4 * n); } else { b0[n] = (f32x4){0.f, 0.f, 0.f, 0.f}; b1[n] = b0[n]; } }
#pragma unroll
        for (int ai = 0; ai < 2; ++ai)
#pragma unroll
            for (int m = 0; m < 4; ++m) { bf16_t* rowp = O + (size_t)(row0 + ai * HALF + m * 16) * ldc + ch0; float o[8];
#pragma unroll
                for (int n = 0; n < 2; ++n) { const f32x4 x0 = acc[ai][0][m][n] + b0[n], x1 = acc[ai][1][m][n] + b1[n];
#pragma unroll
                    for (int e = 0; e < 4; ++e) o[4 * n + e] = (MODE == 0) ? x0[e] * fast_sigmoid(x1[e]) : (x0[e] * fast_sigmoid(x0[e])) * x1[e]; }
                if constexpr (OUT8) { unsigned char* rp8 = (unsigned char*)O + (size_t)(row0 + ai * HALF + m * 16) * ldc + ch0;
                    *(unsigned long long*)rp8 = (unsigned long long)pk4_fp8(o[0], o[1], o[2], o[3]) | ((unsigned long long)pk4_fp8(o[4], o[5], o[6], o[7]) << 32); }
                else { u32x4 w; w.x = cvt_pk_bf16(o[0], o[1]); w.y = cvt_pk_bf16(o[2], o[3]); w.z = cvt_pk_bf16(o[4], o[5]); w.w = cvt_pk_bf16(o[6], o[7]);
                    *(u32x4*)rowp = w; } }
    }
};
struct EpiQkv {
    static constexpr bool PERM = true;
    bf16_t* Q; bf16_t* Kh; bf16_t* Vb; float qscale;
    __device__ __forceinline__ void operator()(const f32x4 (&acc)[2][2][4][2], const Unit& u, int wr, int wc, int fr, int fq) const {
        const int which = u.pn >> 2; const bool isctx = u.pm >= 128;
        const int b = isctx ? (u.pm - 128) : (u.pm >> 4);
        const int key0 = isctx ? SEQ : ((u.pm & 15) << 8);
        const int d0 = 32 * (wc & 1) + 8 * fq;
#pragma unroll
        for (int ai = 0; ai < 2; ++ai)
#pragma unroll
            for (int m = 0; m < 4; ++m) { const int key = key0 + ai * HALF + wr * 64 + m * 16 + fr;
#pragma unroll
                for (int bj = 0; bj < 2; ++bj) { const int h = 4 * (u.pn & 3) + 2 * bj + (wc >> 1); const f32x4 v0 = acc[ai][bj][m][0], v1 = acc[ai][bj][m][1];
                    if (which == 2) {
                        bf16_t* p = Vb + ((size_t)(b * NH + h) * (KSLOT / 8) + (key >> 3)) * 512 + (size_t)d0 * 8 + (key & 7);
                        const unsigned w0 = cvt_pk_bf16(v0[0], v0[1]), w1 = cvt_pk_bf16(v0[2], v0[3]), w2 = cvt_pk_bf16(v1[0], v1[1]), w3 = cvt_pk_bf16(v1[2], v1[3]);
                        p[0] = (bf16_t)w0; p[8] = (bf16_t)(w0 >> 16); p[16] = (bf16_t)w1; p[24] = (bf16_t)(w1 >> 16); p[32] = (bf16_t)w2; p[40] = (bf16_t)(w2 >> 16); p[48] = (bf16_t)w3; p[56] = (bf16_t)(w3 >> 16);
                    } else {
                        const float qs = (which == 0) ? qscale : 1.0f; const f32x4 y0 = v0 * qs, y1 = v1 * qs;
                        u32x4 w; w.x = cvt_pk_bf16(y0[0], y0[1]); w.y = cvt_pk_bf16(y0[2], y0[3]); w.z = cvt_pk_bf16(y1[0], y1[1]); w.w = cvt_pk_bf16(y1[2], y1[3]);
                        bf16_t* p = (which == 0) ? Q + ((size_t)(b * NH + h) * SEQ + key) * HD + d0 : Kh + ((size_t)(b * NH + h) * KSLOT + key) * HD + d0;
                        *(u32x4*)p = w;
                    } } }
    }
};
}
#define XB_TMO      128
#define XB_XCNT(j)  (256  + 64 * (j))
#define XB_XSUB(j)  (1280 + 64 * (j))
#define XB_XGEN(j)  (2304 + 64 * (j))
#define XB_TOP      3328
#define XB_TOPGEN   3392
#define XCD_BAR_WORDS 3456
#define XB_SPIN_CAP (1u << 18)

__device__ __forceinline__ unsigned xb_ld(unsigned* p)              { return __hip_atomic_load(p, __ATOMIC_RELAXED, __HIP_MEMORY_SCOPE_AGENT); }
__device__ __forceinline__ unsigned xb_add(unsigned* p, unsigned v) { return __hip_atomic_fetch_add(p, v, __ATOMIC_RELAXED, __HIP_MEMORY_SCOPE_AGENT); }
__device__ __forceinline__ unsigned xb_xcc_id() { return (unsigned)__builtin_amdgcn_s_getreg((3 << 11) | 20) & 0xFu; }
#define XB_SPIN(cond, bar) do { unsigned _sp = 0; while (cond) { __builtin_amdgcn_s_sleep(1); \
    if ((++_sp & 255u) == 0u) { if (xb_ld(&(bar)[XB_TMO])) break; if (_sp > XB_SPIN_CAP) { atomicAdd(&(bar)[XB_TMO], 1u); break; } } } } while (0)

struct XcdBarrier {
    unsigned* bar; unsigned x;
    volatile LAS unsigned* st;
};

__device__ __forceinline__ XcdBarrier xcd_barrier_post(unsigned* bar, volatile LAS unsigned* st) {
    XcdBarrier b; b.bar = bar; b.x = xb_xcc_id(); b.st = st;
    if (threadIdx.x == 0) (void)xb_add(&bar[XB_XCNT(b.x)], 1u);
    return b;
}
__device__ __forceinline__ void xcd_barrier_complete(unsigned* bar, unsigned x, unsigned& nloc, unsigned& nx) {
    const unsigned G = gridDim.x * gridDim.y * gridDim.z;
    unsigned sum, cnt, mine, sp = 0u;
    for (;;) {
        sum = 0u; cnt = 0u; mine = 0u;
#pragma unroll
        for (unsigned j = 0; j < 16; ++j) { const unsigned c = xb_ld(&bar[XB_XCNT(j)]); sum += c; cnt += (c > 0u) ? 1u : 0u; mine = (j == x) ? c : mine; }
        if (sum == G) break;
        __builtin_amdgcn_s_sleep(1);
        if ((++sp & 255u) == 0u) { if (xb_ld(&bar[XB_TMO])) break; if (sp > XB_SPIN_CAP) { atomicAdd(&bar[XB_TMO], 1u); break; } }
    }
    nloc = mine > 0u ? mine : 1u; nx = cnt > 0u ? cnt : 1u;
}

__device__ __forceinline__ void xcd_barrier(const XcdBarrier& b) {
    asm volatile("s_waitcnt vmcnt(0)" ::: "memory");
    __syncthreads();
    if (threadIdx.x == 0) {
        unsigned* bar = b.bar;
        __builtin_amdgcn_s_waitcnt(0);
        unsigned nloc = b.st[0], nx = b.st[1];
        if (nloc == 0u) { xcd_barrier_complete(bar, b.x, nloc, nx); b.st[0] = nloc; b.st[1] = nx; }
        const unsigned old = xb_add(&bar[XB_XSUB(b.x)], 1u);
        const unsigned gen = old / nloc;
        if (old + 1u == (gen + 1u) * nloc) {
            __builtin_amdgcn_fence(__ATOMIC_RELEASE, "agent");
            asm volatile("s_waitcnt vmcnt(0)" ::: "memory");
            const unsigned og = xb_add(&bar[XB_TOP], 1u);
            const unsigned tg = og / nx;
            if (og + 1u == (tg + 1u) * nx) xb_add(&bar[XB_TOPGEN], 1u);
            else XB_SPIN(xb_ld(&bar[XB_TOPGEN]) == tg, bar);
            __builtin_amdgcn_fence(__ATOMIC_ACQUIRE, "agent");
            xb_add(&bar[XB_XGEN(b.x)], 1u);
            asm volatile("s_waitcnt vmcnt(0)" ::: "memory");
        } else {
            XB_SPIN(xb_ld(&bar[XB_XGEN(b.x)]) == gen, bar);
            __builtin_amdgcn_fence(__ATOMIC_ACQUIRE, "agent");
            asm volatile("s_waitcnt vmcnt(0)" ::: "memory");
        }
    }
    __syncthreads();
}

struct Frame {
    LAS unsigned char* lds;
    volatile LAS unsigned* MISC;
    gu32* ctl;
    int wave, G, bid;
    __device__ __forceinline__ const float* in(int k) const { const volatile LAS unsigned* t = (const volatile LAS unsigned*)(lds + PTAB_OFF) + 2 * k;
        const unsigned lo = __builtin_amdgcn_readfirstlane(t[0]), hi = __builtin_amdgcn_readfirstlane(t[1]); return (const float*)(const GAS float*)(((unsigned long long)hi << 32) | lo); }
    __device__ __forceinline__ int lane() const { return lane_id_asm(); }
    __device__ __forceinline__ int tid() const { return wave * 64 + lane_id_asm(); }
    unsigned char* ws;
    float* out;
};

__device__ __forceinline__ void ld_row_f32(const float* row, int lane, f32x4 (&v)[4]) {
    const f32x4* p = (const f32x4*)row + lane;
#pragma unroll
    for (int j = 0; j < 4; ++j) v[j] = p[64 * j];
}
__device__ __forceinline__ void st_row_f32(float* row, int lane, const f32x4 (&v)[4]) {
    f32x4* p = (f32x4*)row + lane;
#pragma unroll
    for (int j = 0; j < 4; ++j) p[64 * j] = v[j];
}
__device__ __forceinline__ void ld_row_bf16(const bf16* row, int lane, f32x4 (&v)[4]) {
    const v2u* p = (const v2u*)row + lane;
#pragma unroll
    for (int j = 0; j < 4; ++j) { const v2u w = p[64 * j]; v[j] = (f32x4){bflo(w.x), bfhi(w.x), bflo(w.y), bfhi(w.y)}; }
}
__device__ __forceinline__ void ld_raw_bf16(const bf16* row, int lane, v2u (&w)[4]) {
    const v2u* p = (const v2u*)row + lane;
#pragma unroll
    for (int j = 0; j < 4; ++j) w[j] = p[64 * j];
}
__device__ __forceinline__ void unpack_bf16(const v2u (&w)[4], f32x4 (&v)[4]) {
#pragma unroll
    for (int j = 0; j < 4; ++j) { const unsigned a = w[j].x, b = w[j].y; v[j] = (f32x4){bflo(a), bfhi(a), bflo(b), bfhi(b)}; }
}
__device__ __forceinline__ void st_row_bf16(bf16* row, int lane, const f32x4 (&v)[4]) {
    v2u* p = (v2u*)row + lane;
#pragma unroll
    for (int j = 0; j < 4; ++j) { v2u w; w.x = pk2(v[j][0], v[j][1]); w.y = pk2(v[j][2], v[j][3]); p[64 * j] = w; }
}
__device__ __forceinline__ void st_row_fp8(unsigned char* row, int lane, const f32x4 (&v)[4]) {
    unsigned* p = (unsigned*)row + lane;
#pragma unroll
    for (int j = 0; j < 4; ++j) p[64 * j] = pk4_fp8(v[j][0], v[j][1], v[j][2], v[j][3]);
}
__device__ __forceinline__ float sumsq4(const f32x4 (&v)[4]) {
    float s = 0.f;
#pragma unroll
    for (int j = 0; j < 4; ++j) s += (v[j][0] * v[j][0] + v[j][1] * v[j][1]) + (v[j][2] * v[j][2] + v[j][3] * v[j][3]);
    return s;
}
__device__ __forceinline__ void ld_mod(const Frame& F, int l, int r, int ch, f32x4 (&v)[4]) {
    const float* modp = (const float*)(F.ws + WS_MODP); const int lane = F.lane();
    ld_row_f32(F.in(5) + (size_t)l * NMODC + ch * D, lane, v);
#pragma unroll
    for (int kc = 0; kc < MODKC; ++kc) { f32x4 t[4]; ld_row_f32(modp + ((size_t)((kc * 2 + l) * NMODR + r)) * NMODC + ch * D, lane, t);
#pragma unroll
        for (int j = 0; j < 4; ++j) v[j] += t[j]; }
}
__device__ __forceinline__ int row_batch(int m) { return m < NLAT ? (m >> 12) : 8; }

__device__ __forceinline__ void p0_transpose_item(const float* W, int K, int N, bf16* WT, int drow_off, LAS float* scr, int item, int lane) {
    const int nblk = N / 32, kb = item / nblk, nb = item % nblk, k0 = 64 * kb, n0 = 32 * nb;
#pragma unroll 8
    for (int i = 0; i < 32; ++i) { const int kk = 2 * i + (lane >> 5); scr[kk * 33 + (lane & 31)] = W[(size_t)(k0 + kk) * N + n0 + (lane & 31)]; }
    LDS_WAIT(); asm volatile("" ::: "memory");
    const int c = lane & 7;
#pragma unroll
    for (int j = 0; j < 4; ++j) { const int n = (lane >> 3) + 8 * j; const LAS float* s = scr + (8 * c) * 33 + n;
        v4u o; o.x = pk2(s[0 * 33], s[1 * 33]); o.y = pk2(s[2 * 33], s[3 * 33]); o.z = pk2(s[4 * 33], s[5 * 33]); o.w = pk2(s[6 * 33], s[7 * 33]);
        *(GAS v4u*)(WT + (size_t)(drow_off + n0 + n) * K + k0 + 8 * c) = o; }
    LDS_WAIT(); asm volatile("" ::: "memory");
}
__device__ __forceinline__ void p0_transpose_item_fp8(const float* W, int K, int N, unsigned char* WT, int drow_off, float wscale, LAS float* scr, int item, int lane) {
    const int nblk = N / 32, kb = item / nblk, nb = item % nblk, k0 = 64 * kb, n0 = 32 * nb;
#pragma unroll 8
    for (int i = 0; i < 32; ++i) { const int kk = 2 * i + (lane >> 5); scr[kk * 33 + (lane & 31)] = W[(size_t)(k0 + kk) * N + n0 + (lane & 31)] * wscale; }
    LDS_WAIT(); asm volatile("" ::: "memory");
    const int c = lane & 3;
#pragma unroll
    for (int j = 0; j < 2; ++j) { const int n = (lane >> 2) + 16 * j; const LAS float* s = scr + (16 * c) * 33 + n;
        v4u o; o.x = pk4_fp8(s[0 * 33], s[1 * 33], s[2 * 33], s[3 * 33]); o.y = pk4_fp8(s[4 * 33], s[5 * 33], s[6 * 33], s[7 * 33]);
        o.z = pk4_fp8(s[8 * 33], s[9 * 33], s[10 * 33], s[11 * 33]); o.w = pk4_fp8(s[12 * 33], s[13 * 33], s[14 * 33], s[15 * 33]);
        *(GAS v4u*)(WT + (size_t)(drow_off + n0 + n) * K + k0 + 16 * c) = o; }
    LDS_WAIT(); asm volatile("" ::: "memory");
}
constexpr float W8SCALE = 64.0f;
constexpr int I_WIN = 1024, I_WOUT = 512, I_WQKV = 1536, I_WO = 512, I_EXP = 32 * 768, NITEMS_P0 = I_WIN + I_WOUT + I_WQKV + I_WO + I_EXP;
__device__ __forceinline__ void p0_item(const Frame& F, LAS float* scr, int it) {
    int r = it; const int lane = F.lane();
    if (r < I_WIN) { const int n0 = 32 * (r % 64), ch = n0 & 1023, hf = n0 >> 10, drow0 = 256 * (ch >> 7) + 128 * hf + (ch & 127);
        p0_transpose_item(F.in(10), D, 2 * D, (bf16*)(F.ws + WS_WIN), drow0 - n0, scr, r, lane); return; }
    r -= I_WIN;
    if (r < I_WOUT) { p0_transpose_item(F.in(16), D, D, (bf16*)(F.ws + WS_WOUT), 0, scr, r, lane); return; }
    r -= I_WOUT;
    if (r < I_WQKV) { p0_transpose_item(F.in(18), D, 3 * D, (bf16*)(F.ws + WS_WQKV), 0, scr, r, lane); return; }
    r -= I_WQKV;
    if (r < I_WO) { p0_transpose_item(F.in(19), D, D, (bf16*)(F.ws + WS_WO), 0, scr, r, lane); return; }
    r -= I_WO;
    const int le = r / 768; int q = r % 768;
    if (q < 512) { const bool up = q >= 256; if (up) q -= 256; const int n0 = 32 * (q % 16), drow0 = 256 * (n0 >> 7) + (up ? 128 : 0) + (n0 & 127);
        p0_transpose_item_fp8((up ? F.in(24) : F.in(23)) + (size_t)le * D * DE, D, DE, (unsigned char*)(F.ws + WS_WGU) + (size_t)le * 1024 * 1024, drow0 - n0, W8SCALE, scr, q, lane); return; }
    q -= 512;
    p0_transpose_item(F.in(25) + (size_t)le * DE * D, DE, D, (bf16*)(F.ws + WS_WDN) + (size_t)le * 1024 * 512, 0, scr, q, lane);
}
__device__ __forceinline__ void p0_mod_item(const Frame& F, LAS float* scr, int it) {
    const int lane = F.lane(), l = it / 192, rem = it % 192, cg = rem >> 3, kc = rem & 7, k0 = 128 * kc, n0 = 256 * cg + 4 * lane;
    const float* cvec = F.in(1); const float* cctx = F.in(3);
    for (int idx = lane; idx < NMODR * 128; idx += 64) { const int r = idx >> 7, kk = idx & 127; const float cv = (r < 8) ? cvec[r * D + k0 + kk] : cctx[k0 + kk];
        scr[idx] = cv / (1.0f + __expf(-cv)); }
    LDS_WAIT(); asm volatile("" ::: "memory");
    f32x4 acc[NMODR];
#pragma unroll
    for (int r = 0; r < NMODR; ++r) acc[r] = (f32x4){0.f, 0.f, 0.f, 0.f};
    const float* wp = F.in(4) + ((size_t)l * D + k0) * NMODC + n0;
#pragma unroll 8
    for (int kk = 0; kk < 128; ++kk) { const f32x4 w = *(const f32x4*)(wp + (size_t)kk * NMODC);
#pragma unroll
        for (int r = 0; r < NMODR; ++r) { const float s = scr[r * 128 + kk]; acc[r] += w * s; } }
    float* modp = (float*)(F.ws + WS_MODP);
#pragma unroll
    for (int r = 0; r < NMODR; ++r) *(f32x4*)(modp + ((size_t)((kc * 2 + l) * NMODR + r)) * NMODC + n0) = acc[r];
    LDS_WAIT(); asm volatile("" ::: "memory");
}
__device__ __forceinline__ void p0_prologue(const Frame& F) {
    LAS float* scr = (LAS float*)(F.lds + F.wave * 16384);
    if (F.wave == 0) p0_mod_item(F, scr, F.bid);
    if (F.wave == 1 && F.bid < 128) p0_mod_item(F, scr, 256 + F.bid);
    const int gw = F.bid * NWAVES + F.wave, NGW = F.G * NWAVES;
    for (int it = gw; it < NITEMS_P0; it += NGW) p0_item(F, scr, it);
}

__device__ __forceinline__ void p1_modulate(const Frame& F) {
    constexpr int RPB = MT / 256;
    bf16* H = (bf16*)(F.ws + WS_A);
    int rc = -1; f32x4 gs[4], sh[4]; const int lane = F.lane();
    const float* xlat = F.in(0); const float* xctx = F.in(2);
    f32x4 vn[4];
    { const int m = F.bid * RPB + F.wave; ld_row_f32(m < NLAT ? xlat + (size_t)m * D : xctx + (size_t)(m - NLAT) * D, lane, vn); }
    for (int rl = F.wave; rl < RPB; rl += NWAVES) {
        const int m = F.bid * RPB + rl, r = row_batch(m);
        f32x4 v[4];
#pragma unroll
        for (int j = 0; j < 4; ++j) v[j] = vn[j];
        if (rl + NWAVES < RPB) { const int m2 = m + NWAVES; ld_row_f32(m2 < NLAT ? xlat + (size_t)m2 * D : xctx + (size_t)(m2 - NLAT) * D, lane, vn); }
        if (r != rc) { f32x4 g[4], sc[4]; ld_row_f32(F.in(6), lane, g); ld_mod(F, 0, r, 1, sc); ld_mod(F, 0, r, 0, sh);
#pragma unroll
            for (int j = 0; j < 4; ++j) gs[j] = g[j] * (sc[j] + 1.0f);
            rc = r; }
        const float rstd = 1.0f / sqrtf(wave_sum(sumsq4(v)) * (1.0f / D) + EPS);
#pragma unroll
        for (int j = 0; j < 4; ++j) v[j] = v[j] * rstd * gs[j] + sh[j];
        st_row_bf16(H + (size_t)m * D, lane, v);
    }
}

__device__ __forceinline__ void p3_conv(const Frame& F) {
    const bf16* U = (const bf16*)(F.ws + WS_B); bf16* V = (bf16*)(F.ws + WS_A);
    const int tid = F.tid(), lane = F.lane();
    f32x2 w[CONVW]; const float* wdw = F.in(12);
#pragma unroll
    for (int j = 0; j < CONVW; ++j) w[j] = *(const f32x2*)(wdw + j * D + 2 * tid);
    const f32x2 bias2 = *(const f32x2*)(F.in(13) + 2 * tid);
    f32x4 lg[4], lb[4]; ld_row_f32(F.in(14), lane, lg); ld_row_f32(F.in(15), lane, lb);
    constexpr int TT = 32, NIN = TT + CONVW - 1;
    for (int tile = F.bid; tile < MT / TT; tile += F.G) {
        int rowbase, t0, T;
        if (tile < NLAT / TT) { rowbase = (tile >> 7) * SEQ; t0 = (tile & 127) * TT; T = SEQ; } else { const int t2 = tile - NLAT / TT; rowbase = NLAT + (t2 >> 3) * CTXL; t0 = (t2 & 7) * TT; T = CTXL; }
        for (int p = tid; p < NIN * 128; p += NTHR) { const int i = p >> 7, cp = p & 127, t = t0 - 15 + i;
            v4u val = (v4u){0u, 0u, 0u, 0u}; if (t >= 0 && t < T) val = *(const v4u*)(U + (size_t)(rowbase + t) * D + cp * 8);
            *(LAS v4u*)(F.lds + i * 2048 + cp * 16) = val; }
        __syncthreads();
        f32x2 res[TT];
#pragma unroll
        for (int g = 0; g < TT / 8; ++g) {
            f32x2 acc[8];
#pragma unroll
            for (int q = 0; q < 8; ++q) acc[q] = bias2;
#pragma unroll
            for (int ii = 0; ii < 8 + CONVW - 1; ++ii) { const int i = 8 * g + ii; const unsigned uw = *(const LAS unsigned*)(F.lds + i * 2048 + tid * 4); const f32x2 uv = (f32x2){bflo(uw), bfhi(uw)};
#pragma unroll
                for (int q = 0; q < 8; ++q) { const int j = ii - q; if (j >= 0 && j < CONVW) acc[q] += w[j] * uv; } }
#pragma unroll
            for (int q = 0; q < 8; ++q) res[8 * g + q] = acc[q];
        }
        __syncthreads();
#pragma unroll
        for (int tt = 0; tt < TT; ++tt) *(LAS f32x2*)(F.lds + tt * 4096 + tid * 8) = res[tt];
        __syncthreads();
#pragma unroll
        for (int q = 0; q < 4; ++q) { const int tt = 4 * F.wave + q; f32x4 v[4];
#pragma unroll
            for (int j = 0; j < 4; ++j) v[j] = *(const LAS f32x4*)(F.lds + tt * 4096 + j * 1024 + lane * 16);
            float s = 0.f;
#pragma unroll
            for (int j = 0; j < 4; ++j) s += (v[j][0] + v[j][1]) + (v[j][2] + v[j][3]);
            const float mean = wave_sum(s) * (1.0f / D);
#pragma unroll
            for (int j = 0; j < 4; ++j) v[j] = v[j] - mean;
            const float rstd = 1.0f / sqrtf(wave_sum(sumsq4(v)) * (1.0f / D) + EPS);
#pragma unroll
            for (int j = 0; j < 4; ++j) { f32x4 y = v[j] * rstd * lg[j] + lb[j];
#pragma unroll
                for (int e = 0; e < 4; ++e) y[e] = y[e] / (1.0f + __expf(-y[e]));
                v[j] = y; }
            st_row_bf16(V + (size_t)(rowbase + t0 + tt) * D, lane, v); }
        __syncthreads();
    }
}

constexpr int RW_OFF = 0, RW_BYTES = 256 * 272;
constexpr int REC_OFF = 72 * 1024;
constexpr int LRK_OFF = REC_OFF + 4096;
constexpr int BASE_OFF = LRK_OFF + 2048;
template <int L>
__device__ __forceinline__ void p_emid(const Frame& F) {
    constexpr int NROWS = (L == 0) ? MT : NLAT, RPB = NROWS / 256;
    const bf16* Y = (const bf16*)(F.ws + (L == 0 ? WS_B : WS_C)); unsigned char* TOK = (unsigned char*)(F.ws + WS_A);
    bf16* XS = (bf16*)(F.ws + WS_B);
    float* XC = (float*)(F.ws + WS_XC);
    const int tid = F.tid(), lane = F.lane(), m0 = F.bid * RPB;
    const float* rwG = F.in(21);
    for (int idx = tid; idx < 4096; idx += NTHR) { const int k = idx >> 2, ep = idx & 3; const f32x4 v = *(const f32x4*)(rwG + k * 16 + ep * 4);
        *(LAS f32x4*)(F.lds + RW_OFF + (k >> 2) * 272 + (k & 3) * 64 + ep * 16) = v; }
    __syncthreads();
    float rb[16];
    { const float* rbG = F.in(22);
#pragma unroll
    for (int e = 0; e < 16; ++e) rb[e] = rbG[e]; }
    int rc = -1; f32x4 ga[4], gp[4], gs[4], sh[4];
    const float* xlat = F.in(0); const float* xctx = F.in(2);
    v2u yn[4]; f32x4 xn[4];
    v2u xbn[4];
    { const int m = m0 + F.wave; ld_raw_bf16(Y + (size_t)m * D, lane, yn);
      if (L == 0) ld_row_f32(m < NLAT ? xlat + (size_t)m * D : xctx + (size_t)(m - NLAT) * D, lane, xn); else ld_raw_bf16(XS + (size_t)m * D, lane, xbn); }
    for (int rl = F.wave; rl < RPB; rl += NWAVES) {
        const int m = m0 + rl, r = row_batch(m);
        f32x4 y[4], xv[4];
        unpack_bf16(yn, y);
        if (L == 0) {
#pragma unroll
            for (int j = 0; j < 4; ++j) xv[j] = xn[j];
        } else unpack_bf16(xbn, xv);
        if (rl + NWAVES < RPB) { const int m2 = m + NWAVES; ld_raw_bf16(Y + (size_t)m2 * D, lane, yn);
            if (L == 0) ld_row_f32(m2 < NLAT ? xlat + (size_t)m2 * D : xctx + (size_t)(m2 - NLAT) * D, lane, xn); else ld_raw_bf16(XS + (size_t)m2 * D, lane, xbn); }
        if (r != rc) { f32x4 g[4], sc[4]; ld_mod(F, L, r, 2, ga); ld_row_f32(F.in(7) + L * D, lane, gp); ld_row_f32(F.in(8) + L * D, lane, g); ld_mod(F, L, r, 4, sc); ld_mod(F, L, r, 3, sh);
#pragma unroll
            for (int j = 0; j < 4; ++j) gs[j] = g[j] * (sc[j] + 1.0f);
            rc = r; }
        const float rstdy = 1.0f / sqrtf(wave_sum(sumsq4(y)) * (1.0f / D) + EPS);
#pragma unroll
        for (int j = 0; j < 4; ++j) xv[j] = xv[j] + ga[j] * (y[j] * rstdy * gp[j]) * (((DBG_SKIP >> (2 * L)) & 1) ? 0.f : 1.f);
        if (m < NLAT) st_row_bf16(XS + (size_t)m * D, lane, xv); else st_row_f32(XC + (size_t)(m - NLAT) * D, lane, xv);
        const float rstd1 = 1.0f / sqrtf(wave_sum(sumsq4(xv)) * (1.0f / D) + EPS);
#pragma unroll
        for (int j = 0; j < 4; ++j) xv[j] = xv[j] * rstd1 * gs[j] + sh[j];
        st_row_fp8(TOK + (size_t)m * D, lane, xv);
        float a[16];
#pragma unroll
        for (int e = 0; e < 16; ++e) a[e] = 0.f;
#pragma unroll
        for (int j = 0; j < 4; ++j)
#pragma unroll
            for (int i = 0; i < 4; ++i) { const float tv = xv[j][i]; const LAS f32x4* wp = (const LAS f32x4*)(F.lds + RW_OFF + (64 * j + lane) * 272 + i * 64);
#pragma unroll
                for (int ep = 0; ep < 4; ++ep) { const f32x4 wv = wp[ep];
#pragma unroll
                    for (int cc = 0; cc < 4; ++cc) a[4 * ep + cc] += tv * wv[cc]; } }
        float k8[8], k4[4];
#pragma unroll
        for (int i = 0; i < 8; ++i) { const auto rr = __builtin_amdgcn_permlane32_swap(__builtin_bit_cast(unsigned, a[i]), __builtin_bit_cast(unsigned, a[8 + i]), false, false);
            const unsigned r0_ = rr[0], r1_ = rr[1]; k8[i] = __uint_as_float(r0_) + __uint_as_float(r1_); }
#pragma unroll
        for (int i = 0; i < 4; ++i) { const auto rr = __builtin_amdgcn_permlane16_swap(__builtin_bit_cast(unsigned, k8[i]), __builtin_bit_cast(unsigned, k8[4 + i]), false, false);
            const unsigned r0_ = rr[0], r1_ = rr[1]; k4[i] = row16_sum(__uint_as_float(r0_) + __uint_as_float(r1_)); }
        float s[16], ss[16];
        const float lgsel = (lane & 2) ? ((lane & 1) ? k4[3] : k4[2]) : ((lane & 1) ? k4[1] : k4[0]);
        const float sgl = 1.0f / (1.0f + __expf(-lgsel));
#pragma unroll
        for (int e = 0; e < 16; ++e) { s[e] = rdlane(sgl, 16 * (e >> 2) + (e & 3)); ss[e] = s[e] + rb[e]; }
        float gsc[4]; int i0[4], i1[4];
#pragma unroll
        for (int g = 0; g < 4; ++g) { int a0 = 0; float mx = ss[4 * g];
#pragma unroll
            for (int i = 1; i < 4; ++i) if (ss[4 * g + i] > mx) { mx = ss[4 * g + i]; a0 = i; }
            int b0 = -1; float m2 = -3.0e38f;
#pragma unroll
            for (int i = 0; i < 4; ++i) if (i != a0 && ss[4 * g + i] > m2) { m2 = ss[4 * g + i]; b0 = i; }
            gsc[g] = mx + m2; i0[g] = 4 * g + a0; i1[g] = 4 * g + b0; }
        int gst = 0; float gm = gsc[0];
#pragma unroll
        for (int g = 1; g < 4; ++g) if (gsc[g] > gm) { gm = gsc[g]; gst = g; }
        int e0 = i0[0], e1 = i1[0];
#pragma unroll
        for (int g = 1; g < 4; ++g) if (gst == g) { e0 = i0[g]; e1 = i1[g]; }
        float w0 = 0.f, w1 = 0.f;
#pragma unroll
        for (int e = 0; e < 16; ++e) { if (e == e0) w0 = s[e]; if (e == e1) w1 = s[e]; }
        const float inv = 1.0f / (w0 + w1); w0 *= inv; w1 *= inv;
        if (lane == 0) *(LAS v4u*)(F.lds + REC_OFF + rl * 16) = (v4u){(unsigned)e0, (unsigned)e1, __builtin_bit_cast(unsigned, w0), __builtin_bit_cast(unsigned, w1)};
    }
    __syncthreads();
    if (F.wave == 0 && lane < 16) {
        int cntl = 0;
        for (int rl = 0; rl < RPB; ++rl) { const v4u rec = *(const LAS v4u*)(F.lds + REC_OFF + rl * 16);
            if ((int)rec.x == lane) { *(LAS int*)(F.lds + LRK_OFF + rl * 8) = cntl; ++cntl; }
            if ((int)rec.y == lane) { *(LAS int*)(F.lds + LRK_OFF + rl * 8 + 4) = cntl; ++cntl; } }
        const unsigned base = __hip_atomic_fetch_add((unsigned*)(F.ctl + CW_CNT + (L * 16 + lane) * 64), (unsigned)cntl, RLX_AGENT);
        *(LAS int*)(F.lds + BASE_OFF + lane * 4) = (int)base;
    }
    __syncthreads();
    int* perm2 = (int*)(F.ws + WS_PERM); v2u* slot = (v2u*)(F.ws + WS_SLOT);
    for (int idx = tid; idx < RPB * 2; idx += NTHR) { const int rl = idx >> 1, k = idx & 1; const v4u rec = *(const LAS v4u*)(F.lds + REC_OFF + rl * 16);
        const int e = k ? (int)rec.y : (int)rec.x; const unsigned wb = k ? rec.w : rec.z;
        const int rank = *(const LAS int*)(F.lds + BASE_OFF + e * 4) + *(const LAS int*)(F.lds + LRK_OFF + rl * 8 + k * 4);
        const int m = m0 + rl;
        perm2[(size_t)e * MT + rank] = m;
        slot[(size_t)m * 2 + k] = (v2u){((unsigned)e << 24) | (unsigned)rank, wb}; }
    __syncthreads();
}

__device__ __forceinline__ void moe_setup(const Frame& F, int L) {
    const int tid = F.tid();
    if (tid < 16) F.MISC[40 + tid] = __hip_atomic_load((unsigned*)(F.ctl + CW_CNT + (L * 16 + tid) * 64), RLX_AGENT);
    __syncthreads();
    if (tid == 0) { unsigned p = 0; for (int e = 0; e < 16; ++e) { F.MISC[16 + e] = p; p += (F.MISC[40 + e] + 255u) >> 8; } F.MISC[32] = p; }
    __syncthreads();
}
__device__ __forceinline__ void moe_stage_perm(const Frame& F) {
    const int* perm2 = (const int*)(F.ws + WS_PERM); LAS int* permL = (LAS int*)(F.lds + PERML_OFF);
    const int ntile = (int)F.MISC[32], tid = F.tid();
    for (int i = 0; i < 8; ++i) { const int Lu = i * F.G + F.bid; if (Lu >= 4 * ntile) break;
        const int rt = Lu >> 2; int e = 0;
        for (int j = 1; j < 16; ++j) e += (rt >= (int)F.MISC[16 + j]) ? 1 : 0;
        if (tid < 256) { const int rank = (rt - (int)F.MISC[16 + e]) * 256 + tid; permL[i * 256 + tid] = (rank < (int)F.MISC[40 + e]) ? perm2[(size_t)e * MT + rank] : 0; } }
    __syncthreads();
}

template <int L>
__device__ __forceinline__ void p_epost(const Frame& F) {
    constexpr int NROWS = (L == 0) ? MT : NLAT, RPB = NROWS / 256;
    const bf16* FB = (const bf16*)(F.ws + WS_D2); bf16* H = (bf16*)(F.ws + WS_A);
    float* XC = (float*)(F.ws + WS_XC); const v2u* slot = (const v2u*)(F.ws + WS_SLOT);
    const int lane = F.lane(), m0 = F.bid * RPB;
    int rc = -1; f32x4 ga[4], gp[4], gs[4], sh[4];
    v4u sl_n2 = (v4u){0u, 0u, 0u, 0u}; v2u f0n[4], f1n[4], xbn[4]; f32x4 xn[4]; float w0n, w1n;
    bf16* XS = (bf16*)(F.ws + WS_B);
#define EP_ISSUE(mm, slv) do { const unsigned sx0 = __builtin_amdgcn_readfirstlane((slv).x), sy0 = __builtin_amdgcn_readfirstlane((slv).y), sx1 = __builtin_amdgcn_readfirstlane((slv).z), sy1 = __builtin_amdgcn_readfirstlane((slv).w); \
        const size_t v0_ = (size_t)F.MISC[16 + (sx0 >> 24)] * 256 + (sx0 & 0xffffffu), v1_ = (size_t)F.MISC[16 + (sx1 >> 24)] * 256 + (sx1 & 0xffffffu); \
        w0n = __uint_as_float(sy0); w1n = __uint_as_float(sy1); ld_raw_bf16(FB + v0_ * D, lane, f0n); ld_raw_bf16(FB + v1_ * D, lane, f1n); \
        if ((mm) < NLAT) ld_raw_bf16(XS + (size_t)(mm) * D, lane, xbn); else ld_row_f32(XC + (size_t)((mm) - NLAT) * D, lane, xn); } while (0)
    { const int m = m0 + F.wave; const v4u sl0 = *(const v4u*)(slot + (size_t)m * 2);
      if (F.wave + NWAVES < RPB) sl_n2 = *(const v4u*)(slot + (size_t)(m + NWAVES) * 2);
      EP_ISSUE(m, sl0); }
    for (int rl = F.wave; rl < RPB; rl += NWAVES) {
        const int m = m0 + rl, r = row_batch(m);
        f32x4 f0[4], f1[4], xv[4]; const float w0 = w0n, w1 = w1n;
        unpack_bf16(f0n, f0); unpack_bf16(f1n, f1);
        if (m < NLAT) unpack_bf16(xbn, xv); else {
#pragma unroll
            for (int j = 0; j < 4; ++j) xv[j] = xn[j]; }
        if (rl + NWAVES < RPB) { const v4u slc = sl_n2; if (rl + 2 * NWAVES < RPB) sl_n2 = *(const v4u*)(slot + (size_t)(m + 2 * NWAVES) * 2); EP_ISSUE(m + NWAVES, slc); }
        if (r != rc) { ld_mod(F, L, r, 5, ga); ld_row_f32(F.in(9) + L * D, lane, gp);
            if (L == 0) { f32x4 g[4], sc[4]; ld_row_f32(F.in(6) + D, lane, g); ld_mod(F, 1, r, 1, sc); ld_mod(F, 1, r, 0, sh);
#pragma unroll
                for (int j = 0; j < 4; ++j) gs[j] = g[j] * (sc[j] + 1.0f); }
            rc = r; }
#pragma unroll
        for (int j = 0; j < 4; ++j) f0[j] = (DBG_SLOT == 1) ? f0[j] : (DBG_SLOT == 2) ? f1[j] : (DBG_SLOT == 3) ? f0[j] * 0.5f + f1[j] * 0.5f : f0[j] * w0 + f1[j] * w1;
        const float rstdf = 1.0f / sqrtf(wave_sum(sumsq4(f0)) * (1.0f / D) + EPS);
#pragma unroll
        for (int j = 0; j < 4; ++j) xv[j] = xv[j] + ga[j] * (f0[j] * rstdf * gp[j]) * (((DBG_SKIP >> (2 * L + 1)) & 1) ? 0.f : 1.f);
        if (L == 1) st_row_f32(F.out + (size_t)m * D, lane, xv);
        else if (m < NLAT) st_row_bf16(XS + (size_t)m * D, lane, xv); else st_row_f32(XC + (size_t)(m - NLAT) * D, lane, xv);
        if (L == 0) {
            const float rstd2 = 1.0f / sqrtf(wave_sum(sumsq4(xv)) * (1.0f / D) + EPS);
#pragma unroll
            for (int j = 0; j < 4; ++j) xv[j] = xv[j] * rstd2 * gs[j] + sh[j];
            st_row_bf16(H + (size_t)m * D, lane, xv);
        }
    }
#undef EP_ISSUE
}

constexpr int AT_CK = 0, AT_CV = 32768, AT_RPB = 65536;
constexpr float LOG2E = 1.4426950408889634f;
__device__ __forceinline__ float xrow_max(float m) {
    { const auto rr = __builtin_amdgcn_permlane16_swap(__builtin_bit_cast(unsigned, m), __builtin_bit_cast(unsigned, m), false, false); const unsigned a_ = rr[0], b_ = rr[1]; m = fmaxf(__uint_as_float(a_), __uint_as_float(b_)); }
    { const auto rr = __builtin_amdgcn_permlane32_swap(__builtin_bit_cast(unsigned, m), __builtin_bit_cast(unsigned, m), false, false); const unsigned a_ = rr[0], b_ = rr[1]; m = fmaxf(__uint_as_float(a_), __uint_as_float(b_)); }
    return m;
}
__device__ __forceinline__ float xrow_sum(float m) {
    { const auto rr = __builtin_amdgcn_permlane16_swap(__builtin_bit_cast(unsigned, m), __builtin_bit_cast(unsigned, m), false, false); const unsigned a_ = rr[0], b_ = rr[1]; m = __uint_as_float(a_) + __uint_as_float(b_); }
    { const auto rr = __builtin_amdgcn_permlane32_swap(__builtin_bit_cast(unsigned, m), __builtin_bit_cast(unsigned, m), false, false); const unsigned a_ = rr[0], b_ = rr[1]; m = __uint_as_float(a_) + __uint_as_float(b_); }
    return m;
}
__device__ __forceinline__ void attn_softmax(f32x4 (&s)[4], float& mrun, float& lsum, f32x4 (&o)[4], bf16x8 (&pf)[2]) {
    float mx = mrun;
#pragma unroll
    for (int t = 0; t < 4; ++t) mx = fmaxf(fmaxf(mx, fmaxf(s[t][0], s[t][1])), fmaxf(s[t][2], s[t][3]));
    mx = xrow_max(mx);
    const float alpha = __builtin_amdgcn_exp2f(mrun - mx);
    mrun = mx; lsum *= alpha;
#pragma unroll
    for (int db = 0; db < 4; ++db) o[db] = o[db] * alpha;
#pragma unroll
    for (int t = 0; t < 4; ++t)
#pragma unroll
        for (int i = 0; i < 4; ++i) { const float p = __builtin_amdgcn_exp2f(s[t][i] - mx); s[t][i] = p; lsum += p; }
#pragma unroll
    for (int bb = 0; bb < 2; ++bb) { v4u pw; pw.x = pg8::cvt_pk_bf16(s[2 * bb][0], s[2 * bb][1]); pw.y = pg8::cvt_pk_bf16(s[2 * bb][2], s[2 * bb][3]);
        pw.z = pg8::cvt_pk_bf16(s[2 * bb + 1][0], s[2 * bb + 1][1]); pw.w = pg8::cvt_pk_bf16(s[2 * bb + 1][2], s[2 * bb + 1][3]); pf[bb] = __builtin_bit_cast(bf16x8, pw); }
}
__device__ __forceinline__ void p10_attn(const Frame& F) {
    const bf16* Qh = (const bf16*)F.out; const bf16* Kh = (const bf16*)(F.ws + WS_C); const bf16* Vb = (const bf16*)(F.ws + WS_D2); bf16* O = (bf16*)(F.ws + WS_A);
    const int lane = F.lane(), tid = F.wave * 64 + lane, qi = lane & 15, q4 = lane >> 4;
    const int per = (BATCH * NH * GROWS * 4) / F.G;
    const int bh = (F.bid * per) >> 8, h = bh & 15, b = bh >> 4;
    const bf16* Kbh = Kh + (size_t)bh * KSLOT * HD; const bf16* Vbh = Vb + (size_t)bh * (KSLOT / 8) * 512;
#pragma unroll
    for (int i = 0; i < 4; ++i) { const int kf = F.wave * 4 + i, blk = kf >> 2, tl = (kf >> 1) & 1, dh = kf & 1;
        const v4u kv = *(const v4u*)(Kbh + (size_t)(SEQ + 32 * blk + 8 * (qi >> 2) + 4 * tl + (qi & 3)) * HD + dh * 32 + 8 * q4);
        const int vblk = kf >> 2, db = kf & 3;
        const v4u vv = *(const v4u*)(Vbh + (size_t)(SEQ / 8 + 4 * vblk + q4) * 512 + (db * 16 + qi) * 8);
        *(LAS v4u*)(F.lds + AT_CK + kf * 1024 + lane * 16) = kv; *(LAS v4u*)(F.lds + AT_CV + kf * 1024 + lane * 16) = vv; }
    { const float* rpbG = F.in(20) + h * 465; LAS float* rpbW = (LAS float*)(F.lds + AT_RPB);
        for (int idx = tid; idx < 15 * 32; idx += NTHR) { const int ri = idx >> 5, ci = idx & 31; rpbW[idx] = (ci < 31) ? rpbG[ri * 31 + ci] * LOG2E : -1.0e30f; } }
    __syncthreads();
    const int seg = F.wave & 3;
    const int cb = (seg == 0) ? 0 : (seg == 1) ? 8 : (seg == 2) ? 24 : 32;
    const int qc = 16 * seg + qi, cs = min(max(qc - WINW / 2, 0), GRIDW - WINW);
    int coff[2][4];
#pragma unroll
    for (int tl = 0; tl < 2; ++tl)
#pragma unroll
        for (int i = 0; i < 4; ++i) { const int kc = cb + 8 * q4 + 4 * tl + i; const bool ok = (kc >= cs) && (kc < cs + WINW); coff[tl][i] = AT_RPB + 4 * (ok ? (kc - qc + (WINW - 1)) : 31); }
    for (int it = 0; it < per; it += NWAVES) {
        const int wu = F.bid * per + it + F.wave;
        const int r = (wu >> 2) & 63;
        const int r0 = min(max(r - WINH / 2, 0), GROWS - WINH);
        const bf16* Qp = Qh + ((size_t)bh * SEQ + r * GRIDW + qc) * HD;
        const bf16x8 qf0 = *(const bf16x8*)(Qp + 8 * q4), qf1 = *(const bf16x8*)(Qp + 32 + 8 * q4);
        const bf16* kp0 = Kbh + (size_t)(r0 * GRIDW + cb + 8 * (qi >> 2) + (qi & 3)) * HD + 8 * q4;
        const bf16* vp0 = Vbh + (size_t)((r0 * GRIDW + cb) / 8 + q4) * 512 + qi * 8;
        int boff[2][4];
#pragma unroll
        for (int tl = 0; tl < 2; ++tl)
#pragma unroll
            for (int i = 0; i < 4; ++i) boff[tl][i] = coff[tl][i] + (r0 - r + (WINH - 1)) * 128;
        bf16x8 kw[4][2][2][2], vw[4][2][4];
#define AT_LOADK(g) do { _Pragma("unroll") for (int bb = 0; bb < 2; ++bb) _Pragma("unroll") for (int tl = 0; tl < 2; ++tl) { \
            kw[g][bb][tl][0] = *(const bf16x8*)(kp0 + (size_t)((2 * (g) + bb) * GRIDW + 4 * tl) * HD); kw[g][bb][tl][1] = *(const bf16x8*)(kp0 + (size_t)((2 * (g) + bb) * GRIDW + 4 * tl) * HD + 32); } } while (0)
#define AT_LOADV(g) do { _Pragma("unroll") for (int bb = 0; bb < 2; ++bb) _Pragma("unroll") for (int db = 0; db < 4; ++db) vw[g][bb][db] = *(const bf16x8*)(vp0 + (size_t)((2 * (g) + bb) * (GRIDW / 8)) * 512 + db * 128); } while (0)
        float mrun = -1.0e30f, lsum = 0.f;
        f32x4 o[4];
#pragma unroll
        for (int db = 0; db < 4; ++db) o[db] = (f32x4){0.f, 0.f, 0.f, 0.f};
        AT_LOADK(0); AT_LOADV(0);
        __builtin_amdgcn_sched_barrier(0);
#pragma unroll
        for (int g = 0; g < 4; ++g) {
            {
                f32x4 s[4]; bf16x8 pf[2];
#pragma unroll
                for (int bb = 0; bb < 2; ++bb) { const int blk = 2 * g + bb;
#pragma unroll
                    for (int tl = 0; tl < 2; ++tl) { const bf16x8 k0 = *(const LAS bf16x8*)(F.lds + AT_CK + ((blk * 2 + tl) * 2 + 0) * 1024 + lane * 16), k1 = *(const LAS bf16x8*)(F.lds + AT_CK + ((blk * 2 + tl) * 2 + 1) * 1024 + lane * 16);
                        f32x4 acc = (f32x4){0.f, 0.f, 0.f, 0.f};
                        acc = __builtin_amdgcn_mfma_f32_16x16x32_bf16(k0, qf0, acc, 0, 0, 0);
                        acc = __builtin_amdgcn_mfma_f32_16x16x32_bf16(k1, qf1, acc, 0, 0, 0);
                        s[2 * bb + tl] = acc; } }
                attn_softmax(s, mrun, lsum, o, pf);
#pragma unroll
                for (int bb = 0; bb < 2; ++bb)
#pragma unroll
                    for (int db = 0; db < 4; ++db) { const bf16x8 vf = *(const LAS bf16x8*)(F.lds + AT_CV + ((2 * g + bb) * 4 + db) * 1024 + lane * 16);
                        o[db] = __builtin_amdgcn_mfma_f32_16x16x32_bf16(vf, pf[bb], o[db], 0, 0, 0); }
            }
            __builtin_amdgcn_sched_barrier(0);
            {
                f32x4 s[4]; bf16x8 pf[2];
#pragma unroll
                for (int bb = 0; bb < 2; ++bb)
#pragma unroll
                    for (int tl = 0; tl < 2; ++tl) { f32x4 acc = (f32x4){0.f, 0.f, 0.f, 0.f};
                        acc = __builtin_amdgcn_mfma_f32_16x16x32_bf16(kw[g][bb][tl][0], qf0, acc, 0, 0, 0);
                        acc = __builtin_amdgcn_mfma_f32_16x16x32_bf16(kw[g][bb][tl][1], qf1, acc, 0, 0, 0);
#pragma unroll
                        for (int i = 0; i < 4; ++i) acc[i] += *(const LAS float*)(F.lds + boff[tl][i] + (2 * g + bb) * 128);
                        s[2 * bb + tl] = acc; }
                if (g < 3) { AT_LOADK(g + 1); }
                __builtin_amdgcn_sched_barrier(0);
                attn_softmax(s, mrun, lsum, o, pf);
#pragma unroll
                for (int bb = 0; bb < 2; ++bb)
#pragma unroll
                    for (int db = 0; db < 4; ++db) o[db] = __builtin_amdgcn_mfma_f32_16x16x32_bf16(vw[g][bb][db], pf[bb], o[db], 0, 0, 0);
                if (g < 3) { AT_LOADV(g + 1); }
                __builtin_amdgcn_sched_barrier(0);
            }
        }
#undef AT_LOADK
#undef AT_LOADV
        const float inv = 1.0f / xrow_sum(lsum);
        bf16* op = O + ((size_t)b * SEQ + r * GRIDW + qc) * D + h * HD + 4 * q4;
#pragma unroll
        for (int db = 0; db < 4; ++db) { v2u w; w.x = pg8::cvt_pk_bf16(o[db][0] * inv, o[db][1] * inv); w.y = pg8::cvt_pk_bf16(o[db][2] * inv, o[db][3] * inv); *(v2u*)(op + db * 16) = w; }
    }
    __syncthreads();
}

#ifndef MK_N_LAUNCHES
#define MK_N_LAUNCHES 1
#endif
constexpr int N_PHASES = 16;
constexpr int N_LAUNCHES = MK_N_LAUNCHES;
struct Args { const float* in[26]; float* out; unsigned char* ws; int ph_lo, ph_hi; };

__global__ void __launch_bounds__(NTHR, 2) fwd_kernel(Args args) {
    extern __shared__ __attribute__((aligned(16))) unsigned char lds[];
    Frame F;
    F.lds = (LAS unsigned char*)lds;
    F.MISC = (volatile LAS unsigned*)(F.lds + MISC_OFF);
    F.wave = __builtin_amdgcn_readfirstlane((int)threadIdx.x >> 6);
    F.G = gridDim.x; F.bid = blockIdx.x;
    F.ws = args.ws; F.ctl = (gu32*)(args.ws + WS_CTL); F.out = args.out;
    for (int u = threadIdx.x; u < 256; u += NTHR) F.MISC[u] = 0u;
    if (threadIdx.x < 26) { const unsigned long long pv = (unsigned long long)args.in[threadIdx.x]; volatile LAS unsigned* t = (volatile LAS unsigned*)(F.lds + PTAB_OFF) + 2 * threadIdx.x; t[0] = (unsigned)pv; t[1] = (unsigned)(pv >> 32); }
    __syncthreads();
    XcdBarrier bar; bar.bar = (unsigned*)(F.ctl + CW_BAR); bar.x = 0; bar.st = nullptr;
    if (N_LAUNCHES == 1) bar = xcd_barrier_post((unsigned*)(F.ctl + CW_BAR), F.MISC + 8);
    const int lo = args.ph_lo, hi = args.ph_hi;
#ifndef PHASE_MASK
#define PHASE_MASK 0xFFFF
#endif
#define IN(k) ((((PHASE_MASK) >> (k)) & 1) && lo <= (k) && (k) < hi)
#define SEAM(k) do { if (IN(k) && IN((k) + 1)) xcd_barrier(bar); } while (0)
    const char* wsb = (const char*)F.ws;
    LAS unsigned char* ring = F.lds;

    if (IN(0)) { _Pragma("unroll") for (int rep = 0; rep < REP(0); ++rep) { p0_prologue(F); __syncthreads(); } }
    SEAM(0);
    if (IN(1)) { _Pragma("unroll") for (int rep = 0; rep < REP(1); ++rep) p1_modulate(F); }
    SEAM(1);
    if (IN(2)) {
        pg8::DenseSched S{wsb + WS_A, wsb + WS_WIN, D, MT / 256, 8, F.G, F.bid};
        pg8::EpiGated<0> E{(bf16*)(F.ws + WS_B), D, F.in(11), D};
        _Pragma("unroll") for (int rep = 0; rep < REP(2); ++rep) pg8::gemm_phase<pg8::EpiGated<0>, pg8::DenseSched, true>(ring, D, S, E, F.wave);
    }
    SEAM(2);
    if (IN(3)) { _Pragma("unroll") for (int rep = 0; rep < REP(3); ++rep) p3_conv(F); }
    SEAM(3);
    if (IN(4)) {
        pg8::DenseSched S{wsb + WS_A, wsb + WS_WOUT, D, MT / 256, 4, F.G, F.bid};
        pg8::EpiBf16B E{(bf16*)(F.ws + WS_B), D, F.in(17)};
        _Pragma("unroll") for (int rep = 0; rep < REP(4); ++rep) pg8::gemm_phase<pg8::EpiBf16B, pg8::DenseSched, true>(ring, D, S, E, F.wave);
    }
    SEAM(4);
    if (IN(5)) p_emid<0>(F);
    SEAM(5);
    if (IN(6)) {
        moe_setup(F, 0); moe_stage_perm(F);
        pg8::MoeUpSched S; S.tpre = (const volatile LAS int*)(F.MISC + 16); S.G = F.G; S.c = F.bid; S.A = wsb + WS_A; S.Wgu = wsb + WS_WGU + (size_t)0 * 16 * 1024 * 1024; S.permL = (const LAS int*)(F.lds + PERML_OFF); S.kb = D;
        pg8::EpiGated<1> E{(bf16*)(F.ws + WS_C), DE, nullptr, 0};
        _Pragma("unroll") for (int rep = 0; rep < REP(6); ++rep) pg8::gemm_phase<pg8::EpiGated<1>, pg8::MoeUpSched, true, true>(ring, D / 2, S, E, F.wave);
    }
    SEAM(6);
    if (IN(7)) {
        moe_setup(F, 0);
        pg8::MoeDownSched S; S.tpre = (const volatile LAS int*)(F.MISC + 16); S.G = F.G; S.c = F.bid; S.A = wsb + WS_C; S.Wdn = wsb + WS_WDN + (size_t)0 * 16 * 1024 * 512 * 2; S.kb = DE * 2;
        pg8::EpiBf16 E{(bf16*)(F.ws + WS_D2), D, nullptr};
        _Pragma("unroll") for (int rep = 0; rep < REP(7); ++rep) pg8::gemm_phase<pg8::EpiBf16, pg8::MoeDownSched, true>(ring, DE, S, E, F.wave);
    }
    SEAM(7);
    if (IN(8)) { moe_setup(F, 0); p_epost<0>(F); }
    SEAM(8);
    if (IN(9)) {
        pg8::QkvSched S{wsb + WS_A, wsb + WS_WQKV, F.G, F.bid};
        pg8::EpiQkv E{(bf16*)F.out, (bf16*)(F.ws + WS_C), (bf16*)(F.ws + WS_D2), 0.125f * 1.4426950408889634f};
        _Pragma("unroll") for (int rep = 0; rep < REP(9); ++rep) pg8::gemm_phase<pg8::EpiQkv, pg8::QkvSched, true>(ring, D, S, E, F.wave);
    }
    SEAM(9);
    if (IN(10)) { _Pragma("unroll") for (int rep = 0; rep < REP(10); ++rep) p10_attn(F); }
    SEAM(10);
    if (IN(11)) {
        pg8::DenseSched S{wsb + WS_A, wsb + WS_WO, D, NLAT / 256, 4, F.G, F.bid};
        pg8::EpiBf16 E{(bf16*)(F.ws + WS_C), D, nullptr};
        _Pragma("unroll") for (int rep = 0; rep < REP(11); ++rep) pg8::gemm_phase<pg8::EpiBf16, pg8::DenseSched, true>(ring, D, S, E, F.wave);
    }
    SEAM(11);
    if (IN(12)) p_emid<1>(F);
    SEAM(12);
    if (IN(13)) {
        moe_setup(F, 1); moe_stage_perm(F);
        pg8::MoeUpSched S; S.tpre = (const volatile LAS int*)(F.MISC + 16); S.G = F.G; S.c = F.bid; S.A = wsb + WS_A; S.Wgu = wsb + WS_WGU + (size_t)1 * 16 * 1024 * 1024; S.permL = (const LAS int*)(F.lds + PERML_OFF); S.kb = D;
        pg8::EpiGated<1> E{(bf16*)(F.ws + WS_C), DE, nullptr, 0};
        _Pragma("unroll") for (int rep = 0; rep < REP(13); ++rep) pg8::gemm_phase<pg8::EpiGated<1>, pg8::MoeUpSched, true, true>(ring, D / 2, S, E, F.wave);
    }
    SEAM(13);
    if (IN(14)) {
        moe_setup(F, 1);
        pg8::MoeDownSched S; S.tpre = (const volatile LAS int*)(F.MISC + 16); S.G = F.G; S.c = F.bid; S.A = wsb + WS_C; S.Wdn = wsb + WS_WDN + (size_t)1 * 16 * 1024 * 512 * 2; S.kb = DE * 2;
        pg8::EpiBf16 E{(bf16*)(F.ws + WS_D2), D, nullptr};
        _Pragma("unroll") for (int rep = 0; rep < REP(14); ++rep) pg8::gemm_phase<pg8::EpiBf16, pg8::MoeDownSched, true>(ring, DE, S, E, F.wave);
    }
    SEAM(14);
    if (IN(15)) { moe_setup(F, 1); p_epost<1>(F); }
#undef IN
#undef SEAM
}

extern "C" void kernel_launch(void* const* d_in, const int* in_sizes, int n_in, void* d_out, int out_size, void* d_ws, size_t ws_size, hipStream_t stream) {
    static int grid = 0;
    if (grid == 0) {
        if (n_in != 26 || in_sizes[0] != NLAT * D || out_size != NLAT * D || ws_size < WS_END) { fprintf(stderr, "kernel_launch: unexpected shapes (n_in %d, in0 %d, out %d, ws %zu); nothing launched\n", n_in, n_in > 0 ? in_sizes[0] : -1, out_size, ws_size); grid = -1; return; }
        if (hipFuncSetAttribute((const void*)fwd_kernel, hipFuncAttributeMaxDynamicSharedMemorySize, LDS_BYTES) != hipSuccess) { fprintf(stderr, "kernel_launch: hipFuncSetAttribute failed\n"); grid = -1; return; }
        int per_cu = 0;
        if (hipOccupancyMaxActiveBlocksPerMultiprocessor(&per_cu, (const void*)fwd_kernel, NTHR, LDS_BYTES) != hipSuccess || per_cu < 1) fprintf(stderr, "kernel_launch: note: occupancy query reports %d workgroups per CU\n", per_cu);
        (void)hipGetLastError();
        grid = 256;
    }
    if (grid < 0) return;
    if (hipMemsetAsync((char*)d_ws + WS_CTL, 0, CTL_ZERO_BYTES, stream) != hipSuccess) { fprintf(stderr, "kernel_launch: hipMemsetAsync failed\n"); return; }
    Args a{};
    for (int i = 0; i < 26; ++i) a.in[i] = (const float*)d_in[i];
    a.out = (float*)d_out; a.ws = (unsigned char*)d_ws;
    for (int li = 0; li < N_LAUNCHES; ++li) {
        a.ph_lo = (N_LAUNCHES == 1) ? 0 : li; a.ph_hi = (N_LAUNCHES == 1) ? N_PHASES : li + 1;
        hipLaunchKernelGGL(fwd_kernel, dim3(grid), dim3(NTHR), LDS_BYTES, stream, a);
        const hipError_t le = hipPeekAtLastError();
        if (le != hipSuccess) { fprintf(stderr, "kernel_launch: launch %d failed: %s\n", li, hipGetErrorName(le)); break; }
    }
}
```

```cpp
#include <hip/hip_runtime.h>
#include <cstdio>
#include <cstdint>

#ifndef PROBE_MASK
#define PROBE_MASK 0
#endif
#define REP(k) ((((PROBE_MASK) >> (k)) & 1) ? 2 : 1)
#ifndef DBG_SLOT
#define DBG_SLOT 0
#endif
#ifndef DBG_SKIP
#define DBG_SKIP 0
#endif
constexpr int D = 1024, BATCH = 8, SEQ = 4096, CTXL = 256;
constexpr int NLAT = BATCH * SEQ, NCTX = BATCH * CTXL, MT = NLAT + NCTX;
constexpr int NE = 16, DE = 512, NH = 16, HD = 64, GRIDW = 64, GROWS = 64, WINH = 8, WINW = 16, CONVW = 31;
constexpr int KSLOT = SEQ + CTXL;
constexpr int NMODR = 9, NMODC = 6 * D;
constexpr int MODKC = 8;
constexpr float EPS = 1e-6f;
constexpr int NWAVES = 8, NTHR = NWAVES * 64;

constexpr size_t MiB = 1u << 20;
constexpr size_t WS_CTL = 0, CTL_ZERO_BYTES = 1 * MiB;
constexpr size_t WS_SLOT = 1 * MiB;
constexpr size_t WS_PERM = 2 * MiB;
constexpr size_t WS_MODP = 5 * MiB;
constexpr size_t WS_XC = 9 * MiB;
constexpr size_t WS_WIN = 18 * MiB, WS_WOUT = 22 * MiB, WS_WQKV = 24 * MiB, WS_WO = 30 * MiB;
constexpr size_t WS_WGU = 32 * MiB;
constexpr size_t WS_WDN = 96 * MiB;
constexpr size_t WS_A = 128 * MiB, WS_B = 196 * MiB, WS_C = 264 * MiB, WS_D2 = 336 * MiB, WS_END = 480 * MiB;
constexpr int CW_BAR = 4096;
constexpr int CW_CNT = 8192;

constexpr int RING_BYTES = 131072;
constexpr int MISC_OFF = RING_BYTES;
constexpr int PTAB_OFF = RING_BYTES + 1024 + 8192;
constexpr int PERML_OFF = RING_BYTES + 1024;
constexpr int LDS_BYTES = 147456;

#define GAS __attribute__((address_space(1)))
#define LAS __attribute__((address_space(3)))
typedef unsigned short bf16;
typedef unsigned v4u __attribute__((ext_vector_type(4)));
typedef unsigned v2u __attribute__((ext_vector_type(2)));
typedef float f32x4 __attribute__((ext_vector_type(4)));
typedef float f32x2 __attribute__((ext_vector_type(2)));
typedef short bf16x8 __attribute__((ext_vector_type(8)));
typedef GAS unsigned gu32;
#define RLX_AGENT __ATOMIC_RELAXED, __HIP_MEMORY_SCOPE_AGENT
#define LDS_WAIT() asm volatile("s_waitcnt lgkmcnt(0)" ::: "memory")
#define VM_WAIT() asm volatile("s_waitcnt vmcnt(0)" ::: "memory")

__device__ __forceinline__ unsigned f2bf(float f) { unsigned u = __builtin_bit_cast(unsigned, f); return (u + 0x7fffu + ((u >> 16) & 1u)) >> 16; }
__device__ __forceinline__ unsigned pk2(float lo, float hi) { return f2bf(lo) | (f2bf(hi) << 16); }
__device__ __forceinline__ unsigned pk4_fp8(float a, float b, float c, float d) { int p = __builtin_amdgcn_cvt_pk_fp8_f32(a, b, 0, false); p = __builtin_amdgcn_cvt_pk_fp8_f32(c, d, p, true); return (unsigned)p; }
__device__ __forceinline__ float bflo(unsigned w) { return __builtin_bit_cast(float, w << 16); }
__device__ __forceinline__ float bfhi(unsigned w) { return __builtin_bit_cast(float, w & 0xffff0000u); }
__device__ __forceinline__ float row16_sum(float v) {
    v += __builtin_bit_cast(float, __builtin_amdgcn_update_dpp(0, __builtin_bit_cast(int, v), 0xB1, 0xF, 0xF, false));
    v += __builtin_bit_cast(float, __builtin_amdgcn_update_dpp(0, __builtin_bit_cast(int, v), 0x4E, 0xF, 0xF, false));
    v += __builtin_bit_cast(float, __builtin_amdgcn_update_dpp(0, __builtin_bit_cast(int, v), 0x141, 0xF, 0xF, false));
    v += __builtin_bit_cast(float, __builtin_amdgcn_update_dpp(0, __builtin_bit_cast(int, v), 0x140, 0xF, 0xF, false));
    return v;
}
__device__ __forceinline__ float rdlane(float v, int l) { return __builtin_bit_cast(float, __builtin_amdgcn_readlane(__builtin_bit_cast(int, v), l)); }
__device__ __forceinline__ float wave_sum(float v) {
    v = row16_sum(v);
    return (rdlane(v, 0) + rdlane(v, 16)) + (rdlane(v, 32) + rdlane(v, 48));
}
__device__ __forceinline__ int lane_id_asm() { int l; asm volatile("v_mbcnt_lo_u32_b32 %0, -1, 0\n\tv_mbcnt_hi_u32_b32 %0, -1, %0" : "=v"(l)); return l; }
__device__ __forceinline__ float fast_sigmoid(float x) { return __builtin_amdgcn_rcpf(1.0f + __builtin_amdgcn_exp2f(-1.4426950408889634f * x)); }

namespace pg8 {
#define PG8_LAS __attribute__((address_space(3)))
typedef unsigned short bf16_t;
typedef short bf16x8 __attribute__((ext_vector_type(8)));
typedef float f32x4 __attribute__((ext_vector_type(4)));
typedef unsigned u32x4 __attribute__((ext_vector_type(4)));
constexpr int BM = 256, BK = 64, HALF = 128, HTB = HALF * BK * 2, STAGE_BYTES = 8 * HTB, NXCD = 8, WGM = 8;

__host__ __device__ __forceinline__ int lds_byte(int r, int c) { const int st = (r >> 4) * 2 + (c >> 5), rr = r & 15, cc = c & 31, ob = rr * 64 + cc * 2; return st * 1024 + (ob ^ (((ob >> 9) & 1) << 5)); }
__host__ __device__ __forceinline__ void stage_rc(int b, int& R, int& C) { const int st = b / 1024, sb = b % 1024, swz = sb ^ (((sb >> 9) & 1) << 5); R = (st >> 1) * 16 + swz / 64; C = (st & 1) * 32 + (swz % 64) / 2; }
__host__ __device__ __forceinline__ int perm32(int rho) { const int n = rho >> 4, i = rho & 15; return 8 * (i >> 2) + 4 * n + (i & 3); }

struct Unit { int pm, pn; const char* a; const char* b; int li; int ex; };

__device__ __forceinline__ bool static_order(int L, int nM, int nN, int& pm, int& pn) {
    const int nwg = nM * nN; if (L >= nwg) return false;
    int wgid = L; { const int q = nwg / NXCD, r = nwg % NXCD, xcd = wgid % NXCD, off = wgid / NXCD; wgid = (xcd < r ? xcd * (q + 1) : r * (q + 1) + (xcd - r) * q) + off; }
    const int nig = WGM * nN, gid = wgid / nig, fm = gid * WGM, gsz = (nM - fm) < WGM ? (nM - fm) : WGM;
    pm = fm + ((wgid % nig) % gsz); pn = (wgid % nig) / gsz; return true;
}

typedef float cvt_f32x2_t __attribute__((ext_vector_type(2))); typedef __bf16 cvt_bf16x2_t __attribute__((ext_vector_type(2)));
__device__ __forceinline__ unsigned cvt_pk_bf16(float lo, float hi) { const cvt_f32x2_t v = {lo, hi}; const cvt_bf16x2_t b = __builtin_convertvector(v, cvt_bf16x2_t); return __builtin_bit_cast(unsigned, b); }

typedef int v8i_t __attribute__((ext_vector_type(8)));
typedef int v4i_t __attribute__((ext_vector_type(4)));
template <class Epi, class Sched, bool ALIGN_EPI, bool FP8 = false>
__device__ __forceinline__ void gemm_phase(PG8_LAS unsigned char* lds, const int K_, const Sched& S, const Epi& E, const int wid) {
    int K = K_; asm volatile("" : "+s"(K));
    const int lane = lane_id_asm(), tid = wid * 64 + lane, wr = wid >> 2, wc = wid & 3, fr = lane & 15, fq = lane >> 4;
    const int nt = K / BK;
    int R[2], C[2]; unsigned voffB[2], vA[2][2];
    const size_t kstep = (size_t)(BK * 2);
    const size_t hstep = (size_t)HALF * K * 2;
#pragma unroll
    for (int i = 0; i < 2; ++i) { stage_rc(tid * 16 + i * 8192, R[i], C[i]); const int Rb = Epi::PERM ? ((R[i] & ~31) + perm32(R[i] & 31)) : R[i];
        voffB[i] = (unsigned)(Rb * K + C[i]) * 2u; vA[0][i] = (unsigned)(R[i] * K + C[i]) * 2u; vA[1][i] = vA[0][i] + (unsigned)hstep; }
    const unsigned ldsw = (unsigned)wid * 1024u;
    const int aoff = lds_byte(wr * 64 + fr, fq * 8), boff = lds_byte(wc * 32 + fr, fq * 8);
#define PG8_SA(b, h) (((b) * 2 + (h)) * HTB)
#define PG8_SB(b, h) ((4 + (b) * 2 + (h)) * HTB)
#define PG8_STAGE(bufoff, gbase, voff) do { _Pragma("unroll") for (int _i = 0; _i < 2; ++_i) \
        __builtin_amdgcn_global_load_lds((const unsigned*)((const char*)(gbase) + (voff)[_i]), (PG8_LAS unsigned*)(lds + (bufoff) + ldsw + _i * 8192), 16, 0, 0); } while (0)
#define PG8_LD8(addr) __builtin_shufflevector(*(const PG8_LAS v4i_t*)(addr), *(const PG8_LAS v4i_t*)((addr) + 1024), 0, 1, 2, 3, 4, 5, 6, 7)
#define PG8_LDA(dst, b, h) do { _Pragma("unroll") for (int m = 0; m < 4; ++m) dst[m] = PG8_LD8(lds + PG8_SA(b, h) + aoff + m * 2048); } while (0)
#define PG8_LDB(dst, b, h) do { _Pragma("unroll") for (int n = 0; n < 2; ++n) dst[n] = PG8_LD8(lds + PG8_SB(b, h) + boff + n * 2048); } while (0)
#define PG8_LO(x) __builtin_bit_cast(bf16x8, __builtin_shufflevector((x), (x), 0, 1, 2, 3))
#define PG8_HI(x) __builtin_bit_cast(bf16x8, __builtin_shufflevector((x), (x), 4, 5, 6, 7))
#define PG8_MMA(ai, bj, At, Bt) do { __builtin_amdgcn_s_setprio(1); _Pragma("unroll") for (int m = 0; m < 4; ++m) _Pragma("unroll") for (int n = 0; n < 2; ++n) { \
        if constexpr (FP8) asm volatile("v_mfma_scale_f32_16x16x128_f8f6f4 %0, %1, %2, %0, %3, %4 op_sel_hi:[0,0,0]" : "+v"(acc[ai][bj][m][n]) : "v"(Bt[n]), "v"(At[m]), "v"(wscale_r), "v"(ascale_r)); \
        else { acc[ai][bj][m][n] = __builtin_amdgcn_mfma_f32_16x16x32_bf16(PG8_LO(Bt[n]), PG8_LO(At[m]), acc[ai][bj][m][n], 0, 0, 0); \
               acc[ai][bj][m][n] = __builtin_amdgcn_mfma_f32_16x16x32_bf16(PG8_HI(Bt[n]), PG8_HI(At[m]), acc[ai][bj][m][n], 0, 0, 0); } } __builtin_amdgcn_s_setprio(0); } while (0)
#define PG8_WAIT_V(n) asm volatile("s_waitcnt vmcnt(" #n ")" ::: "memory")
#define PG8_WAIT_L(n) asm volatile("s_waitcnt lgkmcnt(" #n ")" ::: "memory")
#define PG8_BAR __builtin_amdgcn_s_barrier()
#define PG8_SCHED __builtin_amdgcn_sched_barrier(0)
    Unit cur, nxt; int ui = 0;
    if (!S.next(0, cur)) return;
    if constexpr (Sched::GATHER) S.a_offsets(cur, R, C, K, vA);
    f32x4 acc[2][2][4][2];
#pragma unroll
    for (int a = 0; a < 2; ++a)
#pragma unroll
        for (int b = 0; b < 2; ++b)
#pragma unroll
            for (int m = 0; m < 4; ++m)
#pragma unroll
                for (int n = 0; n < 2; ++n) acc[a][b][m][n] = (f32x4){0.f, 0.f, 0.f, 0.f};
    int wscale_r = 0x79797979, ascale_r = 0x7f7f7f7f;
    asm volatile("" : "+v"(wscale_r), "+v"(ascale_r));
    v8i_t At[4], B0[2], B1[2];
    const char* cA = cur.a; const char* cB = cur.b;
    PG8_STAGE(PG8_SB(0, 0), cB, voffB); PG8_STAGE(PG8_SB(0, 1), cB + hstep, voffB); PG8_STAGE(PG8_SA(0, 0), cA, vA[0]); PG8_STAGE(PG8_SA(0, 1), cA, vA[1]);
    if (wr == 1) PG8_BAR;
    PG8_WAIT_V(2); PG8_BAR;
    PG8_STAGE(PG8_SB(1, 0), cB + kstep, voffB); PG8_STAGE(PG8_SA(1, 0), cA + kstep, vA[0]); PG8_STAGE(PG8_SB(1, 1), cB + hstep + kstep, voffB);
    PG8_WAIT_V(6); PG8_BAR;
    for (;;) {
        const bool has_next = S.next(ui + 1, nxt);
        const char* nA = has_next ? nxt.a : cA; const char* nB = has_next ? nxt.b : cB;
#pragma unroll 1
        for (int t = 0; t < nt; t += 2) {
            const bool last = (t == nt - 2);
            const char* a1 = cA + (size_t)(t + 1) * kstep;
            const char* a2 = last ? nA : cA + (size_t)(t + 2) * kstep; const char* b2 = last ? nB : cB + (size_t)(t + 2) * kstep;
            const char* a3 = a2 + kstep; const char* b3 = b2 + kstep;
            PG8_LDB(B0, 0, 0); PG8_LDB(B1, 0, 1); PG8_SCHED; PG8_LDA(At, 0, 0); PG8_STAGE(PG8_SA(1, 1), a1, vA[1]);
            if constexpr (Sched::GATHER) { if (last && has_next) S.a_offsets(nxt, R, C, K, vA); }
            PG8_WAIT_V(8); PG8_WAIT_L(0); PG8_BAR; PG8_MMA(0, 0, At, B0); PG8_MMA(0, 1, At, B1); PG8_BAR; PG8_SCHED;
            PG8_LDA(At, 0, 1); PG8_STAGE(PG8_SB(0, 0), b2, voffB); PG8_STAGE(PG8_SB(0, 1), b2 + hstep, voffB); PG8_STAGE(PG8_SA(0, 0), a2, vA[0]);
            PG8_WAIT_V(8); PG8_WAIT_L(0); PG8_BAR; PG8_MMA(1, 0, At, B0); PG8_MMA(1, 1, At, B1); PG8_BAR; PG8_SCHED;
            PG8_LDB(B0, 1, 0); PG8_LDB(B1, 1, 1); PG8_SCHED; PG8_LDA(At, 1, 0); PG8_STAGE(PG8_SA(0, 1), a2, vA[1]);
            PG8_WAIT_V(8); PG8_WAIT_L(0); PG8_BAR; PG8_MMA(0, 0, At, B0); PG8_MMA(0, 1, At, B1); PG8_BAR; PG8_SCHED;
            PG8_LDA(At, 1, 1); PG8_STAGE(PG8_SB(1, 0), b3, voffB); PG8_STAGE(PG8_SB(1, 1), b3 + hstep, voffB); PG8_STAGE(PG8_SA(1, 0), a3, vA[0]);
            PG8_WAIT_V(8); PG8_WAIT_L(0); PG8_BAR; PG8_MMA(1, 0, At, B0); PG8_MMA(1, 1, At, B1); PG8_BAR; PG8_SCHED;
        }
        if constexpr (ALIGN_EPI) { if (wr == 0) PG8_BAR; }
        if constexpr (FP8) asm volatile("s_nop 15\n\ts_nop 7" ::: "memory");
        E(acc, cur, wr, wc, fr, fq);
        if (!has_next) break;
#pragma unroll
        for (int a = 0; a < 2; ++a)
#pragma unroll
            for (int b = 0; b < 2; ++b)
#pragma unroll
                for (int m = 0; m < 4; ++m)
#pragma unroll
                    for (int n = 0; n < 2; ++n) acc[a][b][m][n] = (f32x4){0.f, 0.f, 0.f, 0.f};
        cur = nxt; cA = nA; cB = nB; ++ui;
        if constexpr (ALIGN_EPI) { if (wr == 1) PG8_BAR; }
    }
    PG8_WAIT_V(0);
    if constexpr (!ALIGN_EPI) { if (wr == 0) PG8_BAR; }
    PG8_BAR;
#undef PG8_SA
#undef PG8_SB
#undef PG8_STAGE
#undef PG8_LDA
#undef PG8_LDB
#undef PG8_MMA
#undef PG8_LO
#undef PG8_HI
#undef PG8_LD8
#undef PG8_WAIT_V
#undef PG8_WAIT_L
#undef PG8_BAR
#undef PG8_SCHED
}

struct DenseSched {
    static constexpr bool GATHER = false;
    const char* A; const char* Bt; int K, nM, nN, G, c;
    __device__ __forceinline__ bool next(int i, Unit& u) const {
        int pm, pn; if (!static_order(i * G + c, nM, nN, pm, pn)) return false;
        u.pm = pm; u.pn = pn; u.a = A + (size_t)pm * BM * K * 2; u.b = Bt + (size_t)pn * BM * K * 2; u.li = i; u.ex = 0; return true;
    }
    __device__ __forceinline__ void a_offsets(const Unit&, const int (&)[2], const int (&)[2], int, unsigned (&)[2][2]) const {}
};
struct QkvSched {
    static constexpr bool GATHER = false;
    const char* A; const char* Bt; int G, c, kb;
    __device__ __forceinline__ bool next(int i, Unit& u) const {
        const int L = i * G + c; int pm, pn;
        if (L < 1536) { static_order(L, 128, 12, pm, pn); }
        else { const int l2 = L - 1536; if (l2 >= 64) return false; pm = 128 + (l2 >> 3); pn = 4 + (l2 & 7); }
        u.pm = pm; u.pn = pn; u.a = A + (size_t)pm * BM * kb; u.b = Bt + (size_t)pn * BM * kb; u.li = i; u.ex = 0; return true;
    }
    __device__ __forceinline__ void a_offsets(const Unit&, const int (&)[2], const int (&)[2], int, unsigned (&)[2][2]) const {}
};
struct MoeSchedBase {
    const volatile PG8_LAS int* tpre;
    int G, c;
    __device__ __forceinline__ bool locate(int i, int& rt, int& pn, int& e) const {
        const int L = i * G + c; const int ntile = tpre[16];
        if (L >= 4 * ntile) return false;
        rt = L >> 2; pn = L & 3; int ee = 0;
#pragma unroll
        for (int j = 1; j < 16; ++j) ee += (rt >= tpre[j]) ? 1 : 0;
        e = ee; return true;
    }
};
struct MoeUpSched : MoeSchedBase {
    static constexpr bool GATHER = true;
    const char* A; const char* Wgu; const PG8_LAS int* permL; int kb;
    __device__ __forceinline__ bool next(int i, Unit& u) const {
        int rt, pn, e; if (!locate(i, rt, pn, e)) return false;
        u.pm = rt; u.pn = pn; u.a = A; u.b = Wgu + (size_t)e * 1024 * kb + (size_t)pn * BM * kb; u.li = i; u.ex = e; return true;
    }
    __device__ __forceinline__ void a_offsets(const Unit& u, const int (&R)[2], const int (&C)[2], int K, unsigned (&vA)[2][2]) const {
#pragma unroll
        for (int h = 0; h < 2; ++h)
#pragma unroll
            for (int i = 0; i < 2; ++i) vA[h][i] = (unsigned)permL[u.li * 256 + h * HALF + R[i]] * (unsigned)(K * 2) + (unsigned)(C[i] * 2);
    }
};
struct MoeDownSched : MoeSchedBase {
    static constexpr bool GATHER = false;
    const char* A; const char* Wdn; int kb;
    __device__ __forceinline__ bool next(int i, Unit& u) const {
        int rt, pn, e; if (!locate(i, rt, pn, e)) return false;
        u.pm = rt; u.pn = pn; u.a = A + (size_t)rt * BM * kb; u.b = Wdn + (size_t)e * 1024 * kb + (size_t)pn * BM * kb; u.li = i; u.ex = e; return true;
    }
    __device__ __forceinline__ void a_offsets(const Unit&, const int (&)[2], const int (&)[2], int, unsigned (&)[2][2]) const {}
};

template <bool HAS_BIAS> struct EpiBf16T {
    static constexpr bool PERM = true;
    bf16_t* O; int ldc; const float* bias;
    __device__ __forceinline__ void operator()(const f32x4 (&acc)[2][2][4][2], const Unit& u, int wr, int wc, int fr, int fq) const {
        const int row0 = u.pm * BM + wr * 64 + fr, col0 = u.pn * BM + wc * 32 + 8 * fq;
        f32x4 bv[2][2];
#pragma unroll
        for (int bj = 0; bj < 2; ++bj)
#pragma unroll
            for (int n = 0; n < 2; ++n) bv[bj][n] = HAS_BIAS ? *(const f32x4*)(bias + col0 + bj * HALF + 4 * n) : (f32x4){0.f, 0.f, 0.f, 0.f};
#pragma unroll
        for (int ai = 0; ai < 2; ++ai)
#pragma unroll
            for (int m = 0; m < 4; ++m) { bf16_t* rowp = O + (size_t)(row0 + ai * HALF + m * 16) * ldc + col0;
#pragma unroll
                for (int bj = 0; bj < 2; ++bj) { f32x4 v0 = acc[ai][bj][m][0], v1 = acc[ai][bj][m][1]; if constexpr (HAS_BIAS) { v0 += bv[bj][0]; v1 += bv[bj][1]; }
                    u32x4 w; w.x = cvt_pk_bf16(v0[0], v0[1]); w.y = cvt_pk_bf16(v0[2], v0[3]); w.z = cvt_pk_bf16(v1[0], v1[1]); w.w = cvt_pk_bf16(v1[2], v1[3]);
                    *(u32x4*)(rowp + bj * HALF) = w; } }
    }
};
typedef EpiBf16T<true> EpiBf16B; typedef EpiBf16T<false> EpiBf16;
template <int MODE  , bool OUT8 = false  > struct EpiGated {
    static constexpr bool PERM = true;
    bf16_t* O; int ldc; const float* bias; int nch;
    __device__ __forceinline__ void operator()(const f32x4 (&acc)[2][2][4][2], const Unit& u, int wr, int wc, int fr, int fq) const {
        const int row0 = u.pm * BM + wr * 64 + fr, ch0 = u.pn * HALF + wc * 32 + 8 * fq;
        f32x4 b0[2], b1[2];
#pragma unroll
        for (int n = 0; n < 2; ++n) { if (MODE == 0) { b0[n] = *(const f32x4*)(bias + ch0 + 4 * n); b1[n] = *(const f32x4*)(bias + nch + ch0 + 4 * n); } else { b0[n] = (f32x4){0.f, 0.f, 0.f, 0.f}; b1[n] = b0[n]; } }
#pragma unroll
        for (int ai = 0; ai < 2; ++ai)
#pragma unroll
            for (int m = 0; m < 4; ++m) { bf16_t* rowp = O + (size_t)(row0 + ai * HALF + m * 16) * ldc + ch0; float o[8];
#pragma unroll
                for (int n = 0; n < 2; ++n) { const f32x4 x0 = acc[ai][0][m][n] + b0[n], x1 = acc[ai][1][m][n] + b1[n];
#pragma unroll
                    for (int e = 0; e < 4; ++e) o[4 * n + e] = (MODE == 0) ? x0[e] * fast_sigmoid(x1[e]) : (x0[e] * fast_sigmoid(x0[e])) * x1[e]; }
                if constexpr (OUT8) { unsigned char* rp8 = (unsigned char*)O + (size_t)(row0 + ai * HALF + m * 16) * ldc + ch0;
                    *(unsigned long long*)rp8 = (unsigned long long)pk4_fp8(o[0], o[1], o[2], o[3]) | ((unsigned long long)pk4_fp8(o[4], o[5], o[6], o[7]) << 32); }
                else { u32x4 w; w.x = cvt_pk_bf16(o[0], o[1]); w.y = cvt_pk_bf16(o[2], o[3]); w.z = cvt_pk_bf16(o[4], o[5]); w.w = cvt_pk_bf16(o[6], o[7]);
                    *(u32x4*)rowp = w; } }
    }
};
struct EpiQkv {
    static constexpr bool PERM = true;
    bf16_t* Q; bf16_t* Kh; bf16_t* Vb; float qscale;
    __device__ __forceinline__ void operator()(const f32x4 (&acc)[2][2][4][2], const Unit& u, int wr, int wc, int fr, int fq) const {
        const int which = u.pn >> 2; const bool isctx = u.pm >= 128;
        const int b = isctx ? (u.pm - 128) : (u.pm >> 4);
        const int key0 = isctx ? SEQ : ((u.pm & 15) << 8);
        const int d0 = 32 * (wc & 1) + 8 * fq;
#pragma unroll
        for (int ai = 0; ai < 2; ++ai)
#pragma unroll
            for (int m = 0; m < 4; ++m) { const int key = key0 + ai * HALF + wr * 64 + m * 16 + fr;
#pragma unroll
                for (int bj = 0; bj < 2; ++bj) { const int h = 4 * (u.pn & 3) + 2 * bj + (wc >> 1); const f32x4 v0 = acc[ai][bj][m][0], v1 = acc[ai][bj][m][1];
                    if (which == 2) {
                        bf16_t* p = Vb + ((size_t)(b * NH + h) * (KSLOT / 8) + (key >> 3)) * 512 + (size_t)d0 * 8 + (key & 7);
                        const unsigned w0 = cvt_pk_bf16(v0[0], v0[1]), w1 = cvt_pk_bf16(v0[2], v0[3]), w2 = cvt_pk_bf16(v1[0], v1[1]), w3 = cvt_pk_bf16(v1[2], v1[3]);
                        p[0] = (bf16_t)w0; p[8] = (bf16_t)(w0 >> 16); p[16] = (bf16_t)w1; p[24] = (bf16_t)(w1 >> 16); p[32] = (bf16_t)w2; p[40] = (bf16_t)(w2 >> 16); p[48] = (bf16_t)w3; p[56] = (bf16_t)(w3 >> 16);
                    } else {
                        const float qs = (which == 0) ? qscale : 1.0f; const f32x4 y0 = v0 * qs, y1 = v1 * qs;
                        u32x4 w; w.x = cvt_pk_bf16(y0[0], y0[1]); w.y = cvt_pk_bf16(y0[2], y0[3]); w.z = cvt_pk_bf16(y1[0], y1[1]); w.w = cvt_pk_bf16(y1[2], y1[3]);
                        bf16_t* p = (which == 0) ? Q + ((size_t)(b * NH + h) * SEQ + key) * HD + d0 : Kh + ((size_t)(b * NH + h) * KSLOT + key) * HD + d0;
                        *(u32x4*)p = w;
                    } } }
    }
};
}
#define XB_TMO      128
#define XB_XCNT(j)  (256  + 64 * (j))
#define XB_XSUB(j)  (1280 + 64 * (j))
#define XB_XGEN(j)  (2304 + 64 * (j))
#define XB_TOP      3328
#define XB_TOPGEN   3392
#define XCD_BAR_WORDS 3456
#define XB_SPIN_CAP (1u << 18)

__device__ __forceinline__ unsigned xb_ld(unsigned* p)              { return __hip_atomic_load(p, __ATOMIC_RELAXED, __HIP_MEMORY_SCOPE_AGENT); }
__device__ __forceinline__ unsigned xb_add(unsigned* p, unsigned v) { return __hip_atomic_fetch_add(p, v, __ATOMIC_RELAXED, __HIP_MEMORY_SCOPE_AGENT); }
__device__ __forceinline__ unsigned xb_xcc_id() { return (unsigned)__builtin_amdgcn_s_getreg((3 << 11) | 20) & 0xFu; }
#define XB_SPIN(cond, bar) do { unsigned _sp = 0; while (cond) { __builtin_amdgcn_s_sleep(1); \
    if ((++_sp & 255u) == 0u) { if (xb_ld(&(bar)[XB_TMO])) break; if (_sp > XB_SPIN_CAP) { atomicAdd(&(bar)[XB_TMO], 1u); break; } } } } while (0)

struct XcdBarrier {
    unsigned* bar; unsigned x;
    volatile LAS unsigned* st;
};

__device__ __forceinline__ XcdBarrier xcd_barrier_post(unsigned* bar, volatile LAS unsigned* st) {
    XcdBarrier b; b.bar = bar; b.x = xb_xcc_id(); b.st = st;
    if (threadIdx.x == 0) (void)xb_add(&bar[XB_XCNT(b.x)], 1u);
    return b;
}
__device__ __forceinline__ void xcd_barrier_complete(unsigned* bar, unsigned x, unsigned& nloc, unsigned& nx) {
    const unsigned G = gridDim.x * gridDim.y * gridDim.z;
    unsigned sum, cnt, mine, sp = 0u;
    for (;;) {
        sum = 0u; cnt = 0u; mine = 0u;
#pragma unroll
        for (unsigned j = 0; j < 16; ++j) { const unsigned c = xb_ld(&bar[XB_XCNT(j)]); sum += c; cnt += (c > 0u) ? 1u : 0u; mine = (j == x) ? c : mine; }
        if (sum == G) break;
        __builtin_amdgcn_s_sleep(1);
        if ((++sp & 255u) == 0u) { if (xb_ld(&bar[XB_TMO])) break; if (sp > XB_SPIN_CAP) { atomicAdd(&bar[XB_TMO], 1u); break; } }
    }
    nloc = mine > 0u ? mine : 1u; nx = cnt > 0u ? cnt : 1u;
}

__device__ __forceinline__ void xcd_barrier(const XcdBarrier& b) {
    asm volatile("s_waitcnt vmcnt(0)" ::: "memory");
    __syncthreads();
    if (threadIdx.x == 0) {
        unsigned* bar = b.bar;
        __builtin_amdgcn_s_waitcnt(0);
        unsigned nloc = b.st[0], nx = b.st[1];
        if (nloc == 0u) { xcd_barrier_complete(bar, b.x, nloc, nx); b.st[0] = nloc; b.st[1] = nx; }
        const unsigned old = xb_add(&bar[XB_XSUB(b.x)], 1u);
        const unsigned gen = old / nloc;
        if (old + 1u == (gen + 1u) * nloc) {
            __builtin_amdgcn_fence(__ATOMIC_RELEASE, "agent");
            asm volatile("s_waitcnt vmcnt(0)" ::: "memory");
            const unsigned og = xb_add(&bar[XB_TOP], 1u);
            const unsigned tg = og / nx;
            if (og + 1u == (tg + 1u) * nx) xb_add(&bar[XB_TOPGEN], 1u);
            else XB_SPIN(xb_ld(&bar[XB_TOPGEN]) == tg, bar);
            __builtin_amdgcn_fence(__ATOMIC_ACQUIRE, "agent");
            xb_add(&bar[XB_XGEN(b.x)], 1u);
            asm volatile("s_waitcnt vmcnt(0)" ::: "memory");
        } else {
            XB_SPIN(xb_ld(&bar[XB_XGEN(b.x)]) == gen, bar);
            __builtin_amdgcn_fence(__ATOMIC_ACQUIRE, "agent");
            asm volatile("s_waitcnt vmcnt(0)" ::: "memory");
        }
    }
    __syncthreads();
}

struct Frame {
    LAS unsigned char* lds;
    volatile LAS unsigned* MISC;
    gu32* ctl;
    int wave, G, bid;
    __device__ __forceinline__ const float* in(int k) const { const volatile LAS unsigned* t = (const volatile LAS unsigned*)(lds + PTAB_OFF) + 2 * k;
        const unsigned lo = __builtin_amdgcn_readfirstlane(t[0]), hi = __builtin_amdgcn_readfirstlane(t[1]); return (const float*)(const GAS float*)(((unsigned long long)hi << 32) | lo); }
    __device__ __forceinline__ int lane() const { return lane_id_asm(); }
    __device__ __forceinline__ int tid() const { return wave * 64 + lane_id_asm(); }
    unsigned char* ws;
    float* out;
};

__device__ __forceinline__ void ld_row_f32(const float* row, int lane, f32x4 (&v)[4]) {
    const f32x4* p = (const f32x4*)row + lane;
#pragma unroll
    for (int j = 0; j < 4; ++j) v[j] = p[64 * j];
}
__device__ __forceinline__ void st_row_f32(float* row, int lane, const f32x4 (&v)[4]) {
    f32x4* p = (f32x4*)row + lane;
#pragma unroll
    for (int j = 0; j < 4; ++j) p[64 * j] = v[j];
}
__device__ __forceinline__ void ld_row_bf16(const bf16* row, int lane, f32x4 (&v)[4]) {
    const v2u* p = (const v2u*)row + lane;
#pragma unroll
    for (int j = 0; j < 4; ++j) { const v2u w = p[64 * j]; v[j] = (f32x4){bflo(w.x), bfhi(w.x), bflo(w.y), bfhi(w.y)}; }
}
__device__ __forceinline__ void ld_raw_bf16(const bf16* row, int lane, v2u (&w)[4]) {
    const v2u* p = (const v2u*)row + lane;
#pragma unroll
    for (int j = 0; j < 4; ++j) w[j] = p[64 * j];
}
__device__ __forceinline__ void unpack_bf16(const v2u (&w)[4], f32x4 (&v)[4]) {
#pragma unroll
    for (int j = 0; j < 4; ++j) { const unsigned a = w[j].x, b = w[j].y; v[j] = (f32x4){bflo(a), bfhi(a), bflo(b), bfhi(b)}; }
}
__device__ __forceinline__ void st_row_bf16(bf16* row, int lane, const f32x4 (&v)[4]) {
    v2u* p = (v2u*)row + lane;
#pragma unroll
    for (int j = 0; j < 4; ++j) { v2u w; w.x = pk2(v[j][0], v[j][1]); w.y = pk2(v[j][2], v[j][3]); p[64 * j] = w; }
}
__device__ __forceinline__ void st_row_fp8(unsigned char* row, int lane, const f32x4 (&v)[4]) {
    unsigned* p = (unsigned*)row + lane;
#pragma unroll
    for (int j = 0; j < 4; ++j) p[64 * j] = pk4_fp8(v[j][0], v[j][1], v[j][2], v[j][3]);
}
__device__ __forceinline__ float sumsq4(const f32x4 (&v)[4]) {
    float s = 0.f;
#pragma unroll
    for (int j = 0; j < 4; ++j) s += (v[j][0] * v[j][0] + v[j][1] * v[j][1]) + (v[j][2] * v[j][2] + v[j][3] * v[j][3]);
    return s;
}
__device__ __forceinline__ void ld_mod(const Frame& F, int l, int r, int ch, f32x4 (&v)[4]) {
    const float* modp = (const float*)(F.ws + WS_MODP); const int lane = F.lane();
    ld_row_f32(F.in(5) + (size_t)l * NMODC + ch * D, lane, v);
#pragma unroll
    for (int kc = 0; kc < MODKC; ++kc) { f32x4 t[4]; ld_row_f32(modp + ((size_t)((kc * 2 + l) * NMODR + r)) * NMODC + ch * D, lane, t);
#pragma unroll
        for (int j = 0; j < 4; ++j) v[j] += t[j]; }
}
__device__ __forceinline__ int row_batch(int m) { return m < NLAT ? (m >> 12) : 8; }

__device__ __forceinline__ void p0_transpose_item(const float* W, int K, int N, bf16* WT, int drow_off, LAS float* scr, int item, int lane) {
    const int nblk = N / 32, kb = item / nblk, nb = item % nblk, k0 = 64 * kb, n0 = 32 * nb;
#pragma unroll 8
    for (int i = 0; i < 32; ++i) { const int kk = 2 * i + (lane >> 5); scr[kk * 33 + (lane & 31)] = W[(size_t)(k0 + kk) * N + n0 + (lane & 31)]; }
    LDS_WAIT(); asm volatile("" ::: "memory");
    const int c = lane & 7;
#pragma unroll
    for (int j = 0; j < 4; ++j) { const int n = (lane >> 3) + 8 * j; const LAS float* s = scr + (8 * c) * 33 + n;
        v4u o; o.x = pk2(s[0 * 33], s[1 * 33]); o.y = pk2(s[2 * 33], s[3 * 33]); o.z = pk2(s[4 * 33], s[5 * 33]); o.w = pk2(s[6 * 33], s[7 * 33]);
        *(GAS v4u*)(WT + (size_t)(drow_off + n0 + n) * K + k0 + 8 * c) = o; }
    LDS_WAIT(); asm volatile("" ::: "memory");
}
__device__ __forceinline__ void p0_transpose_item_fp8(const float* W, int K, int N, unsigned char* WT, int drow_off, float wscale, LAS float* scr, int item, int lane) {
    const int nblk = N / 32, kb = item / nblk, nb = item % nblk, k0 = 64 * kb, n0 = 32 * nb;
#pragma unroll 8
    for (int i = 0; i < 32; ++i) { const int kk = 2 * i + (lane >> 5); scr[kk * 33 + (lane & 31)] = W[(size_t)(k0 + kk) * N + n0 + (lane & 31)] * wscale; }
    LDS_WAIT(); asm volatile("" ::: "memory");
    const int c = lane & 3;
#pragma unroll
    for (int j = 0; j < 2; ++j) { const int n = (lane >> 2) + 16 * j; const LAS float* s = scr + (16 * c) * 33 + n;
        v4u o; o.x = pk4_fp8(s[0 * 33], s[1 * 33], s[2 * 33], s[3 * 33]); o.y = pk4_fp8(s[4 * 33], s[5 * 33], s[6 * 33], s[7 * 33]);
        o.z = pk4_fp8(s[8 * 33], s[9 * 33], s[10 * 33], s[11 * 33]); o.w = pk4_fp8(s[12 * 33], s[13 * 33], s[14 * 33], s[15 * 33]);
        *(GAS v4u*)(WT + (size_t)(drow_off + n0 + n) * K + k0 + 16 * c) = o; }
    LDS_WAIT(); asm volatile("" ::: "memory");
}
constexpr float W8SCALE = 64.0f;
constexpr int I_WIN = 1024, I_WOUT = 512, I_WQKV = 1536, I_WO = 512, I_EXP = 32 * 768, NITEMS_P0 = I_WIN + I_WOUT + I_WQKV + I_WO + I_EXP;
__device__ __forceinline__ void p0_item(const Frame& F, LAS float* scr, int it) {
    int r = it; const int lane = F.lane();
    if (r < I_WIN) { const int n0 = 32 * (r % 64), ch = n0 & 1023, hf = n0 >> 10, drow0 = 256 * (ch >> 7) + 128 * hf + (ch & 127);
        p0_transpose_item_fp8(F.in(10), D, 2 * D, (unsigned char*)(F.ws + WS_WIN), drow0 - n0, W8SCALE, scr, r, lane); return; }
    r -= I_WIN;
    if (r < I_WOUT) { p0_transpose_item(F.in(16), D, D, (bf16*)(F.ws + WS_WOUT), 0, scr, r, lane); return; }
    r -= I_WOUT;
    if (r < I_WQKV) { p0_transpose_item_fp8(F.in(18), D, 3 * D, (unsigned char*)(F.ws + WS_WQKV), 0, W8SCALE, scr, r, lane); return; }
    r -= I_WQKV;
    if (r < I_WO) { p0_transpose_item(F.in(19), D, D, (bf16*)(F.ws + WS_WO), 0, scr, r, lane); return; }
    r -= I_WO;
    const int le = r / 768; int q = r % 768;
    if (q < 512) { const bool up = q >= 256; if (up) q -= 256; const int n0 = 32 * (q % 16), drow0 = 256 * (n0 >> 7) + (up ? 128 : 0) + (n0 & 127);
        p0_transpose_item_fp8((up ? F.in(24) : F.in(23)) + (size_t)le * D * DE, D, DE, (unsigned char*)(F.ws + WS_WGU) + (size_t)le * 1024 * 1024, drow0 - n0, W8SCALE, scr, q, lane); return; }
    q -= 512;
    p0_transpose_item(F.in(25) + (size_t)le * DE * D, DE, D, (bf16*)(F.ws + WS_WDN) + (size_t)le * 1024 * 512, 0, scr, q, lane);
}
__device__ __forceinline__ void p0_mod_item(const Frame& F, LAS float* scr, int it) {
    const int lane = F.lane(), l = it / 192, rem = it % 192, cg = rem >> 3, kc = rem & 7, k0 = 128 * kc, n0 = 256 * cg + 4 * lane;
    const float* cvec = F.in(1); const float* cctx = F.in(3);
    for (int idx = lane; idx < NMODR * 128; idx += 64) { const int r = idx >> 7, kk = idx & 127; const float cv = (r < 8) ? cvec[r * D + k0 + kk] : cctx[k0 + kk];
        scr[idx] = cv / (1.0f + __expf(-cv)); }
    LDS_WAIT(); asm volatile("" ::: "memory");
    f32x4 acc[NMODR];
#pragma unroll
    for (int r = 0; r < NMODR; ++r) acc[r] = (f32x4){0.f, 0.f, 0.f, 0.f};
    const float* wp = F.in(4) + ((size_t)l * D + k0) * NMODC + n0;
#pragma unroll 8
    for (int kk = 0; kk < 128; ++kk) { const f32x4 w = *(const f32x4*)(wp + (size_t)kk * NMODC);
#pragma unroll
        for (int r = 0; r < NMODR; ++r) { const float s = scr[r * 128 + kk]; acc[r] += w * s; } }
    float* modp = (float*)(F.ws + WS_MODP);
#pragma unroll
    for (int r = 0; r < NMODR; ++r) *(f32x4*)(modp + ((size_t)((kc * 2 + l) * NMODR + r)) * NMODC + n0) = acc[r];
    LDS_WAIT(); asm volatile("" ::: "memory");
}
__device__ __forceinline__ void p0_prologue(const Frame& F) {
    LAS float* scr = (LAS float*)(F.lds + F.wave * 16384);
    if (F.wave == 0) p0_mod_item(F, scr, F.bid);
    if (F.wave == 1 && F.bid < 128) p0_mod_item(F, scr, 256 + F.bid);
    const int gw = F.bid * NWAVES + F.wave, NGW = F.G * NWAVES;
    for (int it = gw; it < NITEMS_P0; it += NGW) p0_item(F, scr, it);
}

__device__ __forceinline__ void p1_modulate(const Frame& F) {
    constexpr int RPB = MT / 256;
    unsigned char* H = (unsigned char*)(F.ws + WS_A);
    int rc = -1; f32x4 gs[4], sh[4]; const int lane = F.lane();
    const float* xlat = F.in(0); const float* xctx = F.in(2);
    f32x4 vn[4];
    { const int m = F.bid * RPB + F.wave; ld_row_f32(m < NLAT ? xlat + (size_t)m * D : xctx + (size_t)(m - NLAT) * D, lane, vn); }
    for (int rl = F.wave; rl < RPB; rl += NWAVES) {
        const int m = F.bid * RPB + rl, r = row_batch(m);
        f32x4 v[4];
#pragma unroll
        for (int j = 0; j < 4; ++j) v[j] = vn[j];
        if (rl + NWAVES < RPB) { const int m2 = m + NWAVES; ld_row_f32(m2 < NLAT ? xlat + (size_t)m2 * D : xctx + (size_t)(m2 - NLAT) * D, lane, vn); }
        if (r != rc) { f32x4 g[4], sc[4]; ld_row_f32(F.in(6), lane, g); ld_mod(F, 0, r, 1, sc); ld_mod(F, 0, r, 0, sh);
#pragma unroll
            for (int j = 0; j < 4; ++j) gs[j] = g[j] * (sc[j] + 1.0f);
            rc = r; }
        const float rstd = 1.0f / sqrtf(wave_sum(sumsq4(v)) * (1.0f / D) + EPS);
#pragma unroll
        for (int j = 0; j < 4; ++j) v[j] = v[j] * rstd * gs[j] + sh[j];
        st_row_fp8(H + (size_t)m * D, lane, v);
    }
}

__device__ __forceinline__ void p3_conv(const Frame& F) {
    const bf16* U = (const bf16*)(F.ws + WS_B); bf16* V = (bf16*)(F.ws + WS_A);
    const int tid = F.tid(), lane = F.lane();
    f32x2 w[CONVW]; const float* wdw = F.in(12);
#pragma unroll
    for (int j = 0; j < CONVW; ++j) w[j] = *(const f32x2*)(wdw + j * D + 2 * tid);
    const f32x2 bias2 = *(const f32x2*)(F.in(13) + 2 * tid);
    f32x4 lg[4], lb[4]; ld_row_f32(F.in(14), lane, lg); ld_row_f32(F.in(15), lane, lb);
    constexpr int TT = 32, NIN = TT + CONVW - 1;
    for (int tile = F.bid; tile < MT / TT; tile += F.G) {
        int rowbase, t0, T;
        if (tile < NLAT / TT) { rowbase = (tile >> 7) * SEQ; t0 = (tile & 127) * TT; T = SEQ; } else { const int t2 = tile - NLAT / TT; rowbase = NLAT + (t2 >> 3) * CTXL; t0 = (t2 & 7) * TT; T = CTXL; }
        for (int p = tid; p < NIN * 128; p += NTHR) { const int i = p >> 7, cp = p & 127, t = t0 - 15 + i;
            v4u val = (v4u){0u, 0u, 0u, 0u}; if (t >= 0 && t < T) val = *(const v4u*)(U + (size_t)(rowbase + t) * D + cp * 8);
            *(LAS v4u*)(F.lds + i * 2048 + cp * 16) = val; }
        __syncthreads();
        f32x2 res[TT];
#pragma unroll
        for (int g = 0; g < TT / 8; ++g) {
            f32x2 acc[8];
#pragma unroll
            for (int q = 0; q < 8; ++q) acc[q] = bias2;
#pragma unroll
            for (int ii = 0; ii < 8 + CONVW - 1; ++ii) { const int i = 8 * g + ii; const unsigned uw = *(const LAS unsigned*)(F.lds + i * 2048 + tid * 4); const f32x2 uv = (f32x2){bflo(uw), bfhi(uw)};
#pragma unroll
                for (int q = 0; q < 8; ++q) { const int j = ii - q; if (j >= 0 && j < CONVW) acc[q] += w[j] * uv; } }
#pragma unroll
            for (int q = 0; q < 8; ++q) res[8 * g + q] = acc[q];
        }
        __syncthreads();
#pragma unroll
        for (int tt = 0; tt < TT; ++tt) *(LAS f32x2*)(F.lds + tt * 4096 + tid * 8) = res[tt];
        __syncthreads();
#pragma unroll
        for (int q = 0; q < 4; ++q) { const int tt = 4 * F.wave + q; f32x4 v[4];
#pragma unroll
            for (int j = 0; j < 4; ++j) v[j] = *(const LAS f32x4*)(F.lds + tt * 4096 + j * 1024 + lane * 16);
            float s = 0.f;
#pragma unroll
            for (int j = 0; j < 4; ++j) s += (v[j][0] + v[j][1]) + (v[j][2] + v[j][3]);
            const float mean = wave_sum(s) * (1.0f / D);
#pragma unroll
            for (int j = 0; j < 4; ++j) v[j] = v[j] - mean;
            const float rstd = 1.0f / sqrtf(wave_sum(sumsq4(v)) * (1.0f / D) + EPS);
#pragma unroll
            for (int j = 0; j < 4; ++j) { f32x4 y = v[j] * rstd * lg[j] + lb[j];
#pragma unroll
                for (int e = 0; e < 4; ++e) y[e] = y[e] / (1.0f + __expf(-y[e]));
                v[j] = y; }
            st_row_bf16(V + (size_t)(rowbase + t0 + tt) * D, lane, v); }
        __syncthreads();
    }
}

constexpr int RW_OFF = 0, RW_BYTES = 256 * 272;
constexpr int REC_OFF = 72 * 1024;
constexpr int LRK_OFF = REC_OFF + 4096;
constexpr int BASE_OFF = LRK_OFF + 2048;
template <int L>
__device__ __forceinline__ void p_emid(const Frame& F) {
    constexpr int NROWS = (L == 0) ? MT : NLAT, RPB = NROWS / 256;
    const bf16* Y = (const bf16*)(F.ws + (L == 0 ? WS_B : WS_C)); unsigned char* TOK = (unsigned char*)(F.ws + WS_A);
    bf16* XS = (bf16*)(F.ws + WS_B);
    float* XC = (float*)(F.ws + WS_XC);
    const int tid = F.tid(), lane = F.lane(), m0 = F.bid * RPB;
    const float* rwG = F.in(21);
    for (int idx = tid; idx < 4096; idx += NTHR) { const int k = idx >> 2, ep = idx & 3; const f32x4 v = *(const f32x4*)(rwG + k * 16 + ep * 4);
        *(LAS f32x4*)(F.lds + RW_OFF + (k >> 2) * 272 + (k & 3) * 64 + ep * 16) = v; }
    __syncthreads();
    float rb[16];
    { const float* rbG = F.in(22);
#pragma unroll
    for (int e = 0; e < 16; ++e) rb[e] = rbG[e]; }
    int rc = -1; f32x4 ga[4], gp[4], gs[4], sh[4];
    const float* xlat = F.in(0); const float* xctx = F.in(2);
    v2u yn[4]; f32x4 xn[4];
    v2u xbn[4];
    { const int m = m0 + F.wave; ld_raw_bf16(Y + (size_t)m * D, lane, yn);
      if (L == 0) ld_row_f32(m < NLAT ? xlat + (size_t)m * D : xctx + (size_t)(m - NLAT) * D, lane, xn); else ld_raw_bf16(XS + (size_t)m * D, lane, xbn); }
    for (int rl = F.wave; rl < RPB; rl += NWAVES) {
        const int m = m0 + rl, r = row_batch(m);
        f32x4 y[4], xv[4];
        unpack_bf16(yn, y);
        if (L == 0) {
#pragma unroll
            for (int j = 0; j < 4; ++j) xv[j] = xn[j];
        } else unpack_bf16(xbn, xv);
        if (rl + NWAVES < RPB) { const int m2 = m + NWAVES; ld_raw_bf16(Y + (size_t)m2 * D, lane, yn);
            if (L == 0) ld_row_f32(m2 < NLAT ? xlat + (size_t)m2 * D : xctx + (size_t)(m2 - NLAT) * D, lane, xn); else ld_raw_bf16(XS + (size_t)m2 * D, lane, xbn); }
        if (r != rc) { f32x4 g[4], sc[4]; ld_mod(F, L, r, 2, ga); ld_row_f32(F.in(7) + L * D, lane, gp); ld_row_f32(F.in(8) + L * D, lane, g); ld_mod(F, L, r, 4, sc); ld_mod(F, L, r, 3, sh);
#pragma unroll
            for (int j = 0; j < 4; ++j) gs[j] = g[j] * (sc[j] + 1.0f);
            rc = r; }
        const float rstdy = 1.0f / sqrtf(wave_sum(sumsq4(y)) * (1.0f / D) + EPS);
#pragma unroll
        for (int j = 0; j < 4; ++j) xv[j] = xv[j] + ga[j] * (y[j] * rstdy * gp[j]) * (((DBG_SKIP >> (2 * L)) & 1) ? 0.f : 1.f);
        if (m < NLAT) st_row_bf16(XS + (size_t)m * D, lane, xv); else st_row_f32(XC + (size_t)(m - NLAT) * D, lane, xv);
        const float rstd1 = 1.0f / sqrtf(wave_sum(sumsq4(xv)) * (1.0f / D) + EPS);
#pragma unroll
        for (int j = 0; j < 4; ++j) xv[j] = xv[j] * rstd1 * gs[j] + sh[j];
        st_row_fp8(TOK + (size_t)m * D, lane, xv);
        float a[16];
#pragma unroll
        for (int e = 0; e < 16; ++e) a[e] = 0.f;
#pragma unroll
        for (int j = 0; j < 4; ++j)
#pragma unroll
            for (int i = 0; i < 4; ++i) { const float tv = xv[j][i]; const LAS f32x4* wp = (const LAS f32x4*)(F.lds + RW_OFF + (64 * j + lane) * 272 + i * 64);
#pragma unroll
                for (int ep = 0; ep < 4; ++ep) { const f32x4 wv = wp[ep];
#pragma unroll
                    for (int cc = 0; cc < 4; ++cc) a[4 * ep + cc] += tv * wv[cc]; } }
        float k8[8], k4[4];
#pragma unroll
        for (int i = 0; i < 8; ++i) { const auto rr = __builtin_amdgcn_permlane32_swap(__builtin_bit_cast(unsigned, a[i]), __builtin_bit_cast(unsigned, a[8 + i]), false, false);
            const unsigned r0_ = rr[0], r1_ = rr[1]; k8[i] = __uint_as_float(r0_) + __uint_as_float(r1_); }
#pragma unroll
        for (int i = 0; i < 4; ++i) { const auto rr = __builtin_amdgcn_permlane16_swap(__builtin_bit_cast(unsigned, k8[i]), __builtin_bit_cast(unsigned, k8[4 + i]), false, false);
            const unsigned r0_ = rr[0], r1_ = rr[1]; k4[i] = row16_sum(__uint_as_float(r0_) + __uint_as_float(r1_)); }
        float s[16], ss[16];
        const float lgsel = (lane & 2) ? ((lane & 1) ? k4[3] : k4[2]) : ((lane & 1) ? k4[1] : k4[0]);
        const float sgl = 1.0f / (1.0f + __expf(-lgsel));
#pragma unroll
        for (int e = 0; e < 16; ++e) { s[e] = rdlane(sgl, 16 * (e >> 2) + (e & 3)); ss[e] = s[e] + rb[e]; }
        float gsc[4]; int i0[4], i1[4];
#pragma unroll
        for (int g = 0; g < 4; ++g) { int a0 = 0; float mx = ss[4 * g];
#pragma unroll
            for (int i = 1; i < 4; ++i) if (ss[4 * g + i] > mx) { mx = ss[4 * g + i]; a0 = i; }
            int b0 = -1; float m2 = -3.0e38f;
#pragma unroll
            for (int i = 0; i < 4; ++i) if (i != a0 && ss[4 * g + i] > m2) { m2 = ss[4 * g + i]; b0 = i; }
            gsc[g] = mx + m2; i0[g] = 4 * g + a0; i1[g] = 4 * g + b0; }
        int gst = 0; float gm = gsc[0];
#pragma unroll
        for (int g = 1; g < 4; ++g) if (gsc[g] > gm) { gm = gsc[g]; gst = g; }
        int e0 = i0[0], e1 = i1[0];
#pragma unroll
        for (int g = 1; g < 4; ++g) if (gst == g) { e0 = i0[g]; e1 = i1[g]; }
        float w0 = 0.f, w1 = 0.f;
#pragma unroll
        for (int e = 0; e < 16; ++e) { if (e == e0) w0 = s[e]; if (e == e1) w1 = s[e]; }
        const float inv = 1.0f / (w0 + w1); w0 *= inv; w1 *= inv;
        if (lane == 0) *(LAS v4u*)(F.lds + REC_OFF + rl * 16) = (v4u){(unsigned)e0, (unsigned)e1, __builtin_bit_cast(unsigned, w0), __builtin_bit_cast(unsigned, w1)};
    }
    __syncthreads();
    if (F.wave == 0 && lane < 16) {
        int cntl = 0;
        for (int rl = 0; rl < RPB; ++rl) { const v4u rec = *(const LAS v4u*)(F.lds + REC_OFF + rl * 16);
            if ((int)rec.x == lane) { *(LAS int*)(F.lds + LRK_OFF + rl * 8) = cntl; ++cntl; }
            if ((int)rec.y == lane) { *(LAS int*)(F.lds + LRK_OFF + rl * 8 + 4) = cntl; ++cntl; } }
        const unsigned base = __hip_atomic_fetch_add((unsigned*)(F.ctl + CW_CNT + (L * 16 + lane) * 64), (unsigned)cntl, RLX_AGENT);
        *(LAS int*)(F.lds + BASE_OFF + lane * 4) = (int)base;
    }
    __syncthreads();
    int* perm2 = (int*)(F.ws + WS_PERM); v2u* slot = (v2u*)(F.ws + WS_SLOT);
    for (int idx = tid; idx < RPB * 2; idx += NTHR) { const int rl = idx >> 1, k = idx & 1; const v4u rec = *(const LAS v4u*)(F.lds + REC_OFF + rl * 16);
        const int e = k ? (int)rec.y : (int)rec.x; const unsigned wb = k ? rec.w : rec.z;
        const int rank = *(const LAS int*)(F.lds + BASE_OFF + e * 4) + *(const LAS int*)(F.lds + LRK_OFF + rl * 8 + k * 4);
        const int m = m0 + rl;
        perm2[(size_t)e * MT + rank] = m;
        slot[(size_t)m * 2 + k] = (v2u){((unsigned)e << 24) | (unsigned)rank, wb}; }
    __syncthreads();
}

__device__ __forceinline__ void moe_setup(const Frame& F, int L) {
    const int tid = F.tid();
    if (tid < 16) F.MISC[40 + tid] = __hip_atomic_load((unsigned*)(F.ctl + CW_CNT + (L * 16 + tid) * 64), RLX_AGENT);
    __syncthreads();
    if (tid == 0) { unsigned p = 0; for (int e = 0; e < 16; ++e) { F.MISC[16 + e] = p; p += (F.MISC[40 + e] + 255u) >> 8; } F.MISC[32] = p; }
    __syncthreads();
}
__device__ __forceinline__ void moe_stage_perm(const Frame& F) {
    const int* perm2 = (const int*)(F.ws + WS_PERM); LAS int* permL = (LAS int*)(F.lds + PERML_OFF);
    const int ntile = (int)F.MISC[32], tid = F.tid();
    for (int i = 0; i < 8; ++i) { const int Lu = i * F.G + F.bid; if (Lu >= 4 * ntile) break;
        const int rt = Lu >> 2; int e = 0;
        for (int j = 1; j < 16; ++j) e += (rt >= (int)F.MISC[16 + j]) ? 1 : 0;
        if (tid < 256) { const int rank = (rt - (int)F.MISC[16 + e]) * 256 + tid; permL[i * 256 + tid] = (rank < (int)F.MISC[40 + e]) ? perm2[(size_t)e * MT + rank] : 0; } }
    __syncthreads();
}

template <int L>
__device__ __forceinline__ void p_epost(const Frame& F) {
    constexpr int NROWS = (L == 0) ? MT : NLAT, RPB = NROWS / 256;
    const bf16* FB = (const bf16*)(F.ws + WS_D2); unsigned char* H = (unsigned char*)(F.ws + WS_A);
    float* XC = (float*)(F.ws + WS_XC); const v2u* slot = (const v2u*)(F.ws + WS_SLOT);
    const int lane = F.lane(), m0 = F.bid * RPB;
    int rc = -1; f32x4 ga[4], gp[4], gs[4], sh[4];
    v4u sl_n2 = (v4u){0u, 0u, 0u, 0u}; v2u f0n[4], f1n[4], xbn[4]; f32x4 xn[4]; float w0n, w1n;
    bf16* XS = (bf16*)(F.ws + WS_B);
#define EP_ISSUE(mm, slv) do { const unsigned sx0 = __builtin_amdgcn_readfirstlane((slv).x), sy0 = __builtin_amdgcn_readfirstlane((slv).y), sx1 = __builtin_amdgcn_readfirstlane((slv).z), sy1 = __builtin_amdgcn_readfirstlane((slv).w); \
        const size_t v0_ = (size_t)F.MISC[16 + (sx0 >> 24)] * 256 + (sx0 & 0xffffffu), v1_ = (size_t)F.MISC[16 + (sx1 >> 24)] * 256 + (sx1 & 0xffffffu); \
        w0n = __uint_as_float(sy0); w1n = __uint_as_float(sy1); ld_raw_bf16(FB + v0_ * D, lane, f0n); ld_raw_bf16(FB + v1_ * D, lane, f1n); \
        if ((mm) < NLAT) ld_raw_bf16(XS + (size_t)(mm) * D, lane, xbn); else ld_row_f32(XC + (size_t)((mm) - NLAT) * D, lane, xn); } while (0)
    { const int m = m0 + F.wave; const v4u sl0 = *(const v4u*)(slot + (size_t)m * 2);
      if (F.wave + NWAVES < RPB) sl_n2 = *(const v4u*)(slot + (size_t)(m + NWAVES) * 2);
      EP_ISSUE(m, sl0); }
    for (int rl = F.wave; rl < RPB; rl += NWAVES) {
        const int m = m0 + rl, r = row_batch(m);
        f32x4 f0[4], f1[4], xv[4]; const float w0 = w0n, w1 = w1n;
        unpack_bf16(f0n, f0); unpack_bf16(f1n, f1);
        if (m < NLAT) unpack_bf16(xbn, xv); else {
#pragma unroll
            for (int j = 0; j < 4; ++j) xv[j] = xn[j]; }
        if (rl + NWAVES < RPB) { const v4u slc = sl_n2; if (rl + 2 * NWAVES < RPB) sl_n2 = *(const v4u*)(slot + (size_t)(m + 2 * NWAVES) * 2); EP_ISSUE(m + NWAVES, slc); }
        if (r != rc) { ld_mod(F, L, r, 5, ga); ld_row_f32(F.in(9) + L * D, lane, gp);
            if (L == 0) { f32x4 g[4], sc[4]; ld_row_f32(F.in(6) + D, lane, g); ld_mod(F, 1, r, 1, sc); ld_mod(F, 1, r, 0, sh);
#pragma unroll
                for (int j = 0; j < 4; ++j) gs[j] = g[j] * (sc[j] + 1.0f); }
            rc = r; }
#pragma unroll
        for (int j = 0; j < 4; ++j) f0[j] = (DBG_SLOT == 1) ? f0[j] : (DBG_SLOT == 2) ? f1[j] : (DBG_SLOT == 3) ? f0[j] * 0.5f + f1[j] * 0.5f : f0[j] * w0 + f1[j] * w1;
        const float rstdf = 1.0f / sqrtf(wave_sum(sumsq4(f0)) * (1.0f / D) + EPS);
#pragma unroll
        for (int j = 0; j < 4; ++j) xv[j] = xv[j] + ga[j] * (f0[j] * rstdf * gp[j]) * (((DBG_SKIP >> (2 * L + 1)) & 1) ? 0.f : 1.f);
        if (L == 1) st_row_f32(F.out + (size_t)m * D, lane, xv);
        else if (m < NLAT) st_row_bf16(XS + (size_t)m * D, lane, xv); else st_row_f32(XC + (size_t)(m - NLAT) * D, lane, xv);
        if (L == 0) {
            const float rstd2 = 1.0f / sqrtf(wave_sum(sumsq4(xv)) * (1.0f / D) + EPS);
#pragma unroll
            for (int j = 0; j < 4; ++j) xv[j] = xv[j] * rstd2 * gs[j] + sh[j];
            st_row_fp8(H + (size_t)m * D, lane, xv);
        }
    }
#undef EP_ISSUE
}

constexpr int AT_CK = 0, AT_CV = 32768, AT_RPB = 65536;
constexpr float LOG2E = 1.4426950408889634f;
__device__ __forceinline__ float xrow_max(float m) {
    { const auto rr = __builtin_amdgcn_permlane16_swap(__builtin_bit_cast(unsigned, m), __builtin_bit_cast(unsigned, m), false, false); const unsigned a_ = rr[0], b_ = rr[1]; m = fmaxf(__uint_as_float(a_), __uint_as_float(b_)); }
    { const auto rr = __builtin_amdgcn_permlane32_swap(__builtin_bit_cast(unsigned, m), __builtin_bit_cast(unsigned, m), false, false); const unsigned a_ = rr[0], b_ = rr[1]; m = fmaxf(__uint_as_float(a_), __uint_as_float(b_)); }
    return m;
}
__device__ __forceinline__ float xrow_sum(float m) {
    { const auto rr = __builtin_amdgcn_permlane16_swap(__builtin_bit_cast(unsigned, m), __builtin_bit_cast(unsigned, m), false, false); const unsigned a_ = rr[0], b_ = rr[1]; m = __uint_as_float(a_) + __uint_as_float(b_); }
    { const auto rr = __builtin_amdgcn_permlane32_swap(__builtin_bit_cast(unsigned, m), __builtin_bit_cast(unsigned, m), false, false); const unsigned a_ = rr[0], b_ = rr[1]; m = __uint_as_float(a_) + __uint_as_float(b_); }
    return m;
}
__device__ __forceinline__ void attn_softmax(f32x4 (&s)[4], float& mrun, float& lsum, f32x4 (&o)[4], bf16x8 (&pf)[2]) {
    float mx = mrun;
#pragma unroll
    for (int t = 0; t < 4; ++t) mx = fmaxf(fmaxf(mx, fmaxf(s[t][0], s[t][1])), fmaxf(s[t][2], s[t][3]));
    mx = xrow_max(mx);
    const float alpha = __builtin_amdgcn_exp2f(mrun - mx);
    mrun = mx; lsum *= alpha;
#pragma unroll
    for (int db = 0; db < 4; ++db) o[db] = o[db] * alpha;
#pragma unroll
    for (int t = 0; t < 4; ++t)
#pragma unroll
        for (int i = 0; i < 4; ++i) { const float p = __builtin_amdgcn_exp2f(s[t][i] - mx); s[t][i] = p; lsum += p; }
#pragma unroll
    for (int bb = 0; bb < 2; ++bb) { v4u pw; pw.x = pg8::cvt_pk_bf16(s[2 * bb][0], s[2 * bb][1]); pw.y = pg8::cvt_pk_bf16(s[2 * bb][2], s[2 * bb][3]);
        pw.z = pg8::cvt_pk_bf16(s[2 * bb + 1][0], s[2 * bb + 1][1]); pw.w = pg8::cvt_pk_bf16(s[2 * bb + 1][2], s[2 * bb + 1][3]); pf[bb] = __builtin_bit_cast(bf16x8, pw); }
}
__device__ __forceinline__ void p10_attn(const Frame& F) {
    const bf16* Qh = (const bf16*)F.out; const bf16* Kh = (const bf16*)(F.ws + WS_C); const bf16* Vb = (const bf16*)(F.ws + WS_D2); bf16* O = (bf16*)(F.ws + WS_A);
    const int lane = F.lane(), tid = F.wave * 64 + lane, qi = lane & 15, q4 = lane >> 4;
    const int per = (BATCH * NH * GROWS * 4) / F.G;
    const int bh = (F.bid * per) >> 8, h = bh & 15, b = bh >> 4;
    const bf16* Kbh = Kh + (size_t)bh * KSLOT * HD; const bf16* Vbh = Vb + (size_t)bh * (KSLOT / 8) * 512;
#pragma unroll
    for (int i = 0; i < 4; ++i) { const int kf = F.wave * 4 + i, blk = kf >> 2, tl = (kf >> 1) & 1, dh = kf & 1;
        const v4u kv = *(const v4u*)(Kbh + (size_t)(SEQ + 32 * blk + 8 * (qi >> 2) + 4 * tl + (qi & 3)) * HD + dh * 32 + 8 * q4);
        const int vblk = kf >> 2, db = kf & 3;
        const v4u vv = *(const v4u*)(Vbh + (size_t)(SEQ / 8 + 4 * vblk + q4) * 512 + (db * 16 + qi) * 8);
        *(LAS v4u*)(F.lds + AT_CK + kf * 1024 + lane * 16) = kv; *(LAS v4u*)(F.lds + AT_CV + kf * 1024 + lane * 16) = vv; }
    { const float* rpbG = F.in(20) + h * 465; LAS float* rpbW = (LAS float*)(F.lds + AT_RPB);
        for (int idx = tid; idx < 15 * 32; idx += NTHR) { const int ri = idx >> 5, ci = idx & 31; rpbW[idx] = (ci < 31) ? rpbG[ri * 31 + ci] * LOG2E : -1.0e30f; } }
    __syncthreads();
    const int seg = F.wave & 3;
    const int cb = (seg == 0) ? 0 : (seg == 1) ? 8 : (seg == 2) ? 24 : 32;
    const int qc = 16 * seg + qi, cs = min(max(qc - WINW / 2, 0), GRIDW - WINW);
    int coff[2][4];
#pragma unroll
    for (int tl = 0; tl < 2; ++tl)
#pragma unroll
        for (int i = 0; i < 4; ++i) { const int kc = cb + 8 * q4 + 4 * tl + i; const bool ok = (kc >= cs) && (kc < cs + WINW); coff[tl][i] = AT_RPB + 4 * (ok ? (kc - qc + (WINW - 1)) : 31); }
    for (int it = 0; it < per; it += NWAVES) {
        const int wu = F.bid * per + it + F.wave;
        const int r = (wu >> 2) & 63;
        const int r0 = min(max(r - WINH / 2, 0), GROWS - WINH);
        const bf16* Qp = Qh + ((size_t)bh * SEQ + r * GRIDW + qc) * HD;
        const bf16x8 qf0 = *(const bf16x8*)(Qp + 8 * q4), qf1 = *(const bf16x8*)(Qp + 32 + 8 * q4);
        const bf16* kp0 = Kbh + (size_t)(r0 * GRIDW + cb + 8 * (qi >> 2) + (qi & 3)) * HD + 8 * q4;
        const bf16* vp0 = Vbh + (size_t)((r0 * GRIDW + cb) / 8 + q4) * 512 + qi * 8;
        int boff[2][4];
#pragma unroll
        for (int tl = 0; tl < 2; ++tl)
#pragma unroll
            for (int i = 0; i < 4; ++i) boff[tl][i] = coff[tl][i] + (r0 - r + (WINH - 1)) * 128;
        bf16x8 kw[4][2][2][2], vw[4][2][4];
#define AT_LOADK(g) do { _Pragma("unroll") for (int bb = 0; bb < 2; ++bb) _Pragma("unroll") for (int tl = 0; tl < 2; ++tl) { \
            kw[g][bb][tl][0] = *(const bf16x8*)(kp0 + (size_t)((2 * (g) + bb) * GRIDW + 4 * tl) * HD); kw[g][bb][tl][1] = *(const bf16x8*)(kp0 + (size_t)((2 * (g) + bb) * GRIDW + 4 * tl) * HD + 32); } } while (0)
#define AT_LOADV(g) do { _Pragma("unroll") for (int bb = 0; bb < 2; ++bb) _Pragma("unroll") for (int db = 0; db < 4; ++db) vw[g][bb][db] = *(const bf16x8*)(vp0 + (size_t)((2 * (g) + bb) * (GRIDW / 8)) * 512 + db * 128); } while (0)
        float mrun = -1.0e30f, lsum = 0.f;
        f32x4 o[4];
#pragma unroll
        for (int db = 0; db < 4; ++db) o[db] = (f32x4){0.f, 0.f, 0.f, 0.f};
        AT_LOADK(0); AT_LOADV(0);
        __builtin_amdgcn_sched_barrier(0);
#pragma unroll
        for (int g = 0; g < 4; ++g) {
            {
                f32x4 s[4]; bf16x8 pf[2];
#pragma unroll
                for (int bb = 0; bb < 2; ++bb) { const int blk = 2 * g + bb;
#pragma unroll
                    for (int tl = 0; tl < 2; ++tl) { const bf16x8 k0 = *(const LAS bf16x8*)(F.lds + AT_CK + ((blk * 2 + tl) * 2 + 0) * 1024 + lane * 16), k1 = *(const LAS bf16x8*)(F.lds + AT_CK + ((blk * 2 + tl) * 2 + 1) * 1024 + lane * 16);
                        f32x4 acc = (f32x4){0.f, 0.f, 0.f, 0.f};
                        acc = __builtin_amdgcn_mfma_f32_16x16x32_bf16(k0, qf0, acc, 0, 0, 0);
                        acc = __builtin_amdgcn_mfma_f32_16x16x32_bf16(k1, qf1, acc, 0, 0, 0);
                        s[2 * bb + tl] = acc; } }
                attn_softmax(s, mrun, lsum, o, pf);
#pragma unroll
                for (int bb = 0; bb < 2; ++bb)
#pragma unroll
                    for (int db = 0; db < 4; ++db) { const bf16x8 vf = *(const LAS bf16x8*)(F.lds + AT_CV + ((2 * g + bb) * 4 + db) * 1024 + lane * 16);
                        o[db] = __builtin_amdgcn_mfma_f32_16x16x32_bf16(vf, pf[bb], o[db], 0, 0, 0); }
            }
            __builtin_amdgcn_sched_barrier(0);
            {
                f32x4 s[4]; bf16x8 pf[2];
#pragma unroll
                for (int bb = 0; bb < 2; ++bb)
#pragma unroll
                    for (int tl = 0; tl < 2; ++tl) { f32x4 acc = (f32x4){0.f, 0.f, 0.f, 0.f};
                        acc = __builtin_amdgcn_mfma_f32_16x16x32_bf16(kw[g][bb][tl][0], qf0, acc, 0, 0, 0);
                        acc = __builtin_amdgcn_mfma_f32_16x16x32_bf16(kw[g][bb][tl][1], qf1, acc, 0, 0, 0);
#pragma unroll
                        for (int i = 0; i < 4; ++i) acc[i] += *(const LAS float*)(F.lds + boff[tl][i] + (2 * g + bb) * 128);
                        s[2 * bb + tl] = acc; }
                if (g < 3) { AT_LOADK(g + 1); }
                __builtin_amdgcn_sched_barrier(0);
                attn_softmax(s, mrun, lsum, o, pf);
#pragma unroll
                for (int bb = 0; bb < 2; ++bb)
#pragma unroll
                    for (int db = 0; db < 4; ++db) o[db] = __builtin_amdgcn_mfma_f32_16x16x32_bf16(vw[g][bb][db], pf[bb], o[db], 0, 0, 0);
                if (g < 3) { AT_LOADV(g + 1); }
                __builtin_amdgcn_sched_barrier(0);
            }
        }
#undef AT_LOADK
#undef AT_LOADV
        const float inv = 1.0f / xrow_sum(lsum);
        bf16* op = O + ((size_t)b * SEQ + r * GRIDW + qc) * D + h * HD + 4 * q4;
#pragma unroll
        for (int db = 0; db < 4; ++db) { v2u w; w.x = pg8::cvt_pk_bf16(o[db][0] * inv, o[db][1] * inv); w.y = pg8::cvt_pk_bf16(o[db][2] * inv, o[db][3] * inv); *(v2u*)(op + db * 16) = w; }
    }
    __syncthreads();
}

#ifndef MK_N_LAUNCHES
#define MK_N_LAUNCHES 1
#endif
constexpr int N_PHASES = 16;
constexpr int N_LAUNCHES = MK_N_LAUNCHES;
struct Args { const float* in[26]; float* out; unsigned char* ws; int ph_lo, ph_hi; };

__global__ void __launch_bounds__(NTHR, 2) fwd_kernel(Args args) {
    extern __shared__ __attribute__((aligned(16))) unsigned char lds[];
    Frame F;
    F.lds = (LAS unsigned char*)lds;
    F.MISC = (volatile LAS unsigned*)(F.lds + MISC_OFF);
    F.wave = __builtin_amdgcn_readfirstlane((int)threadIdx.x >> 6);
    F.G = gridDim.x; F.bid = blockIdx.x;
    F.ws = args.ws; F.ctl = (gu32*)(args.ws + WS_CTL); F.out = args.out;
    for (int u = threadIdx.x; u < 256; u += NTHR) F.MISC[u] = 0u;
    if (threadIdx.x < 26) { const unsigned long long pv = (unsigned long long)args.in[threadIdx.x]; volatile LAS unsigned* t = (volatile LAS unsigned*)(F.lds + PTAB_OFF) + 2 * threadIdx.x; t[0] = (unsigned)pv; t[1] = (unsigned)(pv >> 32); }
    __syncthreads();
    XcdBarrier bar; bar.bar = (unsigned*)(F.ctl + CW_BAR); bar.x = 0; bar.st = nullptr;
    if (N_LAUNCHES == 1) bar = xcd_barrier_post((unsigned*)(F.ctl + CW_BAR), F.MISC + 8);
    const int lo = args.ph_lo, hi = args.ph_hi;
#ifndef PHASE_MASK
#define PHASE_MASK 0xFFFF
#endif
#define IN(k) ((((PHASE_MASK) >> (k)) & 1) && lo <= (k) && (k) < hi)
#define SEAM(k) do { if (IN(k) && IN((k) + 1)) { xcd_barrier(bar); if (PROBE_MASK == 0x10000) xcd_barrier(bar); } } while (0)
    const char* wsb = (const char*)F.ws;
    LAS unsigned char* ring = F.lds;

    if (IN(0)) { _Pragma("unroll") for (int rep = 0; rep < REP(0); ++rep) { p0_prologue(F); __syncthreads(); } }
    SEAM(0);
    if (IN(1)) { _Pragma("unroll") for (int rep = 0; rep < REP(1); ++rep) p1_modulate(F); }
    SEAM(1);
    if (IN(2)) {
        pg8::DenseSched S{wsb + WS_A, wsb + WS_WIN, D / 2, MT / 256, 8, F.G, F.bid};
        pg8::EpiGated<0> E{(bf16*)(F.ws + WS_B), D, F.in(11), D};
        _Pragma("unroll") for (int rep = 0; rep < REP(2); ++rep) pg8::gemm_phase<pg8::EpiGated<0>, pg8::DenseSched, true, true>(ring, D / 2, S, E, F.wave);
    }
    SEAM(2);
    if (IN(3)) { _Pragma("unroll") for (int rep = 0; rep < REP(3); ++rep) p3_conv(F); }
    SEAM(3);
    if (IN(4)) {
        pg8::DenseSched S{wsb + WS_A, wsb + WS_WOUT, D, MT / 256, 4, F.G, F.bid};
        pg8::EpiBf16B E{(bf16*)(F.ws + WS_B), D, F.in(17)};
        _Pragma("unroll") for (int rep = 0; rep < REP(4); ++rep) pg8::gemm_phase<pg8::EpiBf16B, pg8::DenseSched, true>(ring, D, S, E, F.wave);
    }
    SEAM(4);
    if (IN(5)) p_emid<0>(F);
    SEAM(5);
    if (IN(6)) {
        moe_setup(F, 0); moe_stage_perm(F);
        pg8::MoeUpSched S; S.tpre = (const volatile LAS int*)(F.MISC + 16); S.G = F.G; S.c = F.bid; S.A = wsb + WS_A; S.Wgu = wsb + WS_WGU + (size_t)0 * 16 * 1024 * 1024; S.permL = (const LAS int*)(F.lds + PERML_OFF); S.kb = D;
        pg8::EpiGated<1> E{(bf16*)(F.ws + WS_C), DE, nullptr, 0};
        _Pragma("unroll") for (int rep = 0; rep < REP(6); ++rep) pg8::gemm_phase<pg8::EpiGated<1>, pg8::MoeUpSched, true, true>(ring, D / 2, S, E, F.wave);
    }
    SEAM(6);
    if (IN(7)) {
        moe_setup(F, 0);
        pg8::MoeDownSched S; S.tpre = (const volatile LAS int*)(F.MISC + 16); S.G = F.G; S.c = F.bid; S.A = wsb + WS_C; S.Wdn = wsb + WS_WDN + (size_t)0 * 16 * 1024 * 512 * 2; S.kb = DE * 2;
        pg8::EpiBf16 E{(bf16*)(F.ws + WS_D2), D, nullptr};
        _Pragma("unroll") for (int rep = 0; rep < REP(7); ++rep) pg8::gemm_phase<pg8::EpiBf16, pg8::MoeDownSched, true>(ring, DE, S, E, F.wave);
    }
    SEAM(7);
    if (IN(8)) { moe_setup(F, 0); p_epost<0>(F); }
    SEAM(8);
    if (IN(9)) {
        pg8::QkvSched S{wsb + WS_A, wsb + WS_WQKV, F.G, F.bid, D};
        pg8::EpiQkv E{(bf16*)F.out, (bf16*)(F.ws + WS_C), (bf16*)(F.ws + WS_D2), 0.125f * 1.4426950408889634f};
        _Pragma("unroll") for (int rep = 0; rep < REP(9); ++rep) pg8::gemm_phase<pg8::EpiQkv, pg8::QkvSched, true, true>(ring, D / 2, S, E, F.wave);
    }
    SEAM(9);
    if (IN(10)) { _Pragma("unroll") for (int rep = 0; rep < REP(10); ++rep) p10_attn(F); }
    SEAM(10);
    if (IN(11)) {
        pg8::DenseSched S{wsb + WS_A, wsb + WS_WO, D, NLAT / 256, 4, F.G, F.bid};
        pg8::EpiBf16 E{(bf16*)(F.ws + WS_C), D, nullptr};
        _Pragma("unroll") for (int rep = 0; rep < REP(11); ++rep) pg8::gemm_phase<pg8::EpiBf16, pg8::DenseSched, true>(ring, D, S, E, F.wave);
    }
    SEAM(11);
    if (IN(12)) p_emid<1>(F);
    SEAM(12);
    if (IN(13)) {
        moe_setup(F, 1); moe_stage_perm(F);
        pg8::MoeUpSched S; S.tpre = (const volatile LAS int*)(F.MISC + 16); S.G = F.G; S.c = F.bid; S.A = wsb + WS_A; S.Wgu = wsb + WS_WGU + (size_t)1 * 16 * 1024 * 1024; S.permL = (const LAS int*)(F.lds + PERML_OFF); S.kb = D;
        pg8::EpiGated<1> E{(bf16*)(F.ws + WS_C), DE, nullptr, 0};
        _Pragma("unroll") for (int rep = 0; rep < REP(13); ++rep) pg8::gemm_phase<pg8::EpiGated<1>, pg8::MoeUpSched, true, true>(ring, D / 2, S, E, F.wave);
    }
    SEAM(13);
    if (IN(14)) {
        moe_setup(F, 1);
        pg8::MoeDownSched S; S.tpre = (const volatile LAS int*)(F.MISC + 16); S.G = F.G; S.c = F.bid; S.A = wsb + WS_C; S.Wdn = wsb + WS_WDN + (size_t)1 * 16 * 1024 * 512 * 2; S.kb = DE * 2;
        pg8::EpiBf16 E{(bf16*)(F.ws + WS_D2), D, nullptr};
        _Pragma("unroll") for (int rep = 0; rep < REP(14); ++rep) pg8::gemm_phase<pg8::EpiBf16, pg8::MoeDownSched, true>(ring, DE, S, E, F.wave);
    }
    SEAM(14);
    if (IN(15)) { moe_setup(F, 1); _Pragma("unroll") for (int rep = 0; rep < REP(15); ++rep) p_epost<1>(F); }
#undef IN
#undef SEAM
}

extern "C" void kernel_launch(void* const* d_in, const int* in_sizes, int n_in, void* d_out, int out_size, void* d_ws, size_t ws_size, hipStream_t stream) {
    static int grid = 0;
    if (grid == 0) {
        if (n_in != 26 || in_sizes[0] != NLAT * D || out_size != NLAT * D || ws_size < WS_END) { fprintf(stderr, "kernel_launch: unexpected shapes (n_in %d, in0 %d, out %d, ws %zu); nothing launched\n", n_in, n_in > 0 ? in_sizes[0] : -1, out_size, ws_size); grid = -1; return; }
        if (hipFuncSetAttribute((const void*)fwd_kernel, hipFuncAttributeMaxDynamicSharedMemorySize, LDS_BYTES) != hipSuccess) { fprintf(stderr, "kernel_launch: hipFuncSetAttribute failed\n"); grid = -1; return; }
        int per_cu = 0;
        if (hipOccupancyMaxActiveBlocksPerMultiprocessor(&per_cu, (const void*)fwd_kernel, NTHR, LDS_BYTES) != hipSuccess || per_cu < 1) fprintf(stderr, "kernel_launch: note: occupancy query reports %d workgroups per CU\n", per_cu);
        (void)hipGetLastError();
        grid = 256;
    }
    if (grid < 0) return;
    if (hipMemsetAsync((char*)d_ws + WS_CTL, 0, CTL_ZERO_BYTES, stream) != hipSuccess) { fprintf(stderr, "kernel_launch: hipMemsetAsync failed\n"); return; }
    Args a{};
    for (int i = 0; i < 26; ++i) a.in[i] = (const float*)d_in[i];
    a.out = (float*)d_out; a.ws = (unsigned char*)d_ws;
    for (int li = 0; li < N_LAUNCHES; ++li) {
        a.ph_lo = (N_LAUNCHES == 1) ? 0 : li; a.ph_hi = (N_LAUNCHES == 1) ? N_PHASES : li + 1;
        hipLaunchKernelGGL(fwd_kernel, dim3(grid), dim3(NTHR), LDS_BYTES, stream, a);
        const hipError_t le = hipPeekAtLastError();
        if (le != hipSuccess) { fprintf(stderr, "kernel_launch: launch %d failed: %s\n", li, hipGetErrorName(le)); break; }
    }
}
```

```cpp
#include <hip/hip_runtime.h>
#include <cstdio>
#include <cstdint>

#ifndef PROBE_MASK
#define PROBE_MASK 0
#endif
#define REP(k) ((((PROBE_MASK) >> (k)) & 1) ? 2 : 1)
#ifndef DBG_SLOT
#define DBG_SLOT 0
#endif
#ifndef DBG_SKIP
#define DBG_SKIP 0
#endif
constexpr int D = 1024, BATCH = 8, SEQ = 4096, CTXL = 256;
constexpr int NLAT = BATCH * SEQ, NCTX = BATCH * CTXL, MT = NLAT + NCTX;
constexpr int NE = 16, DE = 512, NH = 16, HD = 64, GRIDW = 64, GROWS = 64, WINH = 8, WINW = 16, CONVW = 31;
constexpr int KSLOT = SEQ + CTXL;
constexpr int NMODR = 9, NMODC = 6 * D;
constexpr int MODKC = 8;
constexpr float EPS = 1e-6f;
constexpr int NWAVES = 8, NTHR = NWAVES * 64;

constexpr size_t MiB = 1u << 20;
constexpr size_t WS_CTL = 0, CTL_ZERO_BYTES = 1 * MiB;
constexpr size_t WS_SLOT = 1 * MiB;
constexpr size_t WS_PERM = 2 * MiB;
constexpr size_t WS_MODP = 5 * MiB;
constexpr size_t WS_XC = 9 * MiB;
constexpr size_t WS_WIN = 18 * MiB, WS_WOUT = 22 * MiB, WS_WQKV = 24 * MiB, WS_WO = 30 * MiB;
constexpr size_t WS_WGU = 32 * MiB;
constexpr size_t WS_WDN = 96 * MiB;
constexpr size_t WS_A = 128 * MiB, WS_B = 196 * MiB, WS_C = 264 * MiB, WS_D2 = 336 * MiB, WS_END = 480 * MiB;
constexpr int CW_BAR = 4096;
constexpr int CW_CNT = 8192;

constexpr int RING_BYTES = 131072;
constexpr int MISC_OFF = RING_BYTES;
constexpr int PTAB_OFF = RING_BYTES + 1024 + 8192;
constexpr int PERML_OFF = RING_BYTES + 1024;
constexpr int LDS_BYTES = 147456;

#define GAS __attribute__((address_space(1)))
#define LAS __attribute__((address_space(3)))
typedef unsigned short bf16;
typedef unsigned v4u __attribute__((ext_vector_type(4)));
typedef unsigned v2u __attribute__((ext_vector_type(2)));
typedef float f32x4 __attribute__((ext_vector_type(4)));
typedef float f32x2 __attribute__((ext_vector_type(2)));
typedef short bf16x8 __attribute__((ext_vector_type(8)));
typedef GAS unsigned gu32;
#define RLX_AGENT __ATOMIC_RELAXED, __HIP_MEMORY_SCOPE_AGENT
#define LDS_WAIT() asm volatile("s_waitcnt lgkmcnt(0)" ::: "memory")
#define VM_WAIT() asm volatile("s_waitcnt vmcnt(0)" ::: "memory")

__device__ __forceinline__ unsigned f2bf(float f) { unsigned u = __builtin_bit_cast(unsigned, f); return (u + 0x7fffu + ((u >> 16) & 1u)) >> 16; }
__device__ __forceinline__ unsigned pk2(float lo, float hi) { return f2bf(lo) | (f2bf(hi) << 16); }
__device__ __forceinline__ unsigned pk4_fp8(float a, float b, float c, float d) { int p = __builtin_amdgcn_cvt_pk_fp8_f32(a, b, 0, false); p = __builtin_amdgcn_cvt_pk_fp8_f32(c, d, p, true); return (unsigned)p; }
__device__ __forceinline__ float bflo(unsigned w) { return __builtin_bit_cast(float, w << 16); }
__device__ __forceinline__ float bfhi(unsigned w) { return __builtin_bit_cast(float, w & 0xffff0000u); }
__device__ __forceinline__ float row16_sum(float v) {
    v += __builtin_bit_cast(float, __builtin_amdgcn_update_dpp(0, __builtin_bit_cast(int, v), 0xB1, 0xF, 0xF, false));
    v += __builtin_bit_cast(float, __builtin_amdgcn_update_dpp(0, __builtin_bit_cast(int, v), 0x4E, 0xF, 0xF, false));
    v += __builtin_bit_cast(float, __builtin_amdgcn_update_dpp(0, __builtin_bit_cast(int, v), 0x141, 0xF, 0xF, false));
    v += __builtin_bit_cast(float, __builtin_amdgcn_update_dpp(0, __builtin_bit_cast(int, v), 0x140, 0xF, 0xF, false));
    return v;
}
__device__ __forceinline__ float rdlane(float v, int l) { return __builtin_bit_cast(float, __builtin_amdgcn_readlane(__builtin_bit_cast(int, v), l)); }
__device__ __forceinline__ float wave_sum(float v) {
    v = row16_sum(v);
    return (rdlane(v, 0) + rdlane(v, 16)) + (rdlane(v, 32) + rdlane(v, 48));
}
__device__ __forceinline__ int lane_id_asm() { int l; asm volatile("v_mbcnt_lo_u32_b32 %0, -1, 0\n\tv_mbcnt_hi_u32_b32 %0, -1, %0" : "=v"(l)); return l; }
__device__ __forceinline__ float fast_sigmoid(float x) { return __builtin_amdgcn_rcpf(1.0f + __builtin_amdgcn_exp2f(-1.4426950408889634f * x)); }

namespace pg8 {
#define PG8_LAS __attribute__((address_space(3)))
typedef unsigned short bf16_t;
typedef short bf16x8 __attribute__((ext_vector_type(8)));
typedef float f32x4 __attribute__((ext_vector_type(4)));
typedef unsigned u32x4 __attribute__((ext_vector_type(4)));
constexpr int BM = 256, BK = 64, HALF = 128, HTB = HALF * BK * 2, STAGE_BYTES = 8 * HTB, NXCD = 8, WGM = 8;

__host__ __device__ __forceinline__ int lds_byte(int r, int c) { const int st = (r >> 4) * 2 + (c >> 5), rr = r & 15, cc = c & 31, ob = rr * 64 + cc * 2; return st * 1024 + (ob ^ (((ob >> 9) & 1) << 5)); }
__host__ __device__ __forceinline__ void stage_rc(int b, int& R, int& C) { const int st = b / 1024, sb = b % 1024, swz = sb ^ (((sb >> 9) & 1) << 5); R = (st >> 1) * 16 + swz / 64; C = (st & 1) * 32 + (swz % 64) / 2; }
__host__ __device__ __forceinline__ int perm32(int rho) { const int n = rho >> 4, i = rho & 15; return 8 * (i >> 2) + 4 * n + (i & 3); }

struct Unit { int pm, pn; const char* a; const char* b; int li; int ex; };

__device__ __forceinline__ bool static_order(int L, int nM, int nN, int& pm, int& pn) {
    const int nwg = nM * nN; if (L >= nwg) return false;
    int wgid = L; { const int q = nwg / NXCD, r = nwg % NXCD, xcd = wgid % NXCD, off = wgid / NXCD; wgid = (xcd < r ? xcd * (q + 1) : r * (q + 1) + (xcd - r) * q) + off; }
    const int nig = WGM * nN, gid = wgid / nig, fm = gid * WGM, gsz = (nM - fm) < WGM ? (nM - fm) : WGM;
    pm = fm + ((wgid % nig) % gsz); pn = (wgid % nig) / gsz; return true;
}

typedef float cvt_f32x2_t __attribute__((ext_vector_type(2))); typedef __bf16 cvt_bf16x2_t __attribute__((ext_vector_type(2)));
__device__ __forceinline__ unsigned cvt_pk_bf16(float lo, float hi) { const cvt_f32x2_t v = {lo, hi}; const cvt_bf16x2_t b = __builtin_convertvector(v, cvt_bf16x2_t); return __builtin_bit_cast(unsigned, b); }

typedef int v8i_t __attribute__((ext_vector_type(8)));
typedef int v4i_t __attribute__((ext_vector_type(4)));
template <class Epi, class Sched, bool ALIGN_EPI, bool FP8 = false>
__device__ __forceinline__ void gemm_phase(PG8_LAS unsigned char* lds, const int K_, const Sched& S, const Epi& E, const int wid) {
    int K = K_; asm volatile("" : "+s"(K));
    const int lane = lane_id_asm(), tid = wid * 64 + lane, wr = wid >> 2, wc = wid & 3, fr = lane & 15, fq = lane >> 4;
    const int nt = K / BK;
    int R[2], C[2]; unsigned voffB[2], vA[2][2];
    const size_t kstep = (size_t)(BK * 2);
    const size_t hstep = (size_t)HALF * K * 2;
#pragma unroll
    for (int i = 0; i < 2; ++i) { stage_rc(tid * 16 + i * 8192, R[i], C[i]); const int Rb = Epi::PERM ? ((R[i] & ~31) + perm32(R[i] & 31)) : R[i];
        voffB[i] = (unsigned)(Rb * K + C[i]) * 2u; vA[0][i] = (unsigned)(R[i] * K + C[i]) * 2u; vA[1][i] = vA[0][i] + (unsigned)hstep; }
    const unsigned ldsw = (unsigned)wid * 1024u;
    const int aoff = lds_byte(wr * 64 + fr, fq * 8), boff = lds_byte(wc * 32 + fr, fq * 8);
#define PG8_SA(b, h) (((b) * 2 + (h)) * HTB)
#define PG8_SB(b, h) ((4 + (b) * 2 + (h)) * HTB)
#define PG8_STAGE(bufoff, gbase, voff) do { _Pragma("unroll") for (int _i = 0; _i < 2; ++_i) \
        __builtin_amdgcn_global_load_lds((const unsigned*)((const char*)(gbase) + (voff)[_i]), (PG8_LAS unsigned*)(lds + (bufoff) + ldsw + _i * 8192), 16, 0, 0); } while (0)
#define PG8_LD8(addr) __builtin_shufflevector(*(const PG8_LAS v4i_t*)(addr), *(const PG8_LAS v4i_t*)((addr) + 1024), 0, 1, 2, 3, 4, 5, 6, 7)
#define PG8_LDA(dst, b, h) do { _Pragma("unroll") for (int m = 0; m < 4; ++m) dst[m] = PG8_LD8(lds + PG8_SA(b, h) + aoff + m * 2048); } while (0)
#define PG8_LDB(dst, b, h) do { _Pragma("unroll") for (int n = 0; n < 2; ++n) dst[n] = PG8_LD8(lds + PG8_SB(b, h) + boff + n * 2048); } while (0)
#define PG8_LO(x) __builtin_bit_cast(bf16x8, __builtin_shufflevector((x), (x), 0, 1, 2, 3))
#define PG8_HI(x) __builtin_bit_cast(bf16x8, __builtin_shufflevector((x), (x), 4, 5, 6, 7))
#define PG8_MMA(ai, bj, At, Bt) do { __builtin_amdgcn_s_setprio(1); _Pragma("unroll") for (int m = 0; m < 4; ++m) _Pragma("unroll") for (int n = 0; n < 2; ++n) { \
        if constexpr (FP8) asm volatile("v_mfma_scale_f32_16x16x128_f8f6f4 %0, %1, %2, %0, %3, %4 op_sel_hi:[0,0,0]" : "+v"(acc[ai][bj][m][n]) : "v"(Bt[n]), "v"(At[m]), "v"(wscale_r), "v"(ascale_r)); \
        else { acc[ai][bj][m][n] = __builtin_amdgcn_mfma_f32_16x16x32_bf16(PG8_LO(Bt[n]), PG8_LO(At[m]), acc[ai][bj][m][n], 0, 0, 0); \
               acc[ai][bj][m][n] = __builtin_amdgcn_mfma_f32_16x16x32_bf16(PG8_HI(Bt[n]), PG8_HI(At[m]), acc[ai][bj][m][n], 0, 0, 0); } } __builtin_amdgcn_s_setprio(0); } while (0)
#define PG8_WAIT_V(n) asm volatile("s_waitcnt vmcnt(" #n ")" ::: "memory")
#define PG8_WAIT_L(n) asm volatile("s_waitcnt lgkmcnt(" #n ")" ::: "memory")
#define PG8_BAR __builtin_amdgcn_s_barrier()
#define PG8_SCHED __builtin_amdgcn_sched_barrier(0)
    Unit cur, nxt; int ui = 0;
    if (!S.next(0, cur)) return;
    if constexpr (Sched::GATHER) S.a_offsets(cur, R, C, K, vA);
    f32x4 acc[2][2][4][2];
#pragma unroll
    for (int a = 0; a < 2; ++a)
#pragma unroll
        for (int b = 0; b < 2; ++b)
#pragma unroll
            for (int m = 0; m < 4; ++m)
#pragma unroll
                for (int n = 0; n < 2; ++n) acc[a][b][m][n] = (f32x4){0.f, 0.f, 0.f, 0.f};
    int wscale_r = 0x79797979, ascale_r = 0x7f7f7f7f;
    asm volatile("" : "+v"(wscale_r), "+v"(ascale_r));
    v8i_t At[4], B0[2], B1[2];
    const char* cA = cur.a; const char* cB = cur.b;
    PG8_STAGE(PG8_SB(0, 0), cB, voffB); PG8_STAGE(PG8_SB(0, 1), cB + hstep, voffB); PG8_STAGE(PG8_SA(0, 0), cA, vA[0]); PG8_STAGE(PG8_SA(0, 1), cA, vA[1]);
    if (wr == 1) PG8_BAR;
    PG8_WAIT_V(2); PG8_BAR;
    PG8_STAGE(PG8_SB(1, 0), cB + kstep, voffB); PG8_STAGE(PG8_SA(1, 0), cA + kstep, vA[0]); PG8_STAGE(PG8_SB(1, 1), cB + hstep + kstep, voffB);
    PG8_WAIT_V(6); PG8_BAR;
    for (;;) {
        const bool has_next = S.next(ui + 1, nxt);
        const char* nA = has_next ? nxt.a : cA; const char* nB = has_next ? nxt.b : cB;
#pragma unroll 1
        for (int t = 0; t < nt; t += 2) {
            const bool last = (t == nt - 2);
            const char* a1 = cA + (size_t)(t + 1) * kstep;
            const char* a2 = last ? nA : cA + (size_t)(t + 2) * kstep; const char* b2 = last ? nB : cB + (size_t)(t + 2) * kstep;
            const char* a3 = a2 + kstep; const char* b3 = b2 + kstep;
            PG8_LDB(B0, 0, 0); PG8_LDB(B1, 0, 1); PG8_SCHED; PG8_LDA(At, 0, 0); PG8_STAGE(PG8_SA(1, 1), a1, vA[1]);
            if constexpr (Sched::GATHER) { if (last && has_next) S.a_offsets(nxt, R, C, K, vA); }
            PG8_WAIT_V(8); PG8_WAIT_L(0); PG8_BAR; PG8_MMA(0, 0, At, B0); PG8_MMA(0, 1, At, B1); PG8_BAR; PG8_SCHED;
            PG8_LDA(At, 0, 1); PG8_STAGE(PG8_SB(0, 0), b2, voffB); PG8_STAGE(PG8_SB(0, 1), b2 + hstep, voffB); PG8_STAGE(PG8_SA(0, 0), a2, vA[0]);
            PG8_WAIT_V(8); PG8_WAIT_L(0); PG8_BAR; PG8_MMA(1, 0, At, B0); PG8_MMA(1, 1, At, B1); PG8_BAR; PG8_SCHED;
            PG8_LDB(B0, 1, 0); PG8_LDB(B1, 1, 1); PG8_SCHED; PG8_LDA(At, 1, 0); PG8_STAGE(PG8_SA(0, 1), a2, vA[1]);
            PG8_WAIT_V(8); PG8_WAIT_L(0); PG8_BAR; PG8_MMA(0, 0, At, B0); PG8_MMA(0, 1, At, B1); PG8_BAR; PG8_SCHED;
            PG8_LDA(At, 1, 1); PG8_STAGE(PG8_SB(1, 0), b3, voffB); PG8_STAGE(PG8_SB(1, 1), b3 + hstep, voffB); PG8_STAGE(PG8_SA(1, 0), a3, vA[0]);
            PG8_WAIT_V(8); PG8_WAIT_L(0); PG8_BAR; PG8_MMA(1, 0, At, B0); PG8_MMA(1, 1, At, B1); PG8_BAR; PG8_SCHED;
        }
        if constexpr (ALIGN_EPI) { if (wr == 0) PG8_BAR; }
        if constexpr (FP8) asm volatile("s_nop 15\n\ts_nop 7" ::: "memory");
        E(acc, cur, wr, wc, fr, fq);
        if (!has_next) break;
#pragma unroll
        for (int a = 0; a < 2; ++a)
#pragma unroll
            for (int b = 0; b < 2; ++b)
#pragma unroll
                for (int m = 0; m < 4; ++m)
#pragma unroll
                    for (int n = 0; n < 2; ++n) acc[a][b][m][n] = (f32x4){0.f, 0.f, 0.f, 0.f};
        cur = nxt; cA = nA; cB = nB; ++ui;
        if constexpr (ALIGN_EPI) { if (wr == 1) PG8_BAR; }
    }
    PG8_WAIT_V(0);
    if constexpr (!ALIGN_EPI) { if (wr == 0) PG8_BAR; }
    PG8_BAR;
#undef PG8_SA
#undef PG8_SB
#undef PG8_STAGE
#undef PG8_LDA
#undef PG8_LDB
#undef PG8_MMA
#undef PG8_LO
#undef PG8_HI
#undef PG8_LD8
#undef PG8_WAIT_V
#undef PG8_WAIT_L
#undef PG8_BAR
#undef PG8_SCHED
}

struct DenseSched {
    static constexpr bool GATHER = false;
    const char* A; const char* Bt; int K, nM, nN, G, c;
    __device__ __forceinline__ bool next(int i, Unit& u) const {
        int pm, pn; if (!static_order(i * G + c, nM, nN, pm, pn)) return false;
        u.pm = pm; u.pn = pn; u.a = A + (size_t)pm * BM * K * 2; u.b = Bt + (size_t)pn * BM * K * 2; u.li = i; u.ex = 0; return true;
    }
    __device__ __forceinline__ void a_offsets(const Unit&, const int (&)[2], const int (&)[2], int, unsigned (&)[2][2]) const {}
};
struct QkvSched {
    static constexpr bool GATHER = false;
    const char* A; const char* Bt; int G, c, kb;
    __device__ __forceinline__ bool next(int i, Unit& u) const {
        const int L = i * G + c; int pm, pn;
        if (L < 1536) { static_order(L, 128, 12, pm, pn); }
        else { const int l2 = L - 1536; if (l2 >= 64) return false; pm = 128 + (l2 >> 3); pn = 4 + (l2 & 7); }
        u.pm = pm; u.pn = pn; u.a = A + (size_t)pm * BM * kb; u.b = Bt + (size_t)pn * BM * kb; u.li = i; u.ex = 0; return true;
    }
    __device__ __forceinline__ void a_offsets(const Unit&, const int (&)[2], const int (&)[2], int, unsigned (&)[2][2]) const {}
};
struct MoeSchedBase {
    const volatile PG8_LAS int* tpre;
    int G, c;
    __device__ __forceinline__ bool locate(int i, int& rt, int& pn, int& e) const {
        const int L = i * G + c; const int ntile = tpre[16];
        if (L >= 4 * ntile) return false;
        rt = L >> 2; pn = L & 3; int ee = 0;
#pragma unroll
        for (int j = 1; j < 16; ++j) ee += (rt >= tpre[j]) ? 1 : 0;
        e = ee; return true;
    }
};
struct MoeUpSched : MoeSchedBase {
    static constexpr bool GATHER = true;
    const char* A; const char* Wgu; const PG8_LAS int* permL; int kb;
    __device__ __forceinline__ bool next(int i, Unit& u) const {
        int rt, pn, e; if (!locate(i, rt, pn, e)) return false;
        u.pm = rt; u.pn = pn; u.a = A; u.b = Wgu + (size_t)e * 1024 * kb + (size_t)pn * BM * kb; u.li = i; u.ex = e; return true;
    }
    __device__ __forceinline__ void a_offsets(const Unit& u, const int (&R)[2], const int (&C)[2], int K, unsigned (&vA)[2][2]) const {
#pragma unroll
        for (int h = 0; h < 2; ++h)
#pragma unroll
            for (int i = 0; i < 2; ++i) vA[h][i] = (unsigned)permL[u.li * 256 + h * HALF + R[i]] * (unsigned)(K * 2) + (unsigned)(C[i] * 2);
    }
};
struct MoeDownSched : MoeSchedBase {
    static constexpr bool GATHER = false;
    const char* A; const char* Wdn; int kb;
    __device__ __forceinline__ bool next(int i, Unit& u) const {
        int rt, pn, e; if (!locate(i, rt, pn, e)) return false;
        u.pm = rt; u.pn = pn; u.a = A + (size_t)rt * BM * kb; u.b = Wdn + (size_t)e * 1024 * kb + (size_t)pn * BM * kb; u.li = i; u.ex = e; return true;
    }
    __device__ __forceinline__ void a_offsets(const Unit&, const int (&)[2], const int (&)[2], int, unsigned (&)[2][2]) const {}
};

template <bool HAS_BIAS> struct EpiBf16T {
    static constexpr bool PERM = true;
    bf16_t* O; int ldc; const float* bias;
    __device__ __forceinline__ void operator()(const f32x4 (&acc)[2][2][4][2], const Unit& u, int wr, int wc, int fr, int fq) const {
        const int row0 = u.pm * BM + wr * 64 + fr, col0 = u.pn * BM + wc * 32 + 8 * fq;
        f32x4 bv[2][2];
#pragma unroll
        for (int bj = 0; bj < 2; ++bj)
#pragma unroll
            for (int n = 0; n < 2; ++n) bv[bj][n] = HAS_BIAS ? *(const f32x4*)(bias + col0 + bj * HALF + 4 * n) : (f32x4){0.f, 0.f, 0.f, 0.f};
#pragma unroll
        for (int ai = 0; ai < 2; ++ai)
#pragma unroll
            for (int m = 0; m < 4; ++m) { bf16_t* rowp = O + (size_t)(row0 + ai * HALF + m * 16) * ldc + col0;
#pragma unroll
                for (int bj = 0; bj < 2; ++bj) { f32x4 v0 = acc[ai][bj][m][0], v1 = acc[ai][bj][m][1]; if constexpr (HAS_BIAS) { v0 += bv[bj][0]; v1 += bv[bj][1]; }
                    u32x4 w; w.x = cvt_pk_bf16(v0[0], v0[1]); w.y = cvt_pk_bf16(v0[2], v0[3]); w.z = cvt_pk_bf16(v1[0], v1[1]); w.w = cvt_pk_bf16(v1[2], v1[3]);
                    *(u32x4*)(rowp + bj * HALF) = w; } }
    }
};
typedef EpiBf16T<true> EpiBf16B; typedef EpiBf16T<false> EpiBf16;
struct EpiF8 {
    static constexpr bool PERM = true;
    unsigned char* O; int ldc;
    __device__ __forceinline__ void operator()(const f32x4 (&acc)[2][2][4][2], const Unit& u, int wr, int wc, int fr, int fq) const {
        const int row0 = u.pm * BM + wr * 64 + fr, col0 = u.pn * BM + wc * 32 + 8 * fq;
#pragma unroll
        for (int ai = 0; ai < 2; ++ai)
#pragma unroll
            for (int m = 0; m < 4; ++m) { unsigned char* rowp = O + (size_t)(row0 + ai * HALF + m * 16) * ldc + col0;
#pragma unroll
                for (int bj = 0; bj < 2; ++bj) { const f32x4 v0 = acc[ai][bj][m][0], v1 = acc[ai][bj][m][1];
                    *(unsigned long long*)(rowp + bj * HALF) = (unsigned long long)pk4_fp8(v0[0], v0[1], v0[2], v0[3]) | ((unsigned long long)pk4_fp8(v1[0], v1[1], v1[2], v1[3]) << 32); } }
    }
};
template <int MODE  , bool OUT8 = false  > struct EpiGated {
    static constexpr bool PERM = true;
    bf16_t* O; int ldc; const float* bias; int nch;
    __device__ __forceinline__ void operator()(const f32x4 (&acc)[2][2][4][2], const Unit& u, int wr, int wc, int fr, int fq) const {
        const int row0 = u.pm * BM + wr * 64 + fr, ch0 = u.pn * HALF + wc * 32 + 8 * fq;
        f32x4 b0[2], b1[2];
#pragma unroll
        for (int n = 0; n < 2; ++n) { if (MODE == 0) { b0[n] = *(const f32x4*)(bias + ch0 + 4 * n); b1[n] = *(const f32x4*)(bias + nch + ch0 + 4 * n); } else { b0[n] = (f32x4){0.f, 0.f, 0.f, 0.f}; b1[n] = b0[n]; } }
#pragma unroll
        for (int ai = 0; ai < 2; ++ai)
#pragma unroll
            for (int m = 0; m < 4; ++m) { bf16_t* rowp = O + (size_t)(row0 + ai * HALF + m * 16) * ldc + ch0; float o[8];
#pragma unroll
                for (int n = 0; n < 2; ++n) { const f32x4 x0 = acc[ai][0][m][n] + b0[n], x1 = acc[ai][1][m][n] + b1[n];
#pragma unroll
                    for (int e = 0; e < 4; ++e) o[4 * n + e] = (MODE == 0) ? x0[e] * fast_sigmoid(x1[e]) : (x0[e] * fast_sigmoid(x0[e])) * x1[e]; }
                if constexpr (OUT8) { unsigned char* rp8 = (unsigned char*)O + (size_t)(row0 + ai * HALF + m * 16) * ldc + ch0;
                    *(unsigned long long*)rp8 = (unsigned long long)pk4_fp8(o[0], o[1], o[2], o[3]) | ((unsigned long long)pk4_fp8(o[4], o[5], o[6], o[7]) << 32); }
                else { u32x4 w; w.x = cvt_pk_bf16(o[0], o[1]); w.y = cvt_pk_bf16(o[2], o[3]); w.z = cvt_pk_bf16(o[4], o[5]); w.w = cvt_pk_bf16(o[6], o[7]);
                    *(u32x4*)rowp = w; } }
    }
};
struct EpiQkv {
    static constexpr bool PERM = true;
    bf16_t* Q; bf16_t* Kh; bf16_t* Vb; float qscale;
    __device__ __forceinline__ void operator()(const f32x4 (&acc)[2][2][4][2], const Unit& u, int wr, int wc, int fr, int fq) const {
        const int which = u.pn >> 2; const bool isctx = u.pm >= 128;
        const int b = isctx ? (u.pm - 128) : (u.pm >> 4);
        const int key0 = isctx ? SEQ : ((u.pm & 15) << 8);
        const int d0 = 32 * (wc & 1) + 8 * fq;
#pragma unroll
        for (int ai = 0; ai < 2; ++ai)
#pragma unroll
            for (int m = 0; m < 4; ++m) { const int key = key0 + ai * HALF + wr * 64 + m * 16 + fr;
#pragma unroll
                for (int bj = 0; bj < 2; ++bj) { const int h = 4 * (u.pn & 3) + 2 * bj + (wc >> 1); const f32x4 v0 = acc[ai][bj][m][0], v1 = acc[ai][bj][m][1];
                    if (which == 2) {
                        bf16_t* p = Vb + ((size_t)(b * NH + h) * (KSLOT / 8) + (key >> 3)) * 512 + (size_t)d0 * 8 + (key & 7);
                        const unsigned w0 = cvt_pk_bf16(v0[0], v0[1]), w1 = cvt_pk_bf16(v0[2], v0[3]), w2 = cvt_pk_bf16(v1[0], v1[1]), w3 = cvt_pk_bf16(v1[2], v1[3]);
                        p[0] = (bf16_t)w0; p[8] = (bf16_t)(w0 >> 16); p[16] = (bf16_t)w1; p[24] = (bf16_t)(w1 >> 16); p[32] = (bf16_t)w2; p[40] = (bf16_t)(w2 >> 16); p[48] = (bf16_t)w3; p[56] = (bf16_t)(w3 >> 16);
                    } else {
                        const float qs = (which == 0) ? qscale : 1.0f; const f32x4 y0 = v0 * qs, y1 = v1 * qs;
                        u32x4 w; w.x = cvt_pk_bf16(y0[0], y0[1]); w.y = cvt_pk_bf16(y0[2], y0[3]); w.z = cvt_pk_bf16(y1[0], y1[1]); w.w = cvt_pk_bf16(y1[2], y1[3]);
                        bf16_t* p = (which == 0) ? Q + ((size_t)(b * NH + h) * SEQ + key) * HD + d0 : Kh + ((size_t)(b * NH + h) * KSLOT + key) * HD + d0;
                        *(u32x4*)p = w;
                    } } }
    }
};
}
#define XB_TMO      128
#define XB_XCNT(j)  (256  + 64 * (j))
#define XB_XSUB(j)  (1280 + 64 * (j))
#define XB_XGEN(j)  (2304 + 64 * (j))
#define XB_TOP      3328
#define XB_TOPGEN   3392
#define XCD_BAR_WORDS 3456
#define XB_SPIN_CAP (1u << 18)

__device__ __forceinline__ unsigned xb_ld(unsigned* p)              { return __hip_atomic_load(p, __ATOMIC_RELAXED, __HIP_MEMORY_SCOPE_AGENT); }
__device__ __forceinline__ unsigned xb_add(unsigned* p, unsigned v) { return __hip_atomic_fetch_add(p, v, __ATOMIC_RELAXED, __HIP_MEMORY_SCOPE_AGENT); }
__device__ __forceinline__ unsigned xb_xcc_id() { return (unsigned)__builtin_amdgcn_s_getreg((3 << 11) | 20) & 0xFu; }
#define XB_SPIN(cond, bar) do { unsigned _sp = 0; while (cond) { __builtin_amdgcn_s_sleep(1); \
    if ((++_sp & 255u) == 0u) { if (xb_ld(&(bar)[XB_TMO])) break; if (_sp > XB_SPIN_CAP) { atomicAdd(&(bar)[XB_TMO], 1u); break; } } } } while (0)

struct XcdBarrier {
    unsigned* bar; unsigned x;
    volatile LAS unsigned* st;
};

__device__ __forceinline__ XcdBarrier xcd_barrier_post(unsigned* bar, volatile LAS unsigned* st) {
    XcdBarrier b; b.bar = bar; b.x = xb_xcc_id(); b.st = st;
    if (threadIdx.x == 0) (void)xb_add(&bar[XB_XCNT(b.x)], 1u);
    return b;
}
__device__ __forceinline__ void xcd_barrier_complete(unsigned* bar, unsigned x, unsigned& nloc, unsigned& nx) {
    const unsigned G = gridDim.x * gridDim.y * gridDim.z;
    unsigned sum, cnt, mine, sp = 0u;
    for (;;) {
        sum = 0u; cnt = 0u; mine = 0u;
#pragma unroll
        for (unsigned j = 0; j < 16; ++j) { const unsigned c = xb_ld(&bar[XB_XCNT(j)]); sum += c; cnt += (c > 0u) ? 1u : 0u; mine = (j == x) ? c : mine; }
        if (sum == G) break;
        __builtin_amdgcn_s_sleep(1);
        if ((++sp & 255u) == 0u) { if (xb_ld(&bar[XB_TMO])) break; if (sp > XB_SPIN_CAP) { atomicAdd(&bar[XB_TMO], 1u); break; } }
    }
    nloc = mine > 0u ? mine : 1u; nx = cnt > 0u ? cnt : 1u;
}

__device__ __forceinline__ void xcd_barrier(const XcdBarrier& b) {
    asm volatile("s_waitcnt vmcnt(0)" ::: "memory");
    __syncthreads();
    if (threadIdx.x == 0) {
        unsigned* bar = b.bar;
        __builtin_amdgcn_s_waitcnt(0);
        unsigned nloc = b.st[0], nx = b.st[1];
        if (nloc == 0u) { xcd_barrier_complete(bar, b.x, nloc, nx); b.st[0] = nloc; b.st[1] = nx; }
        const unsigned old = xb_add(&bar[XB_XSUB(b.x)], 1u);
        const unsigned gen = old / nloc;
        if (old + 1u == (gen + 1u) * nloc) {
            __builtin_amdgcn_fence(__ATOMIC_RELEASE, "agent");
            asm volatile("s_waitcnt vmcnt(0)" ::: "memory");
            const unsigned og = xb_add(&bar[XB_TOP], 1u);
            const unsigned tg = og / nx;
            if (og + 1u == (tg + 1u) * nx) xb_add(&bar[XB_TOPGEN], 1u);
            else XB_SPIN(xb_ld(&bar[XB_TOPGEN]) == tg, bar);
            __builtin_amdgcn_fence(__ATOMIC_ACQUIRE, "agent");
            xb_add(&bar[XB_XGEN(b.x)], 1u);
            asm volatile("s_waitcnt vmcnt(0)" ::: "memory");
        } else {
            XB_SPIN(xb_ld(&bar[XB_XGEN(b.x)]) == gen, bar);
            __builtin_amdgcn_fence(__ATOMIC_ACQUIRE, "agent");
            asm volatile("s_waitcnt vmcnt(0)" ::: "memory");
        }
    }
    __syncthreads();
}

struct Frame {
    LAS unsigned char* lds;
    volatile LAS unsigned* MISC;
    gu32* ctl;
    int wave, G, bid;
    __device__ __forceinline__ const float* in(int k) const { const volatile LAS unsigned* t = (const volatile LAS unsigned*)(lds + PTAB_OFF) + 2 * k;
        const unsigned lo = __builtin_amdgcn_readfirstlane(t[0]), hi = __builtin_amdgcn_readfirstlane(t[1]); return (const float*)(const GAS float*)(((unsigned long long)hi << 32) | lo); }
    __device__ __forceinline__ int lane() const { return lane_id_asm(); }
    __device__ __forceinline__ int tid() const { return wave * 64 + lane_id_asm(); }
    unsigned char* ws;
    float* out;
};

__device__ __forceinline__ void ld_row_f32(const float* row, int lane, f32x4 (&v)[4]) {
    const f32x4* p = (const f32x4*)row + lane;
#pragma unroll
    for (int j = 0; j < 4; ++j) v[j] = p[64 * j];
}
__device__ __forceinline__ void st_row_f32(float* row, int lane, const f32x4 (&v)[4]) {
    f32x4* p = (f32x4*)row + lane;
#pragma unroll
    for (int j = 0; j < 4; ++j) p[64 * j] = v[j];
}
__device__ __forceinline__ void ld_row_bf16(const bf16* row, int lane, f32x4 (&v)[4]) {
    const v2u* p = (const v2u*)row + lane;
#pragma unroll
    for (int j = 0; j < 4; ++j) { const v2u w = p[64 * j]; v[j] = (f32x4){bflo(w.x), bfhi(w.x), bflo(w.y), bfhi(w.y)}; }
}
__device__ __forceinline__ void ld_raw_bf16(const bf16* row, int lane, v2u (&w)[4]) {
    const v2u* p = (const v2u*)row + lane;
#pragma unroll
    for (int j = 0; j < 4; ++j) w[j] = p[64 * j];
}
__device__ __forceinline__ void unpack_bf16(const v2u (&w)[4], f32x4 (&v)[4]) {
#pragma unroll
    for (int j = 0; j < 4; ++j) { const unsigned a = w[j].x, b = w[j].y; v[j] = (f32x4){bflo(a), bfhi(a), bflo(b), bfhi(b)}; }
}
__device__ __forceinline__ void ld_raw_fp8(const unsigned char* row, int lane, unsigned (&w)[4]) {
    const unsigned* p = (const unsigned*)row + lane;
#pragma unroll
    for (int j = 0; j < 4; ++j) w[j] = p[64 * j];
}
__device__ __forceinline__ void unpack_fp8(const unsigned (&w)[4], f32x4 (&v)[4]) {
    typedef float f2_t __attribute__((ext_vector_type(2)));
#pragma unroll
    for (int j = 0; j < 4; ++j) { const f2_t lo = __builtin_amdgcn_cvt_pk_f32_fp8((int)w[j], false), hi = __builtin_amdgcn_cvt_pk_f32_fp8((int)w[j], true); v[j] = (f32x4){lo[0], lo[1], hi[0], hi[1]}; }
}
__device__ __forceinline__ void st_row_bf16(bf16* row, int lane, const f32x4 (&v)[4]) {
    v2u* p = (v2u*)row + lane;
#pragma unroll
    for (int j = 0; j < 4; ++j) { v2u w; w.x = pk2(v[j][0], v[j][1]); w.y = pk2(v[j][2], v[j][3]); p[64 * j] = w; }
}
__device__ __forceinline__ void st_row_fp8(unsigned char* row, int lane, const f32x4 (&v)[4]) {
    unsigned* p = (unsigned*)row + lane;
#pragma unroll
    for (int j = 0; j < 4; ++j) p[64 * j] = pk4_fp8(v[j][0], v[j][1], v[j][2], v[j][3]);
}
__device__ __forceinline__ float sumsq4(const f32x4 (&v)[4]) {
    float s = 0.f;
#pragma unroll
    for (int j = 0; j < 4; ++j) s += (v[j][0] * v[j][0] + v[j][1] * v[j][1]) + (v[j][2] * v[j][2] + v[j][3] * v[j][3]);
    return s;
}
__device__ __forceinline__ void ld_mod(const Frame& F, int l, int r, int ch, f32x4 (&v)[4]) {
    const float* modp = (const float*)(F.ws + WS_MODP); const int lane = F.lane();
    ld_row_f32(F.in(5) + (size_t)l * NMODC + ch * D, lane, v);
#pragma unroll
    for (int kc = 0; kc < MODKC; ++kc) { f32x4 t[4]; ld_row_f32(modp + ((size_t)((kc * 2 + l) * NMODR + r)) * NMODC + ch * D, lane, t);
#pragma unroll
        for (int j = 0; j < 4; ++j) v[j] += t[j]; }
}
__device__ __forceinline__ int row_batch(int m) { return m < NLAT ? (m >> 12) : 8; }

__device__ __forceinline__ void p0_transpose_item(const float* W, int K, int N, bf16* WT, int drow_off, LAS float* scr, int item, int lane) {
    const int nblk = N / 32, kb = item / nblk, nb = item % nblk, k0 = 64 * kb, n0 = 32 * nb;
#pragma unroll 8
    for (int i = 0; i < 32; ++i) { const int kk = 2 * i + (lane >> 5); scr[kk * 33 + (lane & 31)] = W[(size_t)(k0 + kk) * N + n0 + (lane & 31)]; }
    LDS_WAIT(); asm volatile("" ::: "memory");
    const int c = lane & 7;
#pragma unroll
    for (int j = 0; j < 4; ++j) { const int n = (lane >> 3) + 8 * j; const LAS float* s = scr + (8 * c) * 33 + n;
        v4u o; o.x = pk2(s[0 * 33], s[1 * 33]); o.y = pk2(s[2 * 33], s[3 * 33]); o.z = pk2(s[4 * 33], s[5 * 33]); o.w = pk2(s[6 * 33], s[7 * 33]);
        *(GAS v4u*)(WT + (size_t)(drow_off + n0 + n) * K + k0 + 8 * c) = o; }
    LDS_WAIT(); asm volatile("" ::: "memory");
}
__device__ __forceinline__ void p0_transpose_item_fp8(const float* W, int K, int N, unsigned char* WT, int drow_off, float wscale, LAS float* scr, int item, int lane) {
    const int nblk = N / 32, kb = item / nblk, nb = item % nblk, k0 = 64 * kb, n0 = 32 * nb;
#pragma unroll 8
    for (int i = 0; i < 32; ++i) { const int kk = 2 * i + (lane >> 5); scr[kk * 33 + (lane & 31)] = W[(size_t)(k0 + kk) * N + n0 + (lane & 31)] * wscale; }
    LDS_WAIT(); asm volatile("" ::: "memory");
    const int c = lane & 3;
#pragma unroll
    for (int j = 0; j < 2; ++j) { const int n = (lane >> 2) + 16 * j; const LAS float* s = scr + (16 * c) * 33 + n;
        v4u o; o.x = pk4_fp8(s[0 * 33], s[1 * 33], s[2 * 33], s[3 * 33]); o.y = pk4_fp8(s[4 * 33], s[5 * 33], s[6 * 33], s[7 * 33]);
        o.z = pk4_fp8(s[8 * 33], s[9 * 33], s[10 * 33], s[11 * 33]); o.w = pk4_fp8(s[12 * 33], s[13 * 33], s[14 * 33], s[15 * 33]);
        *(GAS v4u*)(WT + (size_t)(drow_off + n0 + n) * K + k0 + 16 * c) = o; }
    LDS_WAIT(); asm volatile("" ::: "memory");
}
constexpr float W8SCALE = 64.0f;
constexpr int I_WIN = 1024, I_WOUT = 512, I_WQKV = 1536, I_WO = 512, I_EXP = 32 * 768, NITEMS_P0 = I_WIN + I_WOUT + I_WQKV + I_WO + I_EXP;
__device__ __forceinline__ void p0_item(const Frame& F, LAS float* scr, int it) {
    int r = it; const int lane = F.lane();
    if (r < I_WIN) { const int n0 = 32 * (r % 64), ch = n0 & 1023, hf = n0 >> 10, drow0 = 256 * (ch >> 7) + 128 * hf + (ch & 127);
        p0_transpose_item_fp8(F.in(10), D, 2 * D, (unsigned char*)(F.ws + WS_WIN), drow0 - n0, W8SCALE, scr, r, lane); return; }
    r -= I_WIN;
    if (r < I_WOUT) { p0_transpose_item(F.in(16), D, D, (bf16*)(F.ws + WS_WOUT), 0, scr, r, lane); return; }
    r -= I_WOUT;
    if (r < I_WQKV) { p0_transpose_item_fp8(F.in(18), D, 3 * D, (unsigned char*)(F.ws + WS_WQKV), 0, W8SCALE, scr, r, lane); return; }
    r -= I_WQKV;
    if (r < I_WO) { p0_transpose_item(F.in(19), D, D, (bf16*)(F.ws + WS_WO), 0, scr, r, lane); return; }
    r -= I_WO;
    const int le = r / 768; int q = r % 768;
    if (q < 512) { const bool up = q >= 256; if (up) q -= 256; const int n0 = 32 * (q % 16), drow0 = 256 * (n0 >> 7) + (up ? 128 : 0) + (n0 & 127);
        p0_transpose_item_fp8((up ? F.in(24) : F.in(23)) + (size_t)le * D * DE, D, DE, (unsigned char*)(F.ws + WS_WGU) + (size_t)le * 1024 * 1024, drow0 - n0, W8SCALE, scr, q, lane); return; }
    q -= 512;
    p0_transpose_item_fp8(F.in(25) + (size_t)le * DE * D, DE, D, (unsigned char*)(F.ws + WS_WDN) + (size_t)le * 1024 * 512, 0, W8SCALE, scr, q, lane);
}
__device__ __forceinline__ void p0_mod_item(const Frame& F, LAS float* scr, int it) {
    const int lane = F.lane(), l = it / 192, rem = it % 192, cg = rem >> 3, kc = rem & 7, k0 = 128 * kc, n0 = 256 * cg + 4 * lane;
    const float* cvec = F.in(1); const float* cctx = F.in(3);
    for (int idx = lane; idx < NMODR * 128; idx += 64) { const int r = idx >> 7, kk = idx & 127; const float cv = (r < 8) ? cvec[r * D + k0 + kk] : cctx[k0 + kk];
        scr[idx] = cv / (1.0f + __expf(-cv)); }
    LDS_WAIT(); asm volatile("" ::: "memory");
    f32x4 acc[NMODR];
#pragma unroll
    for (int r = 0; r < NMODR; ++r) acc[r] = (f32x4){0.f, 0.f, 0.f, 0.f};
    const float* wp = F.in(4) + ((size_t)l * D + k0) * NMODC + n0;
#pragma unroll 8
    for (int kk = 0; kk < 128; ++kk) { const f32x4 w = *(const f32x4*)(wp + (size_t)kk * NMODC);
#pragma unroll
        for (int r = 0; r < NMODR; ++r) { const float s = scr[r * 128 + kk]; acc[r] += w * s; } }
    float* modp = (float*)(F.ws + WS_MODP);
#pragma unroll
    for (int r = 0; r < NMODR; ++r) *(f32x4*)(modp + ((size_t)((kc * 2 + l) * NMODR + r)) * NMODC + n0) = acc[r];
    LDS_WAIT(); asm volatile("" ::: "memory");
}
__device__ __forceinline__ void p0_prologue(const Frame& F) {
    LAS float* scr = (LAS float*)(F.lds + F.wave * 16384);
    if (F.wave == 0) p0_mod_item(F, scr, F.bid);
    if (F.wave == 1 && F.bid < 128) p0_mod_item(F, scr, 256 + F.bid);
    const int gw = F.bid * NWAVES + F.wave, NGW = F.G * NWAVES;
    for (int it = gw; it < NITEMS_P0; it += NGW) p0_item(F, scr, it);
}

__device__ __forceinline__ void p1_modulate(const Frame& F) {
    constexpr int RPB = MT / 256;
    unsigned char* H = (unsigned char*)(F.ws + WS_A);
    int rc = -1; f32x4 gs[4], sh[4]; const int lane = F.lane();
    const float* xlat = F.in(0); const float* xctx = F.in(2);
    f32x4 vn[4];
    { const int m = F.bid * RPB + F.wave; ld_row_f32(m < NLAT ? xlat + (size_t)m * D : xctx + (size_t)(m - NLAT) * D, lane, vn); }
    for (int rl = F.wave; rl < RPB; rl += NWAVES) {
        const int m = F.bid * RPB + rl, r = row_batch(m);
        f32x4 v[4];
#pragma unroll
        for (int j = 0; j < 4; ++j) v[j] = vn[j];
        if (rl + NWAVES < RPB) { const int m2 = m + NWAVES; ld_row_f32(m2 < NLAT ? xlat + (size_t)m2 * D : xctx + (size_t)(m2 - NLAT) * D, lane, vn); }
        if (r != rc) { f32x4 g[4], sc[4]; ld_row_f32(F.in(6), lane, g); ld_mod(F, 0, r, 1, sc); ld_mod(F, 0, r, 0, sh);
#pragma unroll
            for (int j = 0; j < 4; ++j) gs[j] = g[j] * (sc[j] + 1.0f);
            rc = r; }
        const float rstd = 1.0f / sqrtf(wave_sum(sumsq4(v)) * (1.0f / D) + EPS);
#pragma unroll
        for (int j = 0; j < 4; ++j) v[j] = v[j] * rstd * gs[j] + sh[j];
        st_row_fp8(H + (size_t)m * D, lane, v);
    }
}

__device__ __forceinline__ void p3_conv(const Frame& F) {
    const bf16* U = (const bf16*)(F.ws + WS_B); bf16* V = (bf16*)(F.ws + WS_A);
    const int tid = F.tid(), lane = F.lane();
    f32x2 w[CONVW]; const float* wdw = F.in(12);
#pragma unroll
    for (int j = 0; j < CONVW; ++j) w[j] = *(const f32x2*)(wdw + j * D + 2 * tid);
    const f32x2 bias2 = *(const f32x2*)(F.in(13) + 2 * tid);
    f32x4 lg[4], lb[4]; ld_row_f32(F.in(14), lane, lg); ld_row_f32(F.in(15), lane, lb);
    constexpr int TT = 32, NIN = TT + CONVW - 1;
    for (int tile = F.bid; tile < MT / TT; tile += F.G) {
        int rowbase, t0, T;
        if (tile < NLAT / TT) { rowbase = (tile >> 7) * SEQ; t0 = (tile & 127) * TT; T = SEQ; } else { const int t2 = tile - NLAT / TT; rowbase = NLAT + (t2 >> 3) * CTXL; t0 = (t2 & 7) * TT; T = CTXL; }
        for (int p = tid; p < NIN * 128; p += NTHR) { const int i = p >> 7, cp = p & 127, t = t0 - 15 + i;
            v4u val = (v4u){0u, 0u, 0u, 0u}; if (t >= 0 && t < T) val = *(const v4u*)(U + (size_t)(rowbase + t) * D + cp * 8);
            *(LAS v4u*)(F.lds + i * 2048 + cp * 16) = val; }
        __syncthreads();
        f32x2 res[TT];
#pragma unroll
        for (int g = 0; g < TT / 8; ++g) {
            f32x2 acc[8];
#pragma unroll
            for (int q = 0; q < 8; ++q) acc[q] = bias2;
#pragma unroll
            for (int ii = 0; ii < 8 + CONVW - 1; ++ii) { const int i = 8 * g + ii; const unsigned uw = *(const LAS unsigned*)(F.lds + i * 2048 + tid * 4); const f32x2 uv = (f32x2){bflo(uw), bfhi(uw)};
#pragma unroll
                for (int q = 0; q < 8; ++q) { const int j = ii - q; if (j >= 0 && j < CONVW) acc[q] += w[j] * uv; } }
#pragma unroll
            for (int q = 0; q < 8; ++q) res[8 * g + q] = acc[q];
        }
        __syncthreads();
#pragma unroll
        for (int tt = 0; tt < TT; ++tt) *(LAS f32x2*)(F.lds + tt * 4096 + tid * 8) = res[tt];
        __syncthreads();
#pragma unroll
        for (int q = 0; q < 4; ++q) { const int tt = 4 * F.wave + q; f32x4 v[4];
#pragma unroll
            for (int j = 0; j < 4; ++j) v[j] = *(const LAS f32x4*)(F.lds + tt * 4096 + j * 1024 + lane * 16);
            float s = 0.f;
#pragma unroll
            for (int j = 0; j < 4; ++j) s += (v[j][0] + v[j][1]) + (v[j][2] + v[j][3]);
            const float mean = wave_sum(s) * (1.0f / D);
#pragma unroll
            for (int j = 0; j < 4; ++j) v[j] = v[j] - mean;
            const float rstd = 1.0f / sqrtf(wave_sum(sumsq4(v)) * (1.0f / D) + EPS);
#pragma unroll
            for (int j = 0; j < 4; ++j) { f32x4 y = v[j] * rstd * lg[j] + lb[j];
#pragma unroll
                for (int e = 0; e < 4; ++e) y[e] = y[e] / (1.0f + __expf(-y[e]));
                v[j] = y; }
            st_row_bf16(V + (size_t)(rowbase + t0 + tt) * D, lane, v); }
        __syncthreads();
    }
}

constexpr int RW_OFF = 0, RW_BYTES = 256 * 272;
constexpr int REC_OFF = 72 * 1024;
constexpr int LRK_OFF = REC_OFF + 4096;
constexpr int BASE_OFF = LRK_OFF + 2048;
template <int L>
__device__ __forceinline__ void p_emid(const Frame& F) {
    constexpr int NROWS = (L == 0) ? MT : NLAT, RPB = NROWS / 256;
    const bf16* Y = (const bf16*)(F.ws + (L == 0 ? WS_B : WS_C)); unsigned char* TOK = (unsigned char*)(F.ws + WS_A);
    bf16* XS = (bf16*)(F.ws + WS_B);
    float* XC = (float*)(F.ws + WS_XC);
    const int tid = F.tid(), lane = F.lane(), m0 = F.bid * RPB;
    const float* rwG = F.in(21);
    for (int idx = tid; idx < 4096; idx += NTHR) { const int k = idx >> 2, ep = idx & 3; const f32x4 v = *(const f32x4*)(rwG + k * 16 + ep * 4);
        *(LAS f32x4*)(F.lds + RW_OFF + (k >> 2) * 272 + (k & 3) * 64 + ep * 16) = v; }
    __syncthreads();
    float rb[16];
    { const float* rbG = F.in(22);
#pragma unroll
    for (int e = 0; e < 16; ++e) rb[e] = rbG[e]; }
    int rc = -1; f32x4 ga[4], gp[4], gs[4], sh[4];
    const float* xlat = F.in(0); const float* xctx = F.in(2);
    v2u yn[4]; f32x4 xn[4];
    v2u xbn[4];
    { const int m = m0 + F.wave; ld_raw_bf16(Y + (size_t)m * D, lane, yn);
      if (L == 0) ld_row_f32(m < NLAT ? xlat + (size_t)m * D : xctx + (size_t)(m - NLAT) * D, lane, xn); else ld_raw_bf16(XS + (size_t)m * D, lane, xbn); }
    for (int rl = F.wave; rl < RPB; rl += NWAVES) {
        const int m = m0 + rl, r = row_batch(m);
        f32x4 y[4], xv[4];
        unpack_bf16(yn, y);
        if (L == 0) {
#pragma unroll
            for (int j = 0; j < 4; ++j) xv[j] = xn[j];
        } else unpack_bf16(xbn, xv);
        if (rl + NWAVES < RPB) { const int m2 = m + NWAVES; ld_raw_bf16(Y + (size_t)m2 * D, lane, yn);
            if (L == 0) ld_row_f32(m2 < NLAT ? xlat + (size_t)m2 * D : xctx + (size_t)(m2 - NLAT) * D, lane, xn); else ld_raw_bf16(XS + (size_t)m2 * D, lane, xbn); }
        if (r != rc) { f32x4 g[4], sc[4]; ld_mod(F, L, r, 2, ga); ld_row_f32(F.in(7) + L * D, lane, gp); ld_row_f32(F.in(8) + L * D, lane, g); ld_mod(F, L, r, 4, sc); ld_mod(F, L, r, 3, sh);
#pragma unroll
            for (int j = 0; j < 4; ++j) gs[j] = g[j] * (sc[j] + 1.0f);
            rc = r; }
        const float rstdy = 1.0f / sqrtf(wave_sum(sumsq4(y)) * (1.0f / D) + EPS);
#pragma unroll
        for (int j = 0; j < 4; ++j) xv[j] = xv[j] + ga[j] * (y[j] * rstdy * gp[j]) * (((DBG_SKIP >> (2 * L)) & 1) ? 0.f : 1.f);
        if (m < NLAT) st_row_bf16(XS + (size_t)m * D, lane, xv); else st_row_f32(XC + (size_t)(m - NLAT) * D, lane, xv);
        const float rstd1 = 1.0f / sqrtf(wave_sum(sumsq4(xv)) * (1.0f / D) + EPS);
#pragma unroll
        for (int j = 0; j < 4; ++j) xv[j] = xv[j] * rstd1 * gs[j] + sh[j];
        st_row_fp8(TOK + (size_t)m * D, lane, xv);
        float a[16];
#pragma unroll
        for (int e = 0; e < 16; ++e) a[e] = 0.f;
#pragma unroll
        for (int j = 0; j < 4; ++j)
#pragma unroll
            for (int i = 0; i < 4; ++i) { const float tv = xv[j][i]; const LAS f32x4* wp = (const LAS f32x4*)(F.lds + RW_OFF + (64 * j + lane) * 272 + i * 64);
#pragma unroll
                for (int ep = 0; ep < 4; ++ep) { const f32x4 wv = wp[ep];
#pragma unroll
                    for (int cc = 0; cc < 4; ++cc) a[4 * ep + cc] += tv * wv[cc]; } }
        float k8[8], k4[4];
#pragma unroll
        for (int i = 0; i < 8; ++i) { const auto rr = __builtin_amdgcn_permlane32_swap(__builtin_bit_cast(unsigned, a[i]), __builtin_bit_cast(unsigned, a[8 + i]), false, false);
            const unsigned r0_ = rr[0], r1_ = rr[1]; k8[i] = __uint_as_float(r0_) + __uint_as_float(r1_); }
#pragma unroll
        for (int i = 0; i < 4; ++i) { const auto rr = __builtin_amdgcn_permlane16_swap(__builtin_bit_cast(unsigned, k8[i]), __builtin_bit_cast(unsigned, k8[4 + i]), false, false);
            const unsigned r0_ = rr[0], r1_ = rr[1]; k4[i] = row16_sum(__uint_as_float(r0_) + __uint_as_float(r1_)); }
        float s[16], ss[16];
        const float lgsel = (lane & 2) ? ((lane & 1) ? k4[3] : k4[2]) : ((lane & 1) ? k4[1] : k4[0]);
        const float sgl = 1.0f / (1.0f + __expf(-lgsel));
#pragma unroll
        for (int e = 0; e < 16; ++e) { s[e] = rdlane(sgl, 16 * (e >> 2) + (e & 3)); ss[e] = s[e] + rb[e]; }
        float gsc[4]; int i0[4], i1[4];
#pragma unroll
        for (int g = 0; g < 4; ++g) { int a0 = 0; float mx = ss[4 * g];
#pragma unroll
            for (int i = 1; i < 4; ++i) if (ss[4 * g + i] > mx) { mx = ss[4 * g + i]; a0 = i; }
            int b0 = -1; float m2 = -3.0e38f;
#pragma unroll
            for (int i = 0; i < 4; ++i) if (i != a0 && ss[4 * g + i] > m2) { m2 = ss[4 * g + i]; b0 = i; }
            gsc[g] = mx + m2; i0[g] = 4 * g + a0; i1[g] = 4 * g + b0; }
        int gst = 0; float gm = gsc[0];
#pragma unroll
        for (int g = 1; g < 4; ++g) if (gsc[g] > gm) { gm = gsc[g]; gst = g; }
        int e0 = i0[0], e1 = i1[0];
#pragma unroll
        for (int g = 1; g < 4; ++g) if (gst == g) { e0 = i0[g]; e1 = i1[g]; }
        float w0 = 0.f, w1 = 0.f;
#pragma unroll
        for (int e = 0; e < 16; ++e) { if (e == e0) w0 = s[e]; if (e == e1) w1 = s[e]; }
        const float inv = 1.0f / (w0 + w1); w0 *= inv; w1 *= inv;
        if (lane == 0) *(LAS v4u*)(F.lds + REC_OFF + rl * 16) = (v4u){(unsigned)e0, (unsigned)e1, __builtin_bit_cast(unsigned, w0), __builtin_bit_cast(unsigned, w1)};
    }
    __syncthreads();
    if (F.wave == 0 && lane < 16) {
        int cntl = 0;
        for (int rl = 0; rl < RPB; ++rl) { const v4u rec = *(const LAS v4u*)(F.lds + REC_OFF + rl * 16);
            if ((int)rec.x == lane) { *(LAS int*)(F.lds + LRK_OFF + rl * 8) = cntl; ++cntl; }
            if ((int)rec.y == lane) { *(LAS int*)(F.lds + LRK_OFF + rl * 8 + 4) = cntl; ++cntl; } }
        const unsigned base = __hip_atomic_fetch_add((unsigned*)(F.ctl + CW_CNT + (L * 16 + lane) * 64), (unsigned)cntl, RLX_AGENT);
        *(LAS int*)(F.lds + BASE_OFF + lane * 4) = (int)base;
    }
    __syncthreads();
    int* perm2 = (int*)(F.ws + WS_PERM); v2u* slot = (v2u*)(F.ws + WS_SLOT);
    for (int idx = tid; idx < RPB * 2; idx += NTHR) { const int rl = idx >> 1, k = idx & 1; const v4u rec = *(const LAS v4u*)(F.lds + REC_OFF + rl * 16);
        const int e = k ? (int)rec.y : (int)rec.x; const unsigned wb = k ? rec.w : rec.z;
        const int rank = *(const LAS int*)(F.lds + BASE_OFF + e * 4) + *(const LAS int*)(F.lds + LRK_OFF + rl * 8 + k * 4);
        const int m = m0 + rl;
        perm2[(size_t)e * MT + rank] = m;
        slot[(size_t)m * 2 + k] = (v2u){((unsigned)e << 24) | (unsigned)rank, wb}; }
    __syncthreads();
}

__device__ __forceinline__ void moe_setup(const Frame& F, int L) {
    const int tid = F.tid();
    if (tid < 16) F.MISC[40 + tid] = __hip_atomic_load((unsigned*)(F.ctl + CW_CNT + (L * 16 + tid) * 64), RLX_AGENT);
    __syncthreads();
    if (tid == 0) { unsigned p = 0; for (int e = 0; e < 16; ++e) { F.MISC[16 + e] = p; p += (F.MISC[40 + e] + 255u) >> 8; } F.MISC[32] = p; }
    __syncthreads();
}
__device__ __forceinline__ void moe_stage_perm(const Frame& F) {
    const int* perm2 = (const int*)(F.ws + WS_PERM); LAS int* permL = (LAS int*)(F.lds + PERML_OFF);
    const int ntile = (int)F.MISC[32], tid = F.tid();
    for (int i = 0; i < 8; ++i) { const int Lu = i * F.G + F.bid; if (Lu >= 4 * ntile) break;
        const int rt = Lu >> 2; int e = 0;
        for (int j = 1; j < 16; ++j) e += (rt >= (int)F.MISC[16 + j]) ? 1 : 0;
        if (tid < 256) { const int rank = (rt - (int)F.MISC[16 + e]) * 256 + tid; permL[i * 256 + tid] = (rank < (int)F.MISC[40 + e]) ? perm2[(size_t)e * MT + rank] : 0; } }
    __syncthreads();
}

template <int L>
__device__ __forceinline__ void p_epost(const Frame& F) {
    constexpr int NROWS = (L == 0) ? MT : NLAT, RPB = NROWS / 256;
    const unsigned char* FB = (const unsigned char*)(F.ws + WS_D2); unsigned char* H = (unsigned char*)(F.ws + WS_A);
    float* XC = (float*)(F.ws + WS_XC); const v2u* slot = (const v2u*)(F.ws + WS_SLOT);
    const int lane = F.lane(), m0 = F.bid * RPB;
    int rc = -1; f32x4 ga[4], gp[4], gs[4], sh[4];
    v4u sl_n2 = (v4u){0u, 0u, 0u, 0u}; unsigned f0n[4], f1n[4]; v2u xbn[4]; f32x4 xn[4]; float w0n, w1n;
    bf16* XS = (bf16*)(F.ws + WS_B);
#define EP_ISSUE(mm, slv) do { const unsigned sx0 = __builtin_amdgcn_readfirstlane((slv).x), sy0 = __builtin_amdgcn_readfirstlane((slv).y), sx1 = __builtin_amdgcn_readfirstlane((slv).z), sy1 = __builtin_amdgcn_readfirstlane((slv).w); \
        const size_t v0_ = (size_t)F.MISC[16 + (sx0 >> 24)] * 256 + (sx0 & 0xffffffu), v1_ = (size_t)F.MISC[16 + (sx1 >> 24)] * 256 + (sx1 & 0xffffffu); \
        w0n = __uint_as_float(sy0); w1n = __uint_as_float(sy1); ld_raw_fp8(FB + v0_ * D, lane, f0n); ld_raw_fp8(FB + v1_ * D, lane, f1n); \
        if ((mm) < NLAT) ld_raw_bf16(XS + (size_t)(mm) * D, lane, xbn); else ld_row_f32(XC + (size_t)((mm) - NLAT) * D, lane, xn); } while (0)
    { const int m = m0 + F.wave; const v4u sl0 = *(const v4u*)(slot + (size_t)m * 2);
      if (F.wave + NWAVES < RPB) sl_n2 = *(const v4u*)(slot + (size_t)(m + NWAVES) * 2);
      EP_ISSUE(m, sl0); }
    for (int rl = F.wave; rl < RPB; rl += NWAVES) {
        const int m = m0 + rl, r = row_batch(m);
        f32x4 f0[4], f1[4], xv[4]; const float w0 = w0n, w1 = w1n;
        unpack_fp8(f0n, f0); unpack_fp8(f1n, f1);
        if (m < NLAT) unpack_bf16(xbn, xv); else {
#pragma unroll
            for (int j = 0; j < 4; ++j) xv[j] = xn[j]; }
        if (rl + NWAVES < RPB) { const v4u slc = sl_n2; if (rl + 2 * NWAVES < RPB) sl_n2 = *(const v4u*)(slot + (size_t)(m + 2 * NWAVES) * 2); EP_ISSUE(m + NWAVES, slc); }
        if (r != rc) { ld_mod(F, L, r, 5, ga); ld_row_f32(F.in(9) + L * D, lane, gp);
            if (L == 0) { f32x4 g[4], sc[4]; ld_row_f32(F.in(6) + D, lane, g); ld_mod(F, 1, r, 1, sc); ld_mod(F, 1, r, 0, sh);
#pragma unroll
                for (int j = 0; j < 4; ++j) gs[j] = g[j] * (sc[j] + 1.0f); }
            rc = r; }
#pragma unroll
        for (int j = 0; j < 4; ++j) f0[j] = (DBG_SLOT == 1) ? f0[j] : (DBG_SLOT == 2) ? f1[j] : (DBG_SLOT == 3) ? f0[j] * 0.5f + f1[j] * 0.5f : f0[j] * w0 + f1[j] * w1;
        const float rstdf = 1.0f / sqrtf(wave_sum(sumsq4(f0)) * (1.0f / D) + EPS);
#pragma unroll
        for (int j = 0; j < 4; ++j) xv[j] = xv[j] + ga[j] * (f0[j] * rstdf * gp[j]) * (((DBG_SKIP >> (2 * L + 1)) & 1) ? 0.f : 1.f);
        if (L == 1) st_row_f32(F.out + (size_t)m * D, lane, xv);
        else if (m < NLAT) st_row_bf16(XS + (size_t)m * D, lane, xv); else st_row_f32(XC + (size_t)(m - NLAT) * D, lane, xv);
        if (L == 0) {
            const float rstd2 = 1.0f / sqrtf(wave_sum(sumsq4(xv)) * (1.0f / D) + EPS);
#pragma unroll
            for (int j = 0; j < 4; ++j) xv[j] = xv[j] * rstd2 * gs[j] + sh[j];
            st_row_fp8(H + (size_t)m * D, lane, xv);
        }
    }
#undef EP_ISSUE
}

constexpr int AT_CK = 0, AT_CV = 32768, AT_RPB = 65536;
constexpr float LOG2E = 1.4426950408889634f;
__device__ __forceinline__ float xrow_max(float m) {
    { const auto rr = __builtin_amdgcn_permlane16_swap(__builtin_bit_cast(unsigned, m), __builtin_bit_cast(unsigned, m), false, false); const unsigned a_ = rr[0], b_ = rr[1]; m = fmaxf(__uint_as_float(a_), __uint_as_float(b_)); }
    { const auto rr = __builtin_amdgcn_permlane32_swap(__builtin_bit_cast(unsigned, m), __builtin_bit_cast(unsigned, m), false, false); const unsigned a_ = rr[0], b_ = rr[1]; m = fmaxf(__uint_as_float(a_), __uint_as_float(b_)); }
    return m;
}
__device__ __forceinline__ float xrow_sum(float m) {
    { const auto rr = __builtin_amdgcn_permlane16_swap(__builtin_bit_cast(unsigned, m), __builtin_bit_cast(unsigned, m), false, false); const unsigned a_ = rr[0], b_ = rr[1]; m = __uint_as_float(a_) + __uint_as_float(b_); }
    { const auto rr = __builtin_amdgcn_permlane32_swap(__builtin_bit_cast(unsigned, m), __builtin_bit_cast(unsigned, m), false, false); const unsigned a_ = rr[0], b_ = rr[1]; m = __uint_as_float(a_) + __uint_as_float(b_); }
    return m;
}
__device__ __forceinline__ void attn_softmax(f32x4 (&s)[4], float& mrun, float& lsum, f32x4 (&o)[4], bf16x8 (&pf)[2]) {
    float mx = mrun;
#pragma unroll
    for (int t = 0; t < 4; ++t) mx = fmaxf(fmaxf(mx, fmaxf(s[t][0], s[t][1])), fmaxf(s[t][2], s[t][3]));
    mx = xrow_max(mx);
    const float alpha = __builtin_amdgcn_exp2f(mrun - mx);
    mrun = mx; lsum *= alpha;
#pragma unroll
    for (int db = 0; db < 4; ++db) o[db] = o[db] * alpha;
#pragma unroll
    for (int t = 0; t < 4; ++t)
#pragma unroll
        for (int i = 0; i < 4; ++i) { const float p = __builtin_amdgcn_exp2f(s[t][i] - mx); s[t][i] = p; lsum += p; }
#pragma unroll
    for (int bb = 0; bb < 2; ++bb) { v4u pw; pw.x = pg8::cvt_pk_bf16(s[2 * bb][0], s[2 * bb][1]); pw.y = pg8::cvt_pk_bf16(s[2 * bb][2], s[2 * bb][3]);
        pw.z = pg8::cvt_pk_bf16(s[2 * bb + 1][0], s[2 * bb + 1][1]); pw.w = pg8::cvt_pk_bf16(s[2 * bb + 1][2], s[2 * bb + 1][3]); pf[bb] = __builtin_bit_cast(bf16x8, pw); }
}
__device__ __forceinline__ void p10_attn(const Frame& F) {
    const bf16* Qh = (const bf16*)F.out; const bf16* Kh = (const bf16*)(F.ws + WS_C); const bf16* Vb = (const bf16*)(F.ws + WS_D2); bf16* O = (bf16*)(F.ws + WS_A);
    const int lane = F.lane(), tid = F.wave * 64 + lane, qi = lane & 15, q4 = lane >> 4;
    const int per = (BATCH * NH * GROWS * 4) / F.G;
    const int bh = (F.bid * per) >> 8, h = bh & 15, b = bh >> 4;
    const bf16* Kbh = Kh + (size_t)bh * KSLOT * HD; const bf16* Vbh = Vb + (size_t)bh * (KSLOT / 8) * 512;
#pragma unroll
    for (int i = 0; i < 4; ++i) { const int kf = F.wave * 4 + i, blk = kf >> 2, tl = (kf >> 1) & 1, dh = kf & 1;
        const v4u kv = *(const v4u*)(Kbh + (size_t)(SEQ + 32 * blk + 8 * (qi >> 2) + 4 * tl + (qi & 3)) * HD + dh * 32 + 8 * q4);
        const int vblk = kf >> 2, db = kf & 3;
        const v4u vv = *(const v4u*)(Vbh + (size_t)(SEQ / 8 + 4 * vblk + q4) * 512 + (db * 16 + qi) * 8);
        *(LAS v4u*)(F.lds + AT_CK + kf * 1024 + lane * 16) = kv; *(LAS v4u*)(F.lds + AT_CV + kf * 1024 + lane * 16) = vv; }
    { const float* rpbG = F.in(20) + h * 465; LAS float* rpbW = (LAS float*)(F.lds + AT_RPB);
        for (int idx = tid; idx < 15 * 32; idx += NTHR) { const int ri = idx >> 5, ci = idx & 31; rpbW[idx] = (ci < 31) ? rpbG[ri * 31 + ci] * LOG2E : -1.0e30f; } }
    __syncthreads();
    const int seg = F.wave & 3;
    const int cb = (seg == 0) ? 0 : (seg == 1) ? 8 : (seg == 2) ? 24 : 32;
    const int qc = 16 * seg + qi, cs = min(max(qc - WINW / 2, 0), GRIDW - WINW);
    int coff[2][4];
#pragma unroll
    for (int tl = 0; tl < 2; ++tl)
#pragma unroll
        for (int i = 0; i < 4; ++i) { const int kc = cb + 8 * q4 + 4 * tl + i; const bool ok = (kc >= cs) && (kc < cs + WINW); coff[tl][i] = AT_RPB + 4 * (ok ? (kc - qc + (WINW - 1)) : 31); }
    for (int it = 0; it < per; it += NWAVES) {
        const int wu = F.bid * per + it + F.wave;
        const int r = (wu >> 2) & 63;
        const int r0 = min(max(r - WINH / 2, 0), GROWS - WINH);
        const bf16* Qp = Qh + ((size_t)bh * SEQ + r * GRIDW + qc) * HD;
        const bf16x8 qf0 = *(const bf16x8*)(Qp + 8 * q4), qf1 = *(const bf16x8*)(Qp + 32 + 8 * q4);
        const bf16* kp0 = Kbh + (size_t)(r0 * GRIDW + cb + 8 * (qi >> 2) + (qi & 3)) * HD + 8 * q4;
        const bf16* vp0 = Vbh + (size_t)((r0 * GRIDW + cb) / 8 + q4) * 512 + qi * 8;
        int boff[2][4];
#pragma unroll
        for (int tl = 0; tl < 2; ++tl)
#pragma unroll
            for (int i = 0; i < 4; ++i) boff[tl][i] = coff[tl][i] + (r0 - r + (WINH - 1)) * 128;
        bf16x8 kw[4][2][2][2], vw[4][2][4];
#define AT_LOADK(g) do { _Pragma("unroll") for (int bb = 0; bb < 2; ++bb) _Pragma("unroll") for (int tl = 0; tl < 2; ++tl) { \
            kw[g][bb][tl][0] = *(const bf16x8*)(kp0 + (size_t)((2 * (g) + bb) * GRIDW + 4 * tl) * HD); kw[g][bb][tl][1] = *(const bf16x8*)(kp0 + (size_t)((2 * (g) + bb) * GRIDW + 4 * tl) * HD + 32); } } while (0)
#define AT_LOADV(g) do { _Pragma("unroll") for (int bb = 0; bb < 2; ++bb) _Pragma("unroll") for (int db = 0; db < 4; ++db) vw[g][bb][db] = *(const bf16x8*)(vp0 + (size_t)((2 * (g) + bb) * (GRIDW / 8)) * 512 + db * 128); } while (0)
        float mrun = -1.0e30f, lsum = 0.f;
        f32x4 o[4];
#pragma unroll
        for (int db = 0; db < 4; ++db) o[db] = (f32x4){0.f, 0.f, 0.f, 0.f};
        AT_LOADK(0); AT_LOADV(0);
        __builtin_amdgcn_sched_barrier(0);
#pragma unroll
        for (int g = 0; g < 4; ++g) {
            {
                f32x4 s[4]; bf16x8 pf[2];
#pragma unroll
                for (int bb = 0; bb < 2; ++bb) { const int blk = 2 * g + bb;
#pragma unroll
                    for (int tl = 0; tl < 2; ++tl) { const bf16x8 k0 = *(const LAS bf16x8*)(F.lds + AT_CK + ((blk * 2 + tl) * 2 + 0) * 1024 + lane * 16), k1 = *(const LAS bf16x8*)(F.lds + AT_CK + ((blk * 2 + tl) * 2 + 1) * 1024 + lane * 16);
                        f32x4 acc = (f32x4){0.f, 0.f, 0.f, 0.f};
                        acc = __builtin_amdgcn_mfma_f32_16x16x32_bf16(k0, qf0, acc, 0, 0, 0);
                        acc = __builtin_amdgcn_mfma_f32_16x16x32_bf16(k1, qf1, acc, 0, 0, 0);
                        s[2 * bb + tl] = acc; } }
                attn_softmax(s, mrun, lsum, o, pf);
#pragma unroll
                for (int bb = 0; bb < 2; ++bb)
#pragma unroll
                    for (int db = 0; db < 4; ++db) { const bf16x8 vf = *(const LAS bf16x8*)(F.lds + AT_CV + ((2 * g + bb) * 4 + db) * 1024 + lane * 16);
                        o[db] = __builtin_amdgcn_mfma_f32_16x16x32_bf16(vf, pf[bb], o[db], 0, 0, 0); }
            }
            __builtin_amdgcn_sched_barrier(0);
            {
                f32x4 s[4]; bf16x8 pf[2];
#pragma unroll
                for (int bb = 0; bb < 2; ++bb)
#pragma unroll
                    for (int tl = 0; tl < 2; ++tl) { f32x4 acc = (f32x4){0.f, 0.f, 0.f, 0.f};
                        acc = __builtin_amdgcn_mfma_f32_16x16x32_bf16(kw[g][bb][tl][0], qf0, acc, 0, 0, 0);
                        acc = __builtin_amdgcn_mfma_f32_16x16x32_bf16(kw[g][bb][tl][1], qf1, acc, 0, 0, 0);
#pragma unroll
                        for (int i = 0; i < 4; ++i) acc[i] += *(const LAS float*)(F.lds + boff[tl][i] + (2 * g + bb) * 128);
                        s[2 * bb + tl] = acc; }
                if (g < 3) { AT_LOADK(g + 1); }
                __builtin_amdgcn_sched_barrier(0);
                attn_softmax(s, mrun, lsum, o, pf);
#pragma unroll
                for (int bb = 0; bb < 2; ++bb)
#pragma unroll
                    for (int db = 0; db < 4; ++db) o[db] = __builtin_amdgcn_mfma_f32_16x16x32_bf16(vw[g][bb][db], pf[bb], o[db], 0, 0, 0);
                if (g < 3) { AT_LOADV(g + 1); }
                __builtin_amdgcn_sched_barrier(0);
            }
        }
#undef AT_LOADK
#undef AT_LOADV
        const float inv = 1.0f / xrow_sum(lsum);
        bf16* op = O + ((size_t)b * SEQ + r * GRIDW + qc) * D + h * HD + 4 * q4;
#pragma unroll
        for (int db = 0; db < 4; ++db) { v2u w; w.x = pg8::cvt_pk_bf16(o[db][0] * inv, o[db][1] * inv); w.y = pg8::cvt_pk_bf16(o[db][2] * inv, o[db][3] * inv); *(v2u*)(op + db * 16) = w; }
    }
    __syncthreads();
}

#ifndef MK_N_LAUNCHES
#define MK_N_LAUNCHES 1
#endif
constexpr int N_PHASES = 16;
constexpr int N_LAUNCHES = MK_N_LAUNCHES;
struct Args { const float* in[26]; float* out; unsigned char* ws; int ph_lo, ph_hi; };

__global__ void __launch_bounds__(NTHR, 2) fwd_kernel(Args args) {
    extern __shared__ __attribute__((aligned(16))) unsigned char lds[];
    Frame F;
    F.lds = (LAS unsigned char*)lds;
    F.MISC = (volatile LAS unsigned*)(F.lds + MISC_OFF);
    F.wave = __builtin_amdgcn_readfirstlane((int)threadIdx.x >> 6);
    F.G = gridDim.x; F.bid = blockIdx.x;
    F.ws = args.ws; F.ctl = (gu32*)(args.ws + WS_CTL); F.out = args.out;
    for (int u = threadIdx.x; u < 256; u += NTHR) F.MISC[u] = 0u;
    if (threadIdx.x < 26) { const unsigned long long pv = (unsigned long long)args.in[threadIdx.x]; volatile LAS unsigned* t = (volatile LAS unsigned*)(F.lds + PTAB_OFF) + 2 * threadIdx.x; t[0] = (unsigned)pv; t[1] = (unsigned)(pv >> 32); }
    __syncthreads();
    XcdBarrier bar; bar.bar = (unsigned*)(F.ctl + CW_BAR); bar.x = 0; bar.st = nullptr;
    if (N_LAUNCHES == 1) bar = xcd_barrier_post((unsigned*)(F.ctl + CW_BAR), F.MISC + 8);
    const int lo = args.ph_lo, hi = args.ph_hi;
#ifndef PHASE_MASK
#define PHASE_MASK 0xFFFF
#endif
#define IN(k) ((((PHASE_MASK) >> (k)) & 1) && lo <= (k) && (k) < hi)
#define SEAM(k) do { if (IN(k) && IN((k) + 1)) { xcd_barrier(bar); if (PROBE_MASK == 0x10000) xcd_barrier(bar); } } while (0)
    const char* wsb = (const char*)F.ws;
    LAS unsigned char* ring = F.lds;

    if (IN(0)) { _Pragma("unroll") for (int rep = 0; rep < REP(0); ++rep) { p0_prologue(F); __syncthreads(); } }
    SEAM(0);
    if (IN(1)) { _Pragma("unroll") for (int rep = 0; rep < REP(1); ++rep) p1_modulate(F); }
    SEAM(1);
    if (IN(2)) {
        pg8::DenseSched S{wsb + WS_A, wsb + WS_WIN, D / 2, MT / 256, 8, F.G, F.bid};
        pg8::EpiGated<0> E{(bf16*)(F.ws + WS_B), D, F.in(11), D};
        _Pragma("unroll") for (int rep = 0; rep < REP(2); ++rep) pg8::gemm_phase<pg8::EpiGated<0>, pg8::DenseSched, true, true>(ring, D / 2, S, E, F.wave);
    }
    SEAM(2);
    if (IN(3)) { _Pragma("unroll") for (int rep = 0; rep < REP(3); ++rep) p3_conv(F); }
    SEAM(3);
    if (IN(4)) {
        pg8::DenseSched S{wsb + WS_A, wsb + WS_WOUT, D, MT / 256, 4, F.G, F.bid};
        pg8::EpiBf16B E{(bf16*)(F.ws + WS_B), D, F.in(17)};
        _Pragma("unroll") for (int rep = 0; rep < REP(4); ++rep) pg8::gemm_phase<pg8::EpiBf16B, pg8::DenseSched, true>(ring, D, S, E, F.wave);
    }
    SEAM(4);
    if (IN(5)) p_emid<0>(F);
    SEAM(5);
    if (IN(6)) {
        moe_setup(F, 0); moe_stage_perm(F);
        pg8::MoeUpSched S; S.tpre = (const volatile LAS int*)(F.MISC + 16); S.G = F.G; S.c = F.bid; S.A = wsb + WS_A; S.Wgu = wsb + WS_WGU + (size_t)0 * 16 * 1024 * 1024; S.permL = (const LAS int*)(F.lds + PERML_OFF); S.kb = D;
        pg8::EpiGated<1, true> E{(bf16*)(F.ws + WS_C), DE, nullptr, 0};
        _Pragma("unroll") for (int rep = 0; rep < REP(6); ++rep) pg8::gemm_phase<pg8::EpiGated<1, true>, pg8::MoeUpSched, true, true>(ring, D / 2, S, E, F.wave);
    }
    SEAM(6);
    if (IN(7)) {
        moe_setup(F, 0);
        pg8::MoeDownSched S; S.tpre = (const volatile LAS int*)(F.MISC + 16); S.G = F.G; S.c = F.bid; S.A = wsb + WS_C; S.Wdn = wsb + WS_WDN + (size_t)0 * 16 * 1024 * 512; S.kb = DE;
        pg8::EpiF8 E{(unsigned char*)(F.ws + WS_D2), D};
        _Pragma("unroll") for (int rep = 0; rep < REP(7); ++rep) pg8::gemm_phase<pg8::EpiF8, pg8::MoeDownSched, true, true>(ring, DE / 2, S, E, F.wave);
    }
    SEAM(7);
    if (IN(8)) { moe_setup(F, 0); p_epost<0>(F); }
    SEAM(8);
    if (IN(9)) {
        pg8::QkvSched S{wsb + WS_A, wsb + WS_WQKV, F.G, F.bid, D};
        pg8::EpiQkv E{(bf16*)F.out, (bf16*)(F.ws + WS_C), (bf16*)(F.ws + WS_D2), 0.125f * 1.4426950408889634f};
        _Pragma("unroll") for (int rep = 0; rep < REP(9); ++rep) pg8::gemm_phase<pg8::EpiQkv, pg8::QkvSched, true, true>(ring, D / 2, S, E, F.wave);
    }
    SEAM(9);
    if (IN(10)) { _Pragma("unroll") for (int rep = 0; rep < REP(10); ++rep) p10_attn(F); }
    SEAM(10);
    if (IN(11)) {
        pg8::DenseSched S{wsb + WS_A, wsb + WS_WO, D, NLAT / 256, 4, F.G, F.bid};
        pg8::EpiBf16 E{(bf16*)(F.ws + WS_C), D, nullptr};
        _Pragma("unroll") for (int rep = 0; rep < REP(11); ++rep) pg8::gemm_phase<pg8::EpiBf16, pg8::DenseSched, true>(ring, D, S, E, F.wave);
    }
    SEAM(11);
    if (IN(12)) p_emid<1>(F);
    SEAM(12);
    if (IN(13)) {
        moe_setup(F, 1); moe_stage_perm(F);
        pg8::MoeUpSched S; S.tpre = (const volatile LAS int*)(F.MISC + 16); S.G = F.G; S.c = F.bid; S.A = wsb + WS_A; S.Wgu = wsb + WS_WGU + (size_t)1 * 16 * 1024 * 1024; S.permL = (const LAS int*)(F.lds + PERML_OFF); S.kb = D;
        pg8::EpiGated<1, true> E{(bf16*)(F.ws + WS_C), DE, nullptr, 0};
        _Pragma("unroll") for (int rep = 0; rep < REP(13); ++rep) pg8::gemm_phase<pg8::EpiGated<1, true>, pg8::MoeUpSched, true, true>(ring, D / 2, S, E, F.wave);
    }
    SEAM(13);
    if (IN(14)) {
        moe_setup(F, 1);
        pg8::MoeDownSched S; S.tpre = (const volatile LAS int*)(F.MISC + 16); S.G = F.G; S.c = F.bid; S.A = wsb + WS_C; S.Wdn = wsb + WS_WDN + (size_t)1 * 16 * 1024 * 512; S.kb = DE;
        pg8::EpiF8 E{(unsigned char*)(F.ws + WS_D2), D};
        _Pragma("unroll") for (int rep = 0; rep < REP(14); ++rep) pg8::gemm_phase<pg8::EpiF8, pg8::MoeDownSched, true, true>(ring, DE / 2, S, E, F.wave);
    }
    SEAM(14);
    if (IN(15)) { moe_setup(F, 1); _Pragma("unroll") for (int rep = 0; rep < REP(15); ++rep) p_epost<1>(F); }
#undef IN
#undef SEAM
}

extern "C" void kernel_launch(void* const* d_in, const int* in_sizes, int n_in, void* d_out, int out_size, void* d_ws, size_t ws_size, hipStream_t stream) {
    static int grid = 0;
    if (grid == 0) {
        if (n_in != 26 || in_sizes[0] != NLAT * D || out_size != NLAT * D || ws_size < WS_END) { fprintf(stderr, "kernel_launch: unexpected shapes (n_in %d, in0 %d, out %d, ws %zu); nothing launched\n", n_in, n_in > 0 ? in_sizes[0] : -1, out_size, ws_size); grid = -1; return; }
        if (hipFuncSetAttribute((const void*)fwd_kernel, hipFuncAttributeMaxDynamicSharedMemorySize, LDS_BYTES) != hipSuccess) { fprintf(stderr, "kernel_launch: hipFuncSetAttribute failed\n"); grid = -1; return; }
        int per_cu = 0;
        if (hipOccupancyMaxActiveBlocksPerMultiprocessor(&per_cu, (const void*)fwd_kernel, NTHR, LDS_BYTES) != hipSuccess || per_cu < 1) fprintf(stderr, "kernel_launch: note: occupancy query reports %d workgroups per CU\n", per_cu);
        (void)hipGetLastError();
        grid = 256;
    }
    if (grid < 0) return;
    if (hipMemsetAsync((char*)d_ws + WS_CTL, 0, CTL_ZERO_BYTES, stream) != hipSuccess) { fprintf(stderr, "kernel_launch: hipMemsetAsync failed\n"); return; }
    Args a{};
    for (int i = 0; i < 26; ++i) a.in[i] = (const float*)d_in[i];
    a.out = (float*)d_out; a.ws = (unsigned char*)d_ws;
    for (int li = 0; li < N_LAUNCHES; ++li) {
        a.ph_lo = (N_LAUNCHES == 1) ? 0 : li; a.ph_hi = (N_LAUNCHES == 1) ? N_PHASES : li + 1;
        hipLaunchKernelGGL(fwd_kernel, dim3(grid), dim3(NTHR), LDS_BYTES, stream, a);
        const hipError_t le = hipPeekAtLastError();
        if (le != hipSuccess) { fprintf(stderr, "kernel_launch: launch %d failed: %s\n", li, hipGetErrorName(le)); break; }
    }
}
```

```cpp
#include <hip/hip_runtime.h>
#include <cstdio>
#include <cstdint>

#ifndef PROBE_MASK
#define PROBE_MASK 0
#endif
#define REP(k) ((((PROBE_MASK) >> (k)) & 1) ? 2 : 1)
#ifndef DBG_SLOT
#define DBG_SLOT 0
#endif
#ifndef DBG_SKIP
#define DBG_SKIP 0
#endif
constexpr int D = 1024, BATCH = 8, SEQ = 4096, CTXL = 256;
constexpr int NLAT = BATCH * SEQ, NCTX = BATCH * CTXL, MT = NLAT + NCTX;
constexpr int NE = 16, DE = 512, NH = 16, HD = 64, GRIDW = 64, GROWS = 64, WINH = 8, WINW = 16, CONVW = 31;
constexpr int KSLOT = SEQ + CTXL;
constexpr int NMODR = 9, NMODC = 6 * D;
constexpr int MODKC = 8;
constexpr float EPS = 1e-6f;
constexpr int NWAVES = 8, NTHR = NWAVES * 64;

constexpr size_t MiB = 1u << 20;
constexpr size_t WS_CTL = 0, CTL_ZERO_BYTES = 1 * MiB;
constexpr size_t WS_SLOT = 1 * MiB;
constexpr size_t WS_PERM = 2 * MiB;
constexpr size_t WS_MODP = 5 * MiB;
constexpr size_t WS_XC = 9 * MiB;
constexpr size_t WS_WIN = 18 * MiB, WS_WOUT = 22 * MiB, WS_WQKV = 24 * MiB, WS_WO = 30 * MiB;
constexpr size_t WS_WGU = 32 * MiB;
constexpr size_t WS_WDN = 96 * MiB;
constexpr size_t WS_A = 128 * MiB, WS_B = 196 * MiB, WS_C = 264 * MiB, WS_D2 = 336 * MiB, WS_END = 480 * MiB;
constexpr int CW_BAR = 4096;
constexpr int CW_JOB = 12288;
constexpr int CW_CNT = 8192;

constexpr int RING_BYTES = 131072;
constexpr int MISC_OFF = RING_BYTES;
constexpr int PTAB_OFF = RING_BYTES + 1024 + 8192;
constexpr int PERML_OFF = RING_BYTES + 1024;
constexpr int LDS_BYTES = 147456;

#define GAS __attribute__((address_space(1)))
#define LAS __attribute__((address_space(3)))
typedef unsigned short bf16;
typedef unsigned v4u __attribute__((ext_vector_type(4)));
typedef unsigned v2u __attribute__((ext_vector_type(2)));
typedef float f32x4 __attribute__((ext_vector_type(4)));
typedef float f32x2 __attribute__((ext_vector_type(2)));
typedef short bf16x8 __attribute__((ext_vector_type(8)));
typedef GAS unsigned gu32;
#define RLX_AGENT __ATOMIC_RELAXED, __HIP_MEMORY_SCOPE_AGENT
#define LDS_WAIT() asm volatile("s_waitcnt lgkmcnt(0)" ::: "memory")
#define VM_WAIT() asm volatile("s_waitcnt vmcnt(0)" ::: "memory")

__device__ __forceinline__ unsigned f2bf(float f) { unsigned u = __builtin_bit_cast(unsigned, f); return (u + 0x7fffu + ((u >> 16) & 1u)) >> 16; }
__device__ __forceinline__ unsigned pk2(float lo, float hi) { return f2bf(lo) | (f2bf(hi) << 16); }
__device__ __forceinline__ unsigned pk4_fp8(float a, float b, float c, float d) { int p = __builtin_amdgcn_cvt_pk_fp8_f32(a, b, 0, false); p = __builtin_amdgcn_cvt_pk_fp8_f32(c, d, p, true); return (unsigned)p; }
__device__ __forceinline__ float bflo(unsigned w) { return __builtin_bit_cast(float, w << 16); }
__device__ __forceinline__ float bfhi(unsigned w) { return __builtin_bit_cast(float, w & 0xffff0000u); }
__device__ __forceinline__ float row16_sum(float v) {
    v += __builtin_bit_cast(float, __builtin_amdgcn_update_dpp(0, __builtin_bit_cast(int, v), 0xB1, 0xF, 0xF, false));
    v += __builtin_bit_cast(float, __builtin_amdgcn_update_dpp(0, __builtin_bit_cast(int, v), 0x4E, 0xF, 0xF, false));
    v += __builtin_bit_cast(float, __builtin_amdgcn_update_dpp(0, __builtin_bit_cast(int, v), 0x141, 0xF, 0xF, false));
    v += __builtin_bit_cast(float, __builtin_amdgcn_update_dpp(0, __builtin_bit_cast(int, v), 0x140, 0xF, 0xF, false));
    return v;
}
__device__ __forceinline__ float rdlane(float v, int l) { return __builtin_bit_cast(float, __builtin_amdgcn_readlane(__builtin_bit_cast(int, v), l)); }
__device__ __forceinline__ float wave_sum(float v) {
    v = row16_sum(v);
    return (rdlane(v, 0) + rdlane(v, 16)) + (rdlane(v, 32) + rdlane(v, 48));
}
__device__ __forceinline__ int lane_id_asm() { int l; asm volatile("v_mbcnt_lo_u32_b32 %0, -1, 0\n\tv_mbcnt_hi_u32_b32 %0, -1, %0" : "=v"(l)); return l; }
__device__ __forceinline__ float fast_sigmoid(float x) { return __builtin_amdgcn_rcpf(1.0f + __builtin_amdgcn_exp2f(-1.4426950408889634f * x)); }

namespace pg8 {
#define PG8_LAS __attribute__((address_space(3)))
typedef unsigned short bf16_t;
typedef short bf16x8 __attribute__((ext_vector_type(8)));
typedef float f32x4 __attribute__((ext_vector_type(4)));
typedef unsigned u32x4 __attribute__((ext_vector_type(4)));
constexpr int BM = 256, BK = 64, HALF = 128, HTB = HALF * BK * 2, STAGE_BYTES = 8 * HTB, NXCD = 8, WGM = 8;

__host__ __device__ __forceinline__ int lds_byte(int r, int c) { const int st = (r >> 4) * 2 + (c >> 5), rr = r & 15, cc = c & 31, ob = rr * 64 + cc * 2; return st * 1024 + (ob ^ (((ob >> 9) & 1) << 5)); }
__host__ __device__ __forceinline__ void stage_rc(int b, int& R, int& C) { const int st = b / 1024, sb = b % 1024, swz = sb ^ (((sb >> 9) & 1) << 5); R = (st >> 1) * 16 + swz / 64; C = (st & 1) * 32 + (swz % 64) / 2; }
__host__ __device__ __forceinline__ int perm32(int rho) { const int n = rho >> 4, i = rho & 15; return 8 * (i >> 2) + 4 * n + (i & 3); }

struct Unit { int pm, pn; const char* a; const char* b; int li; int ex; };

__device__ __forceinline__ bool static_order(int L, int nM, int nN, int& pm, int& pn) {
    const int nwg = nM * nN; if (L >= nwg) return false;
    int wgid = L; { const int q = nwg / NXCD, r = nwg % NXCD, xcd = wgid % NXCD, off = wgid / NXCD; wgid = (xcd < r ? xcd * (q + 1) : r * (q + 1) + (xcd - r) * q) + off; }
    const int nig = WGM * nN, gid = wgid / nig, fm = gid * WGM, gsz = (nM - fm) < WGM ? (nM - fm) : WGM;
    pm = fm + ((wgid % nig) % gsz); pn = (wgid % nig) / gsz; return true;
}

typedef float cvt_f32x2_t __attribute__((ext_vector_type(2))); typedef __bf16 cvt_bf16x2_t __attribute__((ext_vector_type(2)));
__device__ __forceinline__ unsigned cvt_pk_bf16(float lo, float hi) { const cvt_f32x2_t v = {lo, hi}; const cvt_bf16x2_t b = __builtin_convertvector(v, cvt_bf16x2_t); return __builtin_bit_cast(unsigned, b); }

typedef int v8i_t __attribute__((ext_vector_type(8)));
typedef int v4i_t __attribute__((ext_vector_type(4)));
template <class Epi, class Sched, bool ALIGN_EPI, bool FP8 = false>
__device__ __forceinline__ void gemm_phase(PG8_LAS unsigned char* lds, const int K_, const Sched& S, const Epi& E, const int wid) {
    int K = K_; asm volatile("" : "+s"(K));
    const int lane = lane_id_asm(), tid = wid * 64 + lane, wr = wid >> 2, wc = wid & 3, fr = lane & 15, fq = lane >> 4;
    const int nt = K / BK;
    int R[2], C[2]; unsigned voffB[2], vA[2][2];
    const size_t kstep = (size_t)(BK * 2);
    const size_t hstep = (size_t)HALF * K * 2;
#pragma unroll
    for (int i = 0; i < 2; ++i) { stage_rc(tid * 16 + i * 8192, R[i], C[i]); const int Rb = Epi::PERM ? ((R[i] & ~31) + perm32(R[i] & 31)) : R[i];
        voffB[i] = (unsigned)(Rb * K + C[i]) * 2u; vA[0][i] = (unsigned)(R[i] * K + C[i]) * 2u; vA[1][i] = vA[0][i] + (unsigned)hstep; }
    const unsigned ldsw = (unsigned)wid * 1024u;
    const int aoff = lds_byte(wr * 64 + fr, fq * 8), boff = lds_byte(wc * 32 + fr, fq * 8);
#define PG8_SA(b, h) (((b) * 2 + (h)) * HTB)
#define PG8_SB(b, h) ((4 + (b) * 2 + (h)) * HTB)
#define PG8_STAGE(bufoff, gbase, voff) do { _Pragma("unroll") for (int _i = 0; _i < 2; ++_i) \
        __builtin_amdgcn_global_load_lds((const unsigned*)((const char*)(gbase) + (voff)[_i]), (PG8_LAS unsigned*)(lds + (bufoff) + ldsw + _i * 8192), 16, 0, 0); } while (0)
#define PG8_LD8(addr) __builtin_shufflevector(*(const PG8_LAS v4i_t*)(addr), *(const PG8_LAS v4i_t*)((addr) + 1024), 0, 1, 2, 3, 4, 5, 6, 7)
#define PG8_LDA(dst, b, h) do { _Pragma("unroll") for (int m = 0; m < 4; ++m) dst[m] = PG8_LD8(lds + PG8_SA(b, h) + aoff + m * 2048); } while (0)
#define PG8_LDB(dst, b, h) do { _Pragma("unroll") for (int n = 0; n < 2; ++n) dst[n] = PG8_LD8(lds + PG8_SB(b, h) + boff + n * 2048); } while (0)
#define PG8_LO(x) __builtin_bit_cast(bf16x8, __builtin_shufflevector((x), (x), 0, 1, 2, 3))
#define PG8_HI(x) __builtin_bit_cast(bf16x8, __builtin_shufflevector((x), (x), 4, 5, 6, 7))
#define PG8_MMA(ai, bj, At, Bt) do { __builtin_amdgcn_s_setprio(1); _Pragma("unroll") for (int m = 0; m < 4; ++m) _Pragma("unroll") for (int n = 0; n < 2; ++n) { \
        if constexpr (FP8) asm volatile("v_mfma_scale_f32_16x16x128_f8f6f4 %0, %1, %2, %0, %3, %4 op_sel_hi:[0,0,0]" : "+v"(acc[ai][bj][m][n]) : "v"(Bt[n]), "v"(At[m]), "v"(wscale_r), "v"(ascale_r)); \
        else { acc[ai][bj][m][n] = __builtin_amdgcn_mfma_f32_16x16x32_bf16(PG8_LO(Bt[n]), PG8_LO(At[m]), acc[ai][bj][m][n], 0, 0, 0); \
               acc[ai][bj][m][n] = __builtin_amdgcn_mfma_f32_16x16x32_bf16(PG8_HI(Bt[n]), PG8_HI(At[m]), acc[ai][bj][m][n], 0, 0, 0); } } __builtin_amdgcn_s_setprio(0); } while (0)
#define PG8_WAIT_V(n) asm volatile("s_waitcnt vmcnt(" #n ")" ::: "memory")
#define PG8_WAIT_L(n) asm volatile("s_waitcnt lgkmcnt(" #n ")" ::: "memory")
#define PG8_BAR __builtin_amdgcn_s_barrier()
#define PG8_SCHED __builtin_amdgcn_sched_barrier(0)
    Unit cur, nxt; int ui = 0;
    if (!S.next(0, cur)) return;
    if constexpr (Sched::GATHER) S.a_offsets(cur, R, C, K, vA);
    f32x4 acc[2][2][4][2];
#pragma unroll
    for (int a = 0; a < 2; ++a)
#pragma unroll
        for (int b = 0; b < 2; ++b)
#pragma unroll
            for (int m = 0; m < 4; ++m)
#pragma unroll
                for (int n = 0; n < 2; ++n) acc[a][b][m][n] = (f32x4){0.f, 0.f, 0.f, 0.f};
    int wscale_r = 0x79797979, ascale_r = 0x7f7f7f7f;
    asm volatile("" : "+v"(wscale_r), "+v"(ascale_r));
    v8i_t At[4], B0[2], B1[2];
    const char* cA = cur.a; const char* cB = cur.b;
    PG8_STAGE(PG8_SB(0, 0), cB, voffB); PG8_STAGE(PG8_SB(0, 1), cB + hstep, voffB); PG8_STAGE(PG8_SA(0, 0), cA, vA[0]); PG8_STAGE(PG8_SA(0, 1), cA, vA[1]);
    if (wr == 1) PG8_BAR;
    PG8_WAIT_V(2); PG8_BAR;
    PG8_STAGE(PG8_SB(1, 0), cB + kstep, voffB); PG8_STAGE(PG8_SA(1, 0), cA + kstep, vA[0]); PG8_STAGE(PG8_SB(1, 1), cB + hstep + kstep, voffB);
    PG8_WAIT_V(6); PG8_BAR;
    for (;;) {
        const bool has_next = S.next(ui + 1, nxt);
        const char* nA = has_next ? nxt.a : cA; const char* nB = has_next ? nxt.b : cB;
#pragma unroll 1
        for (int t = 0; t < nt; t += 2) {
            const bool last = (t == nt - 2);
            const char* a1 = cA + (size_t)(t + 1) * kstep;
            const char* a2 = last ? nA : cA + (size_t)(t + 2) * kstep; const char* b2 = last ? nB : cB + (size_t)(t + 2) * kstep;
            const char* a3 = a2 + kstep; const char* b3 = b2 + kstep;
            PG8_LDB(B0, 0, 0); PG8_LDB(B1, 0, 1); PG8_SCHED; PG8_LDA(At, 0, 0); PG8_STAGE(PG8_SA(1, 1), a1, vA[1]);
            if constexpr (Sched::GATHER) { if (last && has_next) S.a_offsets(nxt, R, C, K, vA); }
            PG8_WAIT_V(8); PG8_WAIT_L(0); PG8_BAR; PG8_MMA(0, 0, At, B0); PG8_MMA(0, 1, At, B1); PG8_BAR; PG8_SCHED;
            PG8_LDA(At, 0, 1); PG8_STAGE(PG8_SB(0, 0), b2, voffB); PG8_STAGE(PG8_SB(0, 1), b2 + hstep, voffB); PG8_STAGE(PG8_SA(0, 0), a2, vA[0]);
            PG8_WAIT_V(8); PG8_WAIT_L(0); PG8_BAR; PG8_MMA(1, 0, At, B0); PG8_MMA(1, 1, At, B1); PG8_BAR; PG8_SCHED;
            PG8_LDB(B0, 1, 0); PG8_LDB(B1, 1, 1); PG8_SCHED; PG8_LDA(At, 1, 0); PG8_STAGE(PG8_SA(0, 1), a2, vA[1]);
            PG8_WAIT_V(8); PG8_WAIT_L(0); PG8_BAR; PG8_MMA(0, 0, At, B0); PG8_MMA(0, 1, At, B1); PG8_BAR; PG8_SCHED;
            PG8_LDA(At, 1, 1); PG8_STAGE(PG8_SB(1, 0), b3, voffB); PG8_STAGE(PG8_SB(1, 1), b3 + hstep, voffB); PG8_STAGE(PG8_SA(1, 0), a3, vA[0]);
            PG8_WAIT_V(8); PG8_WAIT_L(0); PG8_BAR; PG8_MMA(1, 0, At, B0); PG8_MMA(1, 1, At, B1); PG8_BAR; PG8_SCHED;
        }
        if constexpr (ALIGN_EPI) { if (wr == 0) PG8_BAR; }
        if constexpr (FP8) asm volatile("s_nop 15\n\ts_nop 7" ::: "memory");
        E(acc, cur, wr, wc, fr, fq);
        if (!has_next) break;
#pragma unroll
        for (int a = 0; a < 2; ++a)
#pragma unroll
            for (int b = 0; b < 2; ++b)
#pragma unroll
                for (int m = 0; m < 4; ++m)
#pragma unroll
                    for (int n = 0; n < 2; ++n) acc[a][b][m][n] = (f32x4){0.f, 0.f, 0.f, 0.f};
        cur = nxt; cA = nA; cB = nB; ++ui;
        if constexpr (ALIGN_EPI) { if (wr == 1) PG8_BAR; }
    }
    PG8_WAIT_V(0);
    if constexpr (!ALIGN_EPI) { if (wr == 0) PG8_BAR; }
    PG8_BAR;
#undef PG8_SA
#undef PG8_SB
#undef PG8_STAGE
#undef PG8_LDA
#undef PG8_LDB
#undef PG8_MMA
#undef PG8_LO
#undef PG8_HI
#undef PG8_LD8
#undef PG8_WAIT_V
#undef PG8_WAIT_L
#undef PG8_BAR
#undef PG8_SCHED
}

struct DenseSched {
    static constexpr bool GATHER = false;
    const char* A; const char* Bt; int K, nM, nN, G, c;
    __device__ __forceinline__ bool next(int i, Unit& u) const {
        int pm, pn; if (!static_order(i * G + c, nM, nN, pm, pn)) return false;
        u.pm = pm; u.pn = pn; u.a = A + (size_t)pm * BM * K * 2; u.b = Bt + (size_t)pn * BM * K * 2; u.li = i; u.ex = 0; return true;
    }
    __device__ __forceinline__ void a_offsets(const Unit&, const int (&)[2], const int (&)[2], int, unsigned (&)[2][2]) const {}
};
struct QkvSched {
    static constexpr bool GATHER = false;
    const char* A; const char* Bt; int G, c, kb;
    __device__ __forceinline__ bool next(int i, Unit& u) const {
        const int L = i * G + c; int pm, pn;
        if (L < 1536) { static_order(L, 128, 12, pm, pn); }
        else { const int l2 = L - 1536; if (l2 >= 64) return false; pm = 128 + (l2 >> 3); pn = 4 + (l2 & 7); }
        u.pm = pm; u.pn = pn; u.a = A + (size_t)pm * BM * kb; u.b = Bt + (size_t)pn * BM * kb; u.li = i; u.ex = 0; return true;
    }
    __device__ __forceinline__ void a_offsets(const Unit&, const int (&)[2], const int (&)[2], int, unsigned (&)[2][2]) const {}
};
struct MoeSchedBase {
    const volatile PG8_LAS int* tpre;
    int G, c;
    __device__ __forceinline__ bool locate(int i, int& rt, int& pn, int& e) const {
        const int L = i * G + c; const int ntile = tpre[16];
        if (L >= 4 * ntile) return false;
        rt = L >> 2; pn = L & 3; int ee = 0;
#pragma unroll
        for (int j = 1; j < 16; ++j) ee += (rt >= tpre[j]) ? 1 : 0;
        e = ee; return true;
    }
};
struct MoeUpSched : MoeSchedBase {
    static constexpr bool GATHER = true;
    const char* A; const char* Wgu; const PG8_LAS int* permL; int kb;
    __device__ __forceinline__ bool next(int i, Unit& u) const {
        int rt, pn, e; if (!locate(i, rt, pn, e)) return false;
        u.pm = rt; u.pn = pn; u.a = A; u.b = Wgu + (size_t)e * 1024 * kb + (size_t)pn * BM * kb; u.li = i; u.ex = e; return true;
    }
    __device__ __forceinline__ void a_offsets(const Unit& u, const int (&R)[2], const int (&C)[2], int K, unsigned (&vA)[2][2]) const {
#pragma unroll
        for (int h = 0; h < 2; ++h)
#pragma unroll
            for (int i = 0; i < 2; ++i) vA[h][i] = (unsigned)permL[u.li * 256 + h * HALF + R[i]] * (unsigned)(K * 2) + (unsigned)(C[i] * 2);
    }
};
struct MoeDownSched : MoeSchedBase {
    static constexpr bool GATHER = false;
    const char* A; const char* Wdn; int kb;
    __device__ __forceinline__ bool next(int i, Unit& u) const {
        int rt, pn, e; if (!locate(i, rt, pn, e)) return false;
        u.pm = rt; u.pn = pn; u.a = A + (size_t)rt * BM * kb; u.b = Wdn + (size_t)e * 1024 * kb + (size_t)pn * BM * kb; u.li = i; u.ex = e; return true;
    }
    __device__ __forceinline__ void a_offsets(const Unit&, const int (&)[2], const int (&)[2], int, unsigned (&)[2][2]) const {}
};

template <bool HAS_BIAS> struct EpiBf16T {
    static constexpr bool PERM = true;
    bf16_t* O; int ldc; const float* bias;
    __device__ __forceinline__ void operator()(const f32x4 (&acc)[2][2][4][2], const Unit& u, int wr, int wc, int fr, int fq) const {
        const int row0 = u.pm * BM + wr * 64 + fr, col0 = u.pn * BM + wc * 32 + 8 * fq;
        f32x4 bv[2][2];
#pragma unroll
        for (int bj = 0; bj < 2; ++bj)
#pragma unroll
            for (int n = 0; n < 2; ++n) bv[bj][n] = HAS_BIAS ? *(const f32x4*)(bias + col0 + bj * HALF + 4 * n) : (f32x4){0.f, 0.f, 0.f, 0.f};
#pragma unroll
        for (int ai = 0; ai < 2; ++ai)
#pragma unroll
            for (int m = 0; m < 4; ++m) { bf16_t* rowp = O + (size_t)(row0 + ai * HALF + m * 16) * ldc + col0;
#pragma unroll
                for (int bj = 0; bj < 2; ++bj) { f32x4 v0 = acc[ai][bj][m][0], v1 = acc[ai][bj][m][1]; if constexpr (HAS_BIAS) { v0 += bv[bj][0]; v1 += bv[bj][1]; }
                    u32x4 w; w.x = cvt_pk_bf16(v0[0], v0[1]); w.y = cvt_pk_bf16(v0[2], v0[3]); w.z = cvt_pk_bf16(v1[0], v1[1]); w.w = cvt_pk_bf16(v1[2], v1[3]);
                    *(u32x4*)(rowp + bj * HALF) = w; } }
    }
};
typedef EpiBf16T<true> EpiBf16B; typedef EpiBf16T<false> EpiBf16;
struct EpiF8 {
    static constexpr bool PERM = true;
    unsigned char* O; int ldc;
    __device__ __forceinline__ void operator()(const f32x4 (&acc)[2][2][4][2], const Unit& u, int wr, int wc, int fr, int fq) const {
        const int row0 = u.pm * BM + wr * 64 + fr, col0 = u.pn * BM + wc * 32 + 8 * fq;
#pragma unroll
        for (int ai = 0; ai < 2; ++ai)
#pragma unroll
            for (int m = 0; m < 4; ++m) { unsigned char* rowp = O + (size_t)(row0 + ai * HALF + m * 16) * ldc + col0;
#pragma unroll
                for (int bj = 0; bj < 2; ++bj) { const f32x4 v0 = acc[ai][bj][m][0], v1 = acc[ai][bj][m][1];
                    *(unsigned long long*)(rowp + bj * HALF) = (unsigned long long)pk4_fp8(v0[0], v0[1], v0[2], v0[3]) | ((unsigned long long)pk4_fp8(v1[0], v1[1], v1[2], v1[3]) << 32); } }
    }
};
template <int MODE  , bool OUT8 = false  > struct EpiGated {
    static constexpr bool PERM = true;
    bf16_t* O; int ldc; const float* bias; int nch;
    __device__ __forceinline__ void operator()(const f32x4 (&acc)[2][2][4][2], const Unit& u, int wr, int wc, int fr, int fq) const {
        const int row0 = u.pm * BM + wr * 64 + fr, ch0 = u.pn * HALF + wc * 32 + 8 * fq;
        f32x4 b0[2], b1[2];
#pragma unroll
        for (int n = 0; n < 2; ++n) { if (MODE == 0) { b0[n] = *(const f32x4*)(bias + ch0 + 4 * n); b1[n] = *(const f32x4*)(bias + nch + ch0 + 4 * n); } else { b0[n] = (f32x4){0.f, 0.f, 0.f, 0.f}; b1[n] = b0[n]; } }
#pragma unroll
        for (int ai = 0; ai < 2; ++ai)
#pragma unroll
            for (int m = 0; m < 4; ++m) { bf16_t* rowp = O + (size_t)(row0 + ai * HALF + m * 16) * ldc + ch0; float o[8];
#pragma unroll
                for (int n = 0; n < 2; ++n) { const f32x4 x0 = acc[ai][0][m][n] + b0[n], x1 = acc[ai][1][m][n] + b1[n];
#pragma unroll
                    for (int e = 0; e < 4; ++e) o[4 * n + e] = (MODE == 0) ? x0[e] * fast_sigmoid(x1[e]) : (x0[e] * fast_sigmoid(x0[e])) * x1[e]; }
                if constexpr (OUT8) { unsigned char* rp8 = (unsigned char*)O + (size_t)(row0 + ai * HALF + m * 16) * ldc + ch0;
                    *(unsigned long long*)rp8 = (unsigned long long)pk4_fp8(o[0], o[1], o[2], o[3]) | ((unsigned long long)pk4_fp8(o[4], o[5], o[6], o[7]) << 32); }
                else { u32x4 w; w.x = cvt_pk_bf16(o[0], o[1]); w.y = cvt_pk_bf16(o[2], o[3]); w.z = cvt_pk_bf16(o[4], o[5]); w.w = cvt_pk_bf16(o[6], o[7]);
                    *(u32x4*)rowp = w; } }
    }
};
struct EpiQkv {
    static constexpr bool PERM = true;
    bf16_t* Q; bf16_t* Kh; bf16_t* Vb; float qscale;
    __device__ __forceinline__ void operator()(const f32x4 (&acc)[2][2][4][2], const Unit& u, int wr, int wc, int fr, int fq) const {
        const int which = u.pn >> 2; const bool isctx = u.pm >= 128;
        const int b = isctx ? (u.pm - 128) : (u.pm >> 4);
        const int key0 = isctx ? SEQ : ((u.pm & 15) << 8);
        const int d0 = 32 * (wc & 1) + 8 * fq;
#pragma unroll
        for (int ai = 0; ai < 2; ++ai)
#pragma unroll
            for (int m = 0; m < 4; ++m) { const int key = key0 + ai * HALF + wr * 64 + m * 16 + fr;
#pragma unroll
                for (int bj = 0; bj < 2; ++bj) { const int h = 4 * (u.pn & 3) + 2 * bj + (wc >> 1); const f32x4 v0 = acc[ai][bj][m][0], v1 = acc[ai][bj][m][1];
                    if (which == 2) {
                        bf16_t* p = Vb + ((size_t)(b * NH + h) * (KSLOT / 8) + (key >> 3)) * 512 + (size_t)d0 * 8 + (key & 7);
                        const unsigned w0 = cvt_pk_bf16(v0[0], v0[1]), w1 = cvt_pk_bf16(v0[2], v0[3]), w2 = cvt_pk_bf16(v1[0], v1[1]), w3 = cvt_pk_bf16(v1[2], v1[3]);
                        p[0] = (bf16_t)w0; p[8] = (bf16_t)(w0 >> 16); p[16] = (bf16_t)w1; p[24] = (bf16_t)(w1 >> 16); p[32] = (bf16_t)w2; p[40] = (bf16_t)(w2 >> 16); p[48] = (bf16_t)w3; p[56] = (bf16_t)(w3 >> 16);
                    } else {
                        const float qs = (which == 0) ? qscale : 1.0f; const f32x4 y0 = v0 * qs, y1 = v1 * qs;
                        u32x4 w; w.x = cvt_pk_bf16(y0[0], y0[1]); w.y = cvt_pk_bf16(y0[2], y0[3]); w.z = cvt_pk_bf16(y1[0], y1[1]); w.w = cvt_pk_bf16(y1[2], y1[3]);
                        bf16_t* p = (which == 0) ? Q + ((size_t)(b * NH + h) * SEQ + key) * HD + d0 : Kh + ((size_t)(b * NH + h) * KSLOT + key) * HD + d0;
                        *(u32x4*)p = w;
                    } } }
    }
};
}
#define XB_TMO      128
#define XB_XCNT(j)  (256  + 64 * (j))
#define XB_XSUB(j)  (1280 + 64 * (j))
#define XB_XGEN(j)  (2304 + 64 * (j))
#define XB_TOP      3328
#define XB_TOPGEN   3392
#define XCD_BAR_WORDS 3456
#define XB_SPIN_CAP (1u << 18)

__device__ __forceinline__ unsigned xb_ld(unsigned* p)              { return __hip_atomic_load(p, __ATOMIC_RELAXED, __HIP_MEMORY_SCOPE_AGENT); }
__device__ __forceinline__ unsigned xb_add(unsigned* p, unsigned v) { return __hip_atomic_fetch_add(p, v, __ATOMIC_RELAXED, __HIP_MEMORY_SCOPE_AGENT); }
__device__ __forceinline__ unsigned xb_xcc_id() { return (unsigned)__builtin_amdgcn_s_getreg((3 << 11) | 20) & 0xFu; }
#define XB_SPIN(cond, bar) do { unsigned _sp = 0; while (cond) { __builtin_amdgcn_s_sleep(1); \
    if ((++_sp & 255u) == 0u) { if (xb_ld(&(bar)[XB_TMO])) break; if (_sp > XB_SPIN_CAP) { atomicAdd(&(bar)[XB_TMO], 1u); break; } } } } while (0)

struct XcdBarrier {
    unsigned* bar; unsigned x;
    volatile LAS unsigned* st;
};

__device__ __forceinline__ XcdBarrier xcd_barrier_post(unsigned* bar, volatile LAS unsigned* st) {
    XcdBarrier b; b.bar = bar; b.x = xb_xcc_id(); b.st = st;
    if (threadIdx.x == 0) (void)xb_add(&bar[XB_XCNT(b.x)], 1u);
    return b;
}
__device__ __forceinline__ void xcd_barrier_complete(unsigned* bar, unsigned x, unsigned& nloc, unsigned& nx) {
    const unsigned G = gridDim.x * gridDim.y * gridDim.z;
    unsigned sum, cnt, mine, sp = 0u;
    for (;;) {
        sum = 0u; cnt = 0u; mine = 0u;
#pragma unroll
        for (unsigned j = 0; j < 16; ++j) { const unsigned c = xb_ld(&bar[XB_XCNT(j)]); sum += c; cnt += (c > 0u) ? 1u : 0u; mine = (j == x) ? c : mine; }
        if (sum == G) break;
        __builtin_amdgcn_s_sleep(1);
        if ((++sp & 255u) == 0u) { if (xb_ld(&bar[XB_TMO])) break; if (sp > XB_SPIN_CAP) { atomicAdd(&bar[XB_TMO], 1u); break; } }
    }
    nloc = mine > 0u ? mine : 1u; nx = cnt > 0u ? cnt : 1u;
}

__device__ __forceinline__ void xcd_barrier(const XcdBarrier& b) {
    asm volatile("s_waitcnt vmcnt(0)" ::: "memory");
    __syncthreads();
    if (threadIdx.x == 0) {
        unsigned* bar = b.bar;
        __builtin_amdgcn_s_waitcnt(0);
        unsigned nloc = b.st[0], nx = b.st[1];
        if (nloc == 0u) { xcd_barrier_complete(bar, b.x, nloc, nx); b.st[0] = nloc; b.st[1] = nx; }
        const unsigned old = xb_add(&bar[XB_XSUB(b.x)], 1u);
        const unsigned gen = old / nloc;
        if (old + 1u == (gen + 1u) * nloc) {
            __builtin_amdgcn_fence(__ATOMIC_RELEASE, "agent");
            asm volatile("s_waitcnt vmcnt(0)" ::: "memory");
            const unsigned og = xb_add(&bar[XB_TOP], 1u);
            const unsigned tg = og / nx;
            if (og + 1u == (tg + 1u) * nx) xb_add(&bar[XB_TOPGEN], 1u);
            else XB_SPIN(xb_ld(&bar[XB_TOPGEN]) == tg, bar);
            __builtin_amdgcn_fence(__ATOMIC_ACQUIRE, "agent");
            xb_add(&bar[XB_XGEN(b.x)], 1u);
            asm volatile("s_waitcnt vmcnt(0)" ::: "memory");
        } else {
            XB_SPIN(xb_ld(&bar[XB_XGEN(b.x)]) == gen, bar);
            __builtin_amdgcn_fence(__ATOMIC_ACQUIRE, "agent");
            asm volatile("s_waitcnt vmcnt(0)" ::: "memory");
        }
    }
    __syncthreads();
}

struct Frame {
    LAS unsigned char* lds;
    volatile LAS unsigned* MISC;
    gu32* ctl;
    int wave, G, bid;
    __device__ __forceinline__ const float* in(int k) const { const volatile LAS unsigned* t = (const volatile LAS unsigned*)(lds + PTAB_OFF) + 2 * k;
        const unsigned lo = __builtin_amdgcn_readfirstlane(t[0]), hi = __builtin_amdgcn_readfirstlane(t[1]); return (const float*)(const GAS float*)(((unsigned long long)hi << 32) | lo); }
    __device__ __forceinline__ int lane() const { return lane_id_asm(); }
    __device__ __forceinline__ int tid() const { return wave * 64 + lane_id_asm(); }
    unsigned char* ws;
    float* out;
};

__device__ __forceinline__ void ld_row_f32(const float* row, int lane, f32x4 (&v)[4]) {
    const f32x4* p = (const f32x4*)row + lane;
#pragma unroll
    for (int j = 0; j < 4; ++j) v[j] = p[64 * j];
}
__device__ __forceinline__ void st_row_f32(float* row, int lane, const f32x4 (&v)[4]) {
    f32x4* p = (f32x4*)row + lane;
#pragma unroll
    for (int j = 0; j < 4; ++j) p[64 * j] = v[j];
}
__device__ __forceinline__ void ld_row_bf16(const bf16* row, int lane, f32x4 (&v)[4]) {
    const v2u* p = (const v2u*)row + lane;
#pragma unroll
    for (int j = 0; j < 4; ++j) { const v2u w = p[64 * j]; v[j] = (f32x4){bflo(w.x), bfhi(w.x), bflo(w.y), bfhi(w.y)}; }
}
__device__ __forceinline__ void ld_raw_bf16(const bf16* row, int lane, v2u (&w)[4]) {
    const v2u* p = (const v2u*)row + lane;
#pragma unroll
    for (int j = 0; j < 4; ++j) w[j] = p[64 * j];
}
__device__ __forceinline__ void unpack_bf16(const v2u (&w)[4], f32x4 (&v)[4]) {
#pragma unroll
    for (int j = 0; j < 4; ++j) { const unsigned a = w[j].x, b = w[j].y; v[j] = (f32x4){bflo(a), bfhi(a), bflo(b), bfhi(b)}; }
}
__device__ __forceinline__ void ld_raw_fp8(const unsigned char* row, int lane, unsigned (&w)[4]) {
    const unsigned* p = (const unsigned*)row + lane;
#pragma unroll
    for (int j = 0; j < 4; ++j) w[j] = p[64 * j];
}
__device__ __forceinline__ void unpack_fp8(const unsigned (&w)[4], f32x4 (&v)[4]) {
    typedef float f2_t __attribute__((ext_vector_type(2)));
#pragma unroll
    for (int j = 0; j < 4; ++j) { const f2_t lo = __builtin_amdgcn_cvt_pk_f32_fp8((int)w[j], false), hi = __builtin_amdgcn_cvt_pk_f32_fp8((int)w[j], true); v[j] = (f32x4){lo[0], lo[1], hi[0], hi[1]}; }
}
__device__ __forceinline__ void st_row_bf16(bf16* row, int lane, const f32x4 (&v)[4]) {
    v2u* p = (v2u*)row + lane;
#pragma unroll
    for (int j = 0; j < 4; ++j) { v2u w; w.x = pk2(v[j][0], v[j][1]); w.y = pk2(v[j][2], v[j][3]); p[64 * j] = w; }
}
__device__ __forceinline__ void st_row_fp8(unsigned char* row, int lane, const f32x4 (&v)[4]) {
    unsigned* p = (unsigned*)row + lane;
#pragma unroll
    for (int j = 0; j < 4; ++j) p[64 * j] = pk4_fp8(v[j][0], v[j][1], v[j][2], v[j][3]);
}
__device__ __forceinline__ float sumsq4(const f32x4 (&v)[4]) {
    float s = 0.f;
#pragma unroll
    for (int j = 0; j < 4; ++j) s += (v[j][0] * v[j][0] + v[j][1] * v[j][1]) + (v[j][2] * v[j][2] + v[j][3] * v[j][3]);
    return s;
}
__device__ __forceinline__ void ld_mod(const Frame& F, int l, int r, int ch, f32x4 (&v)[4]) {
    const float* modp = (const float*)(F.ws + WS_MODP); const int lane = F.lane();
    ld_row_f32(F.in(5) + (size_t)l * NMODC + ch * D, lane, v);
#pragma unroll
    for (int kc = 0; kc < MODKC; ++kc) { f32x4 t[4]; ld_row_f32(modp + ((size_t)((kc * 2 + l) * NMODR + r)) * NMODC + ch * D, lane, t);
#pragma unroll
        for (int j = 0; j < 4; ++j) v[j] += t[j]; }
}
__device__ __forceinline__ int row_batch(int m) { return m < NLAT ? (m >> 12) : 8; }

__device__ __forceinline__ void p0_transpose_item(const float* W, int K, int N, bf16* WT, int drow_off, LAS float* scr, int item, int lane) {
    const int nblk = N / 32, kb = item / nblk, nb = item % nblk, k0 = 64 * kb, n0 = 32 * nb;
#pragma unroll 8
    for (int i = 0; i < 32; ++i) { const int kk = 2 * i + (lane >> 5); scr[kk * 33 + (lane & 31)] = W[(size_t)(k0 + kk) * N + n0 + (lane & 31)]; }
    LDS_WAIT(); asm volatile("" ::: "memory");
    const int c = lane & 7;
#pragma unroll
    for (int j = 0; j < 4; ++j) { const int n = (lane >> 3) + 8 * j; const LAS float* s = scr + (8 * c) * 33 + n;
        v4u o; o.x = pk2(s[0 * 33], s[1 * 33]); o.y = pk2(s[2 * 33], s[3 * 33]); o.z = pk2(s[4 * 33], s[5 * 33]); o.w = pk2(s[6 * 33], s[7 * 33]);
        *(GAS v4u*)(WT + (size_t)(drow_off + n0 + n) * K + k0 + 8 * c) = o; }
    LDS_WAIT(); asm volatile("" ::: "memory");
}
__device__ __forceinline__ void p0_transpose_item_fp8(const float* W, int K, int N, unsigned char* WT, int drow_off, float wscale, LAS float* scr, int item, int lane) {
    const int nblk = N / 32, kb = item / nblk, nb = item % nblk, k0 = 64 * kb, n0 = 32 * nb;
#pragma unroll 8
    for (int i = 0; i < 32; ++i) { const int kk = 2 * i + (lane >> 5); scr[kk * 33 + (lane & 31)] = W[(size_t)(k0 + kk) * N + n0 + (lane & 31)] * wscale; }
    LDS_WAIT(); asm volatile("" ::: "memory");
    const int c = lane & 3;
#pragma unroll
    for (int j = 0; j < 2; ++j) { const int n = (lane >> 2) + 16 * j; const LAS float* s = scr + (16 * c) * 33 + n;
        v4u o; o.x = pk4_fp8(s[0 * 33], s[1 * 33], s[2 * 33], s[3 * 33]); o.y = pk4_fp8(s[4 * 33], s[5 * 33], s[6 * 33], s[7 * 33]);
        o.z = pk4_fp8(s[8 * 33], s[9 * 33], s[10 * 33], s[11 * 33]); o.w = pk4_fp8(s[12 * 33], s[13 * 33], s[14 * 33], s[15 * 33]);
        *(GAS v4u*)(WT + (size_t)(drow_off + n0 + n) * K + k0 + 16 * c) = o; }
    LDS_WAIT(); asm volatile("" ::: "memory");
}
constexpr float W8SCALE = 64.0f;
constexpr int I_WIN = 1024, I_WOUT = 512, I_WQKV = 1536, I_WO = 512, I_EXP = 32 * 768, I_NONEXP = I_WIN + I_WOUT + I_WQKV + I_WO, NITEMS_P0 = I_NONEXP + I_EXP;
__device__ __forceinline__ void p0_item(const Frame& F, LAS float* scr, int it) {
    int r = it; const int lane = F.lane();
    if (r < I_WIN) { const int n0 = 32 * (r % 64), ch = n0 & 1023, hf = n0 >> 10, drow0 = 256 * (ch >> 7) + 128 * hf + (ch & 127);
        p0_transpose_item_fp8(F.in(10), D, 2 * D, (unsigned char*)(F.ws + WS_WIN), drow0 - n0, W8SCALE, scr, r, lane); return; }
    r -= I_WIN;
    if (r < I_WOUT) { p0_transpose_item(F.in(16), D, D, (bf16*)(F.ws + WS_WOUT), 0, scr, r, lane); return; }
    r -= I_WOUT;
    if (r < I_WQKV) { p0_transpose_item_fp8(F.in(18), D, 3 * D, (unsigned char*)(F.ws + WS_WQKV), 0, W8SCALE, scr, r, lane); return; }
    r -= I_WQKV;
    if (r < I_WO) { p0_transpose_item(F.in(19), D, D, (bf16*)(F.ws + WS_WO), 0, scr, r, lane); return; }
    r -= I_WO;
    const int le = r / 768; int q = r % 768;
    if (q < 512) { const bool up = q >= 256; if (up) q -= 256; const int n0 = 32 * (q % 16), drow0 = 256 * (n0 >> 7) + (up ? 128 : 0) + (n0 & 127);
        p0_transpose_item_fp8((up ? F.in(24) : F.in(23)) + (size_t)le * D * DE, D, DE, (unsigned char*)(F.ws + WS_WGU) + (size_t)le * 1024 * 1024, drow0 - n0, W8SCALE, scr, q, lane); return; }
    q -= 512;
    p0_transpose_item_fp8(F.in(25) + (size_t)le * DE * D, DE, D, (unsigned char*)(F.ws + WS_WDN) + (size_t)le * 1024 * 512, 0, W8SCALE, scr, q, lane);
}
__device__ __forceinline__ void p0_mod_item(const Frame& F, LAS float* scr, int it) {
    const int lane = F.lane(), l = it / 192, rem = it % 192, cg = rem >> 3, kc = rem & 7, k0 = 128 * kc, n0 = 256 * cg + 4 * lane;
    const float* cvec = F.in(1); const float* cctx = F.in(3);
    for (int idx = lane; idx < NMODR * 128; idx += 64) { const int r = idx >> 7, kk = idx & 127; const float cv = (r < 8) ? cvec[r * D + k0 + kk] : cctx[k0 + kk];
        scr[idx] = cv / (1.0f + __expf(-cv)); }
    LDS_WAIT(); asm volatile("" ::: "memory");
    f32x4 acc[NMODR];
#pragma unroll
    for (int r = 0; r < NMODR; ++r) acc[r] = (f32x4){0.f, 0.f, 0.f, 0.f};
    const float* wp = F.in(4) + ((size_t)l * D + k0) * NMODC + n0;
#pragma unroll 8
    for (int kk = 0; kk < 128; ++kk) { const f32x4 w = *(const f32x4*)(wp + (size_t)kk * NMODC);
#pragma unroll
        for (int r = 0; r < NMODR; ++r) { const float s = scr[r * 128 + kk]; acc[r] += w * s; } }
    float* modp = (float*)(F.ws + WS_MODP);
#pragma unroll
    for (int r = 0; r < NMODR; ++r) *(f32x4*)(modp + ((size_t)((kc * 2 + l) * NMODR + r)) * NMODC + n0) = acc[r];
    LDS_WAIT(); asm volatile("" ::: "memory");
}
__device__ __forceinline__ void p0_prologue(const Frame& F) {
    LAS float* scr = (LAS float*)(F.lds + F.wave * 16384);
    if (F.wave == 0) p0_mod_item(F, scr, F.bid);
    if (F.wave == 1 && F.bid < 128) p0_mod_item(F, scr, 256 + F.bid);
    const int gw = F.bid * NWAVES + F.wave, NGW = F.G * NWAVES;
    for (int it = gw; it < I_NONEXP; it += NGW) p0_item(F, scr, it);
}
constexpr int JOB_ITEMS = 16 * 768;
__device__ __forceinline__ void filler(const Frame& F, int job, int quota) {
    LAS float* scr = (LAS float*)(F.lds + F.wave * 16384);
    volatile LAS int* slot = (volatile LAS int*)(F.MISC + 60);
    const int lane = F.lane();
    for (;;) {
        __syncthreads();
        if (F.wave == 0 && lane == 0) *slot = (int)__hip_atomic_fetch_add((unsigned*)(F.ctl + CW_JOB + 64 * job), 8u, RLX_AGENT);
        __syncthreads();
        const int base = *slot;
        if (base >= quota) { if (F.wave == 0 && lane == 0) (void)__hip_atomic_fetch_sub((unsigned*)(F.ctl + CW_JOB + 64 * job), 8u, RLX_AGENT); break; }
        const int idx = base + F.wave;
        if (idx < JOB_ITEMS) p0_item(F, scr, I_NONEXP + job * JOB_ITEMS + idx);
    }
}

__device__ __forceinline__ void p1_modulate(const Frame& F) {
    constexpr int RPB = MT / 256;
    unsigned char* H = (unsigned char*)(F.ws + WS_A);
    int rc = -1; f32x4 gs[4], sh[4]; const int lane = F.lane();
    const float* xlat = F.in(0); const float* xctx = F.in(2);
    f32x4 vn[4];
    { const int m = F.bid * RPB + F.wave; ld_row_f32(m < NLAT ? xlat + (size_t)m * D : xctx + (size_t)(m - NLAT) * D, lane, vn); }
    for (int rl = F.wave; rl < RPB; rl += NWAVES) {
        const int m = F.bid * RPB + rl, r = row_batch(m);
        f32x4 v[4];
#pragma unroll
        for (int j = 0; j < 4; ++j) v[j] = vn[j];
        if (rl + NWAVES < RPB) { const int m2 = m + NWAVES; ld_row_f32(m2 < NLAT ? xlat + (size_t)m2 * D : xctx + (size_t)(m2 - NLAT) * D, lane, vn); }
        if (r != rc) { f32x4 g[4], sc[4]; ld_row_f32(F.in(6), lane, g); ld_mod(F, 0, r, 1, sc); ld_mod(F, 0, r, 0, sh);
#pragma unroll
            for (int j = 0; j < 4; ++j) gs[j] = g[j] * (sc[j] + 1.0f);
            rc = r; }
        const float rstd = 1.0f / sqrtf(wave_sum(sumsq4(v)) * (1.0f / D) + EPS);
#pragma unroll
        for (int j = 0; j < 4; ++j) v[j] = v[j] * rstd * gs[j] + sh[j];
        st_row_fp8(H + (size_t)m * D, lane, v);
    }
}

__device__ __forceinline__ void p3_conv(const Frame& F) {
    const bf16* U = (const bf16*)(F.ws + WS_B); bf16* V = (bf16*)(F.ws + WS_A);
    const int tid = F.tid(), lane = F.lane();
    f32x2 w[CONVW]; const float* wdw = F.in(12);
#pragma unroll
    for (int j = 0; j < CONVW; ++j) w[j] = *(const f32x2*)(wdw + j * D + 2 * tid);
    const f32x2 bias2 = *(const f32x2*)(F.in(13) + 2 * tid);
    f32x4 lg[4], lb[4]; ld_row_f32(F.in(14), lane, lg); ld_row_f32(F.in(15), lane, lb);
    constexpr int TT = 32, NIN = TT + CONVW - 1;
    for (int tile = F.bid; tile < MT / TT; tile += F.G) {
        int rowbase, t0, T;
        if (tile < NLAT / TT) { rowbase = (tile >> 7) * SEQ; t0 = (tile & 127) * TT; T = SEQ; } else { const int t2 = tile - NLAT / TT; rowbase = NLAT + (t2 >> 3) * CTXL; t0 = (t2 & 7) * TT; T = CTXL; }
        for (int p = tid; p < NIN * 128; p += NTHR) { const int i = p >> 7, cp = p & 127, t = t0 - 15 + i;
            v4u val = (v4u){0u, 0u, 0u, 0u}; if (t >= 0 && t < T) val = *(const v4u*)(U + (size_t)(rowbase + t) * D + cp * 8);
            *(LAS v4u*)(F.lds + i * 2048 + cp * 16) = val; }
        __syncthreads();
        f32x2 res[TT];
#pragma unroll
        for (int g = 0; g < TT / 8; ++g) {
            f32x2 acc[8];
#pragma unroll
            for (int q = 0; q < 8; ++q) acc[q] = bias2;
#pragma unroll
            for (int ii = 0; ii < 8 + CONVW - 1; ++ii) { const int i = 8 * g + ii; const unsigned uw = *(const LAS unsigned*)(F.lds + i * 2048 + tid * 4); const f32x2 uv = (f32x2){bflo(uw), bfhi(uw)};
#pragma unroll
                for (int q = 0; q < 8; ++q) { const int j = ii - q; if (j >= 0 && j < CONVW) acc[q] += w[j] * uv; } }
#pragma unroll
            for (int q = 0; q < 8; ++q) res[8 * g + q] = acc[q];
        }
        __syncthreads();
#pragma unroll
        for (int tt = 0; tt < TT; ++tt) *(LAS f32x2*)(F.lds + tt * 4096 + tid * 8) = res[tt];
        __syncthreads();
#pragma unroll
        for (int q = 0; q < 4; ++q) { const int tt = 4 * F.wave + q; f32x4 v[4];
#pragma unroll
            for (int j = 0; j < 4; ++j) v[j] = *(const LAS f32x4*)(F.lds + tt * 4096 + j * 1024 + lane * 16);
            float s = 0.f;
#pragma unroll
            for (int j = 0; j < 4; ++j) s += (v[j][0] + v[j][1]) + (v[j][2] + v[j][3]);
            const float mean = wave_sum(s) * (1.0f / D);
#pragma unroll
            for (int j = 0; j < 4; ++j) v[j] = v[j] - mean;
            const float rstd = 1.0f / sqrtf(wave_sum(sumsq4(v)) * (1.0f / D) + EPS);
#pragma unroll
            for (int j = 0; j < 4; ++j) { f32x4 y = v[j] * rstd * lg[j] + lb[j];
#pragma unroll
                for (int e = 0; e < 4; ++e) y[e] = y[e] / (1.0f + __expf(-y[e]));
                v[j] = y; }
            st_row_bf16(V + (size_t)(rowbase + t0 + tt) * D, lane, v); }
        __syncthreads();
    }
}

constexpr int RW_OFF = 0, RW_BYTES = 256 * 272;
constexpr int REC_OFF = 72 * 1024;
constexpr int LRK_OFF = REC_OFF + 4096;
constexpr int BASE_OFF = LRK_OFF + 2048;
template <int L>
__device__ __forceinline__ void p_emid(const Frame& F) {
    constexpr int NROWS = (L == 0) ? MT : NLAT, RPB = NROWS / 256;
    const bf16* Y = (const bf16*)(F.ws + (L == 0 ? WS_B : WS_C)); unsigned char* TOK = (unsigned char*)(F.ws + WS_A);
    bf16* XS = (bf16*)(F.ws + WS_B);
    float* XC = (float*)(F.ws + WS_XC);
    const int tid = F.tid(), lane = F.lane(), m0 = F.bid * RPB;
    const float* rwG = F.in(21);
    for (int idx = tid; idx < 4096; idx += NTHR) { const int k = idx >> 2, ep = idx & 3; const f32x4 v = *(const f32x4*)(rwG + k * 16 + ep * 4);
        *(LAS f32x4*)(F.lds + RW_OFF + (k >> 2) * 272 + (k & 3) * 64 + ep * 16) = v; }
    __syncthreads();
    float rb[16];
    { const float* rbG = F.in(22);
#pragma unroll
    for (int e = 0; e < 16; ++e) rb[e] = rbG[e]; }
    int rc = -1; f32x4 ga[4], gp[4], gs[4], sh[4];
    const float* xlat = F.in(0); const float* xctx = F.in(2);
    v2u yn[4]; f32x4 xn[4];
    v2u xbn[4];
    { const int m = m0 + F.wave; ld_raw_bf16(Y + (size_t)m * D, lane, yn);
      if (L == 0) ld_row_f32(m < NLAT ? xlat + (size_t)m * D : xctx + (size_t)(m - NLAT) * D, lane, xn); else ld_raw_bf16(XS + (size_t)m * D, lane, xbn); }
    for (int rl = F.wave; rl < RPB; rl += NWAVES) {
        const int m = m0 + rl, r = row_batch(m);
        f32x4 y[4], xv[4];
        unpack_bf16(yn, y);
        if (L == 0) {
#pragma unroll
            for (int j = 0; j < 4; ++j) xv[j] = xn[j];
        } else unpack_bf16(xbn, xv);
        if (rl + NWAVES < RPB) { const int m2 = m + NWAVES; ld_raw_bf16(Y + (size_t)m2 * D, lane, yn);
            if (L == 0) ld_row_f32(m2 < NLAT ? xlat + (size_t)m2 * D : xctx + (size_t)(m2 - NLAT) * D, lane, xn); else ld_raw_bf16(XS + (size_t)m2 * D, lane, xbn); }
        if (r != rc) { f32x4 g[4], sc[4]; ld_mod(F, L, r, 2, ga); ld_row_f32(F.in(7) + L * D, lane, gp); ld_row_f32(F.in(8) + L * D, lane, g); ld_mod(F, L, r, 4, sc); ld_mod(F, L, r, 3, sh);
#pragma unroll
            for (int j = 0; j < 4; ++j) gs[j] = g[j] * (sc[j] + 1.0f);
            rc = r; }
        const float rstdy = 1.0f / sqrtf(wave_sum(sumsq4(y)) * (1.0f / D) + EPS);
#pragma unroll
        for (int j = 0; j < 4; ++j) xv[j] = xv[j] + ga[j] * (y[j] * rstdy * gp[j]) * (((DBG_SKIP >> (2 * L)) & 1) ? 0.f : 1.f);
        if (m < NLAT) st_row_bf16(XS + (size_t)m * D, lane, xv); else st_row_f32(XC + (size_t)(m - NLAT) * D, lane, xv);
        const float rstd1 = 1.0f / sqrtf(wave_sum(sumsq4(xv)) * (1.0f / D) + EPS);
#pragma unroll
        for (int j = 0; j < 4; ++j) xv[j] = xv[j] * rstd1 * gs[j] + sh[j];
        st_row_fp8(TOK + (size_t)m * D, lane, xv);
        float a[16];
#pragma unroll
        for (int e = 0; e < 16; ++e) a[e] = 0.f;
#pragma unroll
        for (int j = 0; j < 4; ++j)
#pragma unroll
            for (int i = 0; i < 4; ++i) { const float tv = xv[j][i]; const LAS f32x4* wp = (const LAS f32x4*)(F.lds + RW_OFF + (64 * j + lane) * 272 + i * 64);
#pragma unroll
                for (int ep = 0; ep < 4; ++ep) { const f32x4 wv = wp[ep];
#pragma unroll
                    for (int cc = 0; cc < 4; ++cc) a[4 * ep + cc] += tv * wv[cc]; } }
        float k8[8], k4[4];
#pragma unroll
        for (int i = 0; i < 8; ++i) { const auto rr = __builtin_amdgcn_permlane32_swap(__builtin_bit_cast(unsigned, a[i]), __builtin_bit_cast(unsigned, a[8 + i]), false, false);
            const unsigned r0_ = rr[0], r1_ = rr[1]; k8[i] = __uint_as_float(r0_) + __uint_as_float(r1_); }
#pragma unroll
        for (int i = 0; i < 4; ++i) { const auto rr = __builtin_amdgcn_permlane16_swap(__builtin_bit_cast(unsigned, k8[i]), __builtin_bit_cast(unsigned, k8[4 + i]), false, false);
            const unsigned r0_ = rr[0], r1_ = rr[1]; k4[i] = row16_sum(__uint_as_float(r0_) + __uint_as_float(r1_)); }
        float s[16], ss[16];
        const float lgsel = (lane & 2) ? ((lane & 1) ? k4[3] : k4[2]) : ((lane & 1) ? k4[1] : k4[0]);
        const float sgl = 1.0f / (1.0f + __expf(-lgsel));
#pragma unroll
        for (int e = 0; e < 16; ++e) { s[e] = rdlane(sgl, 16 * (e >> 2) + (e & 3)); ss[e] = s[e] + rb[e]; }
        float gsc[4]; int i0[4], i1[4];
#pragma unroll
        for (int g = 0; g < 4; ++g) { int a0 = 0; float mx = ss[4 * g];
#pragma unroll
            for (int i = 1; i < 4; ++i) if (ss[4 * g + i] > mx) { mx = ss[4 * g + i]; a0 = i; }
            int b0 = -1; float m2 = -3.0e38f;
#pragma unroll
            for (int i = 0; i < 4; ++i) if (i != a0 && ss[4 * g + i] > m2) { m2 = ss[4 * g + i]; b0 = i; }
            gsc[g] = mx + m2; i0[g] = 4 * g + a0; i1[g] = 4 * g + b0; }
        int gst = 0; float gm = gsc[0];
#pragma unroll
        for (int g = 1; g < 4; ++g) if (gsc[g] > gm) { gm = gsc[g]; gst = g; }
        int e0 = i0[0], e1 = i1[0];
#pragma unroll
        for (int g = 1; g < 4; ++g) if (gst == g) { e0 = i0[g]; e1 = i1[g]; }
        float w0 = 0.f, w1 = 0.f;
#pragma unroll
        for (int e = 0; e < 16; ++e) { if (e == e0) w0 = s[e]; if (e == e1) w1 = s[e]; }
        const float inv = 1.0f / (w0 + w1); w0 *= inv; w1 *= inv;
        if (lane == 0) *(LAS v4u*)(F.lds + REC_OFF + rl * 16) = (v4u){(unsigned)e0, (unsigned)e1, __builtin_bit_cast(unsigned, w0), __builtin_bit_cast(unsigned, w1)};
    }
    __syncthreads();
    if (F.wave == 0 && lane < 16) {
        int cntl = 0;
        for (int rl = 0; rl < RPB; ++rl) { const v4u rec = *(const LAS v4u*)(F.lds + REC_OFF + rl * 16);
            if ((int)rec.x == lane) { *(LAS int*)(F.lds + LRK_OFF + rl * 8) = cntl; ++cntl; }
            if ((int)rec.y == lane) { *(LAS int*)(F.lds + LRK_OFF + rl * 8 + 4) = cntl; ++cntl; } }
        const unsigned base = __hip_atomic_fetch_add((unsigned*)(F.ctl + CW_CNT + (L * 16 + lane) * 64), (unsigned)cntl, RLX_AGENT);
        *(LAS int*)(F.lds + BASE_OFF + lane * 4) = (int)base;
    }
    __syncthreads();
    int* perm2 = (int*)(F.ws + WS_PERM); v2u* slot = (v2u*)(F.ws + WS_SLOT);
    for (int idx = tid; idx < RPB * 2; idx += NTHR) { const int rl = idx >> 1, k = idx & 1; const v4u rec = *(const LAS v4u*)(F.lds + REC_OFF + rl * 16);
        const int e = k ? (int)rec.y : (int)rec.x; const unsigned wb = k ? rec.w : rec.z;
        const int rank = *(const LAS int*)(F.lds + BASE_OFF + e * 4) + *(const LAS int*)(F.lds + LRK_OFF + rl * 8 + k * 4);
        const int m = m0 + rl;
        perm2[(size_t)e * MT + rank] = m;
        slot[(size_t)m * 2 + k] = (v2u){((unsigned)e << 24) | (unsigned)rank, wb}; }
    __syncthreads();
}

__device__ __forceinline__ void moe_setup(const Frame& F, int L) {
    const int tid = F.tid();
    if (tid < 16) F.MISC[40 + tid] = __hip_atomic_load((unsigned*)(F.ctl + CW_CNT + (L * 16 + tid) * 64), RLX_AGENT);
    __syncthreads();
    if (tid == 0) { unsigned p = 0; for (int e = 0; e < 16; ++e) { F.MISC[16 + e] = p; p += (F.MISC[40 + e] + 255u) >> 8; } F.MISC[32] = p; }
    __syncthreads();
}
__device__ __forceinline__ void moe_stage_perm(const Frame& F) {
    const int* perm2 = (const int*)(F.ws + WS_PERM); LAS int* permL = (LAS int*)(F.lds + PERML_OFF);
    const int ntile = (int)F.MISC[32], tid = F.tid();
    for (int i = 0; i < 8; ++i) { const int Lu = i * F.G + F.bid; if (Lu >= 4 * ntile) break;
        const int rt = Lu >> 2; int e = 0;
        for (int j = 1; j < 16; ++j) e += (rt >= (int)F.MISC[16 + j]) ? 1 : 0;
        if (tid < 256) { const int rank = (rt - (int)F.MISC[16 + e]) * 256 + tid; permL[i * 256 + tid] = (rank < (int)F.MISC[40 + e]) ? perm2[(size_t)e * MT + rank] : 0; } }
    __syncthreads();
}

template <int L>
__device__ __forceinline__ void p_epost(const Frame& F) {
    constexpr int NROWS = (L == 0) ? MT : NLAT, RPB = NROWS / 256;
    const unsigned char* FB = (const unsigned char*)(F.ws + WS_D2); unsigned char* H = (unsigned char*)(F.ws + WS_A);
    float* XC = (float*)(F.ws + WS_XC); const v2u* slot = (const v2u*)(F.ws + WS_SLOT);
    const int lane = F.lane(), m0 = F.bid * RPB;
    int rc = -1; f32x4 ga[4], gp[4], gs[4], sh[4];
    v4u sl_n2 = (v4u){0u, 0u, 0u, 0u}; unsigned f0n[4], f1n[4]; v2u xbn[4]; f32x4 xn[4]; float w0n, w1n;
    bf16* XS = (bf16*)(F.ws + WS_B);
#define EP_ISSUE(mm, slv) do { const unsigned sx0 = __builtin_amdgcn_readfirstlane((slv).x), sy0 = __builtin_amdgcn_readfirstlane((slv).y), sx1 = __builtin_amdgcn_readfirstlane((slv).z), sy1 = __builtin_amdgcn_readfirstlane((slv).w); \
        const size_t v0_ = (size_t)F.MISC[16 + (sx0 >> 24)] * 256 + (sx0 & 0xffffffu), v1_ = (size_t)F.MISC[16 + (sx1 >> 24)] * 256 + (sx1 & 0xffffffu); \
        w0n = __uint_as_float(sy0); w1n = __uint_as_float(sy1); ld_raw_fp8(FB + v0_ * D, lane, f0n); ld_raw_fp8(FB + v1_ * D, lane, f1n); \
        if ((mm) < NLAT) ld_raw_bf16(XS + (size_t)(mm) * D, lane, xbn); else ld_row_f32(XC + (size_t)((mm) - NLAT) * D, lane, xn); } while (0)
    { const int m = m0 + F.wave; const v4u sl0 = *(const v4u*)(slot + (size_t)m * 2);
      if (F.wave + NWAVES < RPB) sl_n2 = *(const v4u*)(slot + (size_t)(m + NWAVES) * 2);
      EP_ISSUE(m, sl0); }
    for (int rl = F.wave; rl < RPB; rl += NWAVES) {
        const int m = m0 + rl, r = row_batch(m);
        f32x4 f0[4], f1[4], xv[4]; const float w0 = w0n, w1 = w1n;
        unpack_fp8(f0n, f0); unpack_fp8(f1n, f1);
        if (m < NLAT) unpack_bf16(xbn, xv); else {
#pragma unroll
            for (int j = 0; j < 4; ++j) xv[j] = xn[j]; }
        if (rl + NWAVES < RPB) { const v4u slc = sl_n2; if (rl + 2 * NWAVES < RPB) sl_n2 = *(const v4u*)(slot + (size_t)(m + 2 * NWAVES) * 2); EP_ISSUE(m + NWAVES, slc); }
        if (r != rc) { ld_mod(F, L, r, 5, ga); ld_row_f32(F.in(9) + L * D, lane, gp);
            if (L == 0) { f32x4 g[4], sc[4]; ld_row_f32(F.in(6) + D, lane, g); ld_mod(F, 1, r, 1, sc); ld_mod(F, 1, r, 0, sh);
#pragma unroll
                for (int j = 0; j < 4; ++j) gs[j] = g[j] * (sc[j] + 1.0f); }
            rc = r; }
#pragma unroll
        for (int j = 0; j < 4; ++j) f0[j] = (DBG_SLOT == 1) ? f0[j] : (DBG_SLOT == 2) ? f1[j] : (DBG_SLOT == 3) ? f0[j] * 0.5f + f1[j] * 0.5f : f0[j] * w0 + f1[j] * w1;
        const float rstdf = 1.0f / sqrtf(wave_sum(sumsq4(f0)) * (1.0f / D) + EPS);
#pragma unroll
        for (int j = 0; j < 4; ++j) xv[j] = xv[j] + ga[j] * (f0[j] * rstdf * gp[j]) * (((DBG_SKIP >> (2 * L + 1)) & 1) ? 0.f : 1.f);
        if (L == 1) st_row_f32(F.out + (size_t)m * D, lane, xv);
        else if (m < NLAT) st_row_bf16(XS + (size_t)m * D, lane, xv); else st_row_f32(XC + (size_t)(m - NLAT) * D, lane, xv);
        if (L == 0) {
            const float rstd2 = 1.0f / sqrtf(wave_sum(sumsq4(xv)) * (1.0f / D) + EPS);
#pragma unroll
            for (int j = 0; j < 4; ++j) xv[j] = xv[j] * rstd2 * gs[j] + sh[j];
            st_row_fp8(H + (size_t)m * D, lane, xv);
        }
    }
#undef EP_ISSUE
}

constexpr int AT_CK = 0, AT_CV = 32768, AT_RPB = 65536;
constexpr float LOG2E = 1.4426950408889634f;
__device__ __forceinline__ float xrow_max(float m) {
    { const auto rr = __builtin_amdgcn_permlane16_swap(__builtin_bit_cast(unsigned, m), __builtin_bit_cast(unsigned, m), false, false); const unsigned a_ = rr[0], b_ = rr[1]; m = fmaxf(__uint_as_float(a_), __uint_as_float(b_)); }
    { const auto rr = __builtin_amdgcn_permlane32_swap(__builtin_bit_cast(unsigned, m), __builtin_bit_cast(unsigned, m), false, false); const unsigned a_ = rr[0], b_ = rr[1]; m = fmaxf(__uint_as_float(a_), __uint_as_float(b_)); }
    return m;
}
__device__ __forceinline__ float xrow_sum(float m) {
    { const auto rr = __builtin_amdgcn_permlane16_swap(__builtin_bit_cast(unsigned, m), __builtin_bit_cast(unsigned, m), false, false); const unsigned a_ = rr[0], b_ = rr[1]; m = __uint_as_float(a_) + __uint_as_float(b_); }
    { const auto rr = __builtin_amdgcn_permlane32_swap(__builtin_bit_cast(unsigned, m), __builtin_bit_cast(unsigned, m), false, false); const unsigned a_ = rr[0], b_ = rr[1]; m = __uint_as_float(a_) + __uint_as_float(b_); }
    return m;
}
__device__ __forceinline__ void attn_softmax(f32x4 (&s)[4], float& mrun, f32x4& osum, f32x4 (&o)[4], bf16x8 (&pf)[2]) {
    float mx = mrun;
#pragma unroll
    for (int t = 0; t < 4; ++t) mx = fmaxf(fmaxf(mx, fmaxf(s[t][0], s[t][1])), fmaxf(s[t][2], s[t][3]));
    mx = xrow_max(mx);
    if (__builtin_amdgcn_ballot_w64(mx > mrun) != 0ull) {
        const float alpha = __builtin_amdgcn_exp2f(mrun - mx);
        mrun = mx; osum = osum * alpha;
#pragma unroll
        for (int db = 0; db < 4; ++db) o[db] = o[db] * alpha;
    }
#pragma unroll
    for (int t = 0; t < 4; ++t)
#pragma unroll
        for (int i = 0; i < 4; ++i) s[t][i] = __builtin_amdgcn_exp2f(s[t][i] - mx);
#pragma unroll
    for (int bb = 0; bb < 2; ++bb) { v4u pw; pw.x = pg8::cvt_pk_bf16(s[2 * bb][0], s[2 * bb][1]); pw.y = pg8::cvt_pk_bf16(s[2 * bb][2], s[2 * bb][3]);
        pw.z = pg8::cvt_pk_bf16(s[2 * bb + 1][0], s[2 * bb + 1][1]); pw.w = pg8::cvt_pk_bf16(s[2 * bb + 1][2], s[2 * bb + 1][3]); pf[bb] = __builtin_bit_cast(bf16x8, pw); }
}
template <int ABL  >
__device__ __forceinline__ void p10_attn(const Frame& F) {
    const bf16* Qh = (const bf16*)F.out; const bf16* Kh = (const bf16*)(F.ws + WS_C); const bf16* Vb = (const bf16*)(F.ws + WS_D2); bf16* O = (bf16*)(F.ws + WS_A);
    const int lane = F.lane(), tid = F.wave * 64 + lane, qi = lane & 15, q4 = lane >> 4;
    const int per = (BATCH * NH * GROWS * 4) / F.G;
    const int bh = (F.bid * per) >> 8, h = bh & 15, b = bh >> 4;
    const bf16* Kbh = Kh + (size_t)bh * KSLOT * HD; const bf16* Vbh = Vb + (size_t)bh * (KSLOT / 8) * 512;
#pragma unroll
    for (int i = 0; i < 4; ++i) { const int kf = F.wave * 4 + i, blk = kf >> 2, tl = (kf >> 1) & 1, dh = kf & 1;
        const v4u kv = *(const v4u*)(Kbh + (size_t)(SEQ + 32 * blk + 8 * (qi >> 2) + 4 * tl + (qi & 3)) * HD + dh * 32 + 8 * q4);
        const int vblk = kf >> 2, db = kf & 3;
        const v4u vv = *(const v4u*)(Vbh + (size_t)(SEQ / 8 + 4 * vblk + q4) * 512 + (db * 16 + qi) * 8);
        *(LAS v4u*)(F.lds + AT_CK + kf * 1024 + lane * 16) = kv; *(LAS v4u*)(F.lds + AT_CV + kf * 1024 + lane * 16) = vv; }
    { const float* rpbG = F.in(20) + h * 465; LAS float* rpbW = (LAS float*)(F.lds + AT_RPB);
        for (int idx = tid; idx < 15 * 32; idx += NTHR) { const int ri = idx >> 5, ci = idx & 31; rpbW[idx] = (ci < 31) ? rpbG[ri * 31 + ci] * LOG2E : -1.0e30f; } }
    __syncthreads();
    const int seg = F.wave & 3;
    const int cb = (seg == 0) ? 0 : (seg == 1) ? 8 : (seg == 2) ? 24 : 32;
    const int qc = 16 * seg + qi, cs = min(max(qc - WINW / 2, 0), GRIDW - WINW);
    int coff[2][4];
#pragma unroll
    for (int tl = 0; tl < 2; ++tl)
#pragma unroll
        for (int i = 0; i < 4; ++i) { const int kc = cb + 8 * q4 + 4 * tl + i; const bool ok = (kc >= cs) && (kc < cs + WINW); coff[tl][i] = AT_RPB + 4 * (ok ? (kc - qc + (WINW - 1)) : 31); }
    const bf16x8 ones = __builtin_bit_cast(bf16x8, (v4u){0x3f803f80u, 0x3f803f80u, 0x3f803f80u, 0x3f803f80u});
    for (int it = 0; it < per; it += NWAVES) {
        const int wu = F.bid * per + it + F.wave;
        const int r = (wu >> 2) & 63;
        const int r0 = min(max(r - WINH / 2, 0), GROWS - WINH);
        const bf16* Qp = Qh + ((size_t)bh * SEQ + r * GRIDW + qc) * HD;
        const bf16x8 qf0 = *(const bf16x8*)(Qp + 8 * q4), qf1 = *(const bf16x8*)(Qp + 32 + 8 * q4);
        const bf16* kp0 = Kbh + (size_t)(r0 * GRIDW + cb + 8 * (qi >> 2) + (qi & 3)) * HD + 8 * q4;
        const bf16* vp0 = Vbh + (size_t)((r0 * GRIDW + cb) / 8 + q4) * 512 + qi * 8;
        int boff[2][4];
#pragma unroll
        for (int tl = 0; tl < 2; ++tl)
#pragma unroll
            for (int i = 0; i < 4; ++i) boff[tl][i] = coff[tl][i] + (r0 - r + (WINH - 1)) * 128;
        bf16x8 kw[4][2][2][2], vw[4][2][4];
#define AT_LOADK(g) do { _Pragma("unroll") for (int bb = 0; bb < 2; ++bb) _Pragma("unroll") for (int tl = 0; tl < 2; ++tl) { if (ABL & 1) { kw[g][bb][tl][0] = qf0; kw[g][bb][tl][1] = qf1; continue; } \
            kw[g][bb][tl][0] = *(const bf16x8*)(kp0 + (size_t)((2 * (g) + bb) * GRIDW + 4 * tl) * HD); kw[g][bb][tl][1] = *(const bf16x8*)(kp0 + (size_t)((2 * (g) + bb) * GRIDW + 4 * tl) * HD + 32); } } while (0)
#define AT_LOADV(g) do { _Pragma("unroll") for (int bb = 0; bb < 2; ++bb) _Pragma("unroll") for (int db = 0; db < 4; ++db) vw[g][bb][db] = (ABL & 1) ? qf0 : *(const bf16x8*)(vp0 + (size_t)((2 * (g) + bb) * (GRIDW / 8)) * 512 + db * 128); } while (0)
        float mrun = -1.0e30f;
        f32x4 osum = (f32x4){0.f, 0.f, 0.f, 0.f};
        f32x4 o[4];
#pragma unroll
        for (int db = 0; db < 4; ++db) o[db] = (f32x4){0.f, 0.f, 0.f, 0.f};
        AT_LOADK(0); AT_LOADV(0);
        __builtin_amdgcn_sched_barrier(0);
#pragma unroll
        for (int g = 0; g < 4; ++g) {
            {
                f32x4 s[4]; bf16x8 pf[2];
#pragma unroll
                for (int bb = 0; bb < 2; ++bb) { const int blk = 2 * g + bb;
#pragma unroll
                    for (int tl = 0; tl < 2; ++tl) { const bf16x8 k0 = (ABL & 2) ? qf1 : *(const LAS bf16x8*)(F.lds + AT_CK + ((blk * 2 + tl) * 2 + 0) * 1024 + lane * 16), k1 = (ABL & 2) ? qf0 : *(const LAS bf16x8*)(F.lds + AT_CK + ((blk * 2 + tl) * 2 + 1) * 1024 + lane * 16);
                        f32x4 acc = (f32x4){0.f, 0.f, 0.f, 0.f};
                        acc = __builtin_amdgcn_mfma_f32_16x16x32_bf16(k0, qf0, acc, 0, 0, 0);
                        acc = __builtin_amdgcn_mfma_f32_16x16x32_bf16(k1, qf1, acc, 0, 0, 0);
                        s[2 * bb + tl] = acc; } }
                attn_softmax(s, mrun, osum, o, pf);
#pragma unroll
                for (int bb = 0; bb < 2; ++bb) { osum = __builtin_amdgcn_mfma_f32_16x16x32_bf16(ones, pf[bb], osum, 0, 0, 0);
#pragma unroll
                    for (int db = 0; db < 4; ++db) { const bf16x8 vf = (ABL & 2) ? qf1 : *(const LAS bf16x8*)(F.lds + AT_CV + ((2 * g + bb) * 4 + db) * 1024 + lane * 16);
                        o[db] = __builtin_amdgcn_mfma_f32_16x16x32_bf16(vf, pf[bb], o[db], 0, 0, 0); } }
            }
            __builtin_amdgcn_sched_barrier(0);
            {
                f32x4 s[4]; bf16x8 pf[2];
#pragma unroll
                for (int bb = 0; bb < 2; ++bb)
#pragma unroll
                    for (int tl = 0; tl < 2; ++tl) { f32x4 acc;
#pragma unroll
                        for (int i = 0; i < 4; ++i) acc[i] = *(const LAS float*)(F.lds + boff[tl][i] + (2 * g + bb) * 128);
                        acc = __builtin_amdgcn_mfma_f32_16x16x32_bf16(kw[g][bb][tl][0], qf0, acc, 0, 0, 0);
                        acc = __builtin_amdgcn_mfma_f32_16x16x32_bf16(kw[g][bb][tl][1], qf1, acc, 0, 0, 0);
                        s[2 * bb + tl] = acc; }
                if (g < 3) { AT_LOADK(g + 1); }
                __builtin_amdgcn_sched_barrier(0);
                attn_softmax(s, mrun, osum, o, pf);
#pragma unroll
                for (int bb = 0; bb < 2; ++bb) { osum = __builtin_amdgcn_mfma_f32_16x16x32_bf16(ones, pf[bb], osum, 0, 0, 0);
#pragma unroll
                    for (int db = 0; db < 4; ++db) o[db] = __builtin_amdgcn_mfma_f32_16x16x32_bf16(vw[g][bb][db], pf[bb], o[db], 0, 0, 0); }
                if (g < 3) { AT_LOADV(g + 1); }
                __builtin_amdgcn_sched_barrier(0);
            }
        }
#undef AT_LOADK
#undef AT_LOADV
        const float inv = 1.0f / osum[0];
        bf16* op = O + ((size_t)b * SEQ + r * GRIDW + qc) * D + h * HD + 4 * q4;
#pragma unroll
        for (int db = 0; db < 4; ++db) { v2u w; w.x = pg8::cvt_pk_bf16(o[db][0] * inv, o[db][1] * inv); w.y = pg8::cvt_pk_bf16(o[db][2] * inv, o[db][3] * inv); if (ABL == 0 || w.x == 0x12345u) *(v2u*)(op + db * 16) = w; }
    }
    __syncthreads();
}

#ifndef MK_N_LAUNCHES
#define MK_N_LAUNCHES 1
#endif
constexpr int N_PHASES = 16;
constexpr int N_LAUNCHES = MK_N_LAUNCHES;
struct Args { const float* in[26]; float* out; unsigned char* ws; int ph_lo, ph_hi; };

__global__ void __launch_bounds__(NTHR, 2) fwd_kernel(Args args) {
    extern __shared__ __attribute__((aligned(16))) unsigned char lds[];
    Frame F;
    F.lds = (LAS unsigned char*)lds;
    F.MISC = (volatile LAS unsigned*)(F.lds + MISC_OFF);
    F.wave = __builtin_amdgcn_readfirstlane((int)threadIdx.x >> 6);
    F.G = gridDim.x; F.bid = blockIdx.x;
    F.ws = args.ws; F.ctl = (gu32*)(args.ws + WS_CTL); F.out = args.out;
    for (int u = threadIdx.x; u < 256; u += NTHR) F.MISC[u] = 0u;
    if (threadIdx.x < 26) { const unsigned long long pv = (unsigned long long)args.in[threadIdx.x]; volatile LAS unsigned* t = (volatile LAS unsigned*)(F.lds + PTAB_OFF) + 2 * threadIdx.x; t[0] = (unsigned)pv; t[1] = (unsigned)(pv >> 32); }
    __syncthreads();
    XcdBarrier bar; bar.bar = (unsigned*)(F.ctl + CW_BAR); bar.x = 0; bar.st = nullptr;
    if (N_LAUNCHES == 1) bar = xcd_barrier_post((unsigned*)(F.ctl + CW_BAR), F.MISC + 8);
    const int lo = args.ph_lo, hi = args.ph_hi;
#ifndef PHASE_MASK
#define PHASE_MASK 0xFFFF
#endif
#define IN(k) ((((PHASE_MASK) >> (k)) & 1) && lo <= (k) && (k) < hi)
#define SEAM(k) do { if (IN(k) && IN((k) + 1)) { xcd_barrier(bar); if (PROBE_MASK == 0x10000) xcd_barrier(bar); } } while (0)
    const char* wsb = (const char*)F.ws;
    LAS unsigned char* ring = F.lds;

    if (IN(0)) { _Pragma("unroll") for (int rep = 0; rep < REP(0); ++rep) { p0_prologue(F); __syncthreads(); } }
    SEAM(0);
    if (IN(1)) { _Pragma("unroll") for (int rep = 0; rep < REP(1); ++rep) p1_modulate(F); }
    SEAM(1);
    if (IN(2)) {
        pg8::DenseSched S{wsb + WS_A, wsb + WS_WIN, D / 2, MT / 256, 8, F.G, F.bid};
        pg8::EpiGated<0> E{(bf16*)(F.ws + WS_B), D, F.in(11), D};
        _Pragma("unroll") for (int rep = 0; rep < REP(2); ++rep) pg8::gemm_phase<pg8::EpiGated<0>, pg8::DenseSched, true, true>(ring, D / 2, S, E, F.wave);
        filler(F, 0, 3600);
    }
    SEAM(2);
    if (IN(3)) { _Pragma("unroll") for (int rep = 0; rep < REP(3); ++rep) p3_conv(F); }
    SEAM(3);
    if (IN(4)) {
        pg8::DenseSched S{wsb + WS_A, wsb + WS_WOUT, D, MT / 256, 4, F.G, F.bid};
        pg8::EpiBf16B E{(bf16*)(F.ws + WS_B), D, F.in(17)};
        _Pragma("unroll") for (int rep = 0; rep < REP(4); ++rep) pg8::gemm_phase<pg8::EpiBf16B, pg8::DenseSched, true>(ring, D, S, E, F.wave);
        filler(F, 0, JOB_ITEMS);
    }
    SEAM(4);
    if (IN(5)) { filler(F, 0, JOB_ITEMS); p_emid<0>(F); }
    SEAM(5);
    if (IN(6)) {
        moe_setup(F, 0); moe_stage_perm(F);
        pg8::MoeUpSched S; S.tpre = (const volatile LAS int*)(F.MISC + 16); S.G = F.G; S.c = F.bid; S.A = wsb + WS_A; S.Wgu = wsb + WS_WGU + (size_t)0 * 16 * 1024 * 1024; S.permL = (const LAS int*)(F.lds + PERML_OFF); S.kb = D;
        pg8::EpiGated<1, true> E{(bf16*)(F.ws + WS_C), DE, nullptr, 0};
        _Pragma("unroll") for (int rep = 0; rep < REP(6); ++rep) pg8::gemm_phase<pg8::EpiGated<1, true>, pg8::MoeUpSched, true, true>(ring, D / 2, S, E, F.wave);
        filler(F, 1, 3000);
    }
    SEAM(6);
    if (IN(7)) {
        moe_setup(F, 0);
        pg8::MoeDownSched S; S.tpre = (const volatile LAS int*)(F.MISC + 16); S.G = F.G; S.c = F.bid; S.A = wsb + WS_C; S.Wdn = wsb + WS_WDN + (size_t)0 * 16 * 1024 * 512; S.kb = DE;
        pg8::EpiF8 E{(unsigned char*)(F.ws + WS_D2), D};
        _Pragma("unroll") for (int rep = 0; rep < REP(7); ++rep) pg8::gemm_phase<pg8::EpiF8, pg8::MoeDownSched, true, true>(ring, DE / 2, S, E, F.wave);
        filler(F, 1, 4500);
    }
    SEAM(7);
    if (IN(8)) { moe_setup(F, 0); p_epost<0>(F); }
    SEAM(8);
    if (IN(9)) {
        pg8::QkvSched S{wsb + WS_A, wsb + WS_WQKV, F.G, F.bid, D};
        pg8::EpiQkv E{(bf16*)F.out, (bf16*)(F.ws + WS_C), (bf16*)(F.ws + WS_D2), 0.125f * 1.4426950408889634f};
        _Pragma("unroll") for (int rep = 0; rep < REP(9); ++rep) pg8::gemm_phase<pg8::EpiQkv, pg8::QkvSched, true, true>(ring, D / 2, S, E, F.wave);
        filler(F, 1, 8100);
    }
    SEAM(9);
#ifndef ATT_ABL
#define ATT_ABL 0
#endif
    if (IN(10)) { if (REP(10) == 2) p10_attn<ATT_ABL>(F); p10_attn<0>(F); }
    SEAM(10);
    if (IN(11)) {
        pg8::DenseSched S{wsb + WS_A, wsb + WS_WO, D, NLAT / 256, 4, F.G, F.bid};
        pg8::EpiBf16 E{(bf16*)(F.ws + WS_C), D, nullptr};
        _Pragma("unroll") for (int rep = 0; rep < REP(11); ++rep) pg8::gemm_phase<pg8::EpiBf16, pg8::DenseSched, true>(ring, D, S, E, F.wave);
    }
    SEAM(11);
    if (IN(12)) { filler(F, 1, JOB_ITEMS); p_emid<1>(F); }
    SEAM(12);
    if (IN(13)) {
        moe_setup(F, 1); moe_stage_perm(F);
        pg8::MoeUpSched S; S.tpre = (const volatile LAS int*)(F.MISC + 16); S.G = F.G; S.c = F.bid; S.A = wsb + WS_A; S.Wgu = wsb + WS_WGU + (size_t)1 * 16 * 1024 * 1024; S.permL = (const LAS int*)(F.lds + PERML_OFF); S.kb = D;
        pg8::EpiGated<1, true> E{(bf16*)(F.ws + WS_C), DE, nullptr, 0};
        _Pragma("unroll") for (int rep = 0; rep < REP(13); ++rep) pg8::gemm_phase<pg8::EpiGated<1, true>, pg8::MoeUpSched, true, true>(ring, D / 2, S, E, F.wave);
    }
    SEAM(13);
    if (IN(14)) {
        moe_setup(F, 1);
        pg8::MoeDownSched S; S.tpre = (const volatile LAS int*)(F.MISC + 16); S.G = F.G; S.c = F.bid; S.A = wsb + WS_C; S.Wdn = wsb + WS_WDN + (size_t)1 * 16 * 1024 * 512; S.kb = DE;
        pg8::EpiF8 E{(unsigned char*)(F.ws + WS_D2), D};
        _Pragma("unroll") for (int rep = 0; rep < REP(14); ++rep) pg8::gemm_phase<pg8::EpiF8, pg8::MoeDownSched, true, true>(ring, DE / 2, S, E, F.wave);
    }
    SEAM(14);
    if (IN(15)) { moe_setup(F, 1); _Pragma("unroll") for (int rep = 0; rep < REP(15); ++rep) p_epost<1>(F); }
#undef IN
#undef SEAM
}

extern "C" void kernel_launch(void* const* d_in, const int* in_sizes, int n_in, void* d_out, int out_size, void* d_ws, size_t ws_size, hipStream_t stream) {
    static int grid = 0;
    if (grid == 0) {
        if (n_in != 26 || in_sizes[0] != NLAT * D || out_size != NLAT * D || ws_size < WS_END) { fprintf(stderr, "kernel_launch: unexpected shapes (n_in %d, in0 %d, out %d, ws %zu); nothing launched\n", n_in, n_in > 0 ? in_sizes[0] : -1, out_size, ws_size); grid = -1; return; }
        if (hipFuncSetAttribute((const void*)fwd_kernel, hipFuncAttributeMaxDynamicSharedMemorySize, LDS_BYTES) != hipSuccess) { fprintf(stderr, "kernel_launch: hipFuncSetAttribute failed\n"); grid = -1; return; }
        int per_cu = 0;
        if (hipOccupancyMaxActiveBlocksPerMultiprocessor(&per_cu, (const void*)fwd_kernel, NTHR, LDS_BYTES) != hipSuccess || per_cu < 1) fprintf(stderr, "kernel_launch: note: occupancy query reports %d workgroups per CU\n", per_cu);
        (void)hipGetLastError();
        grid = 256;
    }
    if (grid < 0) return;
    if (hipMemsetAsync((char*)d_ws + WS_CTL, 0, CTL_ZERO_BYTES, stream) != hipSuccess) { fprintf(stderr, "kernel_launch: hipMemsetAsync failed\n"); return; }
    Args a{};
    for (int i = 0; i < 26; ++i) a.in[i] = (const float*)d_in[i];
    a.out = (float*)d_out; a.ws = (unsigned char*)d_ws;
    for (int li = 0; li < N_LAUNCHES; ++li) {
        a.ph_lo = (N_LAUNCHES == 1) ? 0 : li; a.ph_hi = (N_LAUNCHES == 1) ? N_PHASES : li + 1;
        hipLaunchKernelGGL(fwd_kernel, dim3(grid), dim3(NTHR), LDS_BYTES, stream, a);
        const hipError_t le = hipPeekAtLastError();
        if (le != hipSuccess) { fprintf(stderr, "kernel_launch: launch %d failed: %s\n", li, hipGetErrorName(le)); break; }
    }
}
```

```cpp
#include <hip/hip_runtime.h>
#include <cstdio>
#include <cstdint>

#ifndef PROBE_MASK
#define PROBE_MASK 0
#endif
#define REP(k) ((((PROBE_MASK) >> (k)) & 1) ? 2 : 1)
#ifndef DBG_SLOT
#define DBG_SLOT 0
#endif
#ifndef DBG_SKIP
#define DBG_SKIP 0
#endif
constexpr int D = 1024, BATCH = 8, SEQ = 4096, CTXL = 256;
constexpr int NLAT = BATCH * SEQ, NCTX = BATCH * CTXL, MT = NLAT + NCTX;
constexpr int NE = 16, DE = 512, NH = 16, HD = 64, GRIDW = 64, GROWS = 64, WINH = 8, WINW = 16, CONVW = 31;
constexpr int KSLOT = SEQ + CTXL;
constexpr int NMODR = 9, NMODC = 6 * D;
constexpr int MODKC = 8;
constexpr float EPS = 1e-6f;
constexpr int NWAVES = 8, NTHR = NWAVES * 64;

constexpr size_t MiB = 1u << 20;
constexpr size_t WS_CTL = 0, CTL_ZERO_BYTES = 1 * MiB;
constexpr size_t WS_SLOT = 1 * MiB;
constexpr size_t WS_PERM = 2 * MiB;
constexpr size_t WS_MODP = 5 * MiB;
constexpr size_t WS_XC = 9 * MiB;
constexpr size_t WS_WIN = 18 * MiB, WS_WOUT = 22 * MiB, WS_WQKV = 24 * MiB, WS_WO = 30 * MiB;
constexpr size_t WS_WGU = 32 * MiB;
constexpr size_t WS_WDN = 96 * MiB;
constexpr size_t WS_A = 128 * MiB, WS_B = 196 * MiB, WS_C = 264 * MiB, WS_D2 = 336 * MiB, WS_END = 480 * MiB;
constexpr int CW_BAR = 4096;
constexpr int CW_JOB = 12288;
constexpr int CW_CNT = 8192;

constexpr int RING_BYTES = 131072;
constexpr int MISC_OFF = RING_BYTES;
constexpr int PTAB_OFF = RING_BYTES + 1024 + 8192;
constexpr int PERML_OFF = RING_BYTES + 1024;
constexpr int LDS_BYTES = 147456;

#define GAS __attribute__((address_space(1)))
#define LAS __attribute__((address_space(3)))
typedef unsigned short bf16;
typedef unsigned v4u __attribute__((ext_vector_type(4)));
typedef unsigned v2u __attribute__((ext_vector_type(2)));
typedef float f32x4 __attribute__((ext_vector_type(4)));
typedef float f32x2 __attribute__((ext_vector_type(2)));
typedef short bf16x8 __attribute__((ext_vector_type(8)));
typedef GAS unsigned gu32;
#define RLX_AGENT __ATOMIC_RELAXED, __HIP_MEMORY_SCOPE_AGENT
#define LDS_WAIT() asm volatile("s_waitcnt lgkmcnt(0)" ::: "memory")
#define VM_WAIT() asm volatile("s_waitcnt vmcnt(0)" ::: "memory")

__device__ __forceinline__ unsigned f2bf(float f) { unsigned u = __builtin_bit_cast(unsigned, f); return (u + 0x7fffu + ((u >> 16) & 1u)) >> 16; }
__device__ __forceinline__ unsigned pk2(float lo, float hi) { return f2bf(lo) | (f2bf(hi) << 16); }
__device__ __forceinline__ unsigned pk4_fp8(float a, float b, float c, float d) { int p = __builtin_amdgcn_cvt_pk_fp8_f32(a, b, 0, false); p = __builtin_amdgcn_cvt_pk_fp8_f32(c, d, p, true); return (unsigned)p; }
__device__ __forceinline__ float bflo(unsigned w) { return __builtin_bit_cast(float, w << 16); }
__device__ __forceinline__ float bfhi(unsigned w) { return __builtin_bit_cast(float, w & 0xffff0000u); }
__device__ __forceinline__ float row16_sum(float v) {
    v += __builtin_bit_cast(float, __builtin_amdgcn_update_dpp(0, __builtin_bit_cast(int, v), 0xB1, 0xF, 0xF, false));
    v += __builtin_bit_cast(float, __builtin_amdgcn_update_dpp(0, __builtin_bit_cast(int, v), 0x4E, 0xF, 0xF, false));
    v += __builtin_bit_cast(float, __builtin_amdgcn_update_dpp(0, __builtin_bit_cast(int, v), 0x141, 0xF, 0xF, false));
    v += __builtin_bit_cast(float, __builtin_amdgcn_update_dpp(0, __builtin_bit_cast(int, v), 0x140, 0xF, 0xF, false));
    return v;
}
__device__ __forceinline__ float rdlane(float v, int l) { return __builtin_bit_cast(float, __builtin_amdgcn_readlane(__builtin_bit_cast(int, v), l)); }
__device__ __forceinline__ float wave_sum(float v) {
    v = row16_sum(v);
    return (rdlane(v, 0) + rdlane(v, 16)) + (rdlane(v, 32) + rdlane(v, 48));
}
__device__ __forceinline__ int lane_id_asm() { int l; asm volatile("v_mbcnt_lo_u32_b32 %0, -1, 0\n\tv_mbcnt_hi_u32_b32 %0, -1, %0" : "=v"(l)); return l; }
__device__ __forceinline__ float fast_sigmoid(float x) { return __builtin_amdgcn_rcpf(1.0f + __builtin_amdgcn_exp2f(-1.4426950408889634f * x)); }

namespace pg8 {
#define PG8_LAS __attribute__((address_space(3)))
typedef unsigned short bf16_t;
typedef short bf16x8 __attribute__((ext_vector_type(8)));
typedef float f32x4 __attribute__((ext_vector_type(4)));
typedef unsigned u32x4 __attribute__((ext_vector_type(4)));
constexpr int BM = 256, BK = 64, HALF = 128, HTB = HALF * BK * 2, STAGE_BYTES = 8 * HTB, NXCD = 8, WGM = 8;

__host__ __device__ __forceinline__ int lds_byte(int r, int c) { const int st = (r >> 4) * 2 + (c >> 5), rr = r & 15, cc = c & 31, ob = rr * 64 + cc * 2; return st * 1024 + (ob ^ (((ob >> 9) & 1) << 5)); }
__host__ __device__ __forceinline__ void stage_rc(int b, int& R, int& C) { const int st = b / 1024, sb = b % 1024, swz = sb ^ (((sb >> 9) & 1) << 5); R = (st >> 1) * 16 + swz / 64; C = (st & 1) * 32 + (swz % 64) / 2; }
__host__ __device__ __forceinline__ int perm32(int rho) { const int n = rho >> 4, i = rho & 15; return 8 * (i >> 2) + 4 * n + (i & 3); }

struct Unit { int pm, pn; const char* a; const char* b; int li; int ex; };

__device__ __forceinline__ bool static_order(int L, int nM, int nN, int& pm, int& pn) {
    const int nwg = nM * nN; if (L >= nwg) return false;
    int wgid = L; { const int q = nwg / NXCD, r = nwg % NXCD, xcd = wgid % NXCD, off = wgid / NXCD; wgid = (xcd < r ? xcd * (q + 1) : r * (q + 1) + (xcd - r) * q) + off; }
    const int nig = WGM * nN, gid = wgid / nig, fm = gid * WGM, gsz = (nM - fm) < WGM ? (nM - fm) : WGM;
    pm = fm + ((wgid % nig) % gsz); pn = (wgid % nig) / gsz; return true;
}

typedef float cvt_f32x2_t __attribute__((ext_vector_type(2))); typedef __bf16 cvt_bf16x2_t __attribute__((ext_vector_type(2)));
__device__ __forceinline__ unsigned cvt_pk_bf16(float lo, float hi) { const cvt_f32x2_t v = {lo, hi}; const cvt_bf16x2_t b = __builtin_convertvector(v, cvt_bf16x2_t); return __builtin_bit_cast(unsigned, b); }

typedef int v8i_t __attribute__((ext_vector_type(8)));
typedef int v4i_t __attribute__((ext_vector_type(4)));
template <class Epi, class Sched, bool ALIGN_EPI, bool FP8 = false>
__device__ __forceinline__ void gemm_phase(PG8_LAS unsigned char* lds, const int K_, const Sched& S, const Epi& E, const int wid) {
    int K = K_; asm volatile("" : "+s"(K));
    const int lane = lane_id_asm(), tid = wid * 64 + lane, wr = wid >> 2, wc = wid & 3, fr = lane & 15, fq = lane >> 4;
    const int nt = K / BK;
    int R[2], C[2]; unsigned voffB[2], vA[2][2];
    const size_t kstep = (size_t)(BK * 2);
    const size_t hstep = (size_t)HALF * K * 2;
#pragma unroll
    for (int i = 0; i < 2; ++i) { stage_rc(tid * 16 + i * 8192, R[i], C[i]); const int Rb = Epi::PERM ? ((R[i] & ~31) + perm32(R[i] & 31)) : R[i];
        voffB[i] = (unsigned)(Rb * K + C[i]) * 2u; vA[0][i] = (unsigned)(R[i] * K + C[i]) * 2u; vA[1][i] = vA[0][i] + (unsigned)hstep; }
    const unsigned ldsw = (unsigned)wid * 1024u;
    const int aoff = lds_byte(wr * 64 + fr, fq * 8), boff = lds_byte(wc * 32 + fr, fq * 8);
#define PG8_SA(b, h) (((b) * 2 + (h)) * HTB)
#define PG8_SB(b, h) ((4 + (b) * 2 + (h)) * HTB)
#define PG8_STAGE(bufoff, gbase, voff) do { _Pragma("unroll") for (int _i = 0; _i < 2; ++_i) \
        __builtin_amdgcn_global_load_lds((const unsigned*)((const char*)(gbase) + (voff)[_i]), (PG8_LAS unsigned*)(lds + (bufoff) + ldsw + _i * 8192), 16, 0, 0); } while (0)
#define PG8_LD8(addr) __builtin_shufflevector(*(const PG8_LAS v4i_t*)(addr), *(const PG8_LAS v4i_t*)((addr) + 1024), 0, 1, 2, 3, 4, 5, 6, 7)
#define PG8_LDA(dst, b, h) do { _Pragma("unroll") for (int m = 0; m < 4; ++m) dst[m] = PG8_LD8(lds + PG8_SA(b, h) + aoff + m * 2048); } while (0)
#define PG8_LDB(dst, b, h) do { _Pragma("unroll") for (int n = 0; n < 2; ++n) dst[n] = PG8_LD8(lds + PG8_SB(b, h) + boff + n * 2048); } while (0)
#define PG8_LO(x) __builtin_bit_cast(bf16x8, __builtin_shufflevector((x), (x), 0, 1, 2, 3))
#define PG8_HI(x) __builtin_bit_cast(bf16x8, __builtin_shufflevector((x), (x), 4, 5, 6, 7))
#define PG8_MMA(ai, bj, At, Bt) do { __builtin_amdgcn_s_setprio(1); _Pragma("unroll") for (int m = 0; m < 4; ++m) _Pragma("unroll") for (int n = 0; n < 2; ++n) { \
        if constexpr (FP8) asm volatile("v_mfma_scale_f32_16x16x128_f8f6f4 %0, %1, %2, %0, %3, %4 op_sel_hi:[0,0,0]" : "+v"(acc[ai][bj][m][n]) : "v"(Bt[n]), "v"(At[m]), "v"(wscale_r), "v"(ascale_r)); \
        else { acc[ai][bj][m][n] = __builtin_amdgcn_mfma_f32_16x16x32_bf16(PG8_LO(Bt[n]), PG8_LO(At[m]), acc[ai][bj][m][n], 0, 0, 0); \
               acc[ai][bj][m][n] = __builtin_amdgcn_mfma_f32_16x16x32_bf16(PG8_HI(Bt[n]), PG8_HI(At[m]), acc[ai][bj][m][n], 0, 0, 0); } } __builtin_amdgcn_s_setprio(0); } while (0)
#define PG8_WAIT_V(n) asm volatile("s_waitcnt vmcnt(" #n ")" ::: "memory")
#define PG8_WAIT_L(n) asm volatile("s_waitcnt lgkmcnt(" #n ")" ::: "memory")
#define PG8_BAR __builtin_amdgcn_s_barrier()
#define PG8_SCHED __builtin_amdgcn_sched_barrier(0)
    Unit cur, nxt; int ui = 0;
    if (!S.next(0, cur)) return;
    if constexpr (Sched::GATHER) S.a_offsets(cur, R, C, K, vA);
    f32x4 acc[2][2][4][2];
#pragma unroll
    for (int a = 0; a < 2; ++a)
#pragma unroll
        for (int b = 0; b < 2; ++b)
#pragma unroll
            for (int m = 0; m < 4; ++m)
#pragma unroll
                for (int n = 0; n < 2; ++n) acc[a][b][m][n] = (f32x4){0.f, 0.f, 0.f, 0.f};
    int wscale_r = 0x79797979, ascale_r = 0x7f7f7f7f;
    asm volatile("" : "+v"(wscale_r), "+v"(ascale_r));
    v8i_t At[4], B0[2], B1[2];
    const char* cA = cur.a; const char* cB = cur.b;
    PG8_STAGE(PG8_SB(0, 0), cB, voffB); PG8_STAGE(PG8_SB(0, 1), cB + hstep, voffB); PG8_STAGE(PG8_SA(0, 0), cA, vA[0]); PG8_STAGE(PG8_SA(0, 1), cA, vA[1]);
    if (wr == 1) PG8_BAR;
    PG8_WAIT_V(2); PG8_BAR;
    PG8_STAGE(PG8_SB(1, 0), cB + kstep, voffB); PG8_STAGE(PG8_SA(1, 0), cA + kstep, vA[0]); PG8_STAGE(PG8_SB(1, 1), cB + hstep + kstep, voffB);
    PG8_WAIT_V(6); PG8_BAR;
    for (;;) {
        const bool has_next = S.next(ui + 1, nxt);
        const char* nA = has_next ? nxt.a : cA; const char* nB = has_next ? nxt.b : cB;
#pragma unroll 1
        for (int t = 0; t < nt; t += 2) {
            const bool last = (t == nt - 2);
            const char* a1 = cA + (size_t)(t + 1) * kstep;
            const char* a2 = last ? nA : cA + (size_t)(t + 2) * kstep; const char* b2 = last ? nB : cB + (size_t)(t + 2) * kstep;
            const char* a3 = a2 + kstep; const char* b3 = b2 + kstep;
            PG8_LDB(B0, 0, 0); PG8_LDB(B1, 0, 1); PG8_SCHED; PG8_LDA(At, 0, 0); PG8_STAGE(PG8_SA(1, 1), a1, vA[1]);
            if constexpr (Sched::GATHER) { if (last && has_next) S.a_offsets(nxt, R, C, K, vA); }
            PG8_WAIT_V(8); PG8_WAIT_L(0); PG8_BAR; PG8_MMA(0, 0, At, B0); PG8_MMA(0, 1, At, B1); PG8_BAR; PG8_SCHED;
            PG8_LDA(At, 0, 1); PG8_STAGE(PG8_SB(0, 0), b2, voffB); PG8_STAGE(PG8_SB(0, 1), b2 + hstep, voffB); PG8_STAGE(PG8_SA(0, 0), a2, vA[0]);
            PG8_WAIT_V(8); PG8_WAIT_L(0); PG8_BAR; PG8_MMA(1, 0, At, B0); PG8_MMA(1, 1, At, B1); PG8_BAR; PG8_SCHED;
            PG8_LDB(B0, 1, 0); PG8_LDB(B1, 1, 1); PG8_SCHED; PG8_LDA(At, 1, 0); PG8_STAGE(PG8_SA(0, 1), a2, vA[1]);
            PG8_WAIT_V(8); PG8_WAIT_L(0); PG8_BAR; PG8_MMA(0, 0, At, B0); PG8_MMA(0, 1, At, B1); PG8_BAR; PG8_SCHED;
            PG8_LDA(At, 1, 1); PG8_STAGE(PG8_SB(1, 0), b3, voffB); PG8_STAGE(PG8_SB(1, 1), b3 + hstep, voffB); PG8_STAGE(PG8_SA(1, 0), a3, vA[0]);
            PG8_WAIT_V(8); PG8_WAIT_L(0); PG8_BAR; PG8_MMA(1, 0, At, B0); PG8_MMA(1, 1, At, B1); PG8_BAR; PG8_SCHED;
        }
        if constexpr (ALIGN_EPI) { if (wr == 0) PG8_BAR; }
        if constexpr (FP8) asm volatile("s_nop 15\n\ts_nop 7" ::: "memory");
        E(acc, cur, wr, wc, fr, fq);
        if (!has_next) break;
#pragma unroll
        for (int a = 0; a < 2; ++a)
#pragma unroll
            for (int b = 0; b < 2; ++b)
#pragma unroll
                for (int m = 0; m < 4; ++m)
#pragma unroll
                    for (int n = 0; n < 2; ++n) acc[a][b][m][n] = (f32x4){0.f, 0.f, 0.f, 0.f};
        cur = nxt; cA = nA; cB = nB; ++ui;
        if constexpr (ALIGN_EPI) { if (wr == 1) PG8_BAR; }
    }
    PG8_WAIT_V(0);
    if constexpr (!ALIGN_EPI) { if (wr == 0) PG8_BAR; }
    PG8_BAR;
#undef PG8_SA
#undef PG8_SB
#undef PG8_STAGE
#undef PG8_LDA
#undef PG8_LDB
#undef PG8_MMA
#undef PG8_LO
#undef PG8_HI
#undef PG8_LD8
#undef PG8_WAIT_V
#undef PG8_WAIT_L
#undef PG8_BAR
#undef PG8_SCHED
}

struct DenseSched {
    static constexpr bool GATHER = false;
    const char* A; const char* Bt; int K, nM, nN, G, c;
    __device__ __forceinline__ bool next(int i, Unit& u) const {
        int pm, pn; if (!static_order(i * G + c, nM, nN, pm, pn)) return false;
        u.pm = pm; u.pn = pn; u.a = A + (size_t)pm * BM * K * 2; u.b = Bt + (size_t)pn * BM * K * 2; u.li = i; u.ex = 0; return true;
    }
    __device__ __forceinline__ void a_offsets(const Unit&, const int (&)[2], const int (&)[2], int, unsigned (&)[2][2]) const {}
};
struct QkvSched {
    static constexpr bool GATHER = false;
    const char* A; const char* Bt; int G, c, kb;
    __device__ __forceinline__ bool next(int i, Unit& u) const {
        const int L = i * G + c; int pm, pn;
        if (L < 1536) { static_order(L, 128, 12, pm, pn); }
        else { const int l2 = L - 1536; if (l2 >= 64) return false; pm = 128 + (l2 >> 3); pn = 4 + (l2 & 7); }
        u.pm = pm; u.pn = pn; u.a = A + (size_t)pm * BM * kb; u.b = Bt + (size_t)pn * BM * kb; u.li = i; u.ex = 0; return true;
    }
    __device__ __forceinline__ void a_offsets(const Unit&, const int (&)[2], const int (&)[2], int, unsigned (&)[2][2]) const {}
};
struct MoeSchedBase {
    const volatile PG8_LAS int* tpre;
    int G, c;
    __device__ __forceinline__ bool locate(int i, int& rt, int& pn, int& e) const {
        const int L = i * G + c; const int ntile = tpre[16];
        if (L >= 4 * ntile) return false;
        rt = L >> 2; pn = L & 3; int ee = 0;
#pragma unroll
        for (int j = 1; j < 16; ++j) ee += (rt >= tpre[j]) ? 1 : 0;
        e = ee; return true;
    }
};
struct MoeUpSched : MoeSchedBase {
    static constexpr bool GATHER = true;
    const char* A; const char* Wgu; const PG8_LAS int* permL; int kb;
    __device__ __forceinline__ bool next(int i, Unit& u) const {
        int rt, pn, e; if (!locate(i, rt, pn, e)) return false;
        u.pm = rt; u.pn = pn; u.a = A; u.b = Wgu + (size_t)e * 1024 * kb + (size_t)pn * BM * kb; u.li = i; u.ex = e; return true;
    }
    __device__ __forceinline__ void a_offsets(const Unit& u, const int (&R)[2], const int (&C)[2], int K, unsigned (&vA)[2][2]) const {
#pragma unroll
        for (int h = 0; h < 2; ++h)
#pragma unroll
            for (int i = 0; i < 2; ++i) vA[h][i] = (unsigned)permL[u.li * 256 + h * HALF + R[i]] * (unsigned)(K * 2) + (unsigned)(C[i] * 2);
    }
};
struct MoeDownSched : MoeSchedBase {
    static constexpr bool GATHER = false;
    const char* A; const char* Wdn; int kb;
    __device__ __forceinline__ bool next(int i, Unit& u) const {
        int rt, pn, e; if (!locate(i, rt, pn, e)) return false;
        u.pm = rt; u.pn = pn; u.a = A + (size_t)rt * BM * kb; u.b = Wdn + (size_t)e * 1024 * kb + (size_t)pn * BM * kb; u.li = i; u.ex = e; return true;
    }
    __device__ __forceinline__ void a_offsets(const Unit&, const int (&)[2], const int (&)[2], int, unsigned (&)[2][2]) const {}
};

template <bool HAS_BIAS> struct EpiBf16T {
    static constexpr bool PERM = true;
    bf16_t* O; int ldc; const float* bias;
    __device__ __forceinline__ void operator()(const f32x4 (&acc)[2][2][4][2], const Unit& u, int wr, int wc, int fr, int fq) const {
        const int row0 = u.pm * BM + wr * 64 + fr, col0 = u.pn * BM + wc * 32 + 8 * fq;
        f32x4 bv[2][2];
#pragma unroll
        for (int bj = 0; bj < 2; ++bj)
#pragma unroll
            for (int n = 0; n < 2; ++n) bv[bj][n] = HAS_BIAS ? *(const f32x4*)(bias + col0 + bj * HALF + 4 * n) : (f32x4){0.f, 0.f, 0.f, 0.f};
#pragma unroll
        for (int ai = 0; ai < 2; ++ai)
#pragma unroll
            for (int m = 0; m < 4; ++m) { bf16_t* rowp = O + (size_t)(row0 + ai * HALF + m * 16) * ldc + col0;
#pragma unroll
                for (int bj = 0; bj < 2; ++bj) { f32x4 v0 = acc[ai][bj][m][0], v1 = acc[ai][bj][m][1]; if constexpr (HAS_BIAS) { v0 += bv[bj][0]; v1 += bv[bj][1]; }
                    u32x4 w; w.x = cvt_pk_bf16(v0[0], v0[1]); w.y = cvt_pk_bf16(v0[2], v0[3]); w.z = cvt_pk_bf16(v1[0], v1[1]); w.w = cvt_pk_bf16(v1[2], v1[3]);
                    *(u32x4*)(rowp + bj * HALF) = w; } }
    }
};
typedef EpiBf16T<true> EpiBf16B; typedef EpiBf16T<false> EpiBf16;
struct EpiF8 {
    static constexpr bool PERM = true;
    unsigned char* O; int ldc;
    __device__ __forceinline__ void operator()(const f32x4 (&acc)[2][2][4][2], const Unit& u, int wr, int wc, int fr, int fq) const {
        const int row0 = u.pm * BM + wr * 64 + fr, col0 = u.pn * BM + wc * 32 + 8 * fq;
#pragma unroll
        for (int ai = 0; ai < 2; ++ai)
#pragma unroll
            for (int m = 0; m < 4; ++m) { unsigned char* rowp = O + (size_t)(row0 + ai * HALF + m * 16) * ldc + col0;
#pragma unroll
                for (int bj = 0; bj < 2; ++bj) { const f32x4 v0 = acc[ai][bj][m][0], v1 = acc[ai][bj][m][1];
                    *(unsigned long long*)(rowp + bj * HALF) = (unsigned long long)pk4_fp8(v0[0], v0[1], v0[2], v0[3]) | ((unsigned long long)pk4_fp8(v1[0], v1[1], v1[2], v1[3]) << 32); } }
    }
};
template <int MODE  , bool OUT8 = false  > struct EpiGated {
    static constexpr bool PERM = true;
    bf16_t* O; int ldc; const float* bias; int nch;
    __device__ __forceinline__ void operator()(const f32x4 (&acc)[2][2][4][2], const Unit& u, int wr, int wc, int fr, int fq) const {
        const int row0 = u.pm * BM + wr * 64 + fr, ch0 = u.pn * HALF + wc * 32 + 8 * fq;
        f32x4 b0[2], b1[2];
#pragma unroll
        for (int n = 0; n < 2; ++n) { if (MODE == 0) { b0[n] = *(const f32x4*)(bias + ch0 + 4 * n); b1[n] = *(const f32x4*)(bias + nch + ch0 + 4 * n); } else { b0[n] = (f32x4){0.f, 0.f, 0.f, 0.f}; b1[n] = b0[n]; } }
#pragma unroll
        for (int ai = 0; ai < 2; ++ai)
#pragma unroll
            for (int m = 0; m < 4; ++m) { bf16_t* rowp = O + (size_t)(row0 + ai * HALF + m * 16) * ldc + ch0; float o[8];
#pragma unroll
                for (int n = 0; n < 2; ++n) { const f32x4 x0 = acc[ai][0][m][n] + b0[n], x1 = acc[ai][1][m][n] + b1[n];
#pragma unroll
                    for (int e = 0; e < 4; ++e) o[4 * n + e] = (MODE == 0) ? x0[e] * fast_sigmoid(x1[e]) : (x0[e] * fast_sigmoid(x0[e])) * x1[e]; }
                if constexpr (OUT8) { unsigned char* rp8 = (unsigned char*)O + (size_t)(row0 + ai * HALF + m * 16) * ldc + ch0;
                    *(unsigned long long*)rp8 = (unsigned long long)pk4_fp8(o[0], o[1], o[2], o[3]) | ((unsigned long long)pk4_fp8(o[4], o[5], o[6], o[7]) << 32); }
                else { u32x4 w; w.x = cvt_pk_bf16(o[0], o[1]); w.y = cvt_pk_bf16(o[2], o[3]); w.z = cvt_pk_bf16(o[4], o[5]); w.w = cvt_pk_bf16(o[6], o[7]);
                    *(u32x4*)rowp = w; } }
    }
};
struct EpiQkv {
    static constexpr bool PERM = true;
    bf16_t* Q; bf16_t* Kh; bf16_t* Vb; float qscale;
    __device__ __forceinline__ void operator()(const f32x4 (&acc)[2][2][4][2], const Unit& u, int wr, int wc, int fr, int fq) const {
        const int which = u.pn >> 2; const bool isctx = u.pm >= 128;
        const int b = isctx ? (u.pm - 128) : (u.pm >> 4);
        const int key0 = isctx ? SEQ : ((u.pm & 15) << 8);
        const int d0 = 32 * (wc & 1) + 8 * fq;
#pragma unroll
        for (int ai = 0; ai < 2; ++ai)
#pragma unroll
            for (int m = 0; m < 4; ++m) { const int key = key0 + ai * HALF + wr * 64 + m * 16 + fr;
#pragma unroll
                for (int bj = 0; bj < 2; ++bj) { const int h = 4 * (u.pn & 3) + 2 * bj + (wc >> 1); const f32x4 v0 = acc[ai][bj][m][0], v1 = acc[ai][bj][m][1];
                    if (which == 2) {
                        bf16_t* p = Vb + ((size_t)(b * NH + h) * (KSLOT / 8) + (key >> 3)) * 512 + (size_t)d0 * 8 + (key & 7);
                        const unsigned w0 = cvt_pk_bf16(v0[0], v0[1]), w1 = cvt_pk_bf16(v0[2], v0[3]), w2 = cvt_pk_bf16(v1[0], v1[1]), w3 = cvt_pk_bf16(v1[2], v1[3]);
                        p[0] = (bf16_t)w0; p[8] = (bf16_t)(w0 >> 16); p[16] = (bf16_t)w1; p[24] = (bf16_t)(w1 >> 16); p[32] = (bf16_t)w2; p[40] = (bf16_t)(w2 >> 16); p[48] = (bf16_t)w3; p[56] = (bf16_t)(w3 >> 16);
                    } else {
                        const float qs = (which == 0) ? qscale : 1.0f; const f32x4 y0 = v0 * qs, y1 = v1 * qs;
                        u32x4 w; w.x = cvt_pk_bf16(y0[0], y0[1]); w.y = cvt_pk_bf16(y0[2], y0[3]); w.z = cvt_pk_bf16(y1[0], y1[1]); w.w = cvt_pk_bf16(y1[2], y1[3]);
                        bf16_t* p = (which == 0) ? Q + ((size_t)(b * NH + h) * SEQ + key) * HD + d0 : Kh + ((size_t)(b * NH + h) * KSLOT + key) * HD + d0;
                        *(u32x4*)p = w;
                    } } }
    }
};
}
#define XB_TMO      128
#define XB_XCNT(j)  (256  + 64 * (j))
#define XB_XSUB(j)  (1280 + 64 * (j))
#define XB_XGEN(j)  (2304 + 64 * (j))
#define XB_TOP      3328
#define XB_TOPGEN   3392
#define XCD_BAR_WORDS 3456
#define XB_SPIN_CAP (1u << 18)

__device__ __forceinline__ unsigned xb_ld(unsigned* p)              { return __hip_atomic_load(p, __ATOMIC_RELAXED, __HIP_MEMORY_SCOPE_AGENT); }
__device__ __forceinline__ unsigned xb_add(unsigned* p, unsigned v) { return __hip_atomic_fetch_add(p, v, __ATOMIC_RELAXED, __HIP_MEMORY_SCOPE_AGENT); }
__device__ __forceinline__ unsigned xb_xcc_id() { return (unsigned)__builtin_amdgcn_s_getreg((3 << 11) | 20) & 0xFu; }
#define XB_SPIN(cond, bar) do { unsigned _sp = 0; while (cond) { __builtin_amdgcn_s_sleep(1); \
    if ((++_sp & 255u) == 0u) { if (xb_ld(&(bar)[XB_TMO])) break; if (_sp > XB_SPIN_CAP) { atomicAdd(&(bar)[XB_TMO], 1u); break; } } } } while (0)

struct XcdBarrier {
    unsigned* bar; unsigned x;
    volatile LAS unsigned* st;
};

__device__ __forceinline__ XcdBarrier xcd_barrier_post(unsigned* bar, volatile LAS unsigned* st) {
    XcdBarrier b; b.bar = bar; b.x = xb_xcc_id(); b.st = st;
    if (threadIdx.x == 0) (void)xb_add(&bar[XB_XCNT(b.x)], 1u);
    return b;
}
__device__ __forceinline__ void xcd_barrier_complete(unsigned* bar, unsigned x, unsigned& nloc, unsigned& nx) {
    const unsigned G = gridDim.x * gridDim.y * gridDim.z;
    unsigned sum, cnt, mine, sp = 0u;
    for (;;) {
        sum = 0u; cnt = 0u; mine = 0u;
#pragma unroll
        for (unsigned j = 0; j < 16; ++j) { const unsigned c = xb_ld(&bar[XB_XCNT(j)]); sum += c; cnt += (c > 0u) ? 1u : 0u; mine = (j == x) ? c : mine; }
        if (sum == G) break;
        __builtin_amdgcn_s_sleep(1);
        if ((++sp & 255u) == 0u) { if (xb_ld(&bar[XB_TMO])) break; if (sp > XB_SPIN_CAP) { atomicAdd(&bar[XB_TMO], 1u); break; } }
    }
    nloc = mine > 0u ? mine : 1u; nx = cnt > 0u ? cnt : 1u;
}

__device__ __forceinline__ void xcd_barrier(const XcdBarrier& b) {
    asm volatile("s_waitcnt vmcnt(0)" ::: "memory");
    __syncthreads();
    if (threadIdx.x == 0) {
        unsigned* bar = b.bar;
        __builtin_amdgcn_s_waitcnt(0);
        unsigned nloc = b.st[0], nx = b.st[1];
        if (nloc == 0u) { xcd_barrier_complete(bar, b.x, nloc, nx); b.st[0] = nloc; b.st[1] = nx; }
        const unsigned old = xb_add(&bar[XB_XSUB(b.x)], 1u);
        const unsigned gen = old / nloc;
        if (old + 1u == (gen + 1u) * nloc) {
            __builtin_amdgcn_fence(__ATOMIC_RELEASE, "agent");
            asm volatile("s_waitcnt vmcnt(0)" ::: "memory");
            const unsigned og = xb_add(&bar[XB_TOP], 1u);
            const unsigned tg = og / nx;
            if (og + 1u == (tg + 1u) * nx) xb_add(&bar[XB_TOPGEN], 1u);
            else XB_SPIN(xb_ld(&bar[XB_TOPGEN]) == tg, bar);
            __builtin_amdgcn_fence(__ATOMIC_ACQUIRE, "agent");
            xb_add(&bar[XB_XGEN(b.x)], 1u);
            asm volatile("s_waitcnt vmcnt(0)" ::: "memory");
        } else {
            XB_SPIN(xb_ld(&bar[XB_XGEN(b.x)]) == gen, bar);
            __builtin_amdgcn_fence(__ATOMIC_ACQUIRE, "agent");
            asm volatile("s_waitcnt vmcnt(0)" ::: "memory");
        }
    }
    __syncthreads();
}

struct Frame {
    LAS unsigned char* lds;
    volatile LAS unsigned* MISC;
    gu32* ctl;
    int wave, G, bid;
    __device__ __forceinline__ const float* in(int k) const { const volatile LAS unsigned* t = (const volatile LAS unsigned*)(lds + PTAB_OFF) + 2 * k;
        const unsigned lo = __builtin_amdgcn_readfirstlane(t[0]), hi = __builtin_amdgcn_readfirstlane(t[1]); return (const float*)(const GAS float*)(((unsigned long long)hi << 32) | lo); }
    __device__ __forceinline__ int lane() const { return lane_id_asm(); }
    __device__ __forceinline__ int tid() const { return wave * 64 + lane_id_asm(); }
    unsigned char* ws;
    float* out;
};

__device__ __forceinline__ void ld_row_f32(const float* row, int lane, f32x4 (&v)[4]) {
    const f32x4* p = (const f32x4*)row + lane;
#pragma unroll
    for (int j = 0; j < 4; ++j) v[j] = p[64 * j];
}
__device__ __forceinline__ void st_row_f32(float* row, int lane, const f32x4 (&v)[4]) {
    f32x4* p = (f32x4*)row + lane;
#pragma unroll
    for (int j = 0; j < 4; ++j) p[64 * j] = v[j];
}
__device__ __forceinline__ void ld_row_bf16(const bf16* row, int lane, f32x4 (&v)[4]) {
    const v2u* p = (const v2u*)row + lane;
#pragma unroll
    for (int j = 0; j < 4; ++j) { const v2u w = p[64 * j]; v[j] = (f32x4){bflo(w.x), bfhi(w.x), bflo(w.y), bfhi(w.y)}; }
}
__device__ __forceinline__ void ld_raw_bf16(const bf16* row, int lane, v2u (&w)[4]) {
    const v2u* p = (const v2u*)row + lane;
#pragma unroll
    for (int j = 0; j < 4; ++j) w[j] = p[64 * j];
}
__device__ __forceinline__ void unpack_bf16(const v2u (&w)[4], f32x4 (&v)[4]) {
#pragma unroll
    for (int j = 0; j < 4; ++j) { const unsigned a = w[j].x, b = w[j].y; v[j] = (f32x4){bflo(a), bfhi(a), bflo(b), bfhi(b)}; }
}
__device__ __forceinline__ void ld_raw_fp8(const unsigned char* row, int lane, unsigned (&w)[4]) {
    const unsigned* p = (const unsigned*)row + lane;
#pragma unroll
    for (int j = 0; j < 4; ++j) w[j] = p[64 * j];
}
__device__ __forceinline__ void unpack_fp8(const unsigned (&w)[4], f32x4 (&v)[4]) {
    typedef float f2_t __attribute__((ext_vector_type(2)));
#pragma unroll
    for (int j = 0; j < 4; ++j) { const f2_t lo = __builtin_amdgcn_cvt_pk_f32_fp8((int)w[j], false), hi = __builtin_amdgcn_cvt_pk_f32_fp8((int)w[j], true); v[j] = (f32x4){lo[0], lo[1], hi[0], hi[1]}; }
}
__device__ __forceinline__ void st_row_bf16(bf16* row, int lane, const f32x4 (&v)[4]) {
    v2u* p = (v2u*)row + lane;
#pragma unroll
    for (int j = 0; j < 4; ++j) { v2u w; w.x = pk2(v[j][0], v[j][1]); w.y = pk2(v[j][2], v[j][3]); p[64 * j] = w; }
}
__device__ __forceinline__ void st_row_fp8(unsigned char* row, int lane, const f32x4 (&v)[4]) {
    unsigned* p = (unsigned*)row + lane;
#pragma unroll
    for (int j = 0; j < 4; ++j) p[64 * j] = pk4_fp8(v[j][0], v[j][1], v[j][2], v[j][3]);
}
__device__ __forceinline__ float sumsq4(const f32x4 (&v)[4]) {
    float s = 0.f;
#pragma unroll
    for (int j = 0; j < 4; ++j) s += (v[j][0] * v[j][0] + v[j][1] * v[j][1]) + (v[j][2] * v[j][2] + v[j][3] * v[j][3]);
    return s;
}
__device__ __forceinline__ void ld_mod(const Frame& F, int l, int r, int ch, f32x4 (&v)[4]) {
    const float* modp = (const float*)(F.ws + WS_MODP); const int lane = F.lane();
    ld_row_f32(F.in(5) + (size_t)l * NMODC + ch * D, lane, v);
#pragma unroll
    for (int kc = 0; kc < MODKC; ++kc) { f32x4 t[4]; ld_row_f32(modp + ((size_t)((kc * 2 + l) * NMODR + r)) * NMODC + ch * D, lane, t);
#pragma unroll
        for (int j = 0; j < 4; ++j) v[j] += t[j]; }
}
__device__ __forceinline__ int row_batch(int m) { return m < NLAT ? (m >> 12) : 8; }

__device__ __forceinline__ void p0_transpose_item(const float* W, int K, int N, bf16* WT, int drow_off, LAS float* scr, int item, int lane) {
    const int nblk = N / 32, kb = item / nblk, nb = item % nblk, k0 = 64 * kb, n0 = 32 * nb;
#pragma unroll 8
    for (int i = 0; i < 32; ++i) { const int kk = 2 * i + (lane >> 5); scr[kk * 33 + (lane & 31)] = W[(size_t)(k0 + kk) * N + n0 + (lane & 31)]; }
    LDS_WAIT(); asm volatile("" ::: "memory");
    const int c = lane & 7;
#pragma unroll
    for (int j = 0; j < 4; ++j) { const int n = (lane >> 3) + 8 * j; const LAS float* s = scr + (8 * c) * 33 + n;
        v4u o; o.x = pk2(s[0 * 33], s[1 * 33]); o.y = pk2(s[2 * 33], s[3 * 33]); o.z = pk2(s[4 * 33], s[5 * 33]); o.w = pk2(s[6 * 33], s[7 * 33]);
        *(GAS v4u*)(WT + (size_t)(drow_off + n0 + n) * K + k0 + 8 * c) = o; }
    LDS_WAIT(); asm volatile("" ::: "memory");
}
__device__ __forceinline__ void p0_transpose_item_fp8(const float* W, int K, int N, unsigned char* WT, int drow_off, float wscale, LAS float* scr, int item, int lane) {
    const int nblk = N / 32, kb = item / nblk, nb = item % nblk, k0 = 64 * kb, n0 = 32 * nb;
#pragma unroll 8
    for (int i = 0; i < 32; ++i) { const int kk = 2 * i + (lane >> 5); scr[kk * 33 + (lane & 31)] = W[(size_t)(k0 + kk) * N + n0 + (lane & 31)] * wscale; }
    LDS_WAIT(); asm volatile("" ::: "memory");
    const int c = lane & 3;
#pragma unroll
    for (int j = 0; j < 2; ++j) { const int n = (lane >> 2) + 16 * j; const LAS float* s = scr + (16 * c) * 33 + n;
        v4u o; o.x = pk4_fp8(s[0 * 33], s[1 * 33], s[2 * 33], s[3 * 33]); o.y = pk4_fp8(s[4 * 33], s[5 * 33], s[6 * 33], s[7 * 33]);
        o.z = pk4_fp8(s[8 * 33], s[9 * 33], s[10 * 33], s[11 * 33]); o.w = pk4_fp8(s[12 * 33], s[13 * 33], s[14 * 33], s[15 * 33]);
        *(GAS v4u*)(WT + (size_t)(drow_off + n0 + n) * K + k0 + 16 * c) = o; }
    LDS_WAIT(); asm volatile("" ::: "memory");
}
constexpr float W8SCALE = 64.0f;
constexpr int I_WIN = 1024, I_WOUT = 512, I_WQKV = 1536, I_WO = 512, I_EXP = 32 * 768, I_NONEXP = I_WIN + I_WOUT + I_WQKV + I_WO, NITEMS_P0 = I_NONEXP + I_EXP;
__device__ __forceinline__ void p0_item(const Frame& F, LAS float* scr, int it) {
    int r = it; const int lane = F.lane();
    if (r < I_WIN) { const int n0 = 32 * (r % 64), ch = n0 & 1023, hf = n0 >> 10, drow0 = 256 * (ch >> 7) + 128 * hf + (ch & 127);
        p0_transpose_item_fp8(F.in(10), D, 2 * D, (unsigned char*)(F.ws + WS_WIN), drow0 - n0, W8SCALE, scr, r, lane); return; }
    r -= I_WIN;
    if (r < I_WOUT) { p0_transpose_item_fp8(F.in(16), D, D, (unsigned char*)(F.ws + WS_WOUT), 0, W8SCALE, scr, r, lane); return; }
    r -= I_WOUT;
    if (r < I_WQKV) { p0_transpose_item_fp8(F.in(18), D, 3 * D, (unsigned char*)(F.ws + WS_WQKV), 0, W8SCALE, scr, r, lane); return; }
    r -= I_WQKV;
    if (r < I_WO) { p0_transpose_item_fp8(F.in(19), D, D, (unsigned char*)(F.ws + WS_WO), 0, W8SCALE, scr, r, lane); return; }
    r -= I_WO;
    const int le = r / 768; int q = r % 768;
    if (q < 512) { const bool up = q >= 256; if (up) q -= 256; const int n0 = 32 * (q % 16), drow0 = 256 * (n0 >> 7) + (up ? 128 : 0) + (n0 & 127);
        p0_transpose_item_fp8((up ? F.in(24) : F.in(23)) + (size_t)le * D * DE, D, DE, (unsigned char*)(F.ws + WS_WGU) + (size_t)le * 1024 * 1024, drow0 - n0, W8SCALE, scr, q, lane); return; }
    q -= 512;
    p0_transpose_item_fp8(F.in(25) + (size_t)le * DE * D, DE, D, (unsigned char*)(F.ws + WS_WDN) + (size_t)le * 1024 * 512, 0, W8SCALE, scr, q, lane);
}
__device__ __forceinline__ void p0_mod_item(const Frame& F, LAS float* scr, int it) {
    const int lane = F.lane(), l = it / 192, rem = it % 192, cg = rem >> 3, kc = rem & 7, k0 = 128 * kc, n0 = 256 * cg + 4 * lane;
    const float* cvec = F.in(1); const float* cctx = F.in(3);
    for (int idx = lane; idx < NMODR * 128; idx += 64) { const int r = idx >> 7, kk = idx & 127; const float cv = (r < 8) ? cvec[r * D + k0 + kk] : cctx[k0 + kk];
        scr[idx] = cv / (1.0f + __expf(-cv)); }
    LDS_WAIT(); asm volatile("" ::: "memory");
    f32x4 acc[NMODR];
#pragma unroll
    for (int r = 0; r < NMODR; ++r) acc[r] = (f32x4){0.f, 0.f, 0.f, 0.f};
    const float* wp = F.in(4) + ((size_t)l * D + k0) * NMODC + n0;
#pragma unroll 8
    for (int kk = 0; kk < 128; ++kk) { const f32x4 w = *(const f32x4*)(wp + (size_t)kk * NMODC);
#pragma unroll
        for (int r = 0; r < NMODR; ++r) { const float s = scr[r * 128 + kk]; acc[r] += w * s; } }
    float* modp = (float*)(F.ws + WS_MODP);
#pragma unroll
    for (int r = 0; r < NMODR; ++r) *(f32x4*)(modp + ((size_t)((kc * 2 + l) * NMODR + r)) * NMODC + n0) = acc[r];
    LDS_WAIT(); asm volatile("" ::: "memory");
}
__device__ __forceinline__ void p0_prologue(const Frame& F) {
    LAS float* scr = (LAS float*)(F.lds + F.wave * 16384);
    if (F.wave == 0) p0_mod_item(F, scr, F.bid);
    if (F.wave == 1 && F.bid < 128) p0_mod_item(F, scr, 256 + F.bid);
    const int gw = F.bid * NWAVES + F.wave, NGW = F.G * NWAVES;
    for (int it = gw; it < I_NONEXP; it += NGW) p0_item(F, scr, it);
}
constexpr int JOB_ITEMS = 16 * 768;
__device__ __forceinline__ void filler(const Frame& F, int job, int quota) {
    LAS float* scr = (LAS float*)(F.lds + F.wave * 16384);
    volatile LAS int* slot = (volatile LAS int*)(F.MISC + 60);
    const int lane = F.lane();
    for (;;) {
        __syncthreads();
        if (F.wave == 0 && lane == 0) *slot = (int)__hip_atomic_fetch_add((unsigned*)(F.ctl + CW_JOB + 64 * job), 8u, RLX_AGENT);
        __syncthreads();
        const int base = *slot;
        if (base >= quota) { if (F.wave == 0 && lane == 0) (void)__hip_atomic_fetch_sub((unsigned*)(F.ctl + CW_JOB + 64 * job), 8u, RLX_AGENT); break; }
        const int idx = base + F.wave;
        if (idx < JOB_ITEMS) p0_item(F, scr, I_NONEXP + job * JOB_ITEMS + idx);
    }
}

__device__ __forceinline__ void p1_modulate(const Frame& F) {
    constexpr int RPB = MT / 256;
    unsigned char* H = (unsigned char*)(F.ws + WS_A);
    int rc = -1; f32x4 gs[4], sh[4]; const int lane = F.lane();
    const float* xlat = F.in(0); const float* xctx = F.in(2);
    f32x4 vn[4];
    { const int m = F.bid * RPB + F.wave; ld_row_f32(m < NLAT ? xlat + (size_t)m * D : xctx + (size_t)(m - NLAT) * D, lane, vn); }
    for (int rl = F.wave; rl < RPB; rl += NWAVES) {
        const int m = F.bid * RPB + rl, r = row_batch(m);
        f32x4 v[4];
#pragma unroll
        for (int j = 0; j < 4; ++j) v[j] = vn[j];
        if (rl + NWAVES < RPB) { const int m2 = m + NWAVES; ld_row_f32(m2 < NLAT ? xlat + (size_t)m2 * D : xctx + (size_t)(m2 - NLAT) * D, lane, vn); }
        if (r != rc) { f32x4 g[4], sc[4]; ld_row_f32(F.in(6), lane, g); ld_mod(F, 0, r, 1, sc); ld_mod(F, 0, r, 0, sh);
#pragma unroll
            for (int j = 0; j < 4; ++j) gs[j] = g[j] * (sc[j] + 1.0f);
            rc = r; }
        const float rstd = 1.0f / sqrtf(wave_sum(sumsq4(v)) * (1.0f / D) + EPS);
#pragma unroll
        for (int j = 0; j < 4; ++j) v[j] = v[j] * rstd * gs[j] + sh[j];
        st_row_fp8(H + (size_t)m * D, lane, v);
    }
}

__device__ __forceinline__ void p3_conv(const Frame& F) {
    const bf16* U = (const bf16*)(F.ws + WS_B); unsigned char* V = (unsigned char*)(F.ws + WS_A);
    const int tid = F.tid(), lane = F.lane();
    f32x2 w[CONVW]; const float* wdw = F.in(12);
#pragma unroll
    for (int j = 0; j < CONVW; ++j) w[j] = *(const f32x2*)(wdw + j * D + 2 * tid);
    const f32x2 bias2 = *(const f32x2*)(F.in(13) + 2 * tid);
    f32x4 lg[4], lb[4]; ld_row_f32(F.in(14), lane, lg); ld_row_f32(F.in(15), lane, lb);
    constexpr int TT = 32, NIN = TT + CONVW - 1;
    for (int tile = F.bid; tile < MT / TT; tile += F.G) {
        int rowbase, t0, T;
        if (tile < NLAT / TT) { rowbase = (tile >> 7) * SEQ; t0 = (tile & 127) * TT; T = SEQ; } else { const int t2 = tile - NLAT / TT; rowbase = NLAT + (t2 >> 3) * CTXL; t0 = (t2 & 7) * TT; T = CTXL; }
        for (int p = tid; p < NIN * 128; p += NTHR) { const int i = p >> 7, cp = p & 127, t = t0 - 15 + i;
            v4u val = (v4u){0u, 0u, 0u, 0u}; if (t >= 0 && t < T) val = *(const v4u*)(U + (size_t)(rowbase + t) * D + cp * 8);
            *(LAS v4u*)(F.lds + i * 2048 + cp * 16) = val; }
        __syncthreads();
        f32x2 res[TT];
#pragma unroll
        for (int g = 0; g < TT / 8; ++g) {
            f32x2 acc[8];
#pragma unroll
            for (int q = 0; q < 8; ++q) acc[q] = bias2;
#pragma unroll
            for (int ii = 0; ii < 8 + CONVW - 1; ++ii) { const int i = 8 * g + ii; const unsigned uw = *(const LAS unsigned*)(F.lds + i * 2048 + tid * 4); const f32x2 uv = (f32x2){bflo(uw), bfhi(uw)};
#pragma unroll
                for (int q = 0; q < 8; ++q) { const int j = ii - q; if (j >= 0 && j < CONVW) acc[q] += w[j] * uv; } }
#pragma unroll
            for (int q = 0; q < 8; ++q) res[8 * g + q] = acc[q];
        }
        __syncthreads();
#pragma unroll
        for (int tt = 0; tt < TT; ++tt) *(LAS f32x2*)(F.lds + tt * 4096 + tid * 8) = res[tt];
        __syncthreads();
#pragma unroll
        for (int q = 0; q < 4; ++q) { const int tt = 4 * F.wave + q; f32x4 v[4];
#pragma unroll
            for (int j = 0; j < 4; ++j) v[j] = *(const LAS f32x4*)(F.lds + tt * 4096 + j * 1024 + lane * 16);
            float s = 0.f;
#pragma unroll
            for (int j = 0; j < 4; ++j) s += (v[j][0] + v[j][1]) + (v[j][2] + v[j][3]);
            const float mean = wave_sum(s) * (1.0f / D);
#pragma unroll
            for (int j = 0; j < 4; ++j) v[j] = v[j] - mean;
            const float rstd = 1.0f / sqrtf(wave_sum(sumsq4(v)) * (1.0f / D) + EPS);
#pragma unroll
            for (int j = 0; j < 4; ++j) { f32x4 y = v[j] * rstd * lg[j] + lb[j];
#pragma unroll
                for (int e = 0; e < 4; ++e) y[e] = y[e] / (1.0f + __expf(-y[e]));
                v[j] = y; }
            st_row_fp8(V + (size_t)(rowbase + t0 + tt) * D, lane, v); }
        __syncthreads();
    }
}

constexpr int RW_OFF = 0, RW_BYTES = 256 * 272;
constexpr int REC_OFF = 72 * 1024;
constexpr int LRK_OFF = REC_OFF + 4096;
constexpr int BASE_OFF = LRK_OFF + 2048;
template <int L>
__device__ __forceinline__ void p_emid(const Frame& F) {
    constexpr int NROWS = (L == 0) ? MT : NLAT, RPB = NROWS / 256;
    const bf16* Y = (const bf16*)(F.ws + (L == 0 ? WS_B : WS_C)); unsigned char* TOK = (unsigned char*)(F.ws + WS_A);
    bf16* XS = (bf16*)(F.ws + WS_B);
    float* XC = (float*)(F.ws + WS_XC);
    const int tid = F.tid(), lane = F.lane(), m0 = F.bid * RPB;
    const float* rwG = F.in(21);
    for (int idx = tid; idx < 4096; idx += NTHR) { const int k = idx >> 2, ep = idx & 3; const f32x4 v = *(const f32x4*)(rwG + k * 16 + ep * 4);
        *(LAS f32x4*)(F.lds + RW_OFF + (k >> 2) * 272 + (k & 3) * 64 + ep * 16) = v; }
    __syncthreads();
    float rb[16];
    { const float* rbG = F.in(22);
#pragma unroll
    for (int e = 0; e < 16; ++e) rb[e] = rbG[e]; }
    int rc = -1; f32x4 ga[4], gp[4], gs[4], sh[4];
    const float* xlat = F.in(0); const float* xctx = F.in(2);
    v2u yn[4]; f32x4 xn[4];
    v2u xbn[4];
    { const int m = m0 + F.wave; ld_raw_bf16(Y + (size_t)m * D, lane, yn);
      if (L == 0) ld_row_f32(m < NLAT ? xlat + (size_t)m * D : xctx + (size_t)(m - NLAT) * D, lane, xn); else ld_raw_bf16(XS + (size_t)m * D, lane, xbn); }
    for (int rl = F.wave; rl < RPB; rl += NWAVES) {
        const int m = m0 + rl, r = row_batch(m);
        f32x4 y[4], xv[4];
        unpack_bf16(yn, y);
        if (L == 0) {
#pragma unroll
            for (int j = 0; j < 4; ++j) xv[j] = xn[j];
        } else unpack_bf16(xbn, xv);
        if (rl + NWAVES < RPB) { const int m2 = m + NWAVES; ld_raw_bf16(Y + (size_t)m2 * D, lane, yn);
            if (L == 0) ld_row_f32(m2 < NLAT ? xlat + (size_t)m2 * D : xctx + (size_t)(m2 - NLAT) * D, lane, xn); else ld_raw_bf16(XS + (size_t)m2 * D, lane, xbn); }
        if (r != rc) { f32x4 g[4], sc[4]; ld_mod(F, L, r, 2, ga); ld_row_f32(F.in(7) + L * D, lane, gp); ld_row_f32(F.in(8) + L * D, lane, g); ld_mod(F, L, r, 4, sc); ld_mod(F, L, r, 3, sh);
#pragma unroll
            for (int j = 0; j < 4; ++j) gs[j] = g[j] * (sc[j] + 1.0f);
            rc = r; }
        const float rstdy = 1.0f / sqrtf(wave_sum(sumsq4(y)) * (1.0f / D) + EPS);
#pragma unroll
        for (int j = 0; j < 4; ++j) xv[j] = xv[j] + ga[j] * (y[j] * rstdy * gp[j]) * (((DBG_SKIP >> (2 * L)) & 1) ? 0.f : 1.f);
        if (m < NLAT) st_row_bf16(XS + (size_t)m * D, lane, xv); else st_row_f32(XC + (size_t)(m - NLAT) * D, lane, xv);
        const float rstd1 = 1.0f / sqrtf(wave_sum(sumsq4(xv)) * (1.0f / D) + EPS);
#pragma unroll
        for (int j = 0; j < 4; ++j) xv[j] = xv[j] * rstd1 * gs[j] + sh[j];
        st_row_fp8(TOK + (size_t)m * D, lane, xv);
        float a[16];
#pragma unroll
        for (int e = 0; e < 16; ++e) a[e] = 0.f;
#pragma unroll
        for (int j = 0; j < 4; ++j)
#pragma unroll
            for (int i = 0; i < 4; ++i) { const float tv = xv[j][i]; const LAS f32x4* wp = (const LAS f32x4*)(F.lds + RW_OFF + (64 * j + lane) * 272 + i * 64);
#pragma unroll
                for (int ep = 0; ep < 4; ++ep) { const f32x4 wv = wp[ep];
#pragma unroll
                    for (int cc = 0; cc < 4; ++cc) a[4 * ep + cc] += tv * wv[cc]; } }
        float k8[8], k4[4];
#pragma unroll
        for (int i = 0; i < 8; ++i) { const auto rr = __builtin_amdgcn_permlane32_swap(__builtin_bit_cast(unsigned, a[i]), __builtin_bit_cast(unsigned, a[8 + i]), false, false);
            const unsigned r0_ = rr[0], r1_ = rr[1]; k8[i] = __uint_as_float(r0_) + __uint_as_float(r1_); }
#pragma unroll
        for (int i = 0; i < 4; ++i) { const auto rr = __builtin_amdgcn_permlane16_swap(__builtin_bit_cast(unsigned, k8[i]), __builtin_bit_cast(unsigned, k8[4 + i]), false, false);
            const unsigned r0_ = rr[0], r1_ = rr[1]; k4[i] = row16_sum(__uint_as_float(r0_) + __uint_as_float(r1_)); }
        float s[16], ss[16];
        const float lgsel = (lane & 2) ? ((lane & 1) ? k4[3] : k4[2]) : ((lane & 1) ? k4[1] : k4[0]);
        const float sgl = 1.0f / (1.0f + __expf(-lgsel));
#pragma unroll
        for (int e = 0; e < 16; ++e) { s[e] = rdlane(sgl, 16 * (e >> 2) + (e & 3)); ss[e] = s[e] + rb[e]; }
        float gsc[4]; int i0[4], i1[4];
#pragma unroll
        for (int g = 0; g < 4; ++g) { int a0 = 0; float mx = ss[4 * g];
#pragma unroll
            for (int i = 1; i < 4; ++i) if (ss[4 * g + i] > mx) { mx = ss[4 * g + i]; a0 = i; }
            int b0 = -1; float m2 = -3.0e38f;
#pragma unroll
            for (int i = 0; i < 4; ++i) if (i != a0 && ss[4 * g + i] > m2) { m2 = ss[4 * g + i]; b0 = i; }
            gsc[g] = mx + m2; i0[g] = 4 * g + a0; i1[g] = 4 * g + b0; }
        int gst = 0; float gm = gsc[0];
#pragma unroll
        for (int g = 1; g < 4; ++g) if (gsc[g] > gm) { gm = gsc[g]; gst = g; }
        int e0 = i0[0], e1 = i1[0];
#pragma unroll
        for (int g = 1; g < 4; ++g) if (gst == g) { e0 = i0[g]; e1 = i1[g]; }
        float w0 = 0.f, w1 = 0.f;
#pragma unroll
        for (int e = 0; e < 16; ++e) { if (e == e0) w0 = s[e]; if (e == e1) w1 = s[e]; }
        const float inv = 1.0f / (w0 + w1); w0 *= inv; w1 *= inv;
        if (lane == 0) *(LAS v4u*)(F.lds + REC_OFF + rl * 16) = (v4u){(unsigned)e0, (unsigned)e1, __builtin_bit_cast(unsigned, w0), __builtin_bit_cast(unsigned, w1)};
    }
    __syncthreads();
    if (F.wave == 0 && lane < 16) {
        int cntl = 0;
        for (int rl = 0; rl < RPB; ++rl) { const v4u rec = *(const LAS v4u*)(F.lds + REC_OFF + rl * 16);
            if ((int)rec.x == lane) { *(LAS int*)(F.lds + LRK_OFF + rl * 8) = cntl; ++cntl; }
            if ((int)rec.y == lane) { *(LAS int*)(F.lds + LRK_OFF + rl * 8 + 4) = cntl; ++cntl; } }
        const unsigned base = __hip_atomic_fetch_add((unsigned*)(F.ctl + CW_CNT + (L * 16 + lane) * 64), (unsigned)cntl, RLX_AGENT);
        *(LAS int*)(F.lds + BASE_OFF + lane * 4) = (int)base;
    }
    __syncthreads();
    int* perm2 = (int*)(F.ws + WS_PERM); v2u* slot = (v2u*)(F.ws + WS_SLOT);
    for (int idx = tid; idx < RPB * 2; idx += NTHR) { const int rl = idx >> 1, k = idx & 1; const v4u rec = *(const LAS v4u*)(F.lds + REC_OFF + rl * 16);
        const int e = k ? (int)rec.y : (int)rec.x; const unsigned wb = k ? rec.w : rec.z;
        const int rank = *(const LAS int*)(F.lds + BASE_OFF + e * 4) + *(const LAS int*)(F.lds + LRK_OFF + rl * 8 + k * 4);
        const int m = m0 + rl;
        perm2[(size_t)e * MT + rank] = m;
        slot[(size_t)m * 2 + k] = (v2u){((unsigned)e << 24) | (unsigned)rank, wb}; }
    __syncthreads();
}

__device__ __forceinline__ void moe_setup(const Frame& F, int L) {
    const int tid = F.tid();
    if (tid < 16) F.MISC[40 + tid] = __hip_atomic_load((unsigned*)(F.ctl + CW_CNT + (L * 16 + tid) * 64), RLX_AGENT);
    __syncthreads();
    if (tid == 0) { unsigned p = 0; for (int e = 0; e < 16; ++e) { F.MISC[16 + e] = p; p += (F.MISC[40 + e] + 255u) >> 8; } F.MISC[32] = p; }
    __syncthreads();
}
__device__ __forceinline__ void moe_stage_perm(const Frame& F) {
    const int* perm2 = (const int*)(F.ws + WS_PERM); LAS int* permL = (LAS int*)(F.lds + PERML_OFF);
    const int ntile = (int)F.MISC[32], tid = F.tid();
    for (int i = 0; i < 8; ++i) { const int Lu = i * F.G + F.bid; if (Lu >= 4 * ntile) break;
        const int rt = Lu >> 2; int e = 0;
        for (int j = 1; j < 16; ++j) e += (rt >= (int)F.MISC[16 + j]) ? 1 : 0;
        if (tid < 256) { const int rank = (rt - (int)F.MISC[16 + e]) * 256 + tid; permL[i * 256 + tid] = (rank < (int)F.MISC[40 + e]) ? perm2[(size_t)e * MT + rank] : 0; } }
    __syncthreads();
}

template <int L>
__device__ __forceinline__ void p_epost(const Frame& F) {
    constexpr int NROWS = (L == 0) ? MT : NLAT, RPB = NROWS / 256;
    const unsigned char* FB = (const unsigned char*)(F.ws + WS_D2); unsigned char* H = (unsigned char*)(F.ws + WS_A);
    float* XC = (float*)(F.ws + WS_XC); const v2u* slot = (const v2u*)(F.ws + WS_SLOT);
    const int lane = F.lane(), m0 = F.bid * RPB;
    int rc = -1; f32x4 ga[4], gp[4], gs[4], sh[4];
    v4u sl_n2 = (v4u){0u, 0u, 0u, 0u}; unsigned f0n[4], f1n[4]; v2u xbn[4]; f32x4 xn[4]; float w0n, w1n;
    bf16* XS = (bf16*)(F.ws + WS_B);
#define EP_ISSUE(mm, slv) do { const unsigned sx0 = __builtin_amdgcn_readfirstlane((slv).x), sy0 = __builtin_amdgcn_readfirstlane((slv).y), sx1 = __builtin_amdgcn_readfirstlane((slv).z), sy1 = __builtin_amdgcn_readfirstlane((slv).w); \
        const size_t v0_ = (size_t)F.MISC[16 + (sx0 >> 24)] * 256 + (sx0 & 0xffffffu), v1_ = (size_t)F.MISC[16 + (sx1 >> 24)] * 256 + (sx1 & 0xffffffu); \
        w0n = __uint_as_float(sy0); w1n = __uint_as_float(sy1); ld_raw_fp8(FB + v0_ * D, lane, f0n); ld_raw_fp8(FB + v1_ * D, lane, f1n); \
        if ((mm) < NLAT) ld_raw_bf16(XS + (size_t)(mm) * D, lane, xbn); else ld_row_f32(XC + (size_t)((mm) - NLAT) * D, lane, xn); } while (0)
    { const int m = m0 + F.wave; const v4u sl0 = *(const v4u*)(slot + (size_t)m * 2);
      if (F.wave + NWAVES < RPB) sl_n2 = *(const v4u*)(slot + (size_t)(m + NWAVES) * 2);
      EP_ISSUE(m, sl0); }
    for (int rl = F.wave; rl < RPB; rl += NWAVES) {
        const int m = m0 + rl, r = row_batch(m);
        f32x4 f0[4], f1[4], xv[4]; const float w0 = w0n, w1 = w1n;
        unpack_fp8(f0n, f0); unpack_fp8(f1n, f1);
        if (m < NLAT) unpack_bf16(xbn, xv); else {
#pragma unroll
            for (int j = 0; j < 4; ++j) xv[j] = xn[j]; }
        if (rl + NWAVES < RPB) { const v4u slc = sl_n2; if (rl + 2 * NWAVES < RPB) sl_n2 = *(const v4u*)(slot + (size_t)(m + 2 * NWAVES) * 2); EP_ISSUE(m + NWAVES, slc); }
        if (r != rc) { ld_mod(F, L, r, 5, ga); ld_row_f32(F.in(9) + L * D, lane, gp);
            if (L == 0) { f32x4 g[4], sc[4]; ld_row_f32(F.in(6) + D, lane, g); ld_mod(F, 1, r, 1, sc); ld_mod(F, 1, r, 0, sh);
#pragma unroll
                for (int j = 0; j < 4; ++j) gs[j] = g[j] * (sc[j] + 1.0f); }
            rc = r; }
#pragma unroll
        for (int j = 0; j < 4; ++j) f0[j] = (DBG_SLOT == 1) ? f0[j] : (DBG_SLOT == 2) ? f1[j] : (DBG_SLOT == 3) ? f0[j] * 0.5f + f1[j] * 0.5f : f0[j] * w0 + f1[j] * w1;
        const float rstdf = 1.0f / sqrtf(wave_sum(sumsq4(f0)) * (1.0f / D) + EPS);
#pragma unroll
        for (int j = 0; j < 4; ++j) xv[j] = xv[j] + ga[j] * (f0[j] * rstdf * gp[j]) * (((DBG_SKIP >> (2 * L + 1)) & 1) ? 0.f : 1.f);
        if (L == 1) st_row_f32(F.out + (size_t)m * D, lane, xv);
        else if (m < NLAT) st_row_bf16(XS + (size_t)m * D, lane, xv); else st_row_f32(XC + (size_t)(m - NLAT) * D, lane, xv);
        if (L == 0) {
            const float rstd2 = 1.0f / sqrtf(wave_sum(sumsq4(xv)) * (1.0f / D) + EPS);
#pragma unroll
            for (int j = 0; j < 4; ++j) xv[j] = xv[j] * rstd2 * gs[j] + sh[j];
            st_row_fp8(H + (size_t)m * D, lane, xv);
        }
    }
#undef EP_ISSUE
}

constexpr int AT_CK = 0, AT_CV = 32768, AT_RPB = 65536;
constexpr float LOG2E = 1.4426950408889634f;
__device__ __forceinline__ float xrow_max(float m) {
    { const auto rr = __builtin_amdgcn_permlane16_swap(__builtin_bit_cast(unsigned, m), __builtin_bit_cast(unsigned, m), false, false); const unsigned a_ = rr[0], b_ = rr[1]; m = fmaxf(__uint_as_float(a_), __uint_as_float(b_)); }
    { const auto rr = __builtin_amdgcn_permlane32_swap(__builtin_bit_cast(unsigned, m), __builtin_bit_cast(unsigned, m), false, false); const unsigned a_ = rr[0], b_ = rr[1]; m = fmaxf(__uint_as_float(a_), __uint_as_float(b_)); }
    return m;
}
__device__ __forceinline__ float xrow_sum(float m) {
    { const auto rr = __builtin_amdgcn_permlane16_swap(__builtin_bit_cast(unsigned, m), __builtin_bit_cast(unsigned, m), false, false); const unsigned a_ = rr[0], b_ = rr[1]; m = __uint_as_float(a_) + __uint_as_float(b_); }
    { const auto rr = __builtin_amdgcn_permlane32_swap(__builtin_bit_cast(unsigned, m), __builtin_bit_cast(unsigned, m), false, false); const unsigned a_ = rr[0], b_ = rr[1]; m = __uint_as_float(a_) + __uint_as_float(b_); }
    return m;
}
__device__ __forceinline__ void attn_softmax(f32x4 (&s)[4], float& mrun, f32x4& osum, f32x4 (&o)[4], bf16x8 (&pf)[2]) {
    float mx = mrun;
#pragma unroll
    for (int t = 0; t < 4; ++t) mx = fmaxf(fmaxf(mx, fmaxf(s[t][0], s[t][1])), fmaxf(s[t][2], s[t][3]));
    mx = xrow_max(mx);
    if (__builtin_amdgcn_ballot_w64(mx > mrun) != 0ull) {
        const float alpha = __builtin_amdgcn_exp2f(mrun - mx);
        mrun = mx; osum = osum * alpha;
#pragma unroll
        for (int db = 0; db < 4; ++db) o[db] = o[db] * alpha;
    }
#pragma unroll
    for (int t = 0; t < 4; ++t)
#pragma unroll
        for (int i = 0; i < 4; ++i) s[t][i] = __builtin_amdgcn_exp2f(s[t][i] - mx);
#pragma unroll
    for (int bb = 0; bb < 2; ++bb) { v4u pw; pw.x = pg8::cvt_pk_bf16(s[2 * bb][0], s[2 * bb][1]); pw.y = pg8::cvt_pk_bf16(s[2 * bb][2], s[2 * bb][3]);
        pw.z = pg8::cvt_pk_bf16(s[2 * bb + 1][0], s[2 * bb + 1][1]); pw.w = pg8::cvt_pk_bf16(s[2 * bb + 1][2], s[2 * bb + 1][3]); pf[bb] = __builtin_bit_cast(bf16x8, pw); }
}
template <int ABL  >
__device__ __forceinline__ void p10_attn(const Frame& F) {
    const bf16* Qh = (const bf16*)F.out; const bf16* Kh = (const bf16*)(F.ws + WS_C); const bf16* Vb = (const bf16*)(F.ws + WS_D2); unsigned char* O = (unsigned char*)(F.ws + WS_A);
    const int lane = F.lane(), tid = F.wave * 64 + lane, qi = lane & 15, q4 = lane >> 4;
    const int per = (BATCH * NH * GROWS * 4) / F.G;
    const int bh = (F.bid * per) >> 8, h = bh & 15, b = bh >> 4;
    const bf16* Kbh = Kh + (size_t)bh * KSLOT * HD; const bf16* Vbh = Vb + (size_t)bh * (KSLOT / 8) * 512;
#pragma unroll
    for (int i = 0; i < 4; ++i) { const int kf = F.wave * 4 + i, blk = kf >> 2, tl = (kf >> 1) & 1, dh = kf & 1;
        const v4u kv = *(const v4u*)(Kbh + (size_t)(SEQ + 32 * blk + 8 * (qi >> 2) + 4 * tl + (qi & 3)) * HD + dh * 32 + 8 * q4);
        const int vblk = kf >> 2, db = kf & 3;
        const v4u vv = *(const v4u*)(Vbh + (size_t)(SEQ / 8 + 4 * vblk + q4) * 512 + (db * 16 + qi) * 8);
        *(LAS v4u*)(F.lds + AT_CK + kf * 1024 + lane * 16) = kv; *(LAS v4u*)(F.lds + AT_CV + kf * 1024 + lane * 16) = vv; }
    { const float* rpbG = F.in(20) + h * 465; LAS float* rpbW = (LAS float*)(F.lds + AT_RPB);
        for (int idx = tid; idx < 15 * 32; idx += NTHR) { const int ri = idx >> 5, ci = idx & 31; rpbW[idx] = (ci < 31) ? rpbG[ri * 31 + ci] * LOG2E : -1.0e30f; } }
    __syncthreads();
    const int seg = F.wave & 3;
    const int cb = (seg == 0) ? 0 : (seg == 1) ? 8 : (seg == 2) ? 24 : 32;
    const int qc = 16 * seg + qi, cs = min(max(qc - WINW / 2, 0), GRIDW - WINW);
    int coff[2][4];
#pragma unroll
    for (int tl = 0; tl < 2; ++tl)
#pragma unroll
        for (int i = 0; i < 4; ++i) { const int kc = cb + 8 * q4 + 4 * tl + i; const bool ok = (kc >= cs) && (kc < cs + WINW); coff[tl][i] = AT_RPB + 4 * (ok ? (kc - qc + (WINW - 1)) : 31); }
    const bf16x8 ones = __builtin_bit_cast(bf16x8, (v4u){0x3f803f80u, 0x3f803f80u, 0x3f803f80u, 0x3f803f80u});
    for (int it = 0; it < per; it += NWAVES) {
        const int wu = F.bid * per + it + F.wave;
        const int r = (wu >> 2) & 63;
        const int r0 = min(max(r - WINH / 2, 0), GROWS - WINH);
        const bf16* Qp = Qh + ((size_t)bh * SEQ + r * GRIDW + qc) * HD;
        const bf16x8 qf0 = *(const bf16x8*)(Qp + 8 * q4), qf1 = *(const bf16x8*)(Qp + 32 + 8 * q4);
        const bf16* kp0 = Kbh + (size_t)(r0 * GRIDW + cb + 8 * (qi >> 2) + (qi & 3)) * HD + 8 * q4;
        const bf16* vp0 = Vbh + (size_t)((r0 * GRIDW + cb) / 8 + q4) * 512 + qi * 8;
        int boff[2][4];
#pragma unroll
        for (int tl = 0; tl < 2; ++tl)
#pragma unroll
            for (int i = 0; i < 4; ++i) boff[tl][i] = coff[tl][i] + (r0 - r + (WINH - 1)) * 128;
        bf16x8 kw[4][2][2][2], vw[4][2][4];
#define AT_LOADK(g) do { _Pragma("unroll") for (int bb = 0; bb < 2; ++bb) _Pragma("unroll") for (int tl = 0; tl < 2; ++tl) { if (ABL & 1) { kw[g][bb][tl][0] = qf0; kw[g][bb][tl][1] = qf1; continue; } \
            kw[g][bb][tl][0] = *(const bf16x8*)(kp0 + (size_t)((2 * (g) + bb) * GRIDW + 4 * tl) * HD); kw[g][bb][tl][1] = *(const bf16x8*)(kp0 + (size_t)((2 * (g) + bb) * GRIDW + 4 * tl) * HD + 32); } } while (0)
#define AT_LOADV(g) do { _Pragma("unroll") for (int bb = 0; bb < 2; ++bb) _Pragma("unroll") for (int db = 0; db < 4; ++db) vw[g][bb][db] = (ABL & 1) ? qf0 : *(const bf16x8*)(vp0 + (size_t)((2 * (g) + bb) * (GRIDW / 8)) * 512 + db * 128); } while (0)
        float mrun = -1.0e30f;
        f32x4 osum = (f32x4){0.f, 0.f, 0.f, 0.f};
        f32x4 o[4];
#pragma unroll
        for (int db = 0; db < 4; ++db) o[db] = (f32x4){0.f, 0.f, 0.f, 0.f};
        AT_LOADK(0); AT_LOADV(0);
        __builtin_amdgcn_sched_barrier(0);
#pragma unroll
        for (int g = 0; g < 4; ++g) {
            {
                f32x4 s[4]; bf16x8 pf[2];
#pragma unroll
                for (int bb = 0; bb < 2; ++bb) { const int blk = 2 * g + bb;
#pragma unroll
                    for (int tl = 0; tl < 2; ++tl) { const bf16x8 k0 = (ABL & 2) ? qf1 : *(const LAS bf16x8*)(F.lds + AT_CK + ((blk * 2 + tl) * 2 + 0) * 1024 + lane * 16), k1 = (ABL & 2) ? qf0 : *(const LAS bf16x8*)(F.lds + AT_CK + ((blk * 2 + tl) * 2 + 1) * 1024 + lane * 16);
                        f32x4 acc = (f32x4){0.f, 0.f, 0.f, 0.f};
                        acc = __builtin_amdgcn_mfma_f32_16x16x32_bf16(k0, qf0, acc, 0, 0, 0);
                        acc = __builtin_amdgcn_mfma_f32_16x16x32_bf16(k1, qf1, acc, 0, 0, 0);
                        s[2 * bb + tl] = acc; } }
                attn_softmax(s, mrun, osum, o, pf);
#pragma unroll
                for (int bb = 0; bb < 2; ++bb) { osum = __builtin_amdgcn_mfma_f32_16x16x32_bf16(ones, pf[bb], osum, 0, 0, 0);
#pragma unroll
                    for (int db = 0; db < 4; ++db) { const bf16x8 vf = (ABL & 2) ? qf1 : *(const LAS bf16x8*)(F.lds + AT_CV + ((2 * g + bb) * 4 + db) * 1024 + lane * 16);
                        o[db] = __builtin_amdgcn_mfma_f32_16x16x32_bf16(vf, pf[bb], o[db], 0, 0, 0); } }
            }
            __builtin_amdgcn_sched_barrier(0);
            {
                f32x4 s[4]; bf16x8 pf[2];
#pragma unroll
                for (int bb = 0; bb < 2; ++bb)
#pragma unroll
                    for (int tl = 0; tl < 2; ++tl) { f32x4 acc;
#pragma unroll
                        for (int i = 0; i < 4; ++i) acc[i] = *(const LAS float*)(F.lds + boff[tl][i] + (2 * g + bb) * 128);
                        acc = __builtin_amdgcn_mfma_f32_16x16x32_bf16(kw[g][bb][tl][0], qf0, acc, 0, 0, 0);
                        acc = __builtin_amdgcn_mfma_f32_16x16x32_bf16(kw[g][bb][tl][1], qf1, acc, 0, 0, 0);
                        s[2 * bb + tl] = acc; }
                if (g < 3) { AT_LOADK(g + 1); }
                __builtin_amdgcn_sched_barrier(0);
                attn_softmax(s, mrun, osum, o, pf);
#pragma unroll
                for (int bb = 0; bb < 2; ++bb) { osum = __builtin_amdgcn_mfma_f32_16x16x32_bf16(ones, pf[bb], osum, 0, 0, 0);
#pragma unroll
                    for (int db = 0; db < 4; ++db) o[db] = __builtin_amdgcn_mfma_f32_16x16x32_bf16(vw[g][bb][db], pf[bb], o[db], 0, 0, 0); }
                if (g < 3) { AT_LOADV(g + 1); }
                __builtin_amdgcn_sched_barrier(0);
            }
        }
#undef AT_LOADK
#undef AT_LOADV
        const float inv = 1.0f / osum[0];
        unsigned char* op = O + ((size_t)b * SEQ + r * GRIDW + qc) * D + h * HD + 4 * q4;
#pragma unroll
        for (int db = 0; db < 4; ++db) { const unsigned w = pk4_fp8(o[db][0] * inv, o[db][1] * inv, o[db][2] * inv, o[db][3] * inv); if (ABL == 0 || w == 0x12345u) *(unsigned*)(op + db * 16) = w; }
    }
    __syncthreads();
}

#ifndef MK_N_LAUNCHES
#define MK_N_LAUNCHES 1
#endif
constexpr int N_PHASES = 16;
constexpr int N_LAUNCHES = MK_N_LAUNCHES;
struct Args { const float* in[26]; float* out; unsigned char* ws; int ph_lo, ph_hi; };

__global__ void __launch_bounds__(NTHR, 2) fwd_kernel(Args args) {
    extern __shared__ __attribute__((aligned(16))) unsigned char lds[];
    Frame F;
    F.lds = (LAS unsigned char*)lds;
    F.MISC = (volatile LAS unsigned*)(F.lds + MISC_OFF);
    F.wave = __builtin_amdgcn_readfirstlane((int)threadIdx.x >> 6);
    F.G = gridDim.x; F.bid = blockIdx.x;
    F.ws = args.ws; F.ctl = (gu32*)(args.ws + WS_CTL); F.out = args.out;
    for (int u = threadIdx.x; u < 256; u += NTHR) F.MISC[u] = 0u;
    if (threadIdx.x < 26) { const unsigned long long pv = (unsigned long long)args.in[threadIdx.x]; volatile LAS unsigned* t = (volatile LAS unsigned*)(F.lds + PTAB_OFF) + 2 * threadIdx.x; t[0] = (unsigned)pv; t[1] = (unsigned)(pv >> 32); }
    __syncthreads();
    XcdBarrier bar; bar.bar = (unsigned*)(F.ctl + CW_BAR); bar.x = 0; bar.st = nullptr;
    if (N_LAUNCHES == 1) bar = xcd_barrier_post((unsigned*)(F.ctl + CW_BAR), F.MISC + 8);
    const int lo = args.ph_lo, hi = args.ph_hi;
#ifndef PHASE_MASK
#define PHASE_MASK 0xFFFF
#endif
#define IN(k) ((((PHASE_MASK) >> (k)) & 1) && lo <= (k) && (k) < hi)
#define SEAM(k) do { if (IN(k) && IN((k) + 1)) { xcd_barrier(bar); if (PROBE_MASK == 0x10000) xcd_barrier(bar); } } while (0)
    const char* wsb = (const char*)F.ws;
    LAS unsigned char* ring = F.lds;

    if (IN(0)) { _Pragma("unroll") for (int rep = 0; rep < REP(0); ++rep) { p0_prologue(F); __syncthreads(); } }
    SEAM(0);
    if (IN(1)) { _Pragma("unroll") for (int rep = 0; rep < REP(1); ++rep) p1_modulate(F); }
    SEAM(1);
    if (IN(2)) {
        pg8::DenseSched S{wsb + WS_A, wsb + WS_WIN, D / 2, MT / 256, 8, F.G, F.bid};
        pg8::EpiGated<0> E{(bf16*)(F.ws + WS_B), D, F.in(11), D};
        _Pragma("unroll") for (int rep = 0; rep < REP(2); ++rep) pg8::gemm_phase<pg8::EpiGated<0>, pg8::DenseSched, true, true>(ring, D / 2, S, E, F.wave);
        filler(F, 0, 3600);
    }
    SEAM(2);
    if (IN(3)) { _Pragma("unroll") for (int rep = 0; rep < REP(3); ++rep) p3_conv(F); }
    SEAM(3);
    if (IN(4)) {
        pg8::DenseSched S{wsb + WS_A, wsb + WS_WOUT, D / 2, MT / 256, 4, F.G, F.bid};
        pg8::EpiBf16B E{(bf16*)(F.ws + WS_B), D, F.in(17)};
        _Pragma("unroll") for (int rep = 0; rep < REP(4); ++rep) pg8::gemm_phase<pg8::EpiBf16B, pg8::DenseSched, true, true>(ring, D / 2, S, E, F.wave);
        filler(F, 0, JOB_ITEMS);
    }
    SEAM(4);
    if (IN(5)) { filler(F, 0, JOB_ITEMS); p_emid<0>(F); }
    SEAM(5);
    if (IN(6)) {
        moe_setup(F, 0); moe_stage_perm(F);
        pg8::MoeUpSched S; S.tpre = (const volatile LAS int*)(F.MISC + 16); S.G = F.G; S.c = F.bid; S.A = wsb + WS_A; S.Wgu = wsb + WS_WGU + (size_t)0 * 16 * 1024 * 1024; S.permL = (const LAS int*)(F.lds + PERML_OFF); S.kb = D;
        pg8::EpiGated<1, true> E{(bf16*)(F.ws + WS_C), DE, nullptr, 0};
        _Pragma("unroll") for (int rep = 0; rep < REP(6); ++rep) pg8::gemm_phase<pg8::EpiGated<1, true>, pg8::MoeUpSched, true, true>(ring, D / 2, S, E, F.wave);
        filler(F, 1, 3000);
    }
    SEAM(6);
    if (IN(7)) {
        moe_setup(F, 0);
        pg8::MoeDownSched S; S.tpre = (const volatile LAS int*)(F.MISC + 16); S.G = F.G; S.c = F.bid; S.A = wsb + WS_C; S.Wdn = wsb + WS_WDN + (size_t)0 * 16 * 1024 * 512; S.kb = DE;
        pg8::EpiF8 E{(unsigned char*)(F.ws + WS_D2), D};
        _Pragma("unroll") for (int rep = 0; rep < REP(7); ++rep) pg8::gemm_phase<pg8::EpiF8, pg8::MoeDownSched, true, true>(ring, DE / 2, S, E, F.wave);
        filler(F, 1, 4500);
    }
    SEAM(7);
    if (IN(8)) { moe_setup(F, 0); p_epost<0>(F); }
    SEAM(8);
    if (IN(9)) {
        pg8::QkvSched S{wsb + WS_A, wsb + WS_WQKV, F.G, F.bid, D};
        pg8::EpiQkv E{(bf16*)F.out, (bf16*)(F.ws + WS_C), (bf16*)(F.ws + WS_D2), 0.125f * 1.4426950408889634f};
        _Pragma("unroll") for (int rep = 0; rep < REP(9); ++rep) pg8::gemm_phase<pg8::EpiQkv, pg8::QkvSched, true, true>(ring, D / 2, S, E, F.wave);
        filler(F, 1, 8100);
    }
    SEAM(9);
#ifndef ATT_ABL
#define ATT_ABL 0
#endif
    if (IN(10)) { if (REP(10) == 2) p10_attn<ATT_ABL>(F); p10_attn<0>(F); }
    SEAM(10);
    if (IN(11)) {
        pg8::DenseSched S{wsb + WS_A, wsb + WS_WO, D / 2, NLAT / 256, 4, F.G, F.bid};
        pg8::EpiBf16 E{(bf16*)(F.ws + WS_C), D, nullptr};
        _Pragma("unroll") for (int rep = 0; rep < REP(11); ++rep) pg8::gemm_phase<pg8::EpiBf16, pg8::DenseSched, true, true>(ring, D / 2, S, E, F.wave);
    }
    SEAM(11);
    if (IN(12)) { filler(F, 1, JOB_ITEMS); p_emid<1>(F); }
    SEAM(12);
    if (IN(13)) {
        moe_setup(F, 1); moe_stage_perm(F);
        pg8::MoeUpSched S; S.tpre = (const volatile LAS int*)(F.MISC + 16); S.G = F.G; S.c = F.bid; S.A = wsb + WS_A; S.Wgu = wsb + WS_WGU + (size_t)1 * 16 * 1024 * 1024; S.permL = (const LAS int*)(F.lds + PERML_OFF); S.kb = D;
        pg8::EpiGated<1, true> E{(bf16*)(F.ws + WS_C), DE, nullptr, 0};
        _Pragma("unroll") for (int rep = 0; rep < REP(13); ++rep) pg8::gemm_phase<pg8::EpiGated<1, true>, pg8::MoeUpSched, true, true>(ring, D / 2, S, E, F.wave);
    }
    SEAM(13);
    if (IN(14)) {
        moe_setup(F, 1);
        pg8::MoeDownSched S; S.tpre = (const volatile LAS int*)(F.MISC + 16); S.G = F.G; S.c = F.bid; S.A = wsb + WS_C; S.Wdn = wsb + WS_WDN + (size_t)1 * 16 * 1024 * 512; S.kb = DE;
        pg8::EpiF8 E{(unsigned char*)(F.ws + WS_D2), D};
        _Pragma("unroll") for (int rep = 0; rep < REP(14); ++rep) pg8::gemm_phase<pg8::EpiF8, pg8::MoeDownSched, true, true>(ring, DE / 2, S, E, F.wave);
    }
    SEAM(14);
    if (IN(15)) { moe_setup(F, 1); _Pragma("unroll") for (int rep = 0; rep < REP(15); ++rep) p_epost<1>(F); }
#undef IN
#undef SEAM
}

extern "C" void kernel_launch(void* const* d_in, const int* in_sizes, int n_in, void* d_out, int out_size, void* d_ws, size_t ws_size, hipStream_t stream) {
    static int grid = 0;
    if (grid == 0) {
        if (n_in != 26 || in_sizes[0] != NLAT * D || out_size != NLAT * D || ws_size < WS_END) { fprintf(stderr, "kernel_launch: unexpected shapes (n_in %d, in0 %d, out %d, ws %zu); nothing launched\n", n_in, n_in > 0 ? in_sizes[0] : -1, out_size, ws_size); grid = -1; return; }
        if (hipFuncSetAttribute((const void*)fwd_kernel, hipFuncAttributeMaxDynamicSharedMemorySize, LDS_BYTES) != hipSuccess) { fprintf(stderr, "kernel_launch: hipFuncSetAttribute failed\n"); grid = -1; return; }
        int per_cu = 0;
        if (hipOccupancyMaxActiveBlocksPerMultiprocessor(&per_cu, (const void*)fwd_kernel, NTHR, LDS_BYTES) != hipSuccess || per_cu < 1) fprintf(stderr, "kernel_launch: note: occupancy query reports %d workgroups per CU\n", per_cu);
        (void)hipGetLastError();
        grid = 256;
    }
    if (grid < 0) return;
    if (hipMemsetAsync((char*)d_ws + WS_CTL, 0, CTL_ZERO_BYTES, stream) != hipSuccess) { fprintf(stderr, "kernel_launch: hipMemsetAsync failed\n"); return; }
    Args a{};
    for (int i = 0; i < 26; ++i) a.in[i] = (const float*)d_in[i];
    a.out = (float*)d_out; a.ws = (unsigned char*)d_ws;
    for (int li = 0; li < N_LAUNCHES; ++li) {
        a.ph_lo = (N_LAUNCHES == 1) ? 0 : li; a.ph_hi = (N_LAUNCHES == 1) ? N_PHASES : li + 1;
        hipLaunchKernelGGL(fwd_kernel, dim3(grid), dim3(NTHR), LDS_BYTES, stream, a);
        const hipError_t le = hipPeekAtLastError();
        if (le != hipSuccess) { fprintf(stderr, "kernel_launch: launch %d failed: %s\n", li, hipGetErrorName(le)); break; }
    }
}
```

```cpp
#include <hip/hip_runtime.h>
#include <cstdio>
#include <cstdint>

#ifndef PROBE_MASK
#define PROBE_MASK 0
#endif
#define REP(k) ((((PROBE_MASK) >> (k)) & 1) ? 2 : 1)
#ifndef DBG_SLOT
#define DBG_SLOT 0
#endif
#ifndef DBG_SKIP
#define DBG_SKIP 0
#endif
constexpr int D = 1024, BATCH = 8, SEQ = 4096, CTXL = 256;
constexpr int NLAT = BATCH * SEQ, NCTX = BATCH * CTXL, MT = NLAT + NCTX;
constexpr int NE = 16, DE = 512, NH = 16, HD = 64, GRIDW = 64, GROWS = 64, WINH = 8, WINW = 16, CONVW = 31;
constexpr int KSLOT = SEQ + CTXL;
constexpr int NMODR = 9, NMODC = 6 * D;
constexpr int MODKC = 8;
constexpr float EPS = 1e-6f;
constexpr int NWAVES = 8, NTHR = NWAVES * 64;

constexpr size_t MiB = 1u << 20;
constexpr size_t WS_CTL = 0, CTL_ZERO_BYTES = 1 * MiB;
constexpr size_t WS_SLOT = 1 * MiB;
constexpr size_t WS_PERM = 2 * MiB;
constexpr size_t WS_MODP = 5 * MiB;
constexpr size_t WS_XC = 9 * MiB;
constexpr size_t WS_WIN = 18 * MiB, WS_WOUT = 22 * MiB, WS_WQKV = 24 * MiB, WS_WO = 30 * MiB;
constexpr size_t WS_WGU = 32 * MiB;
constexpr size_t WS_WDN = 96 * MiB;
constexpr size_t WS_A = 128 * MiB, WS_B = 196 * MiB, WS_C = 264 * MiB, WS_D2 = 336 * MiB, WS_END = 480 * MiB;
constexpr int CW_BAR = 4096;
constexpr int CW_JOB = 12288;
constexpr int CW_CNT = 8192;

constexpr int RING_BYTES = 131072;
constexpr int MISC_OFF = RING_BYTES;
constexpr int PTAB_OFF = RING_BYTES + 1024 + 8192;
constexpr int PERML_OFF = RING_BYTES + 1024;
constexpr int LDS_BYTES = 147456;

#define GAS __attribute__((address_space(1)))
#define LAS __attribute__((address_space(3)))
typedef unsigned short bf16;
typedef unsigned v4u __attribute__((ext_vector_type(4)));
typedef unsigned v2u __attribute__((ext_vector_type(2)));
typedef float f32x4 __attribute__((ext_vector_type(4)));
typedef float f32x2 __attribute__((ext_vector_type(2)));
typedef short bf16x8 __attribute__((ext_vector_type(8)));
typedef GAS unsigned gu32;
#define RLX_AGENT __ATOMIC_RELAXED, __HIP_MEMORY_SCOPE_AGENT
#define LDS_WAIT() asm volatile("s_waitcnt lgkmcnt(0)" ::: "memory")
#define VM_WAIT() asm volatile("s_waitcnt vmcnt(0)" ::: "memory")

__device__ __forceinline__ unsigned f2bf(float f) { unsigned u = __builtin_bit_cast(unsigned, f); return (u + 0x7fffu + ((u >> 16) & 1u)) >> 16; }
__device__ __forceinline__ unsigned pk2(float lo, float hi) { return f2bf(lo) | (f2bf(hi) << 16); }
__device__ __forceinline__ unsigned pk4_fp8(float a, float b, float c, float d) { int p = __builtin_amdgcn_cvt_pk_fp8_f32(a, b, 0, false); p = __builtin_amdgcn_cvt_pk_fp8_f32(c, d, p, true); return (unsigned)p; }
__device__ __forceinline__ float bflo(unsigned w) { return __builtin_bit_cast(float, w << 16); }
__device__ __forceinline__ float bfhi(unsigned w) { return __builtin_bit_cast(float, w & 0xffff0000u); }
__device__ __forceinline__ float row16_sum(float v) {
    v += __builtin_bit_cast(float, __builtin_amdgcn_update_dpp(0, __builtin_bit_cast(int, v), 0xB1, 0xF, 0xF, false));
    v += __builtin_bit_cast(float, __builtin_amdgcn_update_dpp(0, __builtin_bit_cast(int, v), 0x4E, 0xF, 0xF, false));
    v += __builtin_bit_cast(float, __builtin_amdgcn_update_dpp(0, __builtin_bit_cast(int, v), 0x141, 0xF, 0xF, false));
    v += __builtin_bit_cast(float, __builtin_amdgcn_update_dpp(0, __builtin_bit_cast(int, v), 0x140, 0xF, 0xF, false));
    return v;
}
__device__ __forceinline__ float rdlane(float v, int l) { return __builtin_bit_cast(float, __builtin_amdgcn_readlane(__builtin_bit_cast(int, v), l)); }
__device__ __forceinline__ float wave_sum(float v) {
    v = row16_sum(v);
    return (rdlane(v, 0) + rdlane(v, 16)) + (rdlane(v, 32) + rdlane(v, 48));
}
__device__ __forceinline__ int lane_id_asm() { int l; asm volatile("v_mbcnt_lo_u32_b32 %0, -1, 0\n\tv_mbcnt_hi_u32_b32 %0, -1, %0" : "=v"(l)); return l; }
__device__ __forceinline__ float fast_sigmoid(float x) { return __builtin_amdgcn_rcpf(1.0f + __builtin_amdgcn_exp2f(-1.4426950408889634f * x)); }

namespace pg8 {
#define PG8_LAS __attribute__((address_space(3)))
typedef unsigned short bf16_t;
typedef short bf16x8 __attribute__((ext_vector_type(8)));
typedef float f32x4 __attribute__((ext_vector_type(4)));
typedef unsigned u32x4 __attribute__((ext_vector_type(4)));
constexpr int BM = 256, BK = 64, HALF = 128, HTB = HALF * BK * 2, STAGE_BYTES = 8 * HTB, NXCD = 8, WGM = 8;

__host__ __device__ __forceinline__ int lds_byte(int r, int c) { const int st = (r >> 4) * 2 + (c >> 5), rr = r & 15, cc = c & 31, ob = rr * 64 + cc * 2; return st * 1024 + (ob ^ (((ob >> 9) & 1) << 5)); }
__host__ __device__ __forceinline__ void stage_rc(int b, int& R, int& C) { const int st = b / 1024, sb = b % 1024, swz = sb ^ (((sb >> 9) & 1) << 5); R = (st >> 1) * 16 + swz / 64; C = (st & 1) * 32 + (swz % 64) / 2; }
__host__ __device__ __forceinline__ int perm32(int rho) { const int n = rho >> 4, i = rho & 15; return 8 * (i >> 2) + 4 * n + (i & 3); }

struct Unit { int pm, pn; const char* a; const char* b; int li; int ex; };

__device__ __forceinline__ bool static_order(int L, int nM, int nN, int& pm, int& pn) {
    const int nwg = nM * nN; if (L >= nwg) return false;
    int wgid = L; { const int q = nwg / NXCD, r = nwg % NXCD, xcd = wgid % NXCD, off = wgid / NXCD; wgid = (xcd < r ? xcd * (q + 1) : r * (q + 1) + (xcd - r) * q) + off; }
    const int nig = WGM * nN, gid = wgid / nig, fm = gid * WGM, gsz = (nM - fm) < WGM ? (nM - fm) : WGM;
    pm = fm + ((wgid % nig) % gsz); pn = (wgid % nig) / gsz; return true;
}

typedef float cvt_f32x2_t __attribute__((ext_vector_type(2))); typedef __bf16 cvt_bf16x2_t __attribute__((ext_vector_type(2)));
__device__ __forceinline__ unsigned cvt_pk_bf16(float lo, float hi) { const cvt_f32x2_t v = {lo, hi}; const cvt_bf16x2_t b = __builtin_convertvector(v, cvt_bf16x2_t); return __builtin_bit_cast(unsigned, b); }

typedef int v8i_t __attribute__((ext_vector_type(8)));
typedef int v4i_t __attribute__((ext_vector_type(4)));
template <class Epi, class Sched, bool ALIGN_EPI, bool FP8 = false>
__device__ __forceinline__ void gemm_phase(PG8_LAS unsigned char* lds, const int K_, const Sched& S, const Epi& E, const int wid) {
    int K = K_; asm volatile("" : "+s"(K));
    const int lane = lane_id_asm(), tid = wid * 64 + lane, wr = wid >> 2, wc = wid & 3, fr = lane & 15, fq = lane >> 4;
    const int nt = K / BK;
    int R[2], C[2]; unsigned voffB[2], vA[2][2];
    const size_t kstep = (size_t)(BK * 2);
    const size_t hstep = (size_t)HALF * K * 2;
#pragma unroll
    for (int i = 0; i < 2; ++i) { stage_rc(tid * 16 + i * 8192, R[i], C[i]); const int Rb = Epi::PERM ? ((R[i] & ~31) + perm32(R[i] & 31)) : R[i];
        voffB[i] = (unsigned)(Rb * K + C[i]) * 2u; vA[0][i] = (unsigned)(R[i] * K + C[i]) * 2u; vA[1][i] = vA[0][i] + (unsigned)hstep; }
    const unsigned ldsw = (unsigned)wid * 1024u;
    const int aoff = lds_byte(wr * 64 + fr, fq * 8), boff = lds_byte(wc * 32 + fr, fq * 8);
#define PG8_SA(b, h) (((b) * 2 + (h)) * HTB)
#define PG8_SB(b, h) ((4 + (b) * 2 + (h)) * HTB)
#define PG8_STAGE(bufoff, gbase, voff) do { _Pragma("unroll") for (int _i = 0; _i < 2; ++_i) \
        __builtin_amdgcn_global_load_lds((const unsigned*)((const char*)(gbase) + (voff)[_i]), (PG8_LAS unsigned*)(lds + (bufoff) + ldsw + _i * 8192), 16, 0, 0); } while (0)
#define PG8_LD8(addr) __builtin_shufflevector(*(const PG8_LAS v4i_t*)(addr), *(const PG8_LAS v4i_t*)((addr) + 1024), 0, 1, 2, 3, 4, 5, 6, 7)
#define PG8_LDA(dst, b, h) do { _Pragma("unroll") for (int m = 0; m < 4; ++m) dst[m] = PG8_LD8(lds + PG8_SA(b, h) + aoff + m * 2048); } while (0)
#define PG8_LDB(dst, b, h) do { _Pragma("unroll") for (int n = 0; n < 2; ++n) dst[n] = PG8_LD8(lds + PG8_SB(b, h) + boff + n * 2048); } while (0)
#define PG8_LO(x) __builtin_bit_cast(bf16x8, __builtin_shufflevector((x), (x), 0, 1, 2, 3))
#define PG8_HI(x) __builtin_bit_cast(bf16x8, __builtin_shufflevector((x), (x), 4, 5, 6, 7))
#define PG8_MMA(ai, bj, At, Bt) do { __builtin_amdgcn_s_setprio(1); _Pragma("unroll") for (int m = 0; m < 4; ++m) _Pragma("unroll") for (int n = 0; n < 2; ++n) { \
        if constexpr (FP8) asm volatile("v_mfma_scale_f32_16x16x128_f8f6f4 %0, %1, %2, %0, %3, %4 op_sel_hi:[0,0,0]" : "+v"(acc[ai][bj][m][n]) : "v"(Bt[n]), "v"(At[m]), "v"(wscale_r), "v"(ascale_r)); \
        else { acc[ai][bj][m][n] = __builtin_amdgcn_mfma_f32_16x16x32_bf16(PG8_LO(Bt[n]), PG8_LO(At[m]), acc[ai][bj][m][n], 0, 0, 0); \
               acc[ai][bj][m][n] = __builtin_amdgcn_mfma_f32_16x16x32_bf16(PG8_HI(Bt[n]), PG8_HI(At[m]), acc[ai][bj][m][n], 0, 0, 0); } } __builtin_amdgcn_s_setprio(0); } while (0)
#define PG8_WAIT_V(n) asm volatile("s_waitcnt vmcnt(" #n ")" ::: "memory")
#define PG8_WAIT_L(n) asm volatile("s_waitcnt lgkmcnt(" #n ")" ::: "memory")
#define PG8_BAR __builtin_amdgcn_s_barrier()
#define PG8_SCHED __builtin_amdgcn_sched_barrier(0)
    Unit cur, nxt; int ui = 0;
    if (!S.next(0, cur)) return;
    if constexpr (Sched::GATHER) S.a_offsets(cur, R, C, K, vA);
    f32x4 acc[2][2][4][2];
#pragma unroll
    for (int a = 0; a < 2; ++a)
#pragma unroll
        for (int b = 0; b < 2; ++b)
#pragma unroll
            for (int m = 0; m < 4; ++m)
#pragma unroll
                for (int n = 0; n < 2; ++n) acc[a][b][m][n] = (f32x4){0.f, 0.f, 0.f, 0.f};
    int wscale_r = 0x79797979, ascale_r = 0x7f7f7f7f;
    asm volatile("" : "+v"(wscale_r), "+v"(ascale_r));
    v8i_t At[4], B0[2], B1[2];
    const char* cA = cur.a; const char* cB = cur.b;
    PG8_STAGE(PG8_SB(0, 0), cB, voffB); PG8_STAGE(PG8_SB(0, 1), cB + hstep, voffB); PG8_STAGE(PG8_SA(0, 0), cA, vA[0]); PG8_STAGE(PG8_SA(0, 1), cA, vA[1]);
    if (wr == 1) PG8_BAR;
    PG8_WAIT_V(2); PG8_BAR;
    PG8_STAGE(PG8_SB(1, 0), cB + kstep, voffB); PG8_STAGE(PG8_SA(1, 0), cA + kstep, vA[0]); PG8_STAGE(PG8_SB(1, 1), cB + hstep + kstep, voffB);
    PG8_WAIT_V(6); PG8_BAR;
    for (;;) {
        const bool has_next = S.next(ui + 1, nxt);
        const char* nA = has_next ? nxt.a : cA; const char* nB = has_next ? nxt.b : cB;
#pragma unroll 1
        for (int t = 0; t < nt; t += 2) {
            const bool last = (t == nt - 2);
            const char* a1 = cA + (size_t)(t + 1) * kstep;
            const char* a2 = last ? nA : cA + (size_t)(t + 2) * kstep; const char* b2 = last ? nB : cB + (size_t)(t + 2) * kstep;
            const char* a3 = a2 + kstep; const char* b3 = b2 + kstep;
            PG8_LDB(B0, 0, 0); PG8_LDB(B1, 0, 1); PG8_SCHED; PG8_LDA(At, 0, 0); PG8_STAGE(PG8_SA(1, 1), a1, vA[1]);
            if constexpr (Sched::GATHER) { if (last && has_next) S.a_offsets(nxt, R, C, K, vA); }
            PG8_WAIT_V(8); PG8_WAIT_L(0); PG8_BAR; PG8_MMA(0, 0, At, B0); PG8_MMA(0, 1, At, B1); PG8_BAR; PG8_SCHED;
            PG8_LDA(At, 0, 1); PG8_STAGE(PG8_SB(0, 0), b2, voffB); PG8_STAGE(PG8_SB(0, 1), b2 + hstep, voffB); PG8_STAGE(PG8_SA(0, 0), a2, vA[0]);
            PG8_WAIT_V(8); PG8_WAIT_L(0); PG8_BAR; PG8_MMA(1, 0, At, B0); PG8_MMA(1, 1, At, B1); PG8_BAR; PG8_SCHED;
            PG8_LDB(B0, 1, 0); PG8_LDB(B1, 1, 1); PG8_SCHED; PG8_LDA(At, 1, 0); PG8_STAGE(PG8_SA(0, 1), a2, vA[1]);
            PG8_WAIT_V(8); PG8_WAIT_L(0); PG8_BAR; PG8_MMA(0, 0, At, B0); PG8_MMA(0, 1, At, B1); PG8_BAR; PG8_SCHED;
            PG8_LDA(At, 1, 1); PG8_STAGE(PG8_SB(1, 0), b3, voffB); PG8_STAGE(PG8_SB(1, 1), b3 + hstep, voffB); PG8_STAGE(PG8_SA(1, 0), a3, vA[0]);
            PG8_WAIT_V(8); PG8_WAIT_L(0); PG8_BAR; PG8_MMA(1, 0, At, B0); PG8_MMA(1, 1, At, B1); PG8_BAR; PG8_SCHED;
        }
        if constexpr (ALIGN_EPI) { if (wr == 0) PG8_BAR; }
        if constexpr (FP8) asm volatile("s_nop 15\n\ts_nop 7" ::: "memory");
        E(acc, cur, wr, wc, fr, fq);
        if (!has_next) break;
#pragma unroll
        for (int a = 0; a < 2; ++a)
#pragma unroll
            for (int b = 0; b < 2; ++b)
#pragma unroll
                for (int m = 0; m < 4; ++m)
#pragma unroll
                    for (int n = 0; n < 2; ++n) acc[a][b][m][n] = (f32x4){0.f, 0.f, 0.f, 0.f};
        cur = nxt; cA = nA; cB = nB; ++ui;
        if constexpr (ALIGN_EPI) { if (wr == 1) PG8_BAR; }
    }
    PG8_WAIT_V(0);
    if constexpr (!ALIGN_EPI) { if (wr == 0) PG8_BAR; }
    PG8_BAR;
#undef PG8_SA
#undef PG8_SB
#undef PG8_STAGE
#undef PG8_LDA
#undef PG8_LDB
#undef PG8_MMA
#undef PG8_LO
#undef PG8_HI
#undef PG8_LD8
#undef PG8_WAIT_V
#undef PG8_WAIT_L
#undef PG8_BAR
#undef PG8_SCHED
}

struct DenseSched {
    static constexpr bool GATHER = false;
    const char* A; const char* Bt; int K, nM, nN, G, c;
    __device__ __forceinline__ bool next(int i, Unit& u) const {
        int pm, pn; if (!static_order(i * G + c, nM, nN, pm, pn)) return false;
        u.pm = pm; u.pn = pn; u.a = A + (size_t)pm * BM * K * 2; u.b = Bt + (size_t)pn * BM * K * 2; u.li = i; u.ex = 0; return true;
    }
    __device__ __forceinline__ void a_offsets(const Unit&, const int (&)[2], const int (&)[2], int, unsigned (&)[2][2]) const {}
};
struct QkvSched {
    static constexpr bool GATHER = false;
    const char* A; const char* Bt; int G, c, kb;
    __device__ __forceinline__ bool next(int i, Unit& u) const {
        const int L = i * G + c; int pm, pn;
        if (L < 1536) { static_order(L, 128, 12, pm, pn); }
        else { const int l2 = L - 1536; if (l2 >= 64) return false; pm = 128 + (l2 >> 3); pn = 4 + (l2 & 7); }
        u.pm = pm; u.pn = pn; u.a = A + (size_t)pm * BM * kb; u.b = Bt + (size_t)pn * BM * kb; u.li = i; u.ex = 0; return true;
    }
    __device__ __forceinline__ void a_offsets(const Unit&, const int (&)[2], const int (&)[2], int, unsigned (&)[2][2]) const {}
};
struct MoeSchedBase {
    const volatile PG8_LAS int* tpre;
    int G, c;
    __device__ __forceinline__ bool locate(int i, int& rt, int& pn, int& e) const {
        const int L = i * G + c; const int ntile = tpre[16];
        if (L >= 4 * ntile) return false;
        rt = L >> 2; pn = L & 3; int ee = 0;
#pragma unroll
        for (int j = 1; j < 16; ++j) ee += (rt >= tpre[j]) ? 1 : 0;
        e = ee; return true;
    }
};
struct MoeUpSched : MoeSchedBase {
    static constexpr bool GATHER = true;
    const char* A; const char* Wgu; const PG8_LAS int* permL; int kb;
    __device__ __forceinline__ bool next(int i, Unit& u) const {
        int rt, pn, e; if (!locate(i, rt, pn, e)) return false;
        u.pm = rt; u.pn = pn; u.a = A; u.b = Wgu + (size_t)e * 1024 * kb + (size_t)pn * BM * kb; u.li = i; u.ex = e; return true;
    }
    __device__ __forceinline__ void a_offsets(const Unit& u, const int (&R)[2], const int (&C)[2], int K, unsigned (&vA)[2][2]) const {
#pragma unroll
        for (int h = 0; h < 2; ++h)
#pragma unroll
            for (int i = 0; i < 2; ++i) vA[h][i] = (unsigned)permL[u.li * 256 + h * HALF + R[i]] * (unsigned)(K * 2) + (unsigned)(C[i] * 2);
    }
};
struct MoeDownSched : MoeSchedBase {
    static constexpr bool GATHER = false;
    const char* A; const char* Wdn; int kb;
    __device__ __forceinline__ bool next(int i, Unit& u) const {
        int rt, pn, e; if (!locate(i, rt, pn, e)) return false;
        u.pm = rt; u.pn = pn; u.a = A + (size_t)rt * BM * kb; u.b = Wdn + (size_t)e * 1024 * kb + (size_t)pn * BM * kb; u.li = i; u.ex = e; return true;
    }
    __device__ __forceinline__ void a_offsets(const Unit&, const int (&)[2], const int (&)[2], int, unsigned (&)[2][2]) const {}
};

template <bool HAS_BIAS> struct EpiBf16T {
    static constexpr bool PERM = true;
    bf16_t* O; int ldc; const float* bias;
    __device__ __forceinline__ void operator()(const f32x4 (&acc)[2][2][4][2], const Unit& u, int wr, int wc, int fr, int fq) const {
        const int row0 = u.pm * BM + wr * 64 + fr, col0 = u.pn * BM + wc * 32 + 8 * fq;
        f32x4 bv[2][2];
#pragma unroll
        for (int bj = 0; bj < 2; ++bj)
#pragma unroll
            for (int n = 0; n < 2; ++n) bv[bj][n] = HAS_BIAS ? *(const f32x4*)(bias + col0 + bj * HALF + 4 * n) : (f32x4){0.f, 0.f, 0.f, 0.f};
#pragma unroll
        for (int ai = 0; ai < 2; ++ai)
#pragma unroll
            for (int m = 0; m < 4; ++m) { bf16_t* rowp = O + (size_t)(row0 + ai * HALF + m * 16) * ldc + col0;
#pragma unroll
                for (int bj = 0; bj < 2; ++bj) { f32x4 v0 = acc[ai][bj][m][0], v1 = acc[ai][bj][m][1]; if constexpr (HAS_BIAS) { v0 += bv[bj][0]; v1 += bv[bj][1]; }
                    u32x4 w; w.x = cvt_pk_bf16(v0[0], v0[1]); w.y = cvt_pk_bf16(v0[2], v0[3]); w.z = cvt_pk_bf16(v1[0], v1[1]); w.w = cvt_pk_bf16(v1[2], v1[3]);
                    *(u32x4*)(rowp + bj * HALF) = w; } }
    }
};
typedef EpiBf16T<true> EpiBf16B; typedef EpiBf16T<false> EpiBf16;
struct EpiF8 {
    static constexpr bool PERM = true;
    unsigned char* O; int ldc;
    __device__ __forceinline__ void operator()(const f32x4 (&acc)[2][2][4][2], const Unit& u, int wr, int wc, int fr, int fq) const {
        const int row0 = u.pm * BM + wr * 64 + fr, col0 = u.pn * BM + wc * 32 + 8 * fq;
#pragma unroll
        for (int ai = 0; ai < 2; ++ai)
#pragma unroll
            for (int m = 0; m < 4; ++m) { unsigned char* rowp = O + (size_t)(row0 + ai * HALF + m * 16) * ldc + col0;
#pragma unroll
                for (int bj = 0; bj < 2; ++bj) { const f32x4 v0 = acc[ai][bj][m][0], v1 = acc[ai][bj][m][1];
                    *(unsigned long long*)(rowp + bj * HALF) = (unsigned long long)pk4_fp8(v0[0], v0[1], v0[2], v0[3]) | ((unsigned long long)pk4_fp8(v1[0], v1[1], v1[2], v1[3]) << 32); } }
    }
};
template <int MODE  , bool OUT8 = false  > struct EpiGated {
    static constexpr bool PERM = true;
    bf16_t* O; int ldc; const float* bias; int nch;
    __device__ __forceinline__ void operator()(const f32x4 (&acc)[2][2][4][2], const Unit& u, int wr, int wc, int fr, int fq) const {
        const int row0 = u.pm * BM + wr * 64 + fr, ch0 = u.pn * HALF + wc * 32 + 8 * fq;
        f32x4 b0[2], b1[2];
#pragma unroll
        for (int n = 0; n < 2; ++n) { if (MODE == 0) { b0[n] = *(const f32x4*)(bias + ch0 + 4 * n); b1[n] = *(const f32x4*)(bias + nch + ch0 + 4 * n); } else { b0[n] = (f32x4){0.f, 0.f, 0.f, 0.f}; b1[n] = b0[n]; } }
#pragma unroll
        for (int ai = 0; ai < 2; ++ai)
#pragma unroll
            for (int m = 0; m < 4; ++m) { bf16_t* rowp = O + (size_t)(row0 + ai * HALF + m * 16) * ldc + ch0; float o[8];
#pragma unroll
                for (int n = 0; n < 2; ++n) { const f32x4 x0 = acc[ai][0][m][n] + b0[n], x1 = acc[ai][1][m][n] + b1[n];
#pragma unroll
                    for (int e = 0; e < 4; ++e) o[4 * n + e] = (MODE == 0) ? x0[e] * fast_sigmoid(x1[e]) : (x0[e] * fast_sigmoid(x0[e])) * x1[e]; }
                if constexpr (OUT8) { unsigned char* rp8 = (unsigned char*)O + (size_t)(row0 + ai * HALF + m * 16) * ldc + ch0;
                    *(unsigned long long*)rp8 = (unsigned long long)pk4_fp8(o[0], o[1], o[2], o[3]) | ((unsigned long long)pk4_fp8(o[4], o[5], o[6], o[7]) << 32); }
                else { u32x4 w; w.x = cvt_pk_bf16(o[0], o[1]); w.y = cvt_pk_bf16(o[2], o[3]); w.z = cvt_pk_bf16(o[4], o[5]); w.w = cvt_pk_bf16(o[6], o[7]);
                    *(u32x4*)rowp = w; } }
    }
};
struct EpiQkv {
    static constexpr bool PERM = true;
    bf16_t* Q; bf16_t* Kh; bf16_t* Vb; float qscale;
    __device__ __forceinline__ void operator()(const f32x4 (&acc)[2][2][4][2], const Unit& u, int wr, int wc, int fr, int fq) const {
        const int which = u.pn >> 2; const bool isctx = u.pm >= 128;
        const int b = isctx ? (u.pm - 128) : (u.pm >> 4);
        const int key0 = isctx ? SEQ : ((u.pm & 15) << 8);
        const int d0 = 32 * (wc & 1) + 8 * fq;
#pragma unroll
        for (int ai = 0; ai < 2; ++ai)
#pragma unroll
            for (int m = 0; m < 4; ++m) { const int key = key0 + ai * HALF + wr * 64 + m * 16 + fr;
#pragma unroll
                for (int bj = 0; bj < 2; ++bj) { const int h = 4 * (u.pn & 3) + 2 * bj + (wc >> 1); const f32x4 v0 = acc[ai][bj][m][0], v1 = acc[ai][bj][m][1];
                    if (which == 2) {
                        bf16_t* p = Vb + ((size_t)(b * NH + h) * (KSLOT / 8) + (key >> 3)) * 512 + (size_t)d0 * 8 + (key & 7);
                        const unsigned w0 = cvt_pk_bf16(v0[0], v0[1]), w1 = cvt_pk_bf16(v0[2], v0[3]), w2 = cvt_pk_bf16(v1[0], v1[1]), w3 = cvt_pk_bf16(v1[2], v1[3]);
                        p[0] = (bf16_t)w0; p[8] = (bf16_t)(w0 >> 16); p[16] = (bf16_t)w1; p[24] = (bf16_t)(w1 >> 16); p[32] = (bf16_t)w2; p[40] = (bf16_t)(w2 >> 16); p[48] = (bf16_t)w3; p[56] = (bf16_t)(w3 >> 16);
                    } else {
                        const float qs = (which == 0) ? qscale : 1.0f; const f32x4 y0 = v0 * qs, y1 = v1 * qs;
                        u32x4 w; w.x = cvt_pk_bf16(y0[0], y0[1]); w.y = cvt_pk_bf16(y0[2], y0[3]); w.z = cvt_pk_bf16(y1[0], y1[1]); w.w = cvt_pk_bf16(y1[2], y1[3]);
                        bf16_t* p = (which == 0) ? Q + ((size_t)(b * NH + h) * SEQ + key) * HD + d0 : Kh + ((size_t)(b * NH + h) * KSLOT + key) * HD + d0;
                        *(u32x4*)p = w;
                    } } }
    }
};
}
#define XB_TMO      128
#define XB_XCNT(j)  (256  + 64 * (j))
#define XB_XSUB(j)  (1280 + 64 * (j))
#define XB_XGEN(j)  (2304 + 64 * (j))
#define XB_TOP      3328
#define XB_TOPGEN   3392
#define XCD_BAR_WORDS 3456
#define XB_SPIN_CAP (1u << 18)

__device__ __forceinline__ unsigned xb_ld(unsigned* p)              { return __hip_atomic_load(p, __ATOMIC_RELAXED, __HIP_MEMORY_SCOPE_AGENT); }
__device__ __forceinline__ unsigned xb_add(unsigned* p, unsigned v) { return __hip_atomic_fetch_add(p, v, __ATOMIC_RELAXED, __HIP_MEMORY_SCOPE_AGENT); }
__device__ __forceinline__ unsigned xb_xcc_id() { return (unsigned)__builtin_amdgcn_s_getreg((3 << 11) | 20) & 0xFu; }
#define XB_SPIN(cond, bar) do { unsigned _sp = 0; while (cond) { __builtin_amdgcn_s_sleep(1); \
    if ((++_sp & 255u) == 0u) { if (xb_ld(&(bar)[XB_TMO])) break; if (_sp > XB_SPIN_CAP) { atomicAdd(&(bar)[XB_TMO], 1u); break; } } } } while (0)

struct XcdBarrier {
    unsigned* bar; unsigned x;
    volatile LAS unsigned* st;
};

__device__ __forceinline__ XcdBarrier xcd_barrier_post(unsigned* bar, volatile LAS unsigned* st) {
    XcdBarrier b; b.bar = bar; b.x = xb_xcc_id(); b.st = st;
    if (threadIdx.x == 0) (void)xb_add(&bar[XB_XCNT(b.x)], 1u);
    return b;
}
__device__ __forceinline__ void xcd_barrier_complete(unsigned* bar, unsigned x, unsigned& nloc, unsigned& nx) {
    const unsigned G = gridDim.x * gridDim.y * gridDim.z;
    unsigned sum, cnt, mine, sp = 0u;
    for (;;) {
        sum = 0u; cnt = 0u; mine = 0u;
#pragma unroll
        for (unsigned j = 0; j < 16; ++j) { const unsigned c = xb_ld(&bar[XB_XCNT(j)]); sum += c; cnt += (c > 0u) ? 1u : 0u; mine = (j == x) ? c : mine; }
        if (sum == G) break;
        __builtin_amdgcn_s_sleep(1);
        if ((++sp & 255u) == 0u) { if (xb_ld(&bar[XB_TMO])) break; if (sp > XB_SPIN_CAP) { atomicAdd(&bar[XB_TMO], 1u); break; } }
    }
    nloc = mine > 0u ? mine : 1u; nx = cnt > 0u ? cnt : 1u;
}

__device__ __forceinline__ void xcd_barrier(const XcdBarrier& b) {
    asm volatile("s_waitcnt vmcnt(0)" ::: "memory");
    __syncthreads();
    if (threadIdx.x == 0) {
        unsigned* bar = b.bar;
        __builtin_amdgcn_s_waitcnt(0);
        unsigned nloc = b.st[0], nx = b.st[1];
        if (nloc == 0u) { xcd_barrier_complete(bar, b.x, nloc, nx); b.st[0] = nloc; b.st[1] = nx; }
        const unsigned old = xb_add(&bar[XB_XSUB(b.x)], 1u);
        const unsigned gen = old / nloc;
        if (old + 1u == (gen + 1u) * nloc) {
            __builtin_amdgcn_fence(__ATOMIC_RELEASE, "agent");
            asm volatile("s_waitcnt vmcnt(0)" ::: "memory");
            const unsigned og = xb_add(&bar[XB_TOP], 1u);
            const unsigned tg = og / nx;
            if (og + 1u == (tg + 1u) * nx) xb_add(&bar[XB_TOPGEN], 1u);
            else XB_SPIN(xb_ld(&bar[XB_TOPGEN]) == tg, bar);
            __builtin_amdgcn_fence(__ATOMIC_ACQUIRE, "agent");
            xb_add(&bar[XB_XGEN(b.x)], 1u);
            asm volatile("s_waitcnt vmcnt(0)" ::: "memory");
        } else {
            XB_SPIN(xb_ld(&bar[XB_XGEN(b.x)]) == gen, bar);
            __builtin_amdgcn_fence(__ATOMIC_ACQUIRE, "agent");
            asm volatile("s_waitcnt vmcnt(0)" ::: "memory");
        }
    }
    __syncthreads();
}

struct Frame {
    LAS unsigned char* lds;
    volatile LAS unsigned* MISC;
    gu32* ctl;
    int wave, G, bid;
    __device__ __forceinline__ const float* in(int k) const { const volatile LAS unsigned* t = (const volatile LAS unsigned*)(lds + PTAB_OFF) + 2 * k;
        const unsigned lo = __builtin_amdgcn_readfirstlane(t[0]), hi = __builtin_amdgcn_readfirstlane(t[1]); return (const float*)(const GAS float*)(((unsigned long long)hi << 32) | lo); }
    __device__ __forceinline__ int lane() const { return lane_id_asm(); }
    __device__ __forceinline__ int tid() const { return wave * 64 + lane_id_asm(); }
    unsigned char* ws;
    float* out;
};

__device__ __forceinline__ void ld_row_f32(const float* row, int lane, f32x4 (&v)[4]) {
    const f32x4* p = (const f32x4*)row + lane;
#pragma unroll
    for (int j = 0; j < 4; ++j) v[j] = p[64 * j];
}
__device__ __forceinline__ void st_row_f32(float* row, int lane, const f32x4 (&v)[4]) {
    f32x4* p = (f32x4*)row + lane;
#pragma unroll
    for (int j = 0; j < 4; ++j) p[64 * j] = v[j];
}
__device__ __forceinline__ void ld_row_bf16(const bf16* row, int lane, f32x4 (&v)[4]) {
    const v2u* p = (const v2u*)row + lane;
#pragma unroll
    for (int j = 0; j < 4; ++j) { const v2u w = p[64 * j]; v[j] = (f32x4){bflo(w.x), bfhi(w.x), bflo(w.y), bfhi(w.y)}; }
}
__device__ __forceinline__ void ld_raw_bf16(const bf16* row, int lane, v2u (&w)[4]) {
    const v2u* p = (const v2u*)row + lane;
#pragma unroll
    for (int j = 0; j < 4; ++j) w[j] = p[64 * j];
}
__device__ __forceinline__ void unpack_bf16(const v2u (&w)[4], f32x4 (&v)[4]) {
#pragma unroll
    for (int j = 0; j < 4; ++j) { const unsigned a = w[j].x, b = w[j].y; v[j] = (f32x4){bflo(a), bfhi(a), bflo(b), bfhi(b)}; }
}
__device__ __forceinline__ void ld_raw_fp8(const unsigned char* row, int lane, unsigned (&w)[4]) {
    const unsigned* p = (const unsigned*)row + lane;
#pragma unroll
    for (int j = 0; j < 4; ++j) w[j] = p[64 * j];
}
__device__ __forceinline__ void unpack_fp8(const unsigned (&w)[4], f32x4 (&v)[4]) {
    typedef float f2_t __attribute__((ext_vector_type(2)));
#pragma unroll
    for (int j = 0; j < 4; ++j) { const f2_t lo = __builtin_amdgcn_cvt_pk_f32_fp8((int)w[j], false), hi = __builtin_amdgcn_cvt_pk_f32_fp8((int)w[j], true); v[j] = (f32x4){lo[0], lo[1], hi[0], hi[1]}; }
}
__device__ __forceinline__ void st_row_bf16(bf16* row, int lane, const f32x4 (&v)[4]) {
    v2u* p = (v2u*)row + lane;
#pragma unroll
    for (int j = 0; j < 4; ++j) { v2u w; w.x = pk2(v[j][0], v[j][1]); w.y = pk2(v[j][2], v[j][3]); p[64 * j] = w; }
}
__device__ __forceinline__ void st_row_fp8(unsigned char* row, int lane, const f32x4 (&v)[4]) {
    unsigned* p = (unsigned*)row + lane;
#pragma unroll
    for (int j = 0; j < 4; ++j) p[64 * j] = pk4_fp8(v[j][0], v[j][1], v[j][2], v[j][3]);
}
__device__ __forceinline__ float sumsq4(const f32x4 (&v)[4]) {
    float s = 0.f;
#pragma unroll
    for (int j = 0; j < 4; ++j) s += (v[j][0] * v[j][0] + v[j][1] * v[j][1]) + (v[j][2] * v[j][2] + v[j][3] * v[j][3]);
    return s;
}
__device__ __forceinline__ void ld_mod(const Frame& F, int l, int r, int ch, f32x4 (&v)[4]) {
    const float* modp = (const float*)(F.ws + WS_MODP); const int lane = F.lane();
    ld_row_f32(F.in(5) + (size_t)l * NMODC + ch * D, lane, v);
#pragma unroll
    for (int kc = 0; kc < MODKC; ++kc) { f32x4 t[4]; ld_row_f32(modp + ((size_t)((kc * 2 + l) * NMODR + r)) * NMODC + ch * D, lane, t);
#pragma unroll
        for (int j = 0; j < 4; ++j) v[j] += t[j]; }
}
__device__ __forceinline__ int row_batch(int m) { return m < NLAT ? (m >> 12) : 8; }

__device__ __forceinline__ void p0_transpose_item(const float* W, int K, int N, bf16* WT, int drow_off, LAS float* scr, int item, int lane) {
    const int nblk = N / 32, kb = item / nblk, nb = item % nblk, k0 = 64 * kb, n0 = 32 * nb;
#pragma unroll 8
    for (int i = 0; i < 32; ++i) { const int kk = 2 * i + (lane >> 5); scr[kk * 33 + (lane & 31)] = W[(size_t)(k0 + kk) * N + n0 + (lane & 31)]; }
    LDS_WAIT(); asm volatile("" ::: "memory");
    const int c = lane & 7;
#pragma unroll
    for (int j = 0; j < 4; ++j) { const int n = (lane >> 3) + 8 * j; const LAS float* s = scr + (8 * c) * 33 + n;
        v4u o; o.x = pk2(s[0 * 33], s[1 * 33]); o.y = pk2(s[2 * 33], s[3 * 33]); o.z = pk2(s[4 * 33], s[5 * 33]); o.w = pk2(s[6 * 33], s[7 * 33]);
        *(GAS v4u*)(WT + (size_t)(drow_off + n0 + n) * K + k0 + 8 * c) = o; }
    LDS_WAIT(); asm volatile("" ::: "memory");
}
__device__ __forceinline__ void p0_transpose_item_fp8(const float* W, int K, int N, unsigned char* WT, int drow_off, float wscale, LAS float* scr, int item, int lane) {
    const int nblk = N / 32, kb = item / nblk, nb = item % nblk, k0 = 64 * kb, n0 = 32 * nb;
#pragma unroll 8
    for (int i = 0; i < 32; ++i) { const int kk = 2 * i + (lane >> 5); scr[kk * 33 + (lane & 31)] = W[(size_t)(k0 + kk) * N + n0 + (lane & 31)] * wscale; }
    LDS_WAIT(); asm volatile("" ::: "memory");
    const int c = lane & 3;
#pragma unroll
    for (int j = 0; j < 2; ++j) { const int n = (lane >> 2) + 16 * j; const LAS float* s = scr + (16 * c) * 33 + n;
        v4u o; o.x = pk4_fp8(s[0 * 33], s[1 * 33], s[2 * 33], s[3 * 33]); o.y = pk4_fp8(s[4 * 33], s[5 * 33], s[6 * 33], s[7 * 33]);
        o.z = pk4_fp8(s[8 * 33], s[9 * 33], s[10 * 33], s[11 * 33]); o.w = pk4_fp8(s[12 * 33], s[13 * 33], s[14 * 33], s[15 * 33]);
        *(GAS v4u*)(WT + (size_t)(drow_off + n0 + n) * K + k0 + 16 * c) = o; }
    LDS_WAIT(); asm volatile("" ::: "memory");
}
constexpr float W8SCALE = 64.0f;
constexpr int I_WIN = 1024, I_WOUT = 512, I_WQKV = 1536, I_WO = 512, I_EXP = 32 * 768, I_NONEXP = I_WIN + I_WOUT + I_WQKV + I_WO, NITEMS_P0 = I_NONEXP + I_EXP;
__device__ __forceinline__ void p0_item(const Frame& F, LAS float* scr, int it) {
    int r = it; const int lane = F.lane();
    if (r < I_WIN) { const int n0 = 32 * (r % 64), ch = n0 & 1023, hf = n0 >> 10, drow0 = 256 * (ch >> 7) + 128 * hf + (ch & 127);
        p0_transpose_item_fp8(F.in(10), D, 2 * D, (unsigned char*)(F.ws + WS_WIN), drow0 - n0, W8SCALE, scr, r, lane); return; }
    r -= I_WIN;
    if (r < I_WOUT) { p0_transpose_item_fp8(F.in(16), D, D, (unsigned char*)(F.ws + WS_WOUT), 0, W8SCALE, scr, r, lane); return; }
    r -= I_WOUT;
    if (r < I_WQKV) { p0_transpose_item_fp8(F.in(18), D, 3 * D, (unsigned char*)(F.ws + WS_WQKV), 0, W8SCALE, scr, r, lane); return; }
    r -= I_WQKV;
    if (r < I_WO) { p0_transpose_item_fp8(F.in(19), D, D, (unsigned char*)(F.ws + WS_WO), 0, W8SCALE, scr, r, lane); return; }
    r -= I_WO;
    const int le = r / 768; int q = r % 768;
    if (q < 512) { const bool up = q >= 256; if (up) q -= 256; const int n0 = 32 * (q % 16), drow0 = 256 * (n0 >> 7) + (up ? 128 : 0) + (n0 & 127);
        p0_transpose_item_fp8((up ? F.in(24) : F.in(23)) + (size_t)le * D * DE, D, DE, (unsigned char*)(F.ws + WS_WGU) + (size_t)le * 1024 * 1024, drow0 - n0, W8SCALE, scr, q, lane); return; }
    q -= 512;
    p0_transpose_item_fp8(F.in(25) + (size_t)le * DE * D, DE, D, (unsigned char*)(F.ws + WS_WDN) + (size_t)le * 1024 * 512, 0, W8SCALE, scr, q, lane);
}
__device__ __forceinline__ void p0_mod_item(const Frame& F, LAS float* scr, int it) {
    const int lane = F.lane(), l = it / 192, rem = it % 192, cg = rem >> 3, kc = rem & 7, k0 = 128 * kc, n0 = 256 * cg + 4 * lane;
    const float* cvec = F.in(1); const float* cctx = F.in(3);
    for (int idx = lane; idx < NMODR * 128; idx += 64) { const int r = idx >> 7, kk = idx & 127; const float cv = (r < 8) ? cvec[r * D + k0 + kk] : cctx[k0 + kk];
        scr[idx] = cv / (1.0f + __expf(-cv)); }
    LDS_WAIT(); asm volatile("" ::: "memory");
    f32x4 acc[NMODR];
#pragma unroll
    for (int r = 0; r < NMODR; ++r) acc[r] = (f32x4){0.f, 0.f, 0.f, 0.f};
    const float* wp = F.in(4) + ((size_t)l * D + k0) * NMODC + n0;
#pragma unroll 8
    for (int kk = 0; kk < 128; ++kk) { const f32x4 w = *(const f32x4*)(wp + (size_t)kk * NMODC);
#pragma unroll
        for (int r = 0; r < NMODR; ++r) { const float s = scr[r * 128 + kk]; acc[r] += w * s; } }
    float* modp = (float*)(F.ws + WS_MODP);
#pragma unroll
    for (int r = 0; r < NMODR; ++r) *(f32x4*)(modp + ((size_t)((kc * 2 + l) * NMODR + r)) * NMODC + n0) = acc[r];
    LDS_WAIT(); asm volatile("" ::: "memory");
}
__device__ __forceinline__ void p0_prologue(const Frame& F) {
    LAS float* scr = (LAS float*)(F.lds + F.wave * 16384);
    if (F.wave == 0) p0_mod_item(F, scr, F.bid);
    if (F.wave == 1 && F.bid < 128) p0_mod_item(F, scr, 256 + F.bid);
    const int gw = F.bid * NWAVES + F.wave, NGW = F.G * NWAVES;
    for (int it = gw; it < I_NONEXP; it += NGW) p0_item(F, scr, it);
}
constexpr int JOB_ITEMS = 16 * 768;
__device__ __forceinline__ void filler(const Frame& F, int job, int quota) {
    LAS float* scr = (LAS float*)(F.lds + F.wave * 16384);
    volatile LAS int* slot = (volatile LAS int*)(F.MISC + 60);
    const int lane = F.lane();
    for (;;) {
        __syncthreads();
        if (F.wave == 0 && lane == 0) *slot = (int)__hip_atomic_fetch_add((unsigned*)(F.ctl + CW_JOB + 64 * job), 8u, RLX_AGENT);
        __syncthreads();
        const int base = *slot;
        if (base >= quota) { if (F.wave == 0 && lane == 0) (void)__hip_atomic_fetch_sub((unsigned*)(F.ctl + CW_JOB + 64 * job), 8u, RLX_AGENT); break; }
        const int idx = base + F.wave;
        if (idx < JOB_ITEMS) p0_item(F, scr, I_NONEXP + job * JOB_ITEMS + idx);
    }
}

__device__ __forceinline__ void p1_modulate(const Frame& F) {
    constexpr int RPB = MT / 256;
    unsigned char* H = (unsigned char*)(F.ws + WS_A);
    int rc = -1; f32x4 gs[4], sh[4]; const int lane = F.lane();
    const float* xlat = F.in(0); const float* xctx = F.in(2);
    f32x4 vn[4];
    { const int m = F.bid * RPB + F.wave; ld_row_f32(m < NLAT ? xlat + (size_t)m * D : xctx + (size_t)(m - NLAT) * D, lane, vn); }
    for (int rl = F.wave; rl < RPB; rl += NWAVES) {
        const int m = F.bid * RPB + rl, r = row_batch(m);
        f32x4 v[4];
#pragma unroll
        for (int j = 0; j < 4; ++j) v[j] = vn[j];
        if (rl + NWAVES < RPB) { const int m2 = m + NWAVES; ld_row_f32(m2 < NLAT ? xlat + (size_t)m2 * D : xctx + (size_t)(m2 - NLAT) * D, lane, vn); }
        if (r != rc) { f32x4 g[4], sc[4]; ld_row_f32(F.in(6), lane, g); ld_mod(F, 0, r, 1, sc); ld_mod(F, 0, r, 0, sh);
#pragma unroll
            for (int j = 0; j < 4; ++j) gs[j] = g[j] * (sc[j] + 1.0f);
            rc = r; }
        const float rstd = 1.0f / sqrtf(wave_sum(sumsq4(v)) * (1.0f / D) + EPS);
#pragma unroll
        for (int j = 0; j < 4; ++j) v[j] = v[j] * rstd * gs[j] + sh[j];
        st_row_fp8(H + (size_t)m * D, lane, v);
    }
}

__device__ __forceinline__ void p3_conv(const Frame& F) {
    const bf16* U = (const bf16*)(F.ws + WS_B); unsigned char* V = (unsigned char*)(F.ws + WS_A);
    const int tid = F.tid(), lane = F.lane();
    f32x2 w[CONVW]; const float* wdw = F.in(12);
#pragma unroll
    for (int j = 0; j < CONVW; ++j) w[j] = *(const f32x2*)(wdw + j * D + 2 * tid);
    const f32x2 bias2 = *(const f32x2*)(F.in(13) + 2 * tid);
    f32x4 lg[4], lb[4]; ld_row_f32(F.in(14), lane, lg); ld_row_f32(F.in(15), lane, lb);
    constexpr int TT = 32, NIN = TT + CONVW - 1;
    for (int tile = F.bid; tile < MT / TT; tile += F.G) {
        int rowbase, t0, T;
        if (tile < NLAT / TT) { rowbase = (tile >> 7) * SEQ; t0 = (tile & 127) * TT; T = SEQ; } else { const int t2 = tile - NLAT / TT; rowbase = NLAT + (t2 >> 3) * CTXL; t0 = (t2 & 7) * TT; T = CTXL; }
        for (int p = tid; p < NIN * 128; p += NTHR) { const int i = p >> 7, cp = p & 127, t = t0 - 15 + i;
            v4u val = (v4u){0u, 0u, 0u, 0u}; if (t >= 0 && t < T) val = *(const v4u*)(U + (size_t)(rowbase + t) * D + cp * 8);
            *(LAS v4u*)(F.lds + i * 2048 + cp * 16) = val; }
        __syncthreads();
        f32x2 res[TT];
#pragma unroll
        for (int g = 0; g < TT / 8; ++g) {
            f32x2 acc[8];
#pragma unroll
            for (int q = 0; q < 8; ++q) acc[q] = bias2;
#pragma unroll
            for (int ii = 0; ii < 8 + CONVW - 1; ++ii) { const int i = 8 * g + ii; const unsigned uw = *(const LAS unsigned*)(F.lds + i * 2048 + tid * 4); const f32x2 uv = (f32x2){bflo(uw), bfhi(uw)};
#pragma unroll
                for (int q = 0; q < 8; ++q) { const int j = ii - q; if (j >= 0 && j < CONVW) acc[q] += w[j] * uv; } }
#pragma unroll
            for (int q = 0; q < 8; ++q) res[8 * g + q] = acc[q];
        }
        __syncthreads();
#pragma unroll
        for (int tt = 0; tt < TT; ++tt) *(LAS f32x2*)(F.lds + tt * 4096 + tid * 8) = res[tt];
        __syncthreads();
#pragma unroll
        for (int q = 0; q < 4; ++q) { const int tt = 4 * F.wave + q; f32x4 v[4];
#pragma unroll
            for (int j = 0; j < 4; ++j) v[j] = *(const LAS f32x4*)(F.lds + tt * 4096 + j * 1024 + lane * 16);
            float s = 0.f;
#pragma unroll
            for (int j = 0; j < 4; ++j) s += (v[j][0] + v[j][1]) + (v[j][2] + v[j][3]);
            const float mean = wave_sum(s) * (1.0f / D);
#pragma unroll
            for (int j = 0; j < 4; ++j) v[j] = v[j] - mean;
            const float rstd = 1.0f / sqrtf(wave_sum(sumsq4(v)) * (1.0f / D) + EPS);
#pragma unroll
            for (int j = 0; j < 4; ++j) { f32x4 y = v[j] * rstd * lg[j] + lb[j];
#pragma unroll
                for (int e = 0; e < 4; ++e) y[e] = y[e] / (1.0f + __expf(-y[e]));
                v[j] = y; }
            st_row_fp8(V + (size_t)(rowbase + t0 + tt) * D, lane, v); }
        __syncthreads();
    }
}

constexpr int RW_OFF = 0, RW_BYTES = 256 * 272;
constexpr int REC_OFF = 72 * 1024;
constexpr int LRK_OFF = REC_OFF + 4096;
constexpr int BASE_OFF = LRK_OFF + 2048;
template <int L>
__device__ __forceinline__ void p_emid(const Frame& F) {
    constexpr int NROWS = (L == 0) ? MT : NLAT, RPB = NROWS / 256;
    const bf16* Y = (const bf16*)(F.ws + (L == 0 ? WS_B : WS_C)); unsigned char* TOK = (unsigned char*)(F.ws + WS_A);
    bf16* XS = (bf16*)(F.ws + WS_B);
    float* XC = (float*)(F.ws + WS_XC);
    const int tid = F.tid(), lane = F.lane(), m0 = F.bid * RPB;
    const float* rwG = F.in(21);
    for (int idx = tid; idx < 4096; idx += NTHR) { const int k = idx >> 2, ep = idx & 3; const f32x4 v = *(const f32x4*)(rwG + k * 16 + ep * 4);
        *(LAS f32x4*)(F.lds + RW_OFF + (k >> 2) * 272 + (k & 3) * 64 + ep * 16) = v; }
    __syncthreads();
    float rb[16];
    { const float* rbG = F.in(22);
#pragma unroll
    for (int e = 0; e < 16; ++e) rb[e] = rbG[e]; }
    int rc = -1; f32x4 ga[4], gp[4], gs[4], sh[4];
    const float* xlat = F.in(0); const float* xctx = F.in(2);
    v2u yn[4]; f32x4 xn[4];
    v2u xbn[4];
    { const int m = m0 + F.wave; ld_raw_bf16(Y + (size_t)m * D, lane, yn);
      if (L == 0) ld_row_f32(m < NLAT ? xlat + (size_t)m * D : xctx + (size_t)(m - NLAT) * D, lane, xn); else ld_raw_bf16(XS + (size_t)m * D, lane, xbn); }
    for (int rl = F.wave; rl < RPB; rl += NWAVES) {
        const int m = m0 + rl, r = row_batch(m);
        f32x4 y[4], xv[4];
        unpack_bf16(yn, y);
        if (L == 0) {
#pragma unroll
            for (int j = 0; j < 4; ++j) xv[j] = xn[j];
        } else unpack_bf16(xbn, xv);
        if (rl + NWAVES < RPB) { const int m2 = m + NWAVES; ld_raw_bf16(Y + (size_t)m2 * D, lane, yn);
            if (L == 0) ld_row_f32(m2 < NLAT ? xlat + (size_t)m2 * D : xctx + (size_t)(m2 - NLAT) * D, lane, xn); else ld_raw_bf16(XS + (size_t)m2 * D, lane, xbn); }
        if (r != rc) { f32x4 g[4], sc[4]; ld_mod(F, L, r, 2, ga); ld_row_f32(F.in(7) + L * D, lane, gp); ld_row_f32(F.in(8) + L * D, lane, g); ld_mod(F, L, r, 4, sc); ld_mod(F, L, r, 3, sh);
#pragma unroll
            for (int j = 0; j < 4; ++j) gs[j] = g[j] * (sc[j] + 1.0f);
            rc = r; }
        const float rstdy = 1.0f / sqrtf(wave_sum(sumsq4(y)) * (1.0f / D) + EPS);
#pragma unroll
        for (int j = 0; j < 4; ++j) xv[j] = xv[j] + ga[j] * (y[j] * rstdy * gp[j]) * (((DBG_SKIP >> (2 * L)) & 1) ? 0.f : 1.f);
        if (m < NLAT) st_row_bf16(XS + (size_t)m * D, lane, xv); else st_row_f32(XC + (size_t)(m - NLAT) * D, lane, xv);
        const float rstd1 = 1.0f / sqrtf(wave_sum(sumsq4(xv)) * (1.0f / D) + EPS);
#pragma unroll
        for (int j = 0; j < 4; ++j) xv[j] = xv[j] * rstd1 * gs[j] + sh[j];
        st_row_fp8(TOK + (size_t)m * D, lane, xv);
        float a[16];
#pragma unroll
        for (int e = 0; e < 16; ++e) a[e] = 0.f;
#pragma unroll
        for (int j = 0; j < 4; ++j)
#pragma unroll
            for (int i = 0; i < 4; ++i) { const float tv = xv[j][i]; const LAS f32x4* wp = (const LAS f32x4*)(F.lds + RW_OFF + (64 * j + lane) * 272 + i * 64);
#pragma unroll
                for (int ep = 0; ep < 4; ++ep) { const f32x4 wv = wp[ep];
#pragma unroll
                    for (int cc = 0; cc < 4; ++cc) a[4 * ep + cc] += tv * wv[cc]; } }
        float k8[8], k4[4];
#pragma unroll
        for (int i = 0; i < 8; ++i) { const auto rr = __builtin_amdgcn_permlane32_swap(__builtin_bit_cast(unsigned, a[i]), __builtin_bit_cast(unsigned, a[8 + i]), false, false);
            const unsigned r0_ = rr[0], r1_ = rr[1]; k8[i] = __uint_as_float(r0_) + __uint_as_float(r1_); }
#pragma unroll
        for (int i = 0; i < 4; ++i) { const auto rr = __builtin_amdgcn_permlane16_swap(__builtin_bit_cast(unsigned, k8[i]), __builtin_bit_cast(unsigned, k8[4 + i]), false, false);
            const unsigned r0_ = rr[0], r1_ = rr[1]; k4[i] = row16_sum(__uint_as_float(r0_) + __uint_as_float(r1_)); }
        float s[16], ss[16];
        const float lgsel = (lane & 2) ? ((lane & 1) ? k4[3] : k4[2]) : ((lane & 1) ? k4[1] : k4[0]);
        const float sgl = 1.0f / (1.0f + __expf(-lgsel));
#pragma unroll
        for (int e = 0; e < 16; ++e) { s[e] = rdlane(sgl, 16 * (e >> 2) + (e & 3)); ss[e] = s[e] + rb[e]; }
        float gsc[4]; int i0[4], i1[4];
#pragma unroll
        for (int g = 0; g < 4; ++g) { int a0 = 0; float mx = ss[4 * g];
#pragma unroll
            for (int i = 1; i < 4; ++i) if (ss[4 * g + i] > mx) { mx = ss[4 * g + i]; a0 = i; }
            int b0 = -1; float m2 = -3.0e38f;
#pragma unroll
            for (int i = 0; i < 4; ++i) if (i != a0 && ss[4 * g + i] > m2) { m2 = ss[4 * g + i]; b0 = i; }
            gsc[g] = mx + m2; i0[g] = 4 * g + a0; i1[g] = 4 * g + b0; }
        int gst = 0; float gm = gsc[0];
#pragma unroll
        for (int g = 1; g < 4; ++g) if (gsc[g] > gm) { gm = gsc[g]; gst = g; }
        int e0 = i0[0], e1 = i1[0];
#pragma unroll
        for (int g = 1; g < 4; ++g) if (gst == g) { e0 = i0[g]; e1 = i1[g]; }
        float w0 = 0.f, w1 = 0.f;
#pragma unroll
        for (int e = 0; e < 16; ++e) { if (e == e0) w0 = s[e]; if (e == e1) w1 = s[e]; }
        const float inv = 1.0f / (w0 + w1); w0 *= inv; w1 *= inv;
        if (lane == 0) *(LAS v4u*)(F.lds + REC_OFF + rl * 16) = (v4u){(unsigned)e0, (unsigned)e1, __builtin_bit_cast(unsigned, w0), __builtin_bit_cast(unsigned, w1)};
    }
    __syncthreads();
    if (F.wave == 0 && lane < 16) {
        int cntl = 0;
        for (int rl = 0; rl < RPB; ++rl) { const v4u rec = *(const LAS v4u*)(F.lds + REC_OFF + rl * 16);
            if ((int)rec.x == lane) { *(LAS int*)(F.lds + LRK_OFF + rl * 8) = cntl; ++cntl; }
            if ((int)rec.y == lane) { *(LAS int*)(F.lds + LRK_OFF + rl * 8 + 4) = cntl; ++cntl; } }
        const unsigned base = __hip_atomic_fetch_add((unsigned*)(F.ctl + CW_CNT + (L * 16 + lane) * 64), (unsigned)cntl, RLX_AGENT);
        *(LAS int*)(F.lds + BASE_OFF + lane * 4) = (int)base;
    }
    __syncthreads();
    int* perm2 = (int*)(F.ws + WS_PERM); v2u* slot = (v2u*)(F.ws + WS_SLOT);
    for (int idx = tid; idx < RPB * 2; idx += NTHR) { const int rl = idx >> 1, k = idx & 1; const v4u rec = *(const LAS v4u*)(F.lds + REC_OFF + rl * 16);
        const int e = k ? (int)rec.y : (int)rec.x; const unsigned wb = k ? rec.w : rec.z;
        const int rank = *(const LAS int*)(F.lds + BASE_OFF + e * 4) + *(const LAS int*)(F.lds + LRK_OFF + rl * 8 + k * 4);
        const int m = m0 + rl;
        perm2[(size_t)e * MT + rank] = m;
        slot[(size_t)m * 2 + k] = (v2u){((unsigned)e << 24) | (unsigned)rank, wb}; }
    __syncthreads();
}

__device__ __forceinline__ void moe_setup(const Frame& F, int L) {
    const int tid = F.tid();
    if (tid < 16) F.MISC[40 + tid] = __hip_atomic_load((unsigned*)(F.ctl + CW_CNT + (L * 16 + tid) * 64), RLX_AGENT);
    __syncthreads();
    if (tid == 0) { unsigned p = 0; for (int e = 0; e < 16; ++e) { F.MISC[16 + e] = p; p += (F.MISC[40 + e] + 255u) >> 8; } F.MISC[32] = p; }
    __syncthreads();
}
__device__ __forceinline__ void moe_stage_perm(const Frame& F) {
    const int* perm2 = (const int*)(F.ws + WS_PERM); LAS int* permL = (LAS int*)(F.lds + PERML_OFF);
    const int ntile = (int)F.MISC[32], tid = F.tid();
    for (int i = 0; i < 8; ++i) { const int Lu = i * F.G + F.bid; if (Lu >= 4 * ntile) break;
        const int rt = Lu >> 2; int e = 0;
        for (int j = 1; j < 16; ++j) e += (rt >= (int)F.MISC[16 + j]) ? 1 : 0;
        if (tid < 256) { const int rank = (rt - (int)F.MISC[16 + e]) * 256 + tid; permL[i * 256 + tid] = (rank < (int)F.MISC[40 + e]) ? perm2[(size_t)e * MT + rank] : 0; } }
    __syncthreads();
}

template <int L>
__device__ __forceinline__ void p_epost(const Frame& F) {
    constexpr int NROWS = (L == 0) ? MT : NLAT, RPB = NROWS / 256;
    const unsigned char* FB = (const unsigned char*)(F.ws + WS_D2); unsigned char* H = (unsigned char*)(F.ws + WS_A);
    float* XC = (float*)(F.ws + WS_XC); const v2u* slot = (const v2u*)(F.ws + WS_SLOT);
    const int lane = F.lane(), m0 = F.bid * RPB;
    int rc = -1; f32x4 ga[4], gp[4], gs[4], sh[4];
    v4u sl_n2 = (v4u){0u, 0u, 0u, 0u}; unsigned f0n[4], f1n[4]; v2u xbn[4]; f32x4 xn[4]; float w0n, w1n;
    bf16* XS = (bf16*)(F.ws + WS_B);
#define EP_ISSUE(mm, slv) do { const unsigned sx0 = __builtin_amdgcn_readfirstlane((slv).x), sy0 = __builtin_amdgcn_readfirstlane((slv).y), sx1 = __builtin_amdgcn_readfirstlane((slv).z), sy1 = __builtin_amdgcn_readfirstlane((slv).w); \
        const size_t v0_ = (size_t)F.MISC[16 + (sx0 >> 24)] * 256 + (sx0 & 0xffffffu), v1_ = (size_t)F.MISC[16 + (sx1 >> 24)] * 256 + (sx1 & 0xffffffu); \
        w0n = __uint_as_float(sy0); w1n = __uint_as_float(sy1); ld_raw_fp8(FB + v0_ * D, lane, f0n); ld_raw_fp8(FB + v1_ * D, lane, f1n); \
        if ((mm) < NLAT) ld_raw_bf16(XS + (size_t)(mm) * D, lane, xbn); else ld_row_f32(XC + (size_t)((mm) - NLAT) * D, lane, xn); } while (0)
    { const int m = m0 + F.wave; const v4u sl0 = *(const v4u*)(slot + (size_t)m * 2);
      if (F.wave + NWAVES < RPB) sl_n2 = *(const v4u*)(slot + (size_t)(m + NWAVES) * 2);
      EP_ISSUE(m, sl0); }
    for (int rl = F.wave; rl < RPB; rl += NWAVES) {
        const int m = m0 + rl, r = row_batch(m);
        f32x4 f0[4], f1[4], xv[4]; const float w0 = w0n, w1 = w1n;
        unpack_fp8(f0n, f0); unpack_fp8(f1n, f1);
        if (m < NLAT) unpack_bf16(xbn, xv); else {
#pragma unroll
            for (int j = 0; j < 4; ++j) xv[j] = xn[j]; }
        if (rl + NWAVES < RPB) { const v4u slc = sl_n2; if (rl + 2 * NWAVES < RPB) sl_n2 = *(const v4u*)(slot + (size_t)(m + 2 * NWAVES) * 2); EP_ISSUE(m + NWAVES, slc); }
        if (r != rc) { ld_mod(F, L, r, 5, ga); ld_row_f32(F.in(9) + L * D, lane, gp);
            if (L == 0) { f32x4 g[4], sc[4]; ld_row_f32(F.in(6) + D, lane, g); ld_mod(F, 1, r, 1, sc); ld_mod(F, 1, r, 0, sh);
#pragma unroll
                for (int j = 0; j < 4; ++j) gs[j] = g[j] * (sc[j] + 1.0f); }
            rc = r; }
#pragma unroll
        for (int j = 0; j < 4; ++j) f0[j] = (DBG_SLOT == 1) ? f0[j] : (DBG_SLOT == 2) ? f1[j] : (DBG_SLOT == 3) ? f0[j] * 0.5f + f1[j] * 0.5f : f0[j] * w0 + f1[j] * w1;
        const float rstdf = 1.0f / sqrtf(wave_sum(sumsq4(f0)) * (1.0f / D) + EPS);
#pragma unroll
        for (int j = 0; j < 4; ++j) xv[j] = xv[j] + ga[j] * (f0[j] * rstdf * gp[j]) * (((DBG_SKIP >> (2 * L + 1)) & 1) ? 0.f : 1.f);
        if (L == 1) st_row_f32(F.out + (size_t)m * D, lane, xv);
        else if (m < NLAT) st_row_bf16(XS + (size_t)m * D, lane, xv); else st_row_f32(XC + (size_t)(m - NLAT) * D, lane, xv);
        if (L == 0) {
            const float rstd2 = 1.0f / sqrtf(wave_sum(sumsq4(xv)) * (1.0f / D) + EPS);
#pragma unroll
            for (int j = 0; j < 4; ++j) xv[j] = xv[j] * rstd2 * gs[j] + sh[j];
            st_row_fp8(H + (size_t)m * D, lane, xv);
        }
    }
#undef EP_ISSUE
}

constexpr int AT_CK = 0, AT_CV = 32768, AT_RPB = 65536;
constexpr float LOG2E = 1.4426950408889634f;
__device__ __forceinline__ float xrow_max(float m) {
    { const auto rr = __builtin_amdgcn_permlane16_swap(__builtin_bit_cast(unsigned, m), __builtin_bit_cast(unsigned, m), false, false); const unsigned a_ = rr[0], b_ = rr[1]; m = fmaxf(__uint_as_float(a_), __uint_as_float(b_)); }
    { const auto rr = __builtin_amdgcn_permlane32_swap(__builtin_bit_cast(unsigned, m), __builtin_bit_cast(unsigned, m), false, false); const unsigned a_ = rr[0], b_ = rr[1]; m = fmaxf(__uint_as_float(a_), __uint_as_float(b_)); }
    return m;
}
__device__ __forceinline__ float xrow_sum(float m) {
    { const auto rr = __builtin_amdgcn_permlane16_swap(__builtin_bit_cast(unsigned, m), __builtin_bit_cast(unsigned, m), false, false); const unsigned a_ = rr[0], b_ = rr[1]; m = __uint_as_float(a_) + __uint_as_float(b_); }
    { const auto rr = __builtin_amdgcn_permlane32_swap(__builtin_bit_cast(unsigned, m), __builtin_bit_cast(unsigned, m), false, false); const unsigned a_ = rr[0], b_ = rr[1]; m = __uint_as_float(a_) + __uint_as_float(b_); }
    return m;
}
__device__ __forceinline__ void attn_softmax(f32x4 (&s)[4], float& mrun, f32x4& osum, f32x4 (&o)[4], bf16x8 (&pf)[2]) {
    float mx = mrun;
#pragma unroll
    for (int t = 0; t < 4; ++t) mx = fmaxf(fmaxf(mx, fmaxf(s[t][0], s[t][1])), fmaxf(s[t][2], s[t][3]));
    mx = xrow_max(mx);
    if (__builtin_amdgcn_ballot_w64(mx > mrun) != 0ull) {
        const float alpha = __builtin_amdgcn_exp2f(mrun - mx);
        mrun = mx; osum = osum * alpha;
#pragma unroll
        for (int db = 0; db < 4; ++db) o[db] = o[db] * alpha;
    }
#pragma unroll
    for (int t = 0; t < 4; ++t)
#pragma unroll
        for (int i = 0; i < 4; ++i) s[t][i] = __builtin_amdgcn_exp2f(s[t][i] - mx);
#pragma unroll
    for (int bb = 0; bb < 2; ++bb) { v4u pw; pw.x = pg8::cvt_pk_bf16(s[2 * bb][0], s[2 * bb][1]); pw.y = pg8::cvt_pk_bf16(s[2 * bb][2], s[2 * bb][3]);
        pw.z = pg8::cvt_pk_bf16(s[2 * bb + 1][0], s[2 * bb + 1][1]); pw.w = pg8::cvt_pk_bf16(s[2 * bb + 1][2], s[2 * bb + 1][3]); pf[bb] = __builtin_bit_cast(bf16x8, pw); }
}
struct AttnStream { float m; f32x4 osum; f32x4 o[4]; bf16x8 q0, q1; };
__device__ __forceinline__ void attn_block(AttnStream& T, const bf16x8 (&kf)[2][2], const bf16x8 (&vf)[4], const f32x4 (&cinit)[2], const bf16x8 ones) {
    f32x4 s[2];
#pragma unroll
    for (int tl = 0; tl < 2; ++tl) { s[tl] = __builtin_amdgcn_mfma_f32_16x16x32_bf16(kf[tl][0], T.q0, cinit[tl], 0, 0, 0); s[tl] = __builtin_amdgcn_mfma_f32_16x16x32_bf16(kf[tl][1], T.q1, s[tl], 0, 0, 0); }
    float mx = fmaxf(fmaxf(T.m, fmaxf(s[0][0], s[0][1])), fmaxf(s[0][2], s[0][3]));
    mx = fmaxf(fmaxf(mx, fmaxf(s[1][0], s[1][1])), fmaxf(s[1][2], s[1][3]));
    mx = xrow_max(mx);
    if (__builtin_amdgcn_ballot_w64(mx > T.m) != 0ull) {
        const float alpha = __builtin_amdgcn_exp2f(T.m - mx);
        T.m = mx; T.osum = T.osum * alpha;
#pragma unroll
        for (int db = 0; db < 4; ++db) T.o[db] = T.o[db] * alpha;
    }
#pragma unroll
    for (int tl = 0; tl < 2; ++tl)
#pragma unroll
        for (int i = 0; i < 4; ++i) s[tl][i] = __builtin_amdgcn_exp2f(s[tl][i] - mx);
    v4u pw; pw.x = pg8::cvt_pk_bf16(s[0][0], s[0][1]); pw.y = pg8::cvt_pk_bf16(s[0][2], s[0][3]); pw.z = pg8::cvt_pk_bf16(s[1][0], s[1][1]); pw.w = pg8::cvt_pk_bf16(s[1][2], s[1][3]);
    const bf16x8 pf = __builtin_bit_cast(bf16x8, pw);
    T.osum = __builtin_amdgcn_mfma_f32_16x16x32_bf16(ones, pf, T.osum, 0, 0, 0);
#pragma unroll
    for (int db = 0; db < 4; ++db) T.o[db] = __builtin_amdgcn_mfma_f32_16x16x32_bf16(vf[db], pf, T.o[db], 0, 0, 0);
}
template <int ABL  >
__device__ __forceinline__ void p10_attn(const Frame& F) {
    const bf16* Qh = (const bf16*)F.out; const bf16* Kh = (const bf16*)(F.ws + WS_C); const bf16* Vb = (const bf16*)(F.ws + WS_D2); unsigned char* O = (unsigned char*)(F.ws + WS_A);
    const int lane = F.lane(), tid = F.wave * 64 + lane, qi = lane & 15, q4 = lane >> 4;
    const int bh = F.bid >> 1, h = bh & 15, b = bh >> 4, rbase = (F.bid & 1) * 32;
    const bf16* Kbh = Kh + (size_t)bh * KSLOT * HD; const bf16* Vbh = Vb + (size_t)bh * (KSLOT / 8) * 512;
#pragma unroll
    for (int i = 0; i < 4; ++i) { const int kf = F.wave * 4 + i, blk = kf >> 2, tl = (kf >> 1) & 1, dh = kf & 1;
        const v4u kv = *(const v4u*)(Kbh + (size_t)(SEQ + 32 * blk + 8 * (qi >> 2) + 4 * tl + (qi & 3)) * HD + dh * 32 + 8 * q4);
        const int vblk = kf >> 2, db = kf & 3;
        const v4u vv = *(const v4u*)(Vbh + (size_t)(SEQ / 8 + 4 * vblk + q4) * 512 + (db * 16 + qi) * 8);
        *(LAS v4u*)(F.lds + AT_CK + kf * 1024 + lane * 16) = kv; *(LAS v4u*)(F.lds + AT_CV + kf * 1024 + lane * 16) = vv; }
    { const float* rpbG = F.in(20) + h * 465; LAS float* rpbW = (LAS float*)(F.lds + AT_RPB);
        for (int idx = tid; idx < 15 * 32; idx += NTHR) { const int ri = idx >> 5, ci = idx & 31; rpbW[idx] = (ci < 31) ? rpbG[ri * 31 + ci] * LOG2E : -1.0e30f; } }
    __syncthreads();
    const int seg = F.wave & 3;
    const int cb = (seg == 0) ? 0 : (seg == 1) ? 8 : (seg == 2) ? 24 : 32;
    const int qc = 16 * seg + qi, cs = min(max(qc - WINW / 2, 0), GRIDW - WINW);
    int coff[2][4];
#pragma unroll
    for (int tl = 0; tl < 2; ++tl)
#pragma unroll
        for (int i = 0; i < 4; ++i) { const int kc = cb + 8 * q4 + 4 * tl + i; const bool ok = (kc >= cs) && (kc < cs + WINW); coff[tl][i] = AT_RPB + 4 * (ok ? (kc - qc + (WINW - 1)) : 31); }
    const bf16x8 ones = __builtin_bit_cast(bf16x8, (v4u){0x3f803f80u, 0x3f803f80u, 0x3f803f80u, 0x3f803f80u});
    const f32x4 zero2[2] = {(f32x4){0.f, 0.f, 0.f, 0.f}, (f32x4){0.f, 0.f, 0.f, 0.f}};
    for (int it = 0; it < 8; ++it) {
        const int rA = rbase + 2 * ((F.wave >> 2) + 2 * it), rB = rA + 1;
        const int r0A = min(max(rA - WINH / 2, 0), GROWS - WINH), r0B = min(max(rB - WINH / 2, 0), GROWS - WINH), dlt = r0B - r0A;
        AttnStream TA, TB;
        { const bf16* Qp = Qh + ((size_t)bh * SEQ + rA * GRIDW + qc) * HD; TA.q0 = *(const bf16x8*)(Qp + 8 * q4); TA.q1 = *(const bf16x8*)(Qp + 32 + 8 * q4);
          TB.q0 = *(const bf16x8*)(Qp + GRIDW * HD + 8 * q4); TB.q1 = *(const bf16x8*)(Qp + GRIDW * HD + 32 + 8 * q4); }
        TA.m = -1.0e30f; TB.m = -1.0e30f; TA.osum = zero2[0]; TB.osum = zero2[0];
#pragma unroll
        for (int db = 0; db < 4; ++db) { TA.o[db] = zero2[0]; TB.o[db] = zero2[0]; }
        const bf16* kp0 = Kbh + (size_t)(r0A * GRIDW + cb + 8 * (qi >> 2) + (qi & 3)) * HD + 8 * q4;
        const bf16* vp0 = Vbh + (size_t)((r0A * GRIDW + cb) / 8 + q4) * 512 + qi * 8;
        int boA[2][4], boB[2][4];
#pragma unroll
        for (int tl = 0; tl < 2; ++tl)
#pragma unroll
            for (int i = 0; i < 4; ++i) { boA[tl][i] = coff[tl][i] + (r0A - rA + (WINH - 1)) * 128; boB[tl][i] = coff[tl][i] + (r0A - rB + (WINH - 1)) * 128; }
        bf16x8 kw[2][2][2], vw[2][4];
#define AT_LOADW(u) do { const int bf_ = (u) & 1; _Pragma("unroll") for (int tl = 0; tl < 2; ++tl) { \
            kw[bf_][tl][0] = (ABL & 1) ? TA.q0 : *(const bf16x8*)(kp0 + (size_t)((u) * GRIDW + 4 * tl) * HD); kw[bf_][tl][1] = (ABL & 1) ? TA.q1 : *(const bf16x8*)(kp0 + (size_t)((u) * GRIDW + 4 * tl) * HD + 32); } \
            _Pragma("unroll") for (int db = 0; db < 4; ++db) vw[bf_][db] = (ABL & 1) ? TA.q0 : *(const bf16x8*)(vp0 + (size_t)((u) * (GRIDW / 8)) * 512 + db * 128); } while (0)
        AT_LOADW(0);
        __builtin_amdgcn_sched_barrier(0);
#pragma unroll
        for (int u = 0; u < 9; ++u) {
            if (u < 8) { if (u < 7 || dlt) AT_LOADW(u + 1); }
            __builtin_amdgcn_sched_barrier(0);
            if (u < 8) {
                bf16x8 kc[2][2], vc[4];
#pragma unroll
                for (int tl = 0; tl < 2; ++tl) { kc[tl][0] = (ABL & 2) ? TA.q1 : *(const LAS bf16x8*)(F.lds + AT_CK + ((u * 2 + tl) * 2 + 0) * 1024 + lane * 16); kc[tl][1] = (ABL & 2) ? TA.q0 : *(const LAS bf16x8*)(F.lds + AT_CK + ((u * 2 + tl) * 2 + 1) * 1024 + lane * 16); }
#pragma unroll
                for (int db = 0; db < 4; ++db) vc[db] = (ABL & 2) ? TA.q1 : *(const LAS bf16x8*)(F.lds + AT_CV + (u * 4 + db) * 1024 + lane * 16);
                attn_block(TA, kc, vc, zero2, ones); attn_block(TB, kc, vc, zero2, ones);
            }
            __builtin_amdgcn_sched_barrier(0);
            if (u < 8 || dlt) {
                if (u < 8) { f32x4 ci[2];
#pragma unroll
                    for (int tl = 0; tl < 2; ++tl)
#pragma unroll
                        for (int i = 0; i < 4; ++i) ci[tl][i] = *(const LAS float*)(F.lds + boA[tl][i] + u * 128);
                    attn_block(TA, kw[u & 1], vw[u & 1], ci, ones); }
                if (u >= 1 || dlt == 0) { f32x4 ci[2];
#pragma unroll
                    for (int tl = 0; tl < 2; ++tl)
#pragma unroll
                        for (int i = 0; i < 4; ++i) ci[tl][i] = *(const LAS float*)(F.lds + boB[tl][i] + u * 128);
                    attn_block(TB, kw[u & 1], vw[u & 1], ci, ones); }
            }
            __builtin_amdgcn_sched_barrier(0);
        }
#undef AT_LOADW
        {   const float inv = 1.0f / TA.osum[0];
            unsigned char* op = O + ((size_t)b * SEQ + rA * GRIDW + qc) * D + h * HD + 4 * q4;
#pragma unroll
            for (int db = 0; db < 4; ++db) { const unsigned w = pk4_fp8(TA.o[db][0] * inv, TA.o[db][1] * inv, TA.o[db][2] * inv, TA.o[db][3] * inv); if (ABL == 0 || w == 0x12345u) *(unsigned*)(op + db * 16) = w; } }
        {   const float inv = 1.0f / TB.osum[0];
            unsigned char* op = O + ((size_t)b * SEQ + rB * GRIDW + qc) * D + h * HD + 4 * q4;
#pragma unroll
            for (int db = 0; db < 4; ++db) { const unsigned w = pk4_fp8(TB.o[db][0] * inv, TB.o[db][1] * inv, TB.o[db][2] * inv, TB.o[db][3] * inv); if (ABL == 0 || w == 0x12345u) *(unsigned*)(op + db * 16) = w; } }
    }
    __syncthreads();
}

#ifndef MK_N_LAUNCHES
#define MK_N_LAUNCHES 1
#endif
constexpr int N_PHASES = 16;
constexpr int N_LAUNCHES = MK_N_LAUNCHES;
struct Args { const float* in[26]; float* out; unsigned char* ws; int ph_lo, ph_hi; };

__global__ void __launch_bounds__(NTHR, 2) fwd_kernel(Args args) {
    extern __shared__ __attribute__((aligned(16))) unsigned char lds[];
    Frame F;
    F.lds = (LAS unsigned char*)lds;
    F.MISC = (volatile LAS unsigned*)(F.lds + MISC_OFF);
    F.wave = __builtin_amdgcn_readfirstlane((int)threadIdx.x >> 6);
    F.G = gridDim.x; F.bid = blockIdx.x;
    F.ws = args.ws; F.ctl = (gu32*)(args.ws + WS_CTL); F.out = args.out;
    for (int u = threadIdx.x; u < 256; u += NTHR) F.MISC[u] = 0u;
    if (threadIdx.x < 26) { const unsigned long long pv = (unsigned long long)args.in[threadIdx.x]; volatile LAS unsigned* t = (volatile LAS unsigned*)(F.lds + PTAB_OFF) + 2 * threadIdx.x; t[0] = (unsigned)pv; t[1] = (unsigned)(pv >> 32); }
    __syncthreads();
    XcdBarrier bar; bar.bar = (unsigned*)(F.ctl + CW_BAR); bar.x = 0; bar.st = nullptr;
    if (N_LAUNCHES == 1) bar = xcd_barrier_post((unsigned*)(F.ctl + CW_BAR), F.MISC + 8);
    const int lo = args.ph_lo, hi = args.ph_hi;
#ifndef PHASE_MASK
#define PHASE_MASK 0xFFFF
#endif
#define IN(k) ((((PHASE_MASK) >> (k)) & 1) && lo <= (k) && (k) < hi)
#define SEAM(k) do { if (IN(k) && IN((k) + 1)) { xcd_barrier(bar); if (PROBE_MASK == 0x10000) xcd_barrier(bar); } } while (0)
    const char* wsb = (const char*)F.ws;
    LAS unsigned char* ring = F.lds;

    if (IN(0)) { _Pragma("unroll") for (int rep = 0; rep < REP(0); ++rep) { p0_prologue(F); __syncthreads(); } }
    SEAM(0);
    if (IN(1)) { _Pragma("unroll") for (int rep = 0; rep < REP(1); ++rep) p1_modulate(F); }
    SEAM(1);
    if (IN(2)) {
        pg8::DenseSched S{wsb + WS_A, wsb + WS_WIN, D / 2, MT / 256, 8, F.G, F.bid};
        pg8::EpiGated<0> E{(bf16*)(F.ws + WS_B), D, F.in(11), D};
        _Pragma("unroll") for (int rep = 0; rep < REP(2); ++rep) pg8::gemm_phase<pg8::EpiGated<0>, pg8::DenseSched, true, true>(ring, D / 2, S, E, F.wave);
        filler(F, 0, 3600);
    }
    SEAM(2);
    if (IN(3)) { _Pragma("unroll") for (int rep = 0; rep < REP(3); ++rep) p3_conv(F); }
    SEAM(3);
    if (IN(4)) {
        pg8::DenseSched S{wsb + WS_A, wsb + WS_WOUT, D / 2, MT / 256, 4, F.G, F.bid};
        pg8::EpiBf16B E{(bf16*)(F.ws + WS_B), D, F.in(17)};
        _Pragma("unroll") for (int rep = 0; rep < REP(4); ++rep) pg8::gemm_phase<pg8::EpiBf16B, pg8::DenseSched, true, true>(ring, D / 2, S, E, F.wave);
        filler(F, 0, JOB_ITEMS);
    }
    SEAM(4);
    if (IN(5)) { filler(F, 0, JOB_ITEMS); p_emid<0>(F); }
    SEAM(5);
    if (IN(6)) {
        moe_setup(F, 0); moe_stage_perm(F);
        pg8::MoeUpSched S; S.tpre = (const volatile LAS int*)(F.MISC + 16); S.G = F.G; S.c = F.bid; S.A = wsb + WS_A; S.Wgu = wsb + WS_WGU + (size_t)0 * 16 * 1024 * 1024; S.permL = (const LAS int*)(F.lds + PERML_OFF); S.kb = D;
        pg8::EpiGated<1, true> E{(bf16*)(F.ws + WS_C), DE, nullptr, 0};
        _Pragma("unroll") for (int rep = 0; rep < REP(6); ++rep) pg8::gemm_phase<pg8::EpiGated<1, true>, pg8::MoeUpSched, true, true>(ring, D / 2, S, E, F.wave);
        filler(F, 1, 3000);
    }
    SEAM(6);
    if (IN(7)) {
        moe_setup(F, 0);
        pg8::MoeDownSched S; S.tpre = (const volatile LAS int*)(F.MISC + 16); S.G = F.G; S.c = F.bid; S.A = wsb + WS_C; S.Wdn = wsb + WS_WDN + (size_t)0 * 16 * 1024 * 512; S.kb = DE;
        pg8::EpiF8 E{(unsigned char*)(F.ws + WS_D2), D};
        _Pragma("unroll") for (int rep = 0; rep < REP(7); ++rep) pg8::gemm_phase<pg8::EpiF8, pg8::MoeDownSched, true, true>(ring, DE / 2, S, E, F.wave);
        filler(F, 1, 4500);
    }
    SEAM(7);
    if (IN(8)) { moe_setup(F, 0); p_epost<0>(F); }
    SEAM(8);
    if (IN(9)) {
        pg8::QkvSched S{wsb + WS_A, wsb + WS_WQKV, F.G, F.bid, D};
        pg8::EpiQkv E{(bf16*)F.out, (bf16*)(F.ws + WS_C), (bf16*)(F.ws + WS_D2), 0.125f * 1.4426950408889634f};
        _Pragma("unroll") for (int rep = 0; rep < REP(9); ++rep) pg8::gemm_phase<pg8::EpiQkv, pg8::QkvSched, true, true>(ring, D / 2, S, E, F.wave);
        filler(F, 1, 8100);
    }
    SEAM(9);
#ifndef ATT_ABL
#define ATT_ABL 0
#endif
    if (IN(10)) { if (REP(10) == 2) p10_attn<ATT_ABL>(F); p10_attn<0>(F); }
    SEAM(10);
    if (IN(11)) {
        pg8::DenseSched S{wsb + WS_A, wsb + WS_WO, D / 2, NLAT / 256, 4, F.G, F.bid};
        pg8::EpiBf16 E{(bf16*)(F.ws + WS_C), D, nullptr};
        _Pragma("unroll") for (int rep = 0; rep < REP(11); ++rep) pg8::gemm_phase<pg8::EpiBf16, pg8::DenseSched, true, true>(ring, D / 2, S, E, F.wave);
    }
    SEAM(11);
    if (IN(12)) { filler(F, 1, JOB_ITEMS); p_emid<1>(F); }
    SEAM(12);
    if (IN(13)) {
        moe_setup(F, 1); moe_stage_perm(F);
        pg8::MoeUpSched S; S.tpre = (const volatile LAS int*)(F.MISC + 16); S.G = F.G; S.c = F.bid; S.A = wsb + WS_A; S.Wgu = wsb + WS_WGU + (size_t)1 * 16 * 1024 * 1024; S.permL = (const LAS int*)(F.lds + PERML_OFF); S.kb = D;
        pg8::EpiGated<1, true> E{(bf16*)(F.ws + WS_C), DE, nullptr, 0};
        _Pragma("unroll") for (int rep = 0; rep < REP(13); ++rep) pg8::gemm_phase<pg8::EpiGated<1, true>, pg8::MoeUpSched, true, true>(ring, D / 2, S, E, F.wave);
    }
    SEAM(13);
    if (IN(14)) {
        moe_setup(F, 1);
        pg8::MoeDownSched S; S.tpre = (const volatile LAS int*)(F.MISC + 16); S.G = F.G; S.c = F.bid; S.A = wsb + WS_C; S.Wdn = wsb + WS_WDN + (size_t)1 * 16 * 1024 * 512; S.kb = DE;
        pg8::EpiF8 E{(unsigned char*)(F.ws + WS_D2), D};
        _Pragma("unroll") for (int rep = 0; rep < REP(14); ++rep) pg8::gemm_phase<pg8::EpiF8, pg8::MoeDownSched, true, true>(ring, DE / 2, S, E, F.wave);
    }
    SEAM(14);
    if (IN(15)) { moe_setup(F, 1); _Pragma("unroll") for (int rep = 0; rep < REP(15); ++rep) p_epost<1>(F); }
#undef IN
#undef SEAM
}

extern "C" void kernel_launch(void* const* d_in, const int* in_sizes, int n_in, void* d_out, int out_size, void* d_ws, size_t ws_size, hipStream_t stream) {
    static int grid = 0;
    if (grid == 0) {
        if (n_in != 26 || in_sizes[0] != NLAT * D || out_size != NLAT * D || ws_size < WS_END) { fprintf(stderr, "kernel_launch: unexpected shapes (n_in %d, in0 %d, out %d, ws %zu); nothing launched\n", n_in, n_in > 0 ? in_sizes[0] : -1, out_size, ws_size); grid = -1; return; }
        if (hipFuncSetAttribute((const void*)fwd_kernel, hipFuncAttributeMaxDynamicSharedMemorySize, LDS_BYTES) != hipSuccess) { fprintf(stderr, "kernel_launch: hipFuncSetAttribute failed\n"); grid = -1; return; }
        int per_cu = 0;
        if (hipOccupancyMaxActiveBlocksPerMultiprocessor(&per_cu, (const void*)fwd_kernel, NTHR, LDS_BYTES) != hipSuccess || per_cu < 1) fprintf(stderr, "kernel_launch: note: occupancy query reports %d workgroups per CU\n", per_cu);
        (void)hipGetLastError();
        grid = 256;
    }
    if (grid < 0) return;
    if (hipMemsetAsync((char*)d_ws + WS_CTL, 0, CTL_ZERO_BYTES, stream) != hipSuccess) { fprintf(stderr, "kernel_launch: hipMemsetAsync failed\n"); return; }
    Args a{};
    for (int i = 0; i < 26; ++i) a.in[i] = (const float*)d_in[i];
    a.out = (float*)d_out; a.ws = (unsigned char*)d_ws;
    for (int li = 0; li < N_LAUNCHES; ++li) {
        a.ph_lo = (N_LAUNCHES == 1) ? 0 : li; a.ph_hi = (N_LAUNCHES == 1) ? N_PHASES : li + 1;
        hipLaunchKernelGGL(fwd_kernel, dim3(grid), dim3(NTHR), LDS_BYTES, stream, a);
        const hipError_t le = hipPeekAtLastError();
        if (le != hipSuccess) { fprintf(stderr, "kernel_launch: launch %d failed: %s\n", li, hipGetErrorName(le)); break; }
    }
}
```

```cpp
#include <hip/hip_runtime.h>
#include <cstdio>
#include <cstdint>

#ifndef PROBE_MASK
#define PROBE_MASK 0
#endif
#define REP(k) ((((PROBE_MASK) >> (k)) & 1) ? 2 : 1)
#ifndef DBG_SLOT
#define DBG_SLOT 0
#endif
#ifndef DBG_SKIP
#define DBG_SKIP 0
#endif
constexpr int D = 1024, BATCH = 8, SEQ = 4096, CTXL = 256;
constexpr int NLAT = BATCH * SEQ, NCTX = BATCH * CTXL, MT = NLAT + NCTX;
constexpr int NE = 16, DE = 512, NH = 16, HD = 64, GRIDW = 64, GROWS = 64, WINH = 8, WINW = 16, CONVW = 31;
constexpr int KSLOT = SEQ + CTXL;
constexpr int NMODR = 9, NMODC = 6 * D;
constexpr int MODKC = 8;
constexpr float EPS = 1e-6f;
constexpr int NWAVES = 8, NTHR = NWAVES * 64;

constexpr size_t MiB = 1u << 20;
constexpr size_t WS_CTL = 0, CTL_ZERO_BYTES = 1 * MiB;
constexpr size_t WS_SLOT = 1 * MiB;
constexpr size_t WS_PERM = 2 * MiB;
constexpr size_t WS_MODP = 5 * MiB;
constexpr size_t WS_XC = 9 * MiB;
constexpr size_t WS_WIN = 18 * MiB, WS_WOUT = 22 * MiB, WS_WQKV = 24 * MiB, WS_WO = 30 * MiB;
constexpr size_t WS_WGU = 32 * MiB;
constexpr size_t WS_WDN = 96 * MiB;
constexpr size_t WS_A = 128 * MiB, WS_B = 196 * MiB, WS_C = 264 * MiB, WS_D2 = 336 * MiB, WS_END = 480 * MiB;
constexpr int CW_BAR = 4096;
constexpr int CW_JOB = 12288;
constexpr int CW_CNT = 8192;

constexpr int RING_BYTES = 131072;
constexpr int MISC_OFF = RING_BYTES;
constexpr int PTAB_OFF = RING_BYTES + 1024 + 8192;
constexpr int PERML_OFF = RING_BYTES + 1024;
constexpr int LDS_BYTES = 147456;

#define GAS __attribute__((address_space(1)))
#define LAS __attribute__((address_space(3)))
typedef unsigned short bf16;
typedef unsigned v4u __attribute__((ext_vector_type(4)));
typedef unsigned v2u __attribute__((ext_vector_type(2)));
typedef float f32x4 __attribute__((ext_vector_type(4)));
typedef float f32x2 __attribute__((ext_vector_type(2)));
typedef short bf16x8 __attribute__((ext_vector_type(8)));
typedef GAS unsigned gu32;
#define RLX_AGENT __ATOMIC_RELAXED, __HIP_MEMORY_SCOPE_AGENT
#define LDS_WAIT() asm volatile("s_waitcnt lgkmcnt(0)" ::: "memory")
#define VM_WAIT() asm volatile("s_waitcnt vmcnt(0)" ::: "memory")

__device__ __forceinline__ unsigned f2bf(float f) { unsigned u = __builtin_bit_cast(unsigned, f); return (u + 0x7fffu + ((u >> 16) & 1u)) >> 16; }
__device__ __forceinline__ unsigned pk2(float lo, float hi) { return f2bf(lo) | (f2bf(hi) << 16); }
__device__ __forceinline__ unsigned pk4_fp8(float a, float b, float c, float d) { int p = __builtin_amdgcn_cvt_pk_fp8_f32(a, b, 0, false); p = __builtin_amdgcn_cvt_pk_fp8_f32(c, d, p, true); return (unsigned)p; }
__device__ __forceinline__ float bflo(unsigned w) { return __builtin_bit_cast(float, w << 16); }
__device__ __forceinline__ float bfhi(unsigned w) { return __builtin_bit_cast(float, w & 0xffff0000u); }
__device__ __forceinline__ float row16_sum(float v) {
    v += __builtin_bit_cast(float, __builtin_amdgcn_update_dpp(0, __builtin_bit_cast(int, v), 0xB1, 0xF, 0xF, false));
    v += __builtin_bit_cast(float, __builtin_amdgcn_update_dpp(0, __builtin_bit_cast(int, v), 0x4E, 0xF, 0xF, false));
    v += __builtin_bit_cast(float, __builtin_amdgcn_update_dpp(0, __builtin_bit_cast(int, v), 0x141, 0xF, 0xF, false));
    v += __builtin_bit_cast(float, __builtin_amdgcn_update_dpp(0, __builtin_bit_cast(int, v), 0x140, 0xF, 0xF, false));
    return v;
}
__device__ __forceinline__ float rdlane(float v, int l) { return __builtin_bit_cast(float, __builtin_amdgcn_readlane(__builtin_bit_cast(int, v), l)); }
__device__ __forceinline__ float wave_sum(float v) {
    v = row16_sum(v);
    return (rdlane(v, 0) + rdlane(v, 16)) + (rdlane(v, 32) + rdlane(v, 48));
}
__device__ __forceinline__ int lane_id_asm() { int l; asm volatile("v_mbcnt_lo_u32_b32 %0, -1, 0\n\tv_mbcnt_hi_u32_b32 %0, -1, %0" : "=v"(l)); return l; }
__device__ __forceinline__ float fast_sigmoid(float x) { return __builtin_amdgcn_rcpf(1.0f + __builtin_amdgcn_exp2f(-1.4426950408889634f * x)); }

namespace pg8 {
#define PG8_LAS __attribute__((address_space(3)))
typedef unsigned short bf16_t;
typedef short bf16x8 __attribute__((ext_vector_type(8)));
typedef float f32x4 __attribute__((ext_vector_type(4)));
typedef unsigned u32x4 __attribute__((ext_vector_type(4)));
constexpr int BM = 256, BK = 64, HALF = 128, HTB = HALF * BK * 2, STAGE_BYTES = 8 * HTB, NXCD = 8, WGM = 8;

__host__ __device__ __forceinline__ int lds_byte(int r, int c) { const int st = (r >> 4) * 2 + (c >> 5), rr = r & 15, cc = c & 31, ob = rr * 64 + cc * 2; return st * 1024 + (ob ^ (((ob >> 9) & 1) << 5)); }
__host__ __device__ __forceinline__ void stage_rc(int b, int& R, int& C) { const int st = b / 1024, sb = b % 1024, swz = sb ^ (((sb >> 9) & 1) << 5); R = (st >> 1) * 16 + swz / 64; C = (st & 1) * 32 + (swz % 64) / 2; }
__host__ __device__ __forceinline__ int perm32(int rho) { const int n = rho >> 4, i = rho & 15; return 8 * (i >> 2) + 4 * n + (i & 3); }

struct Unit { int pm, pn; const char* a; const char* b; int li; int ex; };

__device__ __forceinline__ bool static_order(int L, int nM, int nN, int& pm, int& pn) {
    const int nwg = nM * nN; if (L >= nwg) return false;
    int wgid = L; { const int q = nwg / NXCD, r = nwg % NXCD, xcd = wgid % NXCD, off = wgid / NXCD; wgid = (xcd < r ? xcd * (q + 1) : r * (q + 1) + (xcd - r) * q) + off; }
    const int nig = WGM * nN, gid = wgid / nig, fm = gid * WGM, gsz = (nM - fm) < WGM ? (nM - fm) : WGM;
    pm = fm + ((wgid % nig) % gsz); pn = (wgid % nig) / gsz; return true;
}

typedef float cvt_f32x2_t __attribute__((ext_vector_type(2))); typedef __bf16 cvt_bf16x2_t __attribute__((ext_vector_type(2)));
__device__ __forceinline__ unsigned cvt_pk_bf16(float lo, float hi) { const cvt_f32x2_t v = {lo, hi}; const cvt_bf16x2_t b = __builtin_convertvector(v, cvt_bf16x2_t); return __builtin_bit_cast(unsigned, b); }

typedef int v8i_t __attribute__((ext_vector_type(8)));
typedef int v4i_t __attribute__((ext_vector_type(4)));
template <class Epi, class Sched, bool ALIGN_EPI, bool FP8 = false>
__device__ __forceinline__ void gemm_phase(PG8_LAS unsigned char* lds, const int K_, const Sched& S, const Epi& E, const int wid) {
    int K = K_; asm volatile("" : "+s"(K));
    const int lane = lane_id_asm(), tid = wid * 64 + lane, wr = wid >> 2, wc = wid & 3, fr = lane & 15, fq = lane >> 4;
    const int nt = K / BK;
    int R[2], C[2]; unsigned voffB[2], vA[2][2];
    const size_t kstep = (size_t)(BK * 2);
    const size_t hstep = (size_t)HALF * K * 2;
#pragma unroll
    for (int i = 0; i < 2; ++i) { stage_rc(tid * 16 + i * 8192, R[i], C[i]); const int Rb = Epi::PERM ? ((R[i] & ~31) + perm32(R[i] & 31)) : R[i];
        voffB[i] = (unsigned)(Rb * K + C[i]) * 2u; vA[0][i] = (unsigned)(R[i] * K + C[i]) * 2u; vA[1][i] = vA[0][i] + (unsigned)hstep; }
    const unsigned ldsw = (unsigned)wid * 1024u;
    const int aoff = lds_byte(wr * 64 + fr, fq * 8), boff = lds_byte(wc * 32 + fr, fq * 8);
#define PG8_SA(b, h) (((b) * 2 + (h)) * HTB)
#define PG8_SB(b, h) ((4 + (b) * 2 + (h)) * HTB)
#define PG8_STAGE(bufoff, gbase, voff) do { _Pragma("unroll") for (int _i = 0; _i < 2; ++_i) \
        __builtin_amdgcn_global_load_lds((const unsigned*)((const char*)(gbase) + (voff)[_i]), (PG8_LAS unsigned*)(lds + (bufoff) + ldsw + _i * 8192), 16, 0, 0); } while (0)
#define PG8_LD8(addr) __builtin_shufflevector(*(const PG8_LAS v4i_t*)(addr), *(const PG8_LAS v4i_t*)((addr) + 1024), 0, 1, 2, 3, 4, 5, 6, 7)
#define PG8_LDA(dst, b, h) do { _Pragma("unroll") for (int m = 0; m < 4; ++m) dst[m] = PG8_LD8(lds + PG8_SA(b, h) + aoff + m * 2048); } while (0)
#define PG8_LDB(dst, b, h) do { _Pragma("unroll") for (int n = 0; n < 2; ++n) dst[n] = PG8_LD8(lds + PG8_SB(b, h) + boff + n * 2048); } while (0)
#define PG8_LO(x) __builtin_bit_cast(bf16x8, __builtin_shufflevector((x), (x), 0, 1, 2, 3))
#define PG8_HI(x) __builtin_bit_cast(bf16x8, __builtin_shufflevector((x), (x), 4, 5, 6, 7))
#define PG8_MMA(ai, bj, At, Bt) do { __builtin_amdgcn_s_setprio(1); _Pragma("unroll") for (int m = 0; m < 4; ++m) _Pragma("unroll") for (int n = 0; n < 2; ++n) { \
        if constexpr (FP8) asm volatile("v_mfma_scale_f32_16x16x128_f8f6f4 %0, %1, %2, %0, %3, %4 op_sel_hi:[0,0,0]" : "+v"(acc[ai][bj][m][n]) : "v"(Bt[n]), "v"(At[m]), "v"(wscale_r), "v"(ascale_r)); \
        else { acc[ai][bj][m][n] = __builtin_amdgcn_mfma_f32_16x16x32_bf16(PG8_LO(Bt[n]), PG8_LO(At[m]), acc[ai][bj][m][n], 0, 0, 0); \
               acc[ai][bj][m][n] = __builtin_amdgcn_mfma_f32_16x16x32_bf16(PG8_HI(Bt[n]), PG8_HI(At[m]), acc[ai][bj][m][n], 0, 0, 0); } } __builtin_amdgcn_s_setprio(0); } while (0)
#define PG8_WAIT_V(n) asm volatile("s_waitcnt vmcnt(" #n ")" ::: "memory")
#define PG8_WAIT_L(n) asm volatile("s_waitcnt lgkmcnt(" #n ")" ::: "memory")
#define PG8_BAR __builtin_amdgcn_s_barrier()
#define PG8_SCHED __builtin_amdgcn_sched_barrier(0)
    Unit cur, nxt; int ui = 0;
    if (!S.next(0, cur)) return;
    if constexpr (Sched::GATHER) S.a_offsets(cur, R, C, K, vA);
    f32x4 acc[2][2][4][2];
#pragma unroll
    for (int a = 0; a < 2; ++a)
#pragma unroll
        for (int b = 0; b < 2; ++b)
#pragma unroll
            for (int m = 0; m < 4; ++m)
#pragma unroll
                for (int n = 0; n < 2; ++n) acc[a][b][m][n] = (f32x4){0.f, 0.f, 0.f, 0.f};
    int wscale_r = 0x79797979, ascale_r = 0x7f7f7f7f;
    asm volatile("" : "+v"(wscale_r), "+v"(ascale_r));
    v8i_t At[4], B0[2], B1[2];
    const char* cA = cur.a; const char* cB = cur.b;
    PG8_STAGE(PG8_SB(0, 0), cB, voffB); PG8_STAGE(PG8_SB(0, 1), cB + hstep, voffB); PG8_STAGE(PG8_SA(0, 0), cA, vA[0]); PG8_STAGE(PG8_SA(0, 1), cA, vA[1]);
    if (wr == 1) PG8_BAR;
    PG8_WAIT_V(2); PG8_BAR;
    PG8_STAGE(PG8_SB(1, 0), cB + kstep, voffB); PG8_STAGE(PG8_SA(1, 0), cA + kstep, vA[0]); PG8_STAGE(PG8_SB(1, 1), cB + hstep + kstep, voffB);
    PG8_WAIT_V(6); PG8_BAR;
    for (;;) {
        const bool has_next = S.next(ui + 1, nxt);
        const char* nA = has_next ? nxt.a : cA; const char* nB = has_next ? nxt.b : cB;
#pragma unroll 1
        for (int t = 0; t < nt; t += 2) {
            const bool last = (t == nt - 2);
            const char* a1 = cA + (size_t)(t + 1) * kstep;
            const char* a2 = last ? nA : cA + (size_t)(t + 2) * kstep; const char* b2 = last ? nB : cB + (size_t)(t + 2) * kstep;
            const char* a3 = a2 + kstep; const char* b3 = b2 + kstep;
            PG8_LDB(B0, 0, 0); PG8_LDB(B1, 0, 1); PG8_SCHED; PG8_LDA(At, 0, 0); PG8_STAGE(PG8_SA(1, 1), a1, vA[1]);
            if constexpr (Sched::GATHER) { if (last && has_next) S.a_offsets(nxt, R, C, K, vA); }
            PG8_WAIT_V(8); PG8_WAIT_L(0); PG8_BAR; PG8_MMA(0, 0, At, B0); PG8_MMA(0, 1, At, B1); PG8_BAR; PG8_SCHED;
            PG8_LDA(At, 0, 1); PG8_STAGE(PG8_SB(0, 0), b2, voffB); PG8_STAGE(PG8_SB(0, 1), b2 + hstep, voffB); PG8_STAGE(PG8_SA(0, 0), a2, vA[0]);
            PG8_WAIT_V(8); PG8_WAIT_L(0); PG8_BAR; PG8_MMA(1, 0, At, B0); PG8_MMA(1, 1, At, B1); PG8_BAR; PG8_SCHED;
            PG8_LDB(B0, 1, 0); PG8_LDB(B1, 1, 1); PG8_SCHED; PG8_LDA(At, 1, 0); PG8_STAGE(PG8_SA(0, 1), a2, vA[1]);
            PG8_WAIT_V(8); PG8_WAIT_L(0); PG8_BAR; PG8_MMA(0, 0, At, B0); PG8_MMA(0, 1, At, B1); PG8_BAR; PG8_SCHED;
            PG8_LDA(At, 1, 1); PG8_STAGE(PG8_SB(1, 0), b3, voffB); PG8_STAGE(PG8_SB(1, 1), b3 + hstep, voffB); PG8_STAGE(PG8_SA(1, 0), a3, vA[0]);
            PG8_WAIT_V(8); PG8_WAIT_L(0); PG8_BAR; PG8_MMA(1, 0, At, B0); PG8_MMA(1, 1, At, B1); PG8_BAR; PG8_SCHED;
        }
        if constexpr (ALIGN_EPI) { if (wr == 0) PG8_BAR; }
        if constexpr (FP8) asm volatile("s_nop 15\n\ts_nop 7" ::: "memory");
        E(acc, cur, wr, wc, fr, fq);
        if (!has_next) break;
#pragma unroll
        for (int a = 0; a < 2; ++a)
#pragma unroll
            for (int b = 0; b < 2; ++b)
#pragma unroll
                for (int m = 0; m < 4; ++m)
#pragma unroll
                    for (int n = 0; n < 2; ++n) acc[a][b][m][n] = (f32x4){0.f, 0.f, 0.f, 0.f};
        cur = nxt; cA = nA; cB = nB; ++ui;
        if constexpr (ALIGN_EPI) { if (wr == 1) PG8_BAR; }
    }
    PG8_WAIT_V(0);
    if constexpr (!ALIGN_EPI) { if (wr == 0) PG8_BAR; }
    PG8_BAR;
#undef PG8_SA
#undef PG8_SB
#undef PG8_STAGE
#undef PG8_LDA
#undef PG8_LDB
#undef PG8_MMA
#undef PG8_LO
#undef PG8_HI
#undef PG8_LD8
#undef PG8_WAIT_V
#undef PG8_WAIT_L
#undef PG8_BAR
#undef PG8_SCHED
}

struct DenseSched {
    static constexpr bool GATHER = false;
    const char* A; const char* Bt; int K, nM, nN, G, c;
    __device__ __forceinline__ bool next(int i, Unit& u) const {
        int pm, pn; if (!static_order(i * G + c, nM, nN, pm, pn)) return false;
        u.pm = pm; u.pn = pn; u.a = A + (size_t)pm * BM * K * 2; u.b = Bt + (size_t)pn * BM * K * 2; u.li = i; u.ex = 0; return true;
    }
    __device__ __forceinline__ void a_offsets(const Unit&, const int (&)[2], const int (&)[2], int, unsigned (&)[2][2]) const {}
};
struct QkvSched {
    static constexpr bool GATHER = false;
    const char* A; const char* Bt; int G, c, kb;
    __device__ __forceinline__ bool next(int i, Unit& u) const {
        const int L = i * G + c; int pm, pn;
        if (L < 1536) { static_order(L, 128, 12, pm, pn); }
        else { const int l2 = L - 1536; if (l2 >= 64) return false; pm = 128 + (l2 >> 3); pn = 4 + (l2 & 7); }
        u.pm = pm; u.pn = pn; u.a = A + (size_t)pm * BM * kb; u.b = Bt + (size_t)pn * BM * kb; u.li = i; u.ex = 0; return true;
    }
    __device__ __forceinline__ void a_offsets(const Unit&, const int (&)[2], const int (&)[2], int, unsigned (&)[2][2]) const {}
};
struct MoeSchedBase {
    const volatile PG8_LAS int* tpre;
    int G, c;
    __device__ __forceinline__ bool locate(int i, int& rt, int& pn, int& e) const {
        const int L = i * G + c; const int ntile = tpre[16];
        if (L >= 4 * ntile) return false;
        rt = L >> 2; pn = L & 3; int ee = 0;
#pragma unroll
        for (int j = 1; j < 16; ++j) ee += (rt >= tpre[j]) ? 1 : 0;
        e = ee; return true;
    }
};
struct MoeUpSched : MoeSchedBase {
    static constexpr bool GATHER = true;
    const char* A; const char* Wgu; const PG8_LAS int* permL; int kb;
    __device__ __forceinline__ bool next(int i, Unit& u) const {
        int rt, pn, e; if (!locate(i, rt, pn, e)) return false;
        u.pm = rt; u.pn = pn; u.a = A; u.b = Wgu + (size_t)e * 1024 * kb + (size_t)pn * BM * kb; u.li = i; u.ex = e; return true;
    }
    __device__ __forceinline__ void a_offsets(const Unit& u, const int (&R)[2], const int (&C)[2], int K, unsigned (&vA)[2][2]) const {
#pragma unroll
        for (int h = 0; h < 2; ++h)
#pragma unroll
            for (int i = 0; i < 2; ++i) vA[h][i] = (unsigned)permL[u.li * 256 + h * HALF + R[i]] * (unsigned)(K * 2) + (unsigned)(C[i] * 2);
    }
};
struct MoeDownSched : MoeSchedBase {
    static constexpr bool GATHER = false;
    const char* A; const char* Wdn; int kb;
    __device__ __forceinline__ bool next(int i, Unit& u) const {
        int rt, pn, e; if (!locate(i, rt, pn, e)) return false;
        u.pm = rt; u.pn = pn; u.a = A + (size_t)rt * BM * kb; u.b = Wdn + (size_t)e * 1024 * kb + (size_t)pn * BM * kb; u.li = i; u.ex = e; return true;
    }
    __device__ __forceinline__ void a_offsets(const Unit&, const int (&)[2], const int (&)[2], int, unsigned (&)[2][2]) const {}
};

template <bool HAS_BIAS> struct EpiBf16T {
    static constexpr bool PERM = true;
    bf16_t* O; int ldc; const float* bias;
    __device__ __forceinline__ void operator()(const f32x4 (&acc)[2][2][4][2], const Unit& u, int wr, int wc, int fr, int fq) const {
        const int row0 = u.pm * BM + wr * 64 + fr, col0 = u.pn * BM + wc * 32 + 8 * fq;
        f32x4 bv[2][2];
#pragma unroll
        for (int bj = 0; bj < 2; ++bj)
#pragma unroll
            for (int n = 0; n < 2; ++n) bv[bj][n] = HAS_BIAS ? *(const f32x4*)(bias + col0 + bj * HALF + 4 * n) : (f32x4){0.f, 0.f, 0.f, 0.f};
#pragma unroll
        for (int ai = 0; ai < 2; ++ai)
#pragma unroll
            for (int m = 0; m < 4; ++m) { bf16_t* rowp = O + (size_t)(row0 + ai * HALF + m * 16) * ldc + col0;
#pragma unroll
                for (int bj = 0; bj < 2; ++bj) { f32x4 v0 = acc[ai][bj][m][0], v1 = acc[ai][bj][m][1]; if constexpr (HAS_BIAS) { v0 += bv[bj][0]; v1 += bv[bj][1]; }
                    u32x4 w; w.x = cvt_pk_bf16(v0[0], v0[1]); w.y = cvt_pk_bf16(v0[2], v0[3]); w.z = cvt_pk_bf16(v1[0], v1[1]); w.w = cvt_pk_bf16(v1[2], v1[3]);
                    *(u32x4*)(rowp + bj * HALF) = w; } }
    }
};
typedef EpiBf16T<true> EpiBf16B; typedef EpiBf16T<false> EpiBf16;
struct EpiF8 {
    static constexpr bool PERM = true;
    unsigned char* O; int ldc;
    __device__ __forceinline__ void operator()(const f32x4 (&acc)[2][2][4][2], const Unit& u, int wr, int wc, int fr, int fq) const {
        const int row0 = u.pm * BM + wr * 64 + fr, col0 = u.pn * BM + wc * 32 + 8 * fq;
#pragma unroll
        for (int ai = 0; ai < 2; ++ai)
#pragma unroll
            for (int m = 0; m < 4; ++m) { unsigned char* rowp = O + (size_t)(row0 + ai * HALF + m * 16) * ldc + col0;
#pragma unroll
                for (int bj = 0; bj < 2; ++bj) { const f32x4 v0 = acc[ai][bj][m][0], v1 = acc[ai][bj][m][1];
                    *(unsigned long long*)(rowp + bj * HALF) = (unsigned long long)pk4_fp8(v0[0], v0[1], v0[2], v0[3]) | ((unsigned long long)pk4_fp8(v1[0], v1[1], v1[2], v1[3]) << 32); } }
    }
};
template <int MODE  , bool OUT8 = false  > struct EpiGated {
    static constexpr bool PERM = true;
    bf16_t* O; int ldc; const float* bias; int nch;
    __device__ __forceinline__ void operator()(const f32x4 (&acc)[2][2][4][2], const Unit& u, int wr, int wc, int fr, int fq) const {
        const int row0 = u.pm * BM + wr * 64 + fr, ch0 = u.pn * HALF + wc * 32 + 8 * fq;
        f32x4 b0[2], b1[2];
#pragma unroll
        for (int n = 0; n < 2; ++n) { if (MODE == 0) { b0[n] = *(const f32x4*)(bias + ch0 + 4 * n); b1[n] = *(const f32x4*)(bias + nch + ch0 + 4 * n); } else { b0[n] = (f32x4){0.f, 0.f, 0.f, 0.f}; b1[n] = b0[n]; } }
#pragma unroll
        for (int ai = 0; ai < 2; ++ai)
#pragma unroll
            for (int m = 0; m < 4; ++m) { bf16_t* rowp = O + (size_t)(row0 + ai * HALF + m * 16) * ldc + ch0; float o[8];
#pragma unroll
                for (int n = 0; n < 2; ++n) { const f32x4 x0 = acc[ai][0][m][n] + b0[n], x1 = acc[ai][1][m][n] + b1[n];
#pragma unroll
                    for (int e = 0; e < 4; ++e) o[4 * n + e] = (MODE == 0) ? x0[e] * fast_sigmoid(x1[e]) : (x0[e] * fast_sigmoid(x0[e])) * x1[e]; }
                if constexpr (OUT8) { unsigned char* rp8 = (unsigned char*)O + (size_t)(row0 + ai * HALF + m * 16) * ldc + ch0;
                    *(unsigned long long*)rp8 = (unsigned long long)pk4_fp8(o[0], o[1], o[2], o[3]) | ((unsigned long long)pk4_fp8(o[4], o[5], o[6], o[7]) << 32); }
                else { u32x4 w; w.x = cvt_pk_bf16(o[0], o[1]); w.y = cvt_pk_bf16(o[2], o[3]); w.z = cvt_pk_bf16(o[4], o[5]); w.w = cvt_pk_bf16(o[6], o[7]);
                    *(u32x4*)rowp = w; } }
    }
};
struct EpiQkv {
    static constexpr bool PERM = true;
    bf16_t* Q; bf16_t* Kh; bf16_t* Vb; float qscale;
    __device__ __forceinline__ void operator()(const f32x4 (&acc)[2][2][4][2], const Unit& u, int wr, int wc, int fr, int fq) const {
        const int which = u.pn >> 2; const bool isctx = u.pm >= 128;
        const int b = isctx ? (u.pm - 128) : (u.pm >> 4);
        const int key0 = isctx ? SEQ : ((u.pm & 15) << 8);
        const int d0 = 32 * (wc & 1) + 8 * fq;
#pragma unroll
        for (int ai = 0; ai < 2; ++ai)
#pragma unroll
            for (int m = 0; m < 4; ++m) { const int key = key0 + ai * HALF + wr * 64 + m * 16 + fr;
#pragma unroll
                for (int bj = 0; bj < 2; ++bj) { const int h = 4 * (u.pn & 3) + 2 * bj + (wc >> 1); const f32x4 v0 = acc[ai][bj][m][0], v1 = acc[ai][bj][m][1];
                    if (which == 2) {
                        bf16_t* p = Vb + ((size_t)(b * NH + h) * (KSLOT / 8) + (key >> 3)) * 512 + (size_t)d0 * 8 + (key & 7);
                        const unsigned w0 = cvt_pk_bf16(v0[0], v0[1]), w1 = cvt_pk_bf16(v0[2], v0[3]), w2 = cvt_pk_bf16(v1[0], v1[1]), w3 = cvt_pk_bf16(v1[2], v1[3]);
                        p[0] = (bf16_t)w0; p[8] = (bf16_t)(w0 >> 16); p[16] = (bf16_t)w1; p[24] = (bf16_t)(w1 >> 16); p[32] = (bf16_t)w2; p[40] = (bf16_t)(w2 >> 16); p[48] = (bf16_t)w3; p[56] = (bf16_t)(w3 >> 16);
                    } else {
                        const float qs = (which == 0) ? qscale : 1.0f; const f32x4 y0 = v0 * qs, y1 = v1 * qs;
                        u32x4 w; w.x = cvt_pk_bf16(y0[0], y0[1]); w.y = cvt_pk_bf16(y0[2], y0[3]); w.z = cvt_pk_bf16(y1[0], y1[1]); w.w = cvt_pk_bf16(y1[2], y1[3]);
                        bf16_t* p = (which == 0) ? Q + ((size_t)(b * NH + h) * SEQ + key) * HD + d0 : Kh + ((size_t)(b * NH + h) * KSLOT + key) * HD + d0;
                        *(u32x4*)p = w;
                    } } }
    }
};
}
#define XB_TMO      128
#define XB_XCNT(j)  (256  + 64 * (j))
#define XB_XSUB(j)  (1280 + 64 * (j))
#define XB_XGEN(j)  (2304 + 64 * (j))
#define XB_TOP      3328
#define XB_TOPGEN   3392
#define XCD_BAR_WORDS 3456
#define XB_SPIN_CAP (1u << 18)

__device__ __forceinline__ unsigned xb_ld(unsigned* p)              { return __hip_atomic_load(p, __ATOMIC_RELAXED, __HIP_MEMORY_SCOPE_AGENT); }
__device__ __forceinline__ unsigned xb_add(unsigned* p, unsigned v) { return __hip_atomic_fetch_add(p, v, __ATOMIC_RELAXED, __HIP_MEMORY_SCOPE_AGENT); }
__device__ __forceinline__ unsigned xb_xcc_id() { return (unsigned)__builtin_amdgcn_s_getreg((3 << 11) | 20) & 0xFu; }
#define XB_SPIN(cond, bar) do { unsigned _sp = 0; while (cond) { __builtin_amdgcn_s_sleep(1); \
    if ((++_sp & 255u) == 0u) { if (xb_ld(&(bar)[XB_TMO])) break; if (_sp > XB_SPIN_CAP) { atomicAdd(&(bar)[XB_TMO], 1u); break; } } } } while (0)

struct XcdBarrier {
    unsigned* bar; unsigned x;
    volatile LAS unsigned* st;
};

__device__ __forceinline__ XcdBarrier xcd_barrier_post(unsigned* bar, volatile LAS unsigned* st) {
    XcdBarrier b; b.bar = bar; b.x = xb_xcc_id(); b.st = st;
    if (threadIdx.x == 0) (void)xb_add(&bar[XB_XCNT(b.x)], 1u);
    return b;
}
__device__ __forceinline__ void xcd_barrier_complete(unsigned* bar, unsigned x, unsigned& nloc, unsigned& nx) {
    const unsigned G = gridDim.x * gridDim.y * gridDim.z;
    unsigned sum, cnt, mine, sp = 0u;
    for (;;) {
        sum = 0u; cnt = 0u; mine = 0u;
#pragma unroll
        for (unsigned j = 0; j < 16; ++j) { const unsigned c = xb_ld(&bar[XB_XCNT(j)]); sum += c; cnt += (c > 0u) ? 1u : 0u; mine = (j == x) ? c : mine; }
        if (sum == G) break;
        __builtin_amdgcn_s_sleep(1);
        if ((++sp & 255u) == 0u) { if (xb_ld(&bar[XB_TMO])) break; if (sp > XB_SPIN_CAP) { atomicAdd(&bar[XB_TMO], 1u); break; } }
    }
    nloc = mine > 0u ? mine : 1u; nx = cnt > 0u ? cnt : 1u;
}

__device__ __forceinline__ void xcd_barrier(const XcdBarrier& b) {
    asm volatile("s_waitcnt vmcnt(0)" ::: "memory");
    __syncthreads();
    if (threadIdx.x == 0) {
        unsigned* bar = b.bar;
        __builtin_amdgcn_s_waitcnt(0);
        unsigned nloc = b.st[0], nx = b.st[1];
        if (nloc == 0u) { xcd_barrier_complete(bar, b.x, nloc, nx); b.st[0] = nloc; b.st[1] = nx; }
        const unsigned old = xb_add(&bar[XB_XSUB(b.x)], 1u);
        const unsigned gen = old / nloc;
        if (old + 1u == (gen + 1u) * nloc) {
            __builtin_amdgcn_fence(__ATOMIC_RELEASE, "agent");
            asm volatile("s_waitcnt vmcnt(0)" ::: "memory");
            const unsigned og = xb_add(&bar[XB_TOP], 1u);
            const unsigned tg = og / nx;
            if (og + 1u == (tg + 1u) * nx) xb_add(&bar[XB_TOPGEN], 1u);
            else XB_SPIN(xb_ld(&bar[XB_TOPGEN]) == tg, bar);
            __builtin_amdgcn_fence(__ATOMIC_ACQUIRE, "agent");
            xb_add(&bar[XB_XGEN(b.x)], 1u);
            asm volatile("s_waitcnt vmcnt(0)" ::: "memory");
        } else {
            XB_SPIN(xb_ld(&bar[XB_XGEN(b.x)]) == gen, bar);
            __builtin_amdgcn_fence(__ATOMIC_ACQUIRE, "agent");
            asm volatile("s_waitcnt vmcnt(0)" ::: "memory");
        }
    }
    __syncthreads();
}

struct Frame {
    LAS unsigned char* lds;
    volatile LAS unsigned* MISC;
    gu32* ctl;
    int wave, G, bid;
    __device__ __forceinline__ const float* in(int k) const { const volatile LAS unsigned* t = (const volatile LAS unsigned*)(lds + PTAB_OFF) + 2 * k;
        const unsigned lo = __builtin_amdgcn_readfirstlane(t[0]), hi = __builtin_amdgcn_readfirstlane(t[1]); return (const float*)(const GAS float*)(((unsigned long long)hi << 32) | lo); }
    __device__ __forceinline__ int lane() const { return lane_id_asm(); }
    __device__ __forceinline__ int tid() const { return wave * 64 + lane_id_asm(); }
    unsigned char* ws;
    float* out;
};

__device__ __forceinline__ void ld_row_f32(const float* row, int lane, f32x4 (&v)[4]) {
    const f32x4* p = (const f32x4*)row + lane;
#pragma unroll
    for (int j = 0; j < 4; ++j) v[j] = p[64 * j];
}
__device__ __forceinline__ void st_row_f32(float* row, int lane, const f32x4 (&v)[4]) {
    f32x4* p = (f32x4*)row + lane;
#pragma unroll
    for (int j = 0; j < 4; ++j) p[64 * j] = v[j];
}
__device__ __forceinline__ void ld_row_bf16(const bf16* row, int lane, f32x4 (&v)[4]) {
    const v2u* p = (const v2u*)row + lane;
#pragma unroll
    for (int j = 0; j < 4; ++j) { const v2u w = p[64 * j]; v[j] = (f32x4){bflo(w.x), bfhi(w.x), bflo(w.y), bfhi(w.y)}; }
}
__device__ __forceinline__ void ld_raw_bf16(const bf16* row, int lane, v2u (&w)[4]) {
    const v2u* p = (const v2u*)row + lane;
#pragma unroll
    for (int j = 0; j < 4; ++j) w[j] = p[64 * j];
}
__device__ __forceinline__ void unpack_bf16(const v2u (&w)[4], f32x4 (&v)[4]) {
#pragma unroll
    for (int j = 0; j < 4; ++j) { const unsigned a = w[j].x, b = w[j].y; v[j] = (f32x4){bflo(a), bfhi(a), bflo(b), bfhi(b)}; }
}
__device__ __forceinline__ void ld_raw_fp8(const unsigned char* row, int lane, unsigned (&w)[4]) {
    const unsigned* p = (const unsigned*)row + lane;
#pragma unroll
    for (int j = 0; j < 4; ++j) w[j] = p[64 * j];
}
__device__ __forceinline__ void unpack_fp8(const unsigned (&w)[4], f32x4 (&v)[4]) {
    typedef float f2_t __attribute__((ext_vector_type(2)));
#pragma unroll
    for (int j = 0; j < 4; ++j) { const f2_t lo = __builtin_amdgcn_cvt_pk_f32_fp8((int)w[j], false), hi = __builtin_amdgcn_cvt_pk_f32_fp8((int)w[j], true); v[j] = (f32x4){lo[0], lo[1], hi[0], hi[1]}; }
}
__device__ __forceinline__ void st_row_bf16(bf16* row, int lane, const f32x4 (&v)[4]) {
    v2u* p = (v2u*)row + lane;
#pragma unroll
    for (int j = 0; j < 4; ++j) { v2u w; w.x = pk2(v[j][0], v[j][1]); w.y = pk2(v[j][2], v[j][3]); p[64 * j] = w; }
}
__device__ __forceinline__ void st_row_fp8(unsigned char* row, int lane, const f32x4 (&v)[4]) {
    unsigned* p = (unsigned*)row + lane;
#pragma unroll
    for (int j = 0; j < 4; ++j) p[64 * j] = pk4_fp8(v[j][0], v[j][1], v[j][2], v[j][3]);
}
__device__ __forceinline__ float sumsq4(const f32x4 (&v)[4]) {
    float s = 0.f;
#pragma unroll
    for (int j = 0; j < 4; ++j) s += (v[j][0] * v[j][0] + v[j][1] * v[j][1]) + (v[j][2] * v[j][2] + v[j][3] * v[j][3]);
    return s;
}
__device__ __forceinline__ void ld_mod(const Frame& F, int l, int r, int ch, f32x4 (&v)[4]) {
    const float* modp = (const float*)(F.ws + WS_MODP); const int lane = F.lane();
    ld_row_f32(F.in(5) + (size_t)l * NMODC + ch * D, lane, v);
#pragma unroll
    for (int kc = 0; kc < MODKC; ++kc) { f32x4 t[4]; ld_row_f32(modp + ((size_t)((kc * 2 + l) * NMODR + r)) * NMODC + ch * D, lane, t);
#pragma unroll
        for (int j = 0; j < 4; ++j) v[j] += t[j]; }
}
__device__ __forceinline__ int row_batch(int m) { return m < NLAT ? (m >> 12) : 8; }

__device__ __forceinline__ void p0_transpose_item(const float* W, int K, int N, bf16* WT, int drow_off, LAS float* scr, int item, int lane) {
    const int nblk = N / 32, kb = item / nblk, nb = item % nblk, k0 = 64 * kb, n0 = 32 * nb;
#pragma unroll 8
    for (int i = 0; i < 32; ++i) { const int kk = 2 * i + (lane >> 5); scr[kk * 33 + (lane & 31)] = W[(size_t)(k0 + kk) * N + n0 + (lane & 31)]; }
    LDS_WAIT(); asm volatile("" ::: "memory");
    const int c = lane & 7;
#pragma unroll
    for (int j = 0; j < 4; ++j) { const int n = (lane >> 3) + 8 * j; const LAS float* s = scr + (8 * c) * 33 + n;
        v4u o; o.x = pk2(s[0 * 33], s[1 * 33]); o.y = pk2(s[2 * 33], s[3 * 33]); o.z = pk2(s[4 * 33], s[5 * 33]); o.w = pk2(s[6 * 33], s[7 * 33]);
        *(GAS v4u*)(WT + (size_t)(drow_off + n0 + n) * K + k0 + 8 * c) = o; }
    LDS_WAIT(); asm volatile("" ::: "memory");
}
__device__ __forceinline__ void p0_transpose_item_fp8(const float* W, int K, int N, unsigned char* WT, int drow_off, float wscale, LAS float* scr, int item, int lane) {
    const int nblk = N / 32, kb = item / nblk, nb = item % nblk, k0 = 64 * kb, n0 = 32 * nb;
#pragma unroll 8
    for (int i = 0; i < 32; ++i) { const int kk = 2 * i + (lane >> 5); scr[kk * 33 + (lane & 31)] = W[(size_t)(k0 + kk) * N + n0 + (lane & 31)] * wscale; }
    LDS_WAIT(); asm volatile("" ::: "memory");
    const int c = lane & 3;
#pragma unroll
    for (int j = 0; j < 2; ++j) { const int n = (lane >> 2) + 16 * j; const LAS float* s = scr + (16 * c) * 33 + n;
        v4u o; o.x = pk4_fp8(s[0 * 33], s[1 * 33], s[2 * 33], s[3 * 33]); o.y = pk4_fp8(s[4 * 33], s[5 * 33], s[6 * 33], s[7 * 33]);
        o.z = pk4_fp8(s[8 * 33], s[9 * 33], s[10 * 33], s[11 * 33]); o.w = pk4_fp8(s[12 * 33], s[13 * 33], s[14 * 33], s[15 * 33]);
        *(GAS v4u*)(WT + (size_t)(drow_off + n0 + n) * K + k0 + 16 * c) = o; }
    LDS_WAIT(); asm volatile("" ::: "memory");
}
constexpr float W8SCALE = 64.0f;
constexpr int I_WIN = 1024, I_WOUT = 512, I_WQKV = 1536, I_WO = 512, I_EXP = 32 * 768, I_NONEXP = I_WIN + I_WOUT + I_WQKV + I_WO, NITEMS_P0 = I_NONEXP + I_EXP;
__device__ __forceinline__ void p0_item(const Frame& F, LAS float* scr, int it) {
    int r = it; const int lane = F.lane();
    if (r < I_WIN) { const int n0 = 32 * (r % 64), ch = n0 & 1023, hf = n0 >> 10, drow0 = 256 * (ch >> 7) + 128 * hf + (ch & 127);
        p0_transpose_item_fp8(F.in(10), D, 2 * D, (unsigned char*)(F.ws + WS_WIN), drow0 - n0, W8SCALE, scr, r, lane); return; }
    r -= I_WIN;
    if (r < I_WOUT) { p0_transpose_item_fp8(F.in(16), D, D, (unsigned char*)(F.ws + WS_WOUT), 0, W8SCALE, scr, r, lane); return; }
    r -= I_WOUT;
    if (r < I_WQKV) { p0_transpose_item_fp8(F.in(18), D, 3 * D, (unsigned char*)(F.ws + WS_WQKV), 0, W8SCALE, scr, r, lane); return; }
    r -= I_WQKV;
    if (r < I_WO) { p0_transpose_item_fp8(F.in(19), D, D, (unsigned char*)(F.ws + WS_WO), 0, W8SCALE, scr, r, lane); return; }
    r -= I_WO;
    const int le = r / 768; int q = r % 768;
    if (q < 512) { const bool up = q >= 256; if (up) q -= 256; const int n0 = 32 * (q % 16), drow0 = 256 * (n0 >> 7) + (up ? 128 : 0) + (n0 & 127);
        p0_transpose_item_fp8((up ? F.in(24) : F.in(23)) + (size_t)le * D * DE, D, DE, (unsigned char*)(F.ws + WS_WGU) + (size_t)le * 1024 * 1024, drow0 - n0, W8SCALE, scr, q, lane); return; }
    q -= 512;
    p0_transpose_item_fp8(F.in(25) + (size_t)le * DE * D, DE, D, (unsigned char*)(F.ws + WS_WDN) + (size_t)le * 1024 * 512, 0, W8SCALE, scr, q, lane);
}
__device__ __forceinline__ void p0_mod_item(const Frame& F, LAS float* scr, int it) {
    const int lane = F.lane(), l = it / 192, rem = it % 192, cg = rem >> 3, kc = rem & 7, k0 = 128 * kc, n0 = 256 * cg + 4 * lane;
    const float* cvec = F.in(1); const float* cctx = F.in(3);
    for (int idx = lane; idx < NMODR * 128; idx += 64) { const int r = idx >> 7, kk = idx & 127; const float cv = (r < 8) ? cvec[r * D + k0 + kk] : cctx[k0 + kk];
        scr[idx] = cv / (1.0f + __expf(-cv)); }
    LDS_WAIT(); asm volatile("" ::: "memory");
    f32x4 acc[NMODR];
#pragma unroll
    for (int r = 0; r < NMODR; ++r) acc[r] = (f32x4){0.f, 0.f, 0.f, 0.f};
    const float* wp = F.in(4) + ((size_t)l * D + k0) * NMODC + n0;
#pragma unroll 8
    for (int kk = 0; kk < 128; ++kk) { const f32x4 w = *(const f32x4*)(wp + (size_t)kk * NMODC);
#pragma unroll
        for (int r = 0; r < NMODR; ++r) { const float s = scr[r * 128 + kk]; acc[r] += w * s; } }
    float* modp = (float*)(F.ws + WS_MODP);
#pragma unroll
    for (int r = 0; r < NMODR; ++r) *(f32x4*)(modp + ((size_t)((kc * 2 + l) * NMODR + r)) * NMODC + n0) = acc[r];
    LDS_WAIT(); asm volatile("" ::: "memory");
}
__device__ __forceinline__ void p0_prologue(const Frame& F) {
    LAS float* scr = (LAS float*)(F.lds + F.wave * 16384);
    if (F.wave == 0) p0_mod_item(F, scr, F.bid);
    if (F.wave == 1 && F.bid < 128) p0_mod_item(F, scr, 256 + F.bid);
    const int gw = F.bid * NWAVES + F.wave, NGW = F.G * NWAVES;
    for (int it = gw; it < I_NONEXP; it += NGW) p0_item(F, scr, it);
}
constexpr int JOB_ITEMS = 16 * 768;
__device__ __forceinline__ void filler(const Frame& F, int job, int quota) {
    LAS float* scr = (LAS float*)(F.lds + F.wave * 16384);
    volatile LAS int* slot = (volatile LAS int*)(F.MISC + 60);
    const int lane = F.lane();
    for (;;) {
        __syncthreads();
        if (F.wave == 0 && lane == 0) *slot = (int)__hip_atomic_fetch_add((unsigned*)(F.ctl + CW_JOB + 64 * job), 8u, RLX_AGENT);
        __syncthreads();
        const int base = *slot;
        if (base >= quota) { if (F.wave == 0 && lane == 0) (void)__hip_atomic_fetch_sub((unsigned*)(F.ctl + CW_JOB + 64 * job), 8u, RLX_AGENT); break; }
        const int idx = base + F.wave;
        if (idx < JOB_ITEMS) p0_item(F, scr, I_NONEXP + job * JOB_ITEMS + idx);
    }
}

__device__ __forceinline__ void p1_modulate(const Frame& F) {
    constexpr int RPB = MT / 256;
    unsigned char* H = (unsigned char*)(F.ws + WS_A);
    int rc = -1; f32x4 gs[4], sh[4]; const int lane = F.lane();
    const float* xlat = F.in(0); const float* xctx = F.in(2);
    f32x4 vn[4];
    { const int m = F.bid * RPB + F.wave; ld_row_f32(m < NLAT ? xlat + (size_t)m * D : xctx + (size_t)(m - NLAT) * D, lane, vn); }
    for (int rl = F.wave; rl < RPB; rl += NWAVES) {
        const int m = F.bid * RPB + rl, r = row_batch(m);
        f32x4 v[4];
#pragma unroll
        for (int j = 0; j < 4; ++j) v[j] = vn[j];
        if (rl + NWAVES < RPB) { const int m2 = m + NWAVES; ld_row_f32(m2 < NLAT ? xlat + (size_t)m2 * D : xctx + (size_t)(m2 - NLAT) * D, lane, vn); }
        if (r != rc) { f32x4 g[4], sc[4]; ld_row_f32(F.in(6), lane, g); ld_mod(F, 0, r, 1, sc); ld_mod(F, 0, r, 0, sh);
#pragma unroll
            for (int j = 0; j < 4; ++j) gs[j] = g[j] * (sc[j] + 1.0f);
            rc = r; }
        const float rstd = 1.0f / sqrtf(wave_sum(sumsq4(v)) * (1.0f / D) + EPS);
#pragma unroll
        for (int j = 0; j < 4; ++j) v[j] = v[j] * rstd * gs[j] + sh[j];
        st_row_fp8(H + (size_t)m * D, lane, v);
    }
}

__device__ __forceinline__ void p3_conv(const Frame& F) {
    const bf16* U = (const bf16*)(F.ws + WS_B); unsigned char* V = (unsigned char*)(F.ws + WS_A);
    const int tid = F.tid(), lane = F.lane();
    f32x2 w[CONVW]; const float* wdw = F.in(12);
#pragma unroll
    for (int j = 0; j < CONVW; ++j) w[j] = *(const f32x2*)(wdw + j * D + 2 * tid);
    const f32x2 bias2 = *(const f32x2*)(F.in(13) + 2 * tid);
    f32x4 lg[4], lb[4]; ld_row_f32(F.in(14), lane, lg); ld_row_f32(F.in(15), lane, lb);
    constexpr int TT = 32, NIN = TT + CONVW - 1;
    for (int tile = F.bid; tile < MT / TT; tile += F.G) {
        int rowbase, t0, T;
        if (tile < NLAT / TT) { rowbase = (tile >> 7) * SEQ; t0 = (tile & 127) * TT; T = SEQ; } else { const int t2 = tile - NLAT / TT; rowbase = NLAT + (t2 >> 3) * CTXL; t0 = (t2 & 7) * TT; T = CTXL; }
        for (int p = tid; p < NIN * 128; p += NTHR) { const int i = p >> 7, cp = p & 127, t = t0 - 15 + i;
            v4u val = (v4u){0u, 0u, 0u, 0u}; if (t >= 0 && t < T) val = *(const v4u*)(U + (size_t)(rowbase + t) * D + cp * 8);
            *(LAS v4u*)(F.lds + i * 2048 + cp * 16) = val; }
        __syncthreads();
        f32x2 res[TT];
#pragma unroll
        for (int g = 0; g < TT / 8; ++g) {
            f32x2 acc[8];
#pragma unroll
            for (int q = 0; q < 8; ++q) acc[q] = bias2;
#pragma unroll
            for (int ii = 0; ii < 8 + CONVW - 1; ++ii) { const int i = 8 * g + ii; const unsigned uw = *(const LAS unsigned*)(F.lds + i * 2048 + tid * 4); const f32x2 uv = (f32x2){bflo(uw), bfhi(uw)};
#pragma unroll
                for (int q = 0; q < 8; ++q) { const int j = ii - q; if (j >= 0 && j < CONVW) acc[q] += w[j] * uv; } }
#pragma unroll
            for (int q = 0; q < 8; ++q) res[8 * g + q] = acc[q];
        }
        __syncthreads();
#pragma unroll
        for (int tt = 0; tt < TT; ++tt) *(LAS f32x2*)(F.lds + tt * 4096 + tid * 8) = res[tt];
        __syncthreads();
#pragma unroll
        for (int q = 0; q < 4; ++q) { const int tt = 4 * F.wave + q; f32x4 v[4];
#pragma unroll
            for (int j = 0; j < 4; ++j) v[j] = *(const LAS f32x4*)(F.lds + tt * 4096 + j * 1024 + lane * 16);
            float s = 0.f;
#pragma unroll
            for (int j = 0; j < 4; ++j) s += (v[j][0] + v[j][1]) + (v[j][2] + v[j][3]);
            const float mean = wave_sum(s) * (1.0f / D);
#pragma unroll
            for (int j = 0; j < 4; ++j) v[j] = v[j] - mean;
            const float rstd = 1.0f / sqrtf(wave_sum(sumsq4(v)) * (1.0f / D) + EPS);
#pragma unroll
            for (int j = 0; j < 4; ++j) { f32x4 y = v[j] * rstd * lg[j] + lb[j];
#pragma unroll
                for (int e = 0; e < 4; ++e) y[e] = y[e] / (1.0f + __expf(-y[e]));
                v[j] = y; }
            st_row_fp8(V + (size_t)(rowbase + t0 + tt) * D, lane, v); }
        __syncthreads();
    }
}

constexpr int RW_OFF = 0, RW_BYTES = 256 * 272;
constexpr int REC_OFF = 72 * 1024;
constexpr int LRK_OFF = REC_OFF + 4096;
constexpr int BASE_OFF = LRK_OFF + 2048;
template <int L, int ABL = 0  >
__device__ __forceinline__ void p_emid(const Frame& F) {
    constexpr int NROWS = (L == 0) ? MT : NLAT, RPB = NROWS / 256;
    const bf16* Y = (const bf16*)(F.ws + (L == 0 ? WS_B : WS_C)); unsigned char* TOK = (unsigned char*)(F.ws + WS_A);
    bf16* XS = (bf16*)(F.ws + WS_B);
    float* XC = (float*)(F.ws + WS_XC);
    const int tid = F.tid(), lane = F.lane(), m0 = F.bid * RPB;
    const float* rwG = F.in(21);
    for (int idx = tid; idx < 4096; idx += NTHR) { const int k = idx >> 2, ep = idx & 3; const f32x4 v = *(const f32x4*)(rwG + k * 16 + ep * 4);
        *(LAS f32x4*)(F.lds + RW_OFF + (k >> 2) * 272 + (k & 3) * 64 + ep * 16) = v; }
    __syncthreads();
    const float rbl = F.in(22)[4 * (lane >> 4) + (lane & 3)];
    int rc = -1; f32x4 ga[4], gp[4], gs[4], sh[4];
    const float* xlat = F.in(0); const float* xctx = F.in(2);
    v2u yn[4]; f32x4 xn[4];
    v2u xbn[4];
    { const int m = m0 + F.wave; ld_raw_bf16(Y + (size_t)m * D, lane, yn);
      if (L == 0) ld_row_f32(m < NLAT ? xlat + (size_t)m * D : xctx + (size_t)(m - NLAT) * D, lane, xn); else ld_raw_bf16(XS + (size_t)m * D, lane, xbn); }
    for (int rl = F.wave; rl < RPB; rl += NWAVES) {
        const int m = m0 + rl, r = row_batch(m);
        f32x4 y[4], xv[4];
        unpack_bf16(yn, y);
        if (L == 0) {
#pragma unroll
            for (int j = 0; j < 4; ++j) xv[j] = xn[j];
        } else unpack_bf16(xbn, xv);
        if (rl + NWAVES < RPB) { const int m2 = m + NWAVES; ld_raw_bf16(Y + (size_t)m2 * D, lane, yn);
            if (L == 0) ld_row_f32(m2 < NLAT ? xlat + (size_t)m2 * D : xctx + (size_t)(m2 - NLAT) * D, lane, xn); else ld_raw_bf16(XS + (size_t)m2 * D, lane, xbn); }
        if (r != rc) { f32x4 g[4], sc[4]; ld_mod(F, L, r, 2, ga); ld_row_f32(F.in(7) + L * D, lane, gp); ld_row_f32(F.in(8) + L * D, lane, g); ld_mod(F, L, r, 4, sc); ld_mod(F, L, r, 3, sh);
#pragma unroll
            for (int j = 0; j < 4; ++j) gs[j] = g[j] * (sc[j] + 1.0f);
            rc = r; }
        const float rstdy = 1.0f / sqrtf(wave_sum(sumsq4(y)) * (1.0f / D) + EPS);
#pragma unroll
        for (int j = 0; j < 4; ++j) xv[j] = xv[j] + ga[j] * (y[j] * rstdy * gp[j]) * (((DBG_SKIP >> (2 * L)) & 1) ? 0.f : 1.f);
        if (ABL == 0 || rstdy == 123.456f) { if (m < NLAT) st_row_bf16(XS + (size_t)m * D, lane, xv); else st_row_f32(XC + (size_t)(m - NLAT) * D, lane, xv); }
        const float rstd1 = 1.0f / sqrtf(wave_sum(sumsq4(xv)) * (1.0f / D) + EPS);
#pragma unroll
        for (int j = 0; j < 4; ++j) xv[j] = xv[j] * rstd1 * gs[j] + sh[j];
        if (ABL == 0 || rstd1 == 123.456f) st_row_fp8(TOK + (size_t)m * D, lane, xv);
        if (ABL == 2) { if (rstd1 == 123.456f) *(LAS float*)(F.lds + REC_OFF + rl * 16) = xv[0][0]; continue; }
        f32x2 a2[8];
#pragma unroll
        for (int e = 0; e < 8; ++e) a2[e] = (f32x2){0.f, 0.f};
#pragma unroll
        for (int j = 0; j < 4; ++j)
#pragma unroll
            for (int i = 0; i < 4; ++i) { const float tv = xv[j][i]; const f32x2 tv2 = (f32x2){tv, tv}; const LAS f32x4* wp = (const LAS f32x4*)(F.lds + RW_OFF + (64 * j + lane) * 272 + i * 64);
#pragma unroll
                for (int ep = 0; ep < 4; ++ep) { const f32x4 wv = wp[ep];
                    a2[2 * ep] = __builtin_elementwise_fma((f32x2){wv[0], wv[1]}, tv2, a2[2 * ep]); a2[2 * ep + 1] = __builtin_elementwise_fma((f32x2){wv[2], wv[3]}, tv2, a2[2 * ep + 1]); } }
        float k8[8], k4[4];
#pragma unroll
        for (int i = 0; i < 8; ++i) { const float alo = a2[i >> 1][i & 1], ahi = a2[4 + (i >> 1)][i & 1];
            const auto rr = __builtin_amdgcn_permlane32_swap(__builtin_bit_cast(unsigned, alo), __builtin_bit_cast(unsigned, ahi), false, false);
            const unsigned r0_ = rr[0], r1_ = rr[1]; k8[i] = __uint_as_float(r0_) + __uint_as_float(r1_); }
#pragma unroll
        for (int i = 0; i < 4; ++i) { const auto rr = __builtin_amdgcn_permlane16_swap(__builtin_bit_cast(unsigned, k8[i]), __builtin_bit_cast(unsigned, k8[4 + i]), false, false);
            const unsigned r0_ = rr[0], r1_ = rr[1]; k4[i] = row16_sum(__uint_as_float(r0_) + __uint_as_float(r1_)); }
        const float lgsel = (lane & 2) ? ((lane & 1) ? k4[3] : k4[2]) : ((lane & 1) ? k4[1] : k4[0]);
        const float sgl = 1.0f / (1.0f + __expf(-lgsel));
        const float vsel = sgl + rbl;
        const int qi_ = lane & 3;
        const float x1 = __builtin_bit_cast(float, __builtin_amdgcn_update_dpp(0, __builtin_bit_cast(int, vsel), 0x39, 0xF, 0xF, false));
        const float x2 = __builtin_bit_cast(float, __builtin_amdgcn_update_dpp(0, __builtin_bit_cast(int, vsel), 0x4E, 0xF, 0xF, false));
        const float x3 = __builtin_bit_cast(float, __builtin_amdgcn_update_dpp(0, __builtin_bit_cast(int, vsel), 0x93, 0xF, 0xF, false));
        const int j1 = (qi_ + 1) & 3, j2 = (qi_ + 2) & 3, j3 = (qi_ + 3) & 3;
        const int cnt = ((x1 > vsel) || (x1 == vsel && j1 < qi_) ? 1 : 0) + ((x2 > vsel) || (x2 == vsel && j2 < qi_) ? 1 : 0) + ((x3 > vsel) || (x3 == vsel && j3 < qi_) ? 1 : 0);
        float gsq = (cnt < 2) ? vsel : 0.f;
        gsq += __builtin_bit_cast(float, __builtin_amdgcn_update_dpp(0, __builtin_bit_cast(int, gsq), 0xB1, 0xF, 0xF, false));
        gsq += __builtin_bit_cast(float, __builtin_amdgcn_update_dpp(0, __builtin_bit_cast(int, gsq), 0x4E, 0xF, 0xF, false));
        const float g0 = rdlane(gsq, 0), g1 = rdlane(gsq, 16), g2 = rdlane(gsq, 32), g3 = rdlane(gsq, 48);
        int gst = 0; float gm = g0;
        if (g1 > gm) { gm = g1; gst = 1; }
        if (g2 > gm) { gm = g2; gst = 2; }
        if (g3 > gm) { gm = g3; gst = 3; }
        const bool mine = (lane >> 2) == 4 * gst;
        const unsigned long long b0 = __builtin_amdgcn_ballot_w64(mine && cnt == 0), b1 = __builtin_amdgcn_ballot_w64(mine && cnt == 1);
        const int l0 = __builtin_ctzll(b0), l1 = __builtin_ctzll(b1);
        const int e0 = 4 * gst + (l0 & 3), e1 = 4 * gst + (l1 & 3);
        float w0 = rdlane(sgl, l0), w1 = rdlane(sgl, l1);
        const float inv = 1.0f / (w0 + w1); w0 *= inv; w1 *= inv;
        if (lane == 0) *(LAS v4u*)(F.lds + REC_OFF + rl * 16) = (v4u){(unsigned)e0, (unsigned)e1, __builtin_bit_cast(unsigned, w0), __builtin_bit_cast(unsigned, w1)};
    }
    __syncthreads();
    if (ABL != 0) return;
    if (F.wave == 0 && lane < 16) {
        int cntl = 0;
        for (int rl = 0; rl < RPB; ++rl) { const v4u rec = *(const LAS v4u*)(F.lds + REC_OFF + rl * 16);
            if ((int)rec.x == lane) { *(LAS int*)(F.lds + LRK_OFF + rl * 8) = cntl; ++cntl; }
            if ((int)rec.y == lane) { *(LAS int*)(F.lds + LRK_OFF + rl * 8 + 4) = cntl; ++cntl; } }
        const unsigned base = __hip_atomic_fetch_add((unsigned*)(F.ctl + CW_CNT + (L * 16 + lane) * 64), (unsigned)cntl, RLX_AGENT);
        *(LAS int*)(F.lds + BASE_OFF + lane * 4) = (int)base;
    }
    __syncthreads();
    int* perm2 = (int*)(F.ws + WS_PERM); v2u* slot = (v2u*)(F.ws + WS_SLOT);
    for (int idx = tid; idx < RPB * 2; idx += NTHR) { const int rl = idx >> 1, k = idx & 1; const v4u rec = *(const LAS v4u*)(F.lds + REC_OFF + rl * 16);
        const int e = k ? (int)rec.y : (int)rec.x; const unsigned wb = k ? rec.w : rec.z;
        const int rank = *(const LAS int*)(F.lds + BASE_OFF + e * 4) + *(const LAS int*)(F.lds + LRK_OFF + rl * 8 + k * 4);
        const int m = m0 + rl;
        perm2[(size_t)e * MT + rank] = m;
        slot[(size_t)m * 2 + k] = (v2u){((unsigned)e << 24) | (unsigned)rank, wb}; }
    __syncthreads();
}

__device__ __forceinline__ void moe_setup(const Frame& F, int L) {
    const int tid = F.tid();
    if (tid < 16) F.MISC[40 + tid] = __hip_atomic_load((unsigned*)(F.ctl + CW_CNT + (L * 16 + tid) * 64), RLX_AGENT);
    __syncthreads();
    if (tid == 0) { unsigned p = 0; for (int e = 0; e < 16; ++e) { F.MISC[16 + e] = p; p += (F.MISC[40 + e] + 255u) >> 8; } F.MISC[32] = p; }
    __syncthreads();
}
__device__ __forceinline__ void moe_stage_perm(const Frame& F) {
    const int* perm2 = (const int*)(F.ws + WS_PERM); LAS int* permL = (LAS int*)(F.lds + PERML_OFF);
    const int ntile = (int)F.MISC[32], tid = F.tid();
    for (int i = 0; i < 8; ++i) { const int Lu = i * F.G + F.bid; if (Lu >= 4 * ntile) break;
        const int rt = Lu >> 2; int e = 0;
        for (int j = 1; j < 16; ++j) e += (rt >= (int)F.MISC[16 + j]) ? 1 : 0;
        if (tid < 256) { const int rank = (rt - (int)F.MISC[16 + e]) * 256 + tid; permL[i * 256 + tid] = (rank < (int)F.MISC[40 + e]) ? perm2[(size_t)e * MT + rank] : 0; } }
    __syncthreads();
}

template <int L>
__device__ __forceinline__ void p_epost(const Frame& F) {
    constexpr int NROWS = (L == 0) ? MT : NLAT, RPB = NROWS / 256;
    const unsigned char* FB = (const unsigned char*)(F.ws + WS_D2); unsigned char* H = (unsigned char*)(F.ws + WS_A);
    float* XC = (float*)(F.ws + WS_XC); const v2u* slot = (const v2u*)(F.ws + WS_SLOT);
    const int lane = F.lane(), m0 = F.bid * RPB;
    int rc = -1; f32x4 ga[4], gp[4], gs[4], sh[4];
    v4u sl_n2 = (v4u){0u, 0u, 0u, 0u}; unsigned f0n[4], f1n[4]; v2u xbn[4]; f32x4 xn[4]; float w0n, w1n;
    bf16* XS = (bf16*)(F.ws + WS_B);
#define EP_ISSUE(mm, slv) do { const unsigned sx0 = __builtin_amdgcn_readfirstlane((slv).x), sy0 = __builtin_amdgcn_readfirstlane((slv).y), sx1 = __builtin_amdgcn_readfirstlane((slv).z), sy1 = __builtin_amdgcn_readfirstlane((slv).w); \
        const size_t v0_ = (size_t)F.MISC[16 + (sx0 >> 24)] * 256 + (sx0 & 0xffffffu), v1_ = (size_t)F.MISC[16 + (sx1 >> 24)] * 256 + (sx1 & 0xffffffu); \
        w0n = __uint_as_float(sy0); w1n = __uint_as_float(sy1); ld_raw_fp8(FB + v0_ * D, lane, f0n); ld_raw_fp8(FB + v1_ * D, lane, f1n); \
        if ((mm) < NLAT) ld_raw_bf16(XS + (size_t)(mm) * D, lane, xbn); else ld_row_f32(XC + (size_t)((mm) - NLAT) * D, lane, xn); } while (0)
    { const int m = m0 + F.wave; const v4u sl0 = *(const v4u*)(slot + (size_t)m * 2);
      if (F.wave + NWAVES < RPB) sl_n2 = *(const v4u*)(slot + (size_t)(m + NWAVES) * 2);
      EP_ISSUE(m, sl0); }
    for (int rl = F.wave; rl < RPB; rl += NWAVES) {
        const int m = m0 + rl, r = row_batch(m);
        f32x4 f0[4], f1[4], xv[4]; const float w0 = w0n, w1 = w1n;
        unpack_fp8(f0n, f0); unpack_fp8(f1n, f1);
        if (m < NLAT) unpack_bf16(xbn, xv); else {
#pragma unroll
            for (int j = 0; j < 4; ++j) xv[j] = xn[j]; }
        if (rl + NWAVES < RPB) { const v4u slc = sl_n2; if (rl + 2 * NWAVES < RPB) sl_n2 = *(const v4u*)(slot + (size_t)(m + 2 * NWAVES) * 2); EP_ISSUE(m + NWAVES, slc); }
        if (r != rc) { ld_mod(F, L, r, 5, ga); ld_row_f32(F.in(9) + L * D, lane, gp);
            if (L == 0) { f32x4 g[4], sc[4]; ld_row_f32(F.in(6) + D, lane, g); ld_mod(F, 1, r, 1, sc); ld_mod(F, 1, r, 0, sh);
#pragma unroll
                for (int j = 0; j < 4; ++j) gs[j] = g[j] * (sc[j] + 1.0f); }
            rc = r; }
#pragma unroll
        for (int j = 0; j < 4; ++j) f0[j] = (DBG_SLOT == 1) ? f0[j] : (DBG_SLOT == 2) ? f1[j] : (DBG_SLOT == 3) ? f0[j] * 0.5f + f1[j] * 0.5f : f0[j] * w0 + f1[j] * w1;
        const float rstdf = 1.0f / sqrtf(wave_sum(sumsq4(f0)) * (1.0f / D) + EPS);
#pragma unroll
        for (int j = 0; j < 4; ++j) xv[j] = xv[j] + ga[j] * (f0[j] * rstdf * gp[j]) * (((DBG_SKIP >> (2 * L + 1)) & 1) ? 0.f : 1.f);
        if (L == 1) st_row_f32(F.out + (size_t)m * D, lane, xv);
        else if (m < NLAT) st_row_bf16(XS + (size_t)m * D, lane, xv); else st_row_f32(XC + (size_t)(m - NLAT) * D, lane, xv);
        if (L == 0) {
            const float rstd2 = 1.0f / sqrtf(wave_sum(sumsq4(xv)) * (1.0f / D) + EPS);
#pragma unroll
            for (int j = 0; j < 4; ++j) xv[j] = xv[j] * rstd2 * gs[j] + sh[j];
            st_row_fp8(H + (size_t)m * D, lane, xv);
        }
    }
#undef EP_ISSUE
}

constexpr int AT_CK = 0, AT_CV = 32768, AT_RPB = 65536;
constexpr float LOG2E = 1.4426950408889634f;
__device__ __forceinline__ float xrow_max(float m) {
    { const auto rr = __builtin_amdgcn_permlane16_swap(__builtin_bit_cast(unsigned, m), __builtin_bit_cast(unsigned, m), false, false); const unsigned a_ = rr[0], b_ = rr[1]; m = fmaxf(__uint_as_float(a_), __uint_as_float(b_)); }
    { const auto rr = __builtin_amdgcn_permlane32_swap(__builtin_bit_cast(unsigned, m), __builtin_bit_cast(unsigned, m), false, false); const unsigned a_ = rr[0], b_ = rr[1]; m = fmaxf(__uint_as_float(a_), __uint_as_float(b_)); }
    return m;
}
__device__ __forceinline__ float xrow_sum(float m) {
    { const auto rr = __builtin_amdgcn_permlane16_swap(__builtin_bit_cast(unsigned, m), __builtin_bit_cast(unsigned, m), false, false); const unsigned a_ = rr[0], b_ = rr[1]; m = __uint_as_float(a_) + __uint_as_float(b_); }
    { const auto rr = __builtin_amdgcn_permlane32_swap(__builtin_bit_cast(unsigned, m), __builtin_bit_cast(unsigned, m), false, false); const unsigned a_ = rr[0], b_ = rr[1]; m = __uint_as_float(a_) + __uint_as_float(b_); }
    return m;
}
__device__ __forceinline__ void attn_softmax(f32x4 (&s)[4], float& mrun, f32x4& osum, f32x4 (&o)[4], bf16x8 (&pf)[2]) {
    float mx = mrun;
#pragma unroll
    for (int t = 0; t < 4; ++t) mx = fmaxf(fmaxf(mx, fmaxf(s[t][0], s[t][1])), fmaxf(s[t][2], s[t][3]));
    mx = xrow_max(mx);
    if (__builtin_amdgcn_ballot_w64(mx > mrun) != 0ull) {
        const float alpha = __builtin_amdgcn_exp2f(mrun - mx);
        mrun = mx; osum = osum * alpha;
#pragma unroll
        for (int db = 0; db < 4; ++db) o[db] = o[db] * alpha;
    }
#pragma unroll
    for (int t = 0; t < 4; ++t)
#pragma unroll
        for (int i = 0; i < 4; ++i) s[t][i] = __builtin_amdgcn_exp2f(s[t][i] - mx);
#pragma unroll
    for (int bb = 0; bb < 2; ++bb) { v4u pw; pw.x = pg8::cvt_pk_bf16(s[2 * bb][0], s[2 * bb][1]); pw.y = pg8::cvt_pk_bf16(s[2 * bb][2], s[2 * bb][3]);
        pw.z = pg8::cvt_pk_bf16(s[2 * bb + 1][0], s[2 * bb + 1][1]); pw.w = pg8::cvt_pk_bf16(s[2 * bb + 1][2], s[2 * bb + 1][3]); pf[bb] = __builtin_bit_cast(bf16x8, pw); }
}
struct AttnStream { float m; f32x4 osum; f32x4 o[4]; bf16x8 q0, q1; };
__device__ __forceinline__ void attn_block(AttnStream& T, const bf16x8 (&kf)[2][2], const bf16x8 (&vf)[4], const f32x4 (&cinit)[2], const bf16x8 ones) {
    f32x4 s[2];
#pragma unroll
    for (int tl = 0; tl < 2; ++tl) { s[tl] = __builtin_amdgcn_mfma_f32_16x16x32_bf16(kf[tl][0], T.q0, cinit[tl], 0, 0, 0); s[tl] = __builtin_amdgcn_mfma_f32_16x16x32_bf16(kf[tl][1], T.q1, s[tl], 0, 0, 0); }
    float mx = fmaxf(fmaxf(T.m, fmaxf(s[0][0], s[0][1])), fmaxf(s[0][2], s[0][3]));
    mx = fmaxf(fmaxf(mx, fmaxf(s[1][0], s[1][1])), fmaxf(s[1][2], s[1][3]));
    mx = xrow_max(mx);
    if (__builtin_amdgcn_ballot_w64(mx > T.m) != 0ull) {
        const float alpha = __builtin_amdgcn_exp2f(T.m - mx);
        T.m = mx; T.osum = T.osum * alpha;
#pragma unroll
        for (int db = 0; db < 4; ++db) T.o[db] = T.o[db] * alpha;
    }
#pragma unroll
    for (int tl = 0; tl < 2; ++tl)
#pragma unroll
        for (int i = 0; i < 4; ++i) s[tl][i] = __builtin_amdgcn_exp2f(s[tl][i] - mx);
    v4u pw; pw.x = pg8::cvt_pk_bf16(s[0][0], s[0][1]); pw.y = pg8::cvt_pk_bf16(s[0][2], s[0][3]); pw.z = pg8::cvt_pk_bf16(s[1][0], s[1][1]); pw.w = pg8::cvt_pk_bf16(s[1][2], s[1][3]);
    const bf16x8 pf = __builtin_bit_cast(bf16x8, pw);
    T.osum = __builtin_amdgcn_mfma_f32_16x16x32_bf16(ones, pf, T.osum, 0, 0, 0);
#pragma unroll
    for (int db = 0; db < 4; ++db) T.o[db] = __builtin_amdgcn_mfma_f32_16x16x32_bf16(vf[db], pf, T.o[db], 0, 0, 0);
}
template <int ABL  >
__device__ __forceinline__ void p10_attn(const Frame& F) {
    const bf16* Qh = (const bf16*)F.out; const bf16* Kh = (const bf16*)(F.ws + WS_C); const bf16* Vb = (const bf16*)(F.ws + WS_D2); unsigned char* O = (unsigned char*)(F.ws + WS_A);
    const int lane = F.lane(), tid = F.wave * 64 + lane, qi = lane & 15, q4 = lane >> 4;
    const int bh = F.bid >> 1, h = bh & 15, b = bh >> 4, rbase = (F.bid & 1) * 32;
    const bf16* Kbh = Kh + (size_t)bh * KSLOT * HD; const bf16* Vbh = Vb + (size_t)bh * (KSLOT / 8) * 512;
#pragma unroll
    for (int i = 0; i < 4; ++i) { const int kf = F.wave * 4 + i, blk = kf >> 2, tl = (kf >> 1) & 1, dh = kf & 1;
        const v4u kv = *(const v4u*)(Kbh + (size_t)(SEQ + 32 * blk + 8 * (qi >> 2) + 4 * tl + (qi & 3)) * HD + dh * 32 + 8 * q4);
        const int vblk = kf >> 2, db = kf & 3;
        const v4u vv = *(const v4u*)(Vbh + (size_t)(SEQ / 8 + 4 * vblk + q4) * 512 + (db * 16 + qi) * 8);
        *(LAS v4u*)(F.lds + AT_CK + kf * 1024 + lane * 16) = kv; *(LAS v4u*)(F.lds + AT_CV + kf * 1024 + lane * 16) = vv; }
    { const float* rpbG = F.in(20) + h * 465; LAS float* rpbW = (LAS float*)(F.lds + AT_RPB);
        for (int idx = tid; idx < 15 * 32; idx += NTHR) { const int ri = idx >> 5, ci = idx & 31; rpbW[idx] = (ci < 31) ? rpbG[ri * 31 + ci] * LOG2E : -1.0e30f; } }
    __syncthreads();
    const int seg = F.wave & 3;
    const int cb = (seg == 0) ? 0 : (seg == 1) ? 8 : (seg == 2) ? 24 : 32;
    const int qc = 16 * seg + qi, cs = min(max(qc - WINW / 2, 0), GRIDW - WINW);
    int coff[2][4];
#pragma unroll
    for (int tl = 0; tl < 2; ++tl)
#pragma unroll
        for (int i = 0; i < 4; ++i) { const int kc = cb + 8 * q4 + 4 * tl + i; const bool ok = (kc >= cs) && (kc < cs + WINW); coff[tl][i] = AT_RPB + 4 * (ok ? (kc - qc + (WINW - 1)) : 31); }
    const bf16x8 ones = __builtin_bit_cast(bf16x8, (v4u){0x3f803f80u, 0x3f803f80u, 0x3f803f80u, 0x3f803f80u});
    const f32x4 zero2[2] = {(f32x4){0.f, 0.f, 0.f, 0.f}, (f32x4){0.f, 0.f, 0.f, 0.f}};
    for (int it = 0; it < 8; ++it) {
        const int rA = rbase + 2 * ((F.wave >> 2) + 2 * it), rB = rA + 1;
        const int r0A = min(max(rA - WINH / 2, 0), GROWS - WINH), r0B = min(max(rB - WINH / 2, 0), GROWS - WINH), dlt = r0B - r0A;
        AttnStream TA, TB;
        { const bf16* Qp = Qh + ((size_t)bh * SEQ + rA * GRIDW + qc) * HD; TA.q0 = *(const bf16x8*)(Qp + 8 * q4); TA.q1 = *(const bf16x8*)(Qp + 32 + 8 * q4);
          TB.q0 = *(const bf16x8*)(Qp + GRIDW * HD + 8 * q4); TB.q1 = *(const bf16x8*)(Qp + GRIDW * HD + 32 + 8 * q4); }
        TA.m = -1.0e30f; TB.m = -1.0e30f; TA.osum = zero2[0]; TB.osum = zero2[0];
#pragma unroll
        for (int db = 0; db < 4; ++db) { TA.o[db] = zero2[0]; TB.o[db] = zero2[0]; }
        const bf16* kp0 = Kbh + (size_t)(r0A * GRIDW + cb + 8 * (qi >> 2) + (qi & 3)) * HD + 8 * q4;
        const bf16* vp0 = Vbh + (size_t)((r0A * GRIDW + cb) / 8 + q4) * 512 + qi * 8;
        int boA[2][4], boB[2][4];
#pragma unroll
        for (int tl = 0; tl < 2; ++tl)
#pragma unroll
            for (int i = 0; i < 4; ++i) { boA[tl][i] = coff[tl][i] + (r0A - rA + (WINH - 1)) * 128; boB[tl][i] = coff[tl][i] + (r0A - rB + (WINH - 1)) * 128; }
        bf16x8 kw[2][2][2], vw[2][4];
#define AT_LOADW(u) do { const int bf_ = (u) & 1; _Pragma("unroll") for (int tl = 0; tl < 2; ++tl) { \
            kw[bf_][tl][0] = (ABL & 1) ? TA.q0 : *(const bf16x8*)(kp0 + (size_t)((u) * GRIDW + 4 * tl) * HD); kw[bf_][tl][1] = (ABL & 1) ? TA.q1 : *(const bf16x8*)(kp0 + (size_t)((u) * GRIDW + 4 * tl) * HD + 32); } \
            _Pragma("unroll") for (int db = 0; db < 4; ++db) vw[bf_][db] = (ABL & 1) ? TA.q0 : *(const bf16x8*)(vp0 + (size_t)((u) * (GRIDW / 8)) * 512 + db * 128); } while (0)
        AT_LOADW(0);
        __builtin_amdgcn_sched_barrier(0);
#pragma unroll
        for (int u = 0; u < 9; ++u) {
            if (u < 8) { if (u < 7 || dlt) AT_LOADW(u + 1); }
            __builtin_amdgcn_sched_barrier(0);
            if (u < 8) {
                bf16x8 kc[2][2], vc[4];
#pragma unroll
                for (int tl = 0; tl < 2; ++tl) { kc[tl][0] = (ABL & 2) ? TA.q1 : *(const LAS bf16x8*)(F.lds + AT_CK + ((u * 2 + tl) * 2 + 0) * 1024 + lane * 16); kc[tl][1] = (ABL & 2) ? TA.q0 : *(const LAS bf16x8*)(F.lds + AT_CK + ((u * 2 + tl) * 2 + 1) * 1024 + lane * 16); }
#pragma unroll
                for (int db = 0; db < 4; ++db) vc[db] = (ABL & 2) ? TA.q1 : *(const LAS bf16x8*)(F.lds + AT_CV + (u * 4 + db) * 1024 + lane * 16);
                attn_block(TA, kc, vc, zero2, ones); attn_block(TB, kc, vc, zero2, ones);
            }
            __builtin_amdgcn_sched_barrier(0);
            if (u < 8 || dlt) {
                if (u < 8) { f32x4 ci[2];
#pragma unroll
                    for (int tl = 0; tl < 2; ++tl)
#pragma unroll
                        for (int i = 0; i < 4; ++i) ci[tl][i] = *(const LAS float*)(F.lds + boA[tl][i] + u * 128);
                    attn_block(TA, kw[u & 1], vw[u & 1], ci, ones); }
                if (u >= 1 || dlt == 0) { f32x4 ci[2];
#pragma unroll
                    for (int tl = 0; tl < 2; ++tl)
#pragma unroll
                        for (int i = 0; i < 4; ++i) ci[tl][i] = *(const LAS float*)(F.lds + boB[tl][i] + u * 128);
                    attn_block(TB, kw[u & 1], vw[u & 1], ci, ones); }
            }
            __builtin_amdgcn_sched_barrier(0);
        }
#undef AT_LOADW
        {   const float inv = 1.0f / TA.osum[0];
            unsigned char* op = O + ((size_t)b * SEQ + rA * GRIDW + qc) * D + h * HD + 4 * q4;
#pragma unroll
            for (int db = 0; db < 4; ++db) { const unsigned w = pk4_fp8(TA.o[db][0] * inv, TA.o[db][1] * inv, TA.o[db][2] * inv, TA.o[db][3] * inv); if (ABL == 0 || w == 0x12345u) *(unsigned*)(op + db * 16) = w; } }
        {   const float inv = 1.0f / TB.osum[0];
            unsigned char* op = O + ((size_t)b * SEQ + rB * GRIDW + qc) * D + h * HD + 4 * q4;
#pragma unroll
            for (int db = 0; db < 4; ++db) { const unsigned w = pk4_fp8(TB.o[db][0] * inv, TB.o[db][1] * inv, TB.o[db][2] * inv, TB.o[db][3] * inv); if (ABL == 0 || w == 0x12345u) *(unsigned*)(op + db * 16) = w; } }
    }
    __syncthreads();
}

#ifndef MK_N_LAUNCHES
#define MK_N_LAUNCHES 1
#endif
constexpr int N_PHASES = 16;
constexpr int N_LAUNCHES = MK_N_LAUNCHES;
struct Args { const float* in[26]; float* out; unsigned char* ws; int ph_lo, ph_hi; };

__global__ void __launch_bounds__(NTHR, 2) fwd_kernel(Args args) {
    extern __shared__ __attribute__((aligned(16))) unsigned char lds[];
    Frame F;
    F.lds = (LAS unsigned char*)lds;
    F.MISC = (volatile LAS unsigned*)(F.lds + MISC_OFF);
    F.wave = __builtin_amdgcn_readfirstlane((int)threadIdx.x >> 6);
    F.G = gridDim.x; F.bid = blockIdx.x;
    F.ws = args.ws; F.ctl = (gu32*)(args.ws + WS_CTL); F.out = args.out;
    for (int u = threadIdx.x; u < 256; u += NTHR) F.MISC[u] = 0u;
    if (threadIdx.x < 26) { const unsigned long long pv = (unsigned long long)args.in[threadIdx.x]; volatile LAS unsigned* t = (volatile LAS unsigned*)(F.lds + PTAB_OFF) + 2 * threadIdx.x; t[0] = (unsigned)pv; t[1] = (unsigned)(pv >> 32); }
    __syncthreads();
    XcdBarrier bar; bar.bar = (unsigned*)(F.ctl + CW_BAR); bar.x = 0; bar.st = nullptr;
    if (N_LAUNCHES == 1) bar = xcd_barrier_post((unsigned*)(F.ctl + CW_BAR), F.MISC + 8);
    const int lo = args.ph_lo, hi = args.ph_hi;
#ifndef PHASE_MASK
#define PHASE_MASK 0xFFFF
#endif
#define IN(k) ((((PHASE_MASK) >> (k)) & 1) && lo <= (k) && (k) < hi)
#define SEAM(k) do { if (IN(k) && IN((k) + 1)) { xcd_barrier(bar); if (PROBE_MASK == 0x10000) xcd_barrier(bar); } } while (0)
    const char* wsb = (const char*)F.ws;
    LAS unsigned char* ring = F.lds;

    if (IN(0)) { _Pragma("unroll") for (int rep = 0; rep < REP(0); ++rep) { p0_prologue(F); __syncthreads(); } }
    SEAM(0);
    if (IN(1)) { _Pragma("unroll") for (int rep = 0; rep < REP(1); ++rep) p1_modulate(F); }
    SEAM(1);
    if (IN(2)) {
        pg8::DenseSched S{wsb + WS_A, wsb + WS_WIN, D / 2, MT / 256, 8, F.G, F.bid};
        pg8::EpiGated<0> E{(bf16*)(F.ws + WS_B), D, F.in(11), D};
        _Pragma("unroll") for (int rep = 0; rep < REP(2); ++rep) pg8::gemm_phase<pg8::EpiGated<0>, pg8::DenseSched, true, true>(ring, D / 2, S, E, F.wave);
        filler(F, 0, 3600);
    }
    SEAM(2);
    if (IN(3)) { _Pragma("unroll") for (int rep = 0; rep < REP(3); ++rep) p3_conv(F); }
    SEAM(3);
    if (IN(4)) {
        pg8::DenseSched S{wsb + WS_A, wsb + WS_WOUT, D / 2, MT / 256, 4, F.G, F.bid};
        pg8::EpiBf16B E{(bf16*)(F.ws + WS_B), D, F.in(17)};
        _Pragma("unroll") for (int rep = 0; rep < REP(4); ++rep) pg8::gemm_phase<pg8::EpiBf16B, pg8::DenseSched, true, true>(ring, D / 2, S, E, F.wave);
        filler(F, 0, JOB_ITEMS);
    }
    SEAM(4);
#ifndef EMID_ABL
#define EMID_ABL 1
#endif
    if (IN(5)) { filler(F, 0, JOB_ITEMS); if (REP(5) == 2) { p_emid<0, EMID_ABL>(F); __syncthreads(); } p_emid<0>(F); }
    SEAM(5);
    if (IN(6)) {
        moe_setup(F, 0); moe_stage_perm(F);
        pg8::MoeUpSched S; S.tpre = (const volatile LAS int*)(F.MISC + 16); S.G = F.G; S.c = F.bid; S.A = wsb + WS_A; S.Wgu = wsb + WS_WGU + (size_t)0 * 16 * 1024 * 1024; S.permL = (const LAS int*)(F.lds + PERML_OFF); S.kb = D;
        pg8::EpiGated<1, true> E{(bf16*)(F.ws + WS_C), DE, nullptr, 0};
        _Pragma("unroll") for (int rep = 0; rep < REP(6); ++rep) pg8::gemm_phase<pg8::EpiGated<1, true>, pg8::MoeUpSched, true, true>(ring, D / 2, S, E, F.wave);
        filler(F, 1, 3000);
    }
    SEAM(6);
    if (IN(7)) {
        moe_setup(F, 0);
        pg8::MoeDownSched S; S.tpre = (const volatile LAS int*)(F.MISC + 16); S.G = F.G; S.c = F.bid; S.A = wsb + WS_C; S.Wdn = wsb + WS_WDN + (size_t)0 * 16 * 1024 * 512; S.kb = DE;
        pg8::EpiF8 E{(unsigned char*)(F.ws + WS_D2), D};
        _Pragma("unroll") for (int rep = 0; rep < REP(7); ++rep) pg8::gemm_phase<pg8::EpiF8, pg8::MoeDownSched, true, true>(ring, DE / 2, S, E, F.wave);
        filler(F, 1, 4500);
    }
    SEAM(7);
    if (IN(8)) { moe_setup(F, 0); p_epost<0>(F); }
    SEAM(8);
    if (IN(9)) {
        pg8::QkvSched S{wsb + WS_A, wsb + WS_WQKV, F.G, F.bid, D};
        pg8::EpiQkv E{(bf16*)F.out, (bf16*)(F.ws + WS_C), (bf16*)(F.ws + WS_D2), 0.125f * 1.4426950408889634f};
        _Pragma("unroll") for (int rep = 0; rep < REP(9); ++rep) pg8::gemm_phase<pg8::EpiQkv, pg8::QkvSched, true, true>(ring, D / 2, S, E, F.wave);
        filler(F, 1, 8100);
    }
    SEAM(9);
#ifndef ATT_ABL
#define ATT_ABL 0
#endif
    if (IN(10)) { if (REP(10) == 2) p10_attn<ATT_ABL>(F); p10_attn<0>(F); }
    SEAM(10);
    if (IN(11)) {
        pg8::DenseSched S{wsb + WS_A, wsb + WS_WO, D / 2, NLAT / 256, 4, F.G, F.bid};
        pg8::EpiBf16 E{(bf16*)(F.ws + WS_C), D, nullptr};
        _Pragma("unroll") for (int rep = 0; rep < REP(11); ++rep) pg8::gemm_phase<pg8::EpiBf16, pg8::DenseSched, true, true>(ring, D / 2, S, E, F.wave);
    }
    SEAM(11);
    if (IN(12)) { filler(F, 1, JOB_ITEMS); p_emid<1>(F); }
    SEAM(12);
    if (IN(13)) {
        moe_setup(F, 1); moe_stage_perm(F);
        pg8::MoeUpSched S; S.tpre = (const volatile LAS int*)(F.MISC + 16); S.G = F.G; S.c = F.bid; S.A = wsb + WS_A; S.Wgu = wsb + WS_WGU + (size_t)1 * 16 * 1024 * 1024; S.permL = (const LAS int*)(F.lds + PERML_OFF); S.kb = D;
        pg8::EpiGated<1, true> E{(bf16*)(F.ws + WS_C), DE, nullptr, 0};
        _Pragma("unroll") for (int rep = 0; rep < REP(13); ++rep) pg8::gemm_phase<pg8::EpiGated<1, true>, pg8::MoeUpSched, true, true>(ring, D / 2, S, E, F.wave);
    }
    SEAM(13);
    if (IN(14)) {
        moe_setup(F, 1);
        pg8::MoeDownSched S; S.tpre = (const volatile LAS int*)(F.MISC + 16); S.G = F.G; S.c = F.bid; S.A = wsb + WS_C; S.Wdn = wsb + WS_WDN + (size_t)1 * 16 * 1024 * 512; S.kb = DE;
        pg8::EpiF8 E{(unsigned char*)(F.ws + WS_D2), D};
        _Pragma("unroll") for (int rep = 0; rep < REP(14); ++rep) pg8::gemm_phase<pg8::EpiF8, pg8::MoeDownSched, true, true>(ring, DE / 2, S, E, F.wave);
    }
    SEAM(14);
    if (IN(15)) { moe_setup(F, 1); _Pragma("unroll") for (int rep = 0; rep < REP(15); ++rep) p_epost<1>(F); }
#undef IN
#undef SEAM
}

extern "C" void kernel_launch(void* const* d_in, const int* in_sizes, int n_in, void* d_out, int out_size, void* d_ws, size_t ws_size, hipStream_t stream) {
    static int grid = 0;
    if (grid == 0) {
        if (n_in != 26 || in_sizes[0] != NLAT * D || out_size != NLAT * D || ws_size < WS_END) { fprintf(stderr, "kernel_launch: unexpected shapes (n_in %d, in0 %d, out %d, ws %zu); nothing launched\n", n_in, n_in > 0 ? in_sizes[0] : -1, out_size, ws_size); grid = -1; return; }
        if (hipFuncSetAttribute((const void*)fwd_kernel, hipFuncAttributeMaxDynamicSharedMemorySize, LDS_BYTES) != hipSuccess) { fprintf(stderr, "kernel_launch: hipFuncSetAttribute failed\n"); grid = -1; return; }
        int per_cu = 0;
        if (hipOccupancyMaxActiveBlocksPerMultiprocessor(&per_cu, (const void*)fwd_kernel, NTHR, LDS_BYTES) != hipSuccess || per_cu < 1) fprintf(stderr, "kernel_launch: note: occupancy query reports %d workgroups per CU\n", per_cu);
        (void)hipGetLastError();
        grid = 256;
    }
    if (grid < 0) return;
    if (hipMemsetAsync((char*)d_ws + WS_CTL, 0, CTL_ZERO_BYTES, stream) != hipSuccess) { fprintf(stderr, "kernel_launch: hipMemsetAsync failed\n"); return; }
    Args a{};
    for (int i = 0; i < 26; ++i) a.in[i] = (const float*)d_in[i];
    a.out = (float*)d_out; a.ws = (unsigned char*)d_ws;
    for (int li = 0; li < N_LAUNCHES; ++li) {
        a.ph_lo = (N_LAUNCHES == 1) ? 0 : li; a.ph_hi = (N_LAUNCHES == 1) ? N_PHASES : li + 1;
        hipLaunchKernelGGL(fwd_kernel, dim3(grid), dim3(NTHR), LDS_BYTES, stream, a);
        const hipError_t le = hipPeekAtLastError();
        if (le != hipSuccess) { fprintf(stderr, "kernel_launch: launch %d failed: %s\n", li, hipGetErrorName(le)); break; }
    }
}
```
